# Optimizing an MI355X kernel written in HIP

```python
import jax, jax.numpy as jnp
from jax import lax
import numpy as np

D_MODEL = 2048
BATCH = 16
SEQ = 256
DEPTH = 4
DEC_BATCH = 8
DEC_SEQ = 1024
PAST_LEN = 256

GRID_W = 64
N_AB = (DEPTH + 1) // 2
N_POOL = DEPTH // 2
C_A = D_MODEL // 2
HEAD_A = 64
H_A = C_A // HEAD_A
DECAY_LORA = 64
ICLR_LORA = 64
GATE_LORA = 160
C_B = D_MODEL // 2
HEAD_B = 128
H_B = C_B // HEAD_B
CONV_W = 3
CHUNK = 64
C_PA = 3 * C_A + 2 * DECAY_LORA + 2 * ICLR_LORA + GATE_LORA
C_PB = 4 * C_B + 4 * H_B
C_IN = C_PA + C_PB
POOL_WINDOWS = (2, 4, 8, 16)
N_POOL_GROUPS = 4
C_G = D_MODEL // N_POOL_GROUPS
D_FF = ((8 * D_MODEL + 3 * 256 - 1) // (3 * 256)) * 256
RMS_EPS = 1e-6
GN_EPS = 64e-5

kernel_name = 'hybrid_rwkv7_gdn_pool_dit_step'


def _rmsnorm(x, w):
    xf = x.astype(jnp.float32)
    y = xf * lax.rsqrt(jnp.mean(xf * xf, -1, keepdims=True) + RMS_EPS)
    return (y * w.astype(jnp.float32)).astype(x.dtype)


def _l2norm(x, eps):
    return x * lax.rsqrt(jnp.sum(x * x, -1, keepdims=True) + eps)


def _from_prev(x, axis):
    pad = [(0, 0)] * x.ndim
    pad[axis] = (1, 0)
    return lax.slice_in_dim(jnp.pad(x, pad), 0, x.shape[axis], axis=axis)


def _from_next(x, axis):
    pad = [(0, 0)] * x.ndim
    pad[axis] = (0, 1)
    return lax.slice_in_dim(jnp.pad(x, pad), 1, x.shape[axis] + 1, axis=axis)


def _token_shift(p, grid):
    b, t, ch = p.shape
    if grid:
        rows = t // GRID_W
        p4 = p.reshape(b, rows, GRID_W, ch // 4, 4)
        s = jnp.stack([_from_prev(p4[..., 0], 2), _from_next(p4[..., 1], 2),
                       _from_prev(p4[..., 2], 1), _from_next(p4[..., 3], 1)], -1)
    else:
        p2 = p.reshape(b, t, ch // 2, 2)
        s = jnp.stack([_from_prev(p2[..., 0], 1), _from_next(p2[..., 1], 1)], -1)
    return s.reshape(b, t, ch)


def _centred_dwconv(x, w):
    t = x.shape[1]
    half = CONV_W // 2
    xp = jnp.pad(x, ((0, 0), (half, CONV_W - 1 - half), (0, 0)))
    return sum(xp[:, j:j + t] * w[j] for j in range(CONV_W))


def _groupnorm_heads(y, w, b):
    mu = jnp.mean(y, -1, keepdims=True)
    var = jnp.mean(jnp.square(y - mu), -1, keepdims=True)
    return (y - mu) * lax.rsqrt(var + GN_EPS) * w + b


def _rwkv7_scan(r, w, k, v, a, bb, s0, reverse):
    def step(S, inp):
        r_t, w_t, k_t, v_t, a_t, b_t = inp
        sa = jnp.einsum('bhvk,bhk->bhv', S, a_t)
        S = S * w_t[:, :, None, :] + sa[..., None] * b_t[:, :, None, :] + v_t[..., None] * k_t[:, :, None, :]
        return S, jnp.einsum('bhvk,bhk->bhv', S, r_t)
    xs = tuple(jnp.moveaxis(z, 1, 0) for z in (r, w, k, v, a, bb))
    S, ys = lax.scan(step, s0, xs, reverse=reverse)
    return jnp.moveaxis(ys, 0, 1), S


def _gdn_chunked(q, k, v, g, beta, s0):
    bn, t, h, dk = q.shape
    dv = v.shape[-1]
    n = t // CHUNK

    def blk(z):
        return jnp.moveaxis(z.reshape(bn, n, CHUNK, *z.shape[2:]), 3, 2)
    q = blk(q) * (dk ** -0.5)
    k = blk(k)
    v = blk(v)
    beta = blk(beta)
    g = jnp.cumsum(blk(g), axis=-1)
    idx = jnp.arange(CHUNK)
    incl = idx[:, None] >= idx[None, :]
    strict = idx[:, None] > idx[None, :]
    decay = jnp.exp(jnp.where(incl, g[..., :, None] - g[..., None, :], -jnp.inf))
    kb = k * beta[..., None]
    lmat = jnp.einsum('bnhik,bnhjk->bnhij', kb, k) * decay * strict
    amat = lmat + jnp.eye(CHUNK, dtype=lmat.dtype)
    rhs = jnp.concatenate([v * beta[..., None], kb * jnp.exp(g)[..., None]], -1)
    sol = lax.linalg.triangular_solve(amat, rhs, left_side=True, lower=True, unit_diagonal=True)
    u, wy = sol[..., :dv], sol[..., dv:]
    attn = jnp.einsum('bnhik,bnhjk->bnhij', q, k) * decay
    qg = q * jnp.exp(g)[..., None]
    g_last = g[..., -1]
    k_dec = k * jnp.exp(g_last[..., None] - g)[..., None]

    def step(S, inp):
        qg_c, w_c, u_c, attn_c, kd_c, gl_c = inp
        v_new = u_c - jnp.einsum('bhck,bhkv->bhcv', w_c, S)
        o = jnp.einsum('bhck,bhkv->bhcv', qg_c, S) + jnp.einsum('bhij,bhjv->bhiv', attn_c, v_new)
        S = S * jnp.exp(gl_c)[..., None, None] + jnp.einsum('bhck,bhcv->bhkv', kd_c, v_new)
        return S, o
    xs = tuple(jnp.moveaxis(z, 1, 0) for z in (qg, wy, u, attn, k_dec, g_last))
    S, o = lax.scan(step, s0, xs)
    o = jnp.transpose(o, (1, 0, 3, 2, 4)).reshape(bn, t, h, dv)
    return o, S


def _mixer_ab(h, grid, s_rwkv0, s_delta0, w_in, w_out, mu, w0, w2, a0, a2, g2, k_k, k_a, r_k,
              ln_w, ln_b, conv_w, a_log, dt_bias, gn_w):
    f32 = jnp.float32
    b, t, _ = h.shape
    p = h @ w_in
    pa = p[..., :C_PA]
    pa = (pa + (_token_shift(pa, grid) - pa) * mu).astype(f32)
    r, k, v, w_lo, a_lo, g_lo = jnp.split(
        pa, [C_A, 2 * C_A, 3 * C_A, 3 * C_A + 2 * DECAY_LORA, 3 * C_A + 2 * DECAY_LORA + 2 * ICLR_LORA], -1)
    w_lo = jnp.tanh(w_lo.reshape(b, t, 2, DECAY_LORA))
    a_lo = a_lo.reshape(b, t, 2, ICLR_LORA)
    w_log = -jax.nn.softplus(-(w0 + jnp.einsum('btdr,drc->btdc', w_lo, w2))) - 0.5
    decay = jnp.exp(-jnp.exp(w_log))
    iclr = jax.nn.sigmoid(a0 + jnp.einsum('btdr,drc->btdc', a_lo, a2))
    gate = jax.nn.sigmoid(g_lo) @ g2

    def heads(z):
        return z.reshape(b, t, H_A, HEAD_A)
    kk = _l2norm(heads(k * k_k), 1e-12)
    rh, vh = heads(r), heads(v)
    lnw, lnb = ln_w.reshape(H_A, HEAD_A), ln_b.reshape(H_A, HEAD_A)
    ys, fin_a = [], []
    for d in range(2):
        k_d = heads(k * (1 + (iclr[:, :, d] - 1) * k_a))
        y_d, s_d = _rwkv7_scan(rh, heads(decay[:, :, d]), k_d, vh, -kk, kk * heads(iclr[:, :, d]),
                               s_rwkv0[:, d].astype(f32), d == 1)
        ys.append(_groupnorm_heads(y_d, lnw, lnb) + jnp.sum(rh * k_d * r_k, -1, keepdims=True) * vh)
        fin_a.append(s_d)
    o_a = (ys[0] + ys[1]).reshape(b, t, C_A) * gate
    pb = p[..., C_PA:]
    qkv = jax.nn.silu(_centred_dwconv(pb[..., :3 * C_B], conv_w)).astype(f32)
    qd, kd, vd = jnp.split(qkv, 3, -1)
    qd = _l2norm(qd.reshape(b, t, H_B, HEAD_B), 1e-6)
    kd = _l2norm(kd.reshape(b, t, H_B, HEAD_B), 1e-6)
    vd = vd.reshape(b, t, H_B, HEAD_B)
    z = pb[..., 3 * C_B:4 * C_B].astype(f32).reshape(b, t, H_B, HEAD_B)
    beta = jax.nn.sigmoid(pb[..., 4 * C_B:4 * C_B + 2 * H_B].astype(f32)).reshape(b, t, 2, H_B)
    alpha = pb[..., 4 * C_B + 2 * H_B:].astype(f32).reshape(b, t, 2, H_B)
    g_log = -jnp.exp(a_log) * jax.nn.softplus(alpha + dt_bias)
    o_f, s_f = _gdn_chunked(qd, kd, vd, g_log[:, :, 0], beta[:, :, 0], s_delta0[:, 0].astype(f32))
    fl = lambda u_: jnp.flip(u_, 1)
    o_r, s_r = _gdn_chunked(fl(qd), fl(kd), fl(vd), fl(g_log[:, :, 1]), fl(beta[:, :, 1]),
                            s_delta0[:, 1].astype(f32))
    o_bd = o_f + fl(o_r)
    o_bd = o_bd * lax.rsqrt(jnp.mean(o_bd * o_bd, -1, keepdims=True) + RMS_EPS) * gn_w * jax.nn.silu(z)
    o_b = o_bd.reshape(b, t, C_B)
    out = jnp.concatenate([o_a, o_b], -1).astype(h.dtype) @ w_out
    return out, jnp.stack(fin_a, 1).astype(h.dtype), jnp.stack([s_f, s_r], 1).astype(h.dtype)


def _multiscale_pool(h, w_pool, scale):
    f32 = jnp.float32
    b, t, _ = h.shape
    hf = h.astype(f32)
    cs = jnp.pad(jnp.cumsum(hf, 1), ((0, 0), (1, 0), (0, 0)))
    pos = jnp.arange(t)
    means = []
    for gi, win in enumerate(POOL_WINDOWS):
        lo = jnp.clip(pos - win // 2, 0, t)
        hi = jnp.clip(pos - win // 2 + win, 0, t)
        cg = cs[..., gi * C_G:(gi + 1) * C_G]
        s = jnp.take(cg, hi, axis=1) - jnp.take(cg, lo, axis=1)
        means.append(s / (hi - lo).astype(f32)[:, None])
    p = jnp.stack(means, 2) - hf.reshape(b, t, N_POOL_GROUPS, C_G)
    y = jnp.einsum('btgc,gce->btge', p, w_pool).reshape(b, t, D_MODEL)
    return (y * scale).astype(h.dtype)


def _swiglu(h, wg, wu, wd):
    return (jax.nn.silu(h @ wg) * (h @ wu)) @ wd


def _trunk(x, cond, grid, s_rwkv0, s_delta0, shared, ab, pool, keep_state):
    mod_w, mod_b, norm_mix_w, norm_ffn_w, norm_final_w, w_gate, w_up, w_down = shared
    pool_w, pool_scale = pool
    cond_act = jax.nn.silu(cond)
    st_r, st_d = [], []
    for l in range(DEPTH):
        mod = (cond_act @ mod_w[l] + mod_b[l]).reshape(cond.shape[0], 1, 6, D_MODEL)
        shift_m, scale_m, gate_m, shift_f, scale_f, gate_f = (mod[:, :, j] for j in range(6))
        h = _rmsnorm(x, norm_mix_w[l]) * (1 + scale_m) + shift_m
        i = l // 2
        if l % 2 == 0:
            out, s_r, s_d = _mixer_ab(h, grid, s_rwkv0[:, i], s_delta0[:, i], *(prm[i] for prm in ab))
            if keep_state:
                st_r.append(s_r)
                st_d.append(s_d)
        else:
            out = _multiscale_pool(h, pool_w[i], pool_scale[i])
        x = x + gate_m * out
        h = _rmsnorm(x, norm_ffn_w[l]) * (1 + scale_f) + shift_f
        x = x + gate_f * _swiglu(h, w_gate[l], w_up[l], w_down[l])
    y = _rmsnorm(x, norm_final_w)
    if keep_state:
        return y, jnp.stack(st_r, 1), jnp.stack(st_d, 1)
    return y, None, None


def setup_inputs(seed: int = 0) -> dict:
    key = jax.random.key(seed)
    ks = iter(jax.random.split(key, 48))
    f32 = jnp.float32
    D = D_MODEL

    def nrm(shape, s):
        return jax.random.normal(next(ks), shape, f32) * s

    def uni(shape, lo, hi):
        return jax.random.uniform(next(ks), shape, f32, minval=lo, maxval=hi)

    dt = jnp.exp(uni((N_AB, 2, H_B), float(np.log(1e-3)), float(np.log(1e-1))))
    return {
        'x_prompt': nrm((BATCH, SEQ, D), 1.0),
        'x_sample': nrm((DEC_BATCH, DEC_SEQ, D), 1.0),
        'state_rwkv': nrm((DEC_BATCH, N_AB, 2, H_A, HEAD_A, HEAD_A), 1.0),
        'state_delta': nrm((DEC_BATCH, N_AB, 2, H_B, HEAD_B, HEAD_B), 0.3),
        'c': nrm((DEC_BATCH, D), 1.0),
        'c_ctx': nrm((D,), 1.0),
        'mod_w': nrm((DEPTH, D, 6 * D), 0.5 * D ** -0.5),
        'mod_b': nrm((DEPTH, 6 * D), 0.02),
        'norm_mix_w': 1.0 + nrm((DEPTH, D), 0.05),
        'norm_ffn_w': 1.0 + nrm((DEPTH, D), 0.05),
        'norm_final_w': 1.0 + nrm((D,), 0.05),
        'ab_w_in': nrm((N_AB, D, C_IN), D ** -0.5),
        'ab_w_out': nrm((N_AB, C_A + C_B, D), (C_A + C_B) ** -0.5),
        'rwkv_mu': uni((N_AB, C_PA), 0.0, 1.0),
        'rwkv_w0': uni((N_AB, 2, C_A), -6.0, -1.0),
        'rwkv_w2': nrm((N_AB, 2, DECAY_LORA, C_A), 0.1 * DECAY_LORA ** -0.5),
        'rwkv_a0': nrm((N_AB, 2, C_A), 0.1),
        'rwkv_a2': nrm((N_AB, 2, ICLR_LORA, C_A), 0.5 * ICLR_LORA ** -0.5),
        'rwkv_g2': nrm((N_AB, GATE_LORA, C_A), GATE_LORA ** -0.5),
        'rwkv_k_k': 0.85 + nrm((N_AB, C_A), 0.05),
        'rwkv_k_a': 1.0 + nrm((N_AB, C_A), 0.05),
        'rwkv_r_k': nrm((N_AB, H_A, HEAD_A), 0.1),
        'rwkv_ln_w': 1.0 + nrm((N_AB, C_A), 0.05),
        'rwkv_ln_b': nrm((N_AB, C_A), 0.01),
        'gdn_conv_w': nrm((N_AB, CONV_W, 3 * C_B), CONV_W ** -0.5),
        'gdn_a_log': jnp.log(uni((N_AB, 2, H_B), 1.0, 16.0)),
        'gdn_dt_bias': dt + jnp.log(-jnp.expm1(-dt)),
        'gdn_norm_w': 1.0 + nrm((N_AB, HEAD_B), 0.05),
        'pool_w': nrm((N_POOL, N_POOL_GROUPS, C_G, C_G), C_G ** -0.5),
        'pool_scale': 1.0 + nrm((N_POOL, D), 0.1),
        'ffn_w_gate': nrm((DEPTH, D, D_FF), D ** -0.5),
        'ffn_w_up': nrm((DEPTH, D, D_FF), D ** -0.5),
        'ffn_w_down': nrm((DEPTH, D_FF, D), D_FF ** -0.5),
    }


def reference(x_prompt, x_sample, state_rwkv, state_delta, c, c_ctx, mod_w, mod_b, norm_mix_w,
              norm_ffn_w, norm_final_w, ab_w_in, ab_w_out, rwkv_mu, rwkv_w0, rwkv_w2, rwkv_a0, rwkv_a2,
              rwkv_g2, rwkv_k_k, rwkv_k_a, rwkv_r_k, rwkv_ln_w, rwkv_ln_b, gdn_conv_w, gdn_a_log,
              gdn_dt_bias, gdn_norm_w, pool_w, pool_scale, ffn_w_gate, ffn_w_up, ffn_w_down):
    shared = (mod_w, mod_b, norm_mix_w, norm_ffn_w, norm_final_w, ffn_w_gate, ffn_w_up, ffn_w_down)
    ab = (ab_w_in, ab_w_out, rwkv_mu, rwkv_w0, rwkv_w2, rwkv_a0, rwkv_a2, rwkv_g2, rwkv_k_k, rwkv_k_a,
          rwkv_r_k, rwkv_ln_w, rwkv_ln_b, gdn_conv_w, gdn_a_log, gdn_dt_bias, gdn_norm_w)
    pool = (pool_w, pool_scale)
    bp = x_prompt.shape[0]
    zero_r = jnp.zeros((bp, N_AB, 2, H_A, HEAD_A, HEAD_A), x_prompt.dtype)
    zero_d = jnp.zeros((bp, N_AB, 2, H_B, HEAD_B, HEAD_B), x_prompt.dtype)
    y_prompt, new_state_rwkv, new_state_delta = _trunk(x_prompt, c_ctx[None, :], False, zero_r, zero_d,
                                                       shared, ab, pool, True)
    y_sample, _, _ = _trunk(x_sample, c, True, state_rwkv, state_delta, shared, ab, pool, False)
    return (y_prompt, y_sample, new_state_rwkv, new_state_delta)
```

```cpp
#include <hip/hip_runtime.h>
#include <cstdio>
#include <cstdint>

namespace pg8 {
#define PG8_LAS __attribute__((address_space(3)))
typedef unsigned short bf16_t;
typedef short bf16x8 __attribute__((ext_vector_type(8)));
typedef float f32x4 __attribute__((ext_vector_type(4)));
typedef unsigned u32x4 __attribute__((ext_vector_type(4)));
constexpr int BM = 256, BK = 64, HALF = 128, HTB = HALF * BK * 2  , STAGE_BYTES = 8 * HTB, NXCD = 8, WGM = 8;

__host__ __device__ __forceinline__ int lds_byte(int r, int c) { const int st = (r >> 4) * 2 + (c >> 5), rr = r & 15, cc = c & 31, ob = rr * 64 + cc * 2; return st * 1024 + (ob ^ (((ob >> 9) & 1) << 5)); }
__host__ __device__ __forceinline__ void stage_rc(int b, int& R, int& C) { const int st = b / 1024, sb = b % 1024, swz = sb ^ (((sb >> 9) & 1) << 5); R = (st >> 1) * 16 + swz / 64; C = (st & 1) * 32 + (swz % 64) / 2; }
__host__ __device__ __forceinline__ int perm32(int rho) { const int n = rho >> 4, i = rho & 15; return 8 * (i >> 2) + 4 * n + (i & 3); }

struct Unit { int pm, pn; };
struct Gemm { const bf16_t* A; const bf16_t* Bt; int M, N, K, lda, ldb, gsh, gk; };

struct StaticOrder {
    int nM, nN, nwg, G, c;
    __host__ __device__ void init(int M, int N, int G_, int c_) { nM = M / BM; nN = N / BM; nwg = nM * nN; G = G_; c = c_; }
    __host__ __device__ bool next(int i, Unit& u) const {
        const long L = (long)i * G + c; if (L >= nwg) return false;
        int wgid = (int)L; { const int q = nwg / NXCD, r = nwg % NXCD, xcd = wgid % NXCD, off = wgid / NXCD; wgid = (xcd < r ? xcd * (q + 1) : r * (q + 1) + (xcd - r) * q) + off; }
        const int nig = WGM * nN, gid = wgid / nig, fm = gid * WGM, gsz = (nM - fm) < WGM ? (nM - fm) : WGM;
        u.pm = fm + ((wgid % nig) % gsz); u.pn = (wgid % nig) / gsz; return true;
    }
    __device__ __forceinline__ void a_ready(const Unit&) const {}
    __device__ __forceinline__ void done(const Unit&) const {}
};

__device__ __forceinline__ unsigned cvt_pk_bf16(float lo, float hi) { unsigned r; asm volatile("v_cvt_pk_bf16_f32 %0, %1, %2" : "=v"(r) : "v"(lo), "v"(hi)); return r; }

__device__ __forceinline__ int cond_of_panel(int pm) { return pm < 16 ? 0 : 1 + ((pm - 16) >> 2); }

struct EpiBf16 {
    static constexpr bool PERM = true, AFTER_DRAIN = false;
    bf16_t* O; int ldc;
    __device__ __forceinline__ void operator()(const f32x4 (&acc)[2][2][4][2], const Unit& u, int wr, int wc, int fr, int fq) const {
        const int row0 = u.pm * BM + wr * 64 + fr; const int col0 = u.pn * BM + wc * 32 + 8 * fq;
#pragma unroll
        for (int ai = 0; ai < 2; ++ai)
#pragma unroll
            for (int m = 0; m < 4; ++m) { bf16_t* rowp = O + (size_t)(row0 + ai * HALF + m * 16) * ldc + col0;
#pragma unroll
                for (int bj = 0; bj < 2; ++bj) { const f32x4 v0 = acc[ai][bj][m][0], v1 = acc[ai][bj][m][1];
                    u32x4 w; w.x = cvt_pk_bf16(v0[0], v0[1]); w.y = cvt_pk_bf16(v0[2], v0[3]); w.z = cvt_pk_bf16(v1[0], v1[1]); w.w = cvt_pk_bf16(v1[2], v1[3]);
                    *(u32x4*)(rowp + bj * HALF) = w; } }
    }
};
struct EpiSwiGLU {
    static constexpr bool PERM = true, AFTER_DRAIN = false;
    bf16_t* O; int ldc;
    __device__ __forceinline__ void operator()(const f32x4 (&acc)[2][2][4][2], const Unit& u, int wr, int wc, int fr, int fq) const {
        const int row0 = u.pm * BM + wr * 64 + fr; const int col0 = u.pn * HALF + wc * 32 + 8 * fq;
#pragma unroll
        for (int ai = 0; ai < 2; ++ai)
#pragma unroll
            for (int m = 0; m < 4; ++m) { bf16_t* rowp = O + (size_t)(row0 + ai * HALF + m * 16) * ldc + col0;
                float o[8];
#pragma unroll
                for (int n = 0; n < 2; ++n)
#pragma unroll
                    for (int e = 0; e < 4; ++e) { const float gte = acc[ai][0][m][n][e], up = acc[ai][1][m][n][e]; o[n * 4 + e] = gte * __builtin_amdgcn_rcpf(1.0f + __expf(-gte)) * up; }
                u32x4 w; w.x = cvt_pk_bf16(o[0], o[1]); w.y = cvt_pk_bf16(o[2], o[3]); w.z = cvt_pk_bf16(o[4], o[5]); w.w = cvt_pk_bf16(o[6], o[7]);
                *(u32x4*)rowp = w; }
    }
};
struct EpiResid {
    static constexpr bool PERM = false, AFTER_DRAIN = false;
    const float* xin_p; const float* xin_s; float* xout; const float* gate  ; const float* cscale;
    __device__ __forceinline__ void operator()(const f32x4 (&acc)[2][2][4][2], const Unit& u, int wr, int wc, int fr, int fq) const {
        const int row0 = u.pm * BM + wr * 64 + fr, col0 = u.pn * BM + wc * 32 + 4 * fq;
        const float* gp = gate + (size_t)cond_of_panel(u.pm) * 12288 + col0;
        f32x4 gv[2][2];
#pragma unroll
        for (int bj = 0; bj < 2; ++bj)
#pragma unroll
            for (int n = 0; n < 2; ++n) { gv[bj][n] = *(const f32x4*)(gp + bj * HALF + n * 16); if (cscale) gv[bj][n] = gv[bj][n] * *(const f32x4*)(cscale + col0 + bj * HALF + n * 16); }
#pragma unroll
        for (int ai = 0; ai < 2; ++ai)
#pragma unroll
            for (int m = 0; m < 4; ++m) { const int row = row0 + ai * HALF + m * 16;
                const float* xi = xin_p ? (row < 4096 ? xin_p + (size_t)row * 2048 : xin_s + (size_t)(row - 4096) * 2048) : xout + (size_t)row * 2048;
                float* xo = xout + (size_t)row * 2048;
#pragma unroll
                for (int bj = 0; bj < 2; ++bj)
#pragma unroll
                    for (int n = 0; n < 2; ++n) { const f32x4 xv = *(const f32x4*)(xi + col0 + bj * HALF + n * 16); *(f32x4*)(xo + col0 + bj * HALF + n * 16) = xv + gv[bj][n] * acc[ai][bj][m][n]; } }
    }
};

template <class Epi, class Sched, bool ALIGN_EPI = false, bool SP2 = false>
__device__ __forceinline__ void gemm_phase(PG8_LAS unsigned char* lds, const Gemm g, const Sched& S, const Epi& E) {
    const int tid = threadIdx.x, wid = __builtin_amdgcn_readfirstlane(tid >> 6), lane = tid & 63, wr = wid >> 2, wc = wid & 3, fr = lane & 15, fq = lane >> 4;
    const int K = g.K, nt = K / BK;
    unsigned voffA[2], voffB[2];
#pragma unroll
    for (int i = 0; i < 2; ++i) { int R, C; stage_rc(tid * 16 + i * 8192, R, C); const int Rb = Epi::PERM ? ((R & ~31) + perm32(R & 31)) : R;
        voffA[i] = (unsigned)(R * g.lda + C) * 2u; voffB[i] = (unsigned)(Rb * g.ldb + C) * 2u; }
    const size_t kstep = (size_t)(BK * 2);
    const size_t hstepA = (size_t)HALF * g.lda * 2, hstepB = (size_t)HALF * g.ldb * 2;
    const size_t tstepA = 2 * hstepA, tstepB = 2 * hstepB;
    const unsigned ldsw = (unsigned)wid * 1024u;
    const int aoff = lds_byte(wr * 64 + fr, fq * 8), boff = lds_byte(wc * 32 + fr, fq * 8);
#define PG8_SA(b, h) (((b) * 2 + (h)) * HTB)
#define PG8_SB(b, h) ((4 + (b) * 2 + (h)) * HTB)
#define PG8_STAGE(bufoff, gbase, voff) do { _Pragma("unroll") for (int _i = 0; _i < 2; ++_i) \
        __builtin_amdgcn_global_load_lds((const unsigned*)((const char*)(gbase) + (voff)[_i]), (PG8_LAS unsigned*)(lds + (bufoff) + ldsw + _i * 8192), 16, 0, 0); } while (0)
#define PG8_LDA(dst, b, h) do { _Pragma("unroll") for (int m = 0; m < 4; ++m) _Pragma("unroll") for (int k = 0; k < 2; ++k) dst[m][k] = *(const PG8_LAS bf16x8*)(lds + PG8_SA(b, h) + aoff + m * 2048 + k * 1024); } while (0)
#define PG8_LDB(dst, b, h) do { _Pragma("unroll") for (int n = 0; n < 2; ++n) _Pragma("unroll") for (int k = 0; k < 2; ++k) dst[n][k] = *(const PG8_LAS bf16x8*)(lds + PG8_SB(b, h) + boff + n * 2048 + k * 1024); } while (0)
#define PG8_MMA(ai, bj, At, Bt) do { __builtin_amdgcn_s_setprio(1); _Pragma("unroll") for (int m = 0; m < 4; ++m) _Pragma("unroll") for (int n = 0; n < 2; ++n) _Pragma("unroll") for (int k = 0; k < 2; ++k) \
        acc[ai][bj][m][n] = __builtin_amdgcn_mfma_f32_16x16x32_bf16(Bt[n][k], At[m][k], acc[ai][bj][m][n], 0, 0, 0); __builtin_amdgcn_s_setprio(0); } while (0)
#define PG8_WAIT_V(n) asm volatile("s_waitcnt vmcnt(" #n ")" ::: "memory")
#define PG8_WAIT_L(n) asm volatile("s_waitcnt lgkmcnt(" #n ")" ::: "memory")
#define PG8_BAR __builtin_amdgcn_s_barrier()
#define PG8_SCHED __builtin_amdgcn_sched_barrier(0)
    Unit cur, nxt; int ui = 0;
    if (!S.next(0, cur)) return;
    f32x4 acc[2][2][4][2];
#pragma unroll
    for (int a = 0; a < 2; ++a)
#pragma unroll
        for (int b = 0; b < 2; ++b)
#pragma unroll
            for (int m = 0; m < 4; ++m)
#pragma unroll
                for (int n = 0; n < 2; ++n) acc[a][b][m][n] = (f32x4){0.f, 0.f, 0.f, 0.f};
    bf16x8 At[4][2], B0[2][2], B1[2][2];
    const char* cA = (const char*)g.A + (size_t)cur.pm * tstepA + (size_t)((cur.pn >> g.gsh) * g.gk) * 2; const char* cB = (const char*)g.Bt + (size_t)cur.pn * tstepB;
    S.a_ready(cur);
    if constexpr (SP2) {
        PG8_STAGE(PG8_SB(0, 0), cB, voffB); PG8_STAGE(PG8_SB(0, 1), cB + hstepB, voffB); PG8_STAGE(PG8_SA(0, 0), cA, voffA); PG8_STAGE(PG8_SA(0, 1), cA + hstepA, voffA);
        if (wr == 1) PG8_BAR;
        PG8_WAIT_V(2); PG8_BAR;
        PG8_STAGE(PG8_SB(1, 0), cB + kstep, voffB); PG8_STAGE(PG8_SA(1, 0), cA + kstep, voffA); PG8_STAGE(PG8_SB(1, 1), cB + hstepB + kstep, voffB);
        PG8_WAIT_V(6); PG8_BAR;
    } else {
        PG8_STAGE(PG8_SB(0, 0), cB, voffB); PG8_STAGE(PG8_SA(0, 0), cA, voffA); PG8_STAGE(PG8_SB(0, 1), cB + hstepB, voffB); PG8_STAGE(PG8_SA(0, 1), cA + hstepA, voffA);
        if (wr == 1) PG8_BAR;
        PG8_WAIT_V(4); PG8_BAR;
        PG8_STAGE(PG8_SB(1, 0), cB + kstep, voffB); PG8_STAGE(PG8_SA(1, 0), cA + kstep, voffA); PG8_STAGE(PG8_SB(1, 1), cB + hstepB + kstep, voffB);
        PG8_WAIT_V(6); PG8_BAR;
    }
    for (;;) {
        const bool has_next = S.next(ui + 1, nxt);
        const char* nA = has_next ? (const char*)g.A + (size_t)nxt.pm * tstepA + (size_t)((nxt.pn >> g.gsh) * g.gk) * 2 : cA; const char* nB = has_next ? (const char*)g.Bt + (size_t)nxt.pn * tstepB : cB;
        for (int t = 0; t < nt; t += 2) {
            const bool last = (t == nt - 2);
            const char* a1 = cA + (size_t)(t + 1) * kstep;
            const char* a2 = last ? nA : cA + (size_t)(t + 2) * kstep; const char* b2 = last ? nB : cB + (size_t)(t + 2) * kstep;
            const char* a3 = a2 + kstep; const char* b3 = b2 + kstep;
            if (last && has_next) S.a_ready(nxt);
            if constexpr (SP2) {
            PG8_LDB(B0, 0, 0); PG8_LDB(B1, 0, 1); PG8_SCHED; PG8_LDA(At, 0, 0); PG8_STAGE(PG8_SA(1, 1), a1 + hstepA, voffA);
            PG8_WAIT_V(8); PG8_WAIT_L(0); PG8_BAR; PG8_MMA(0, 0, At, B0); PG8_MMA(0, 1, At, B1); PG8_BAR; PG8_SCHED;
            PG8_LDA(At, 0, 1); PG8_STAGE(PG8_SB(0, 0), b2, voffB); PG8_STAGE(PG8_SB(0, 1), b2 + hstepB, voffB); PG8_STAGE(PG8_SA(0, 0), a2, voffA);
            PG8_WAIT_V(8); PG8_WAIT_L(0); PG8_BAR; PG8_MMA(1, 0, At, B0); PG8_MMA(1, 1, At, B1); PG8_BAR; PG8_SCHED;
            PG8_LDB(B0, 1, 0); PG8_LDB(B1, 1, 1); PG8_SCHED; PG8_LDA(At, 1, 0); PG8_STAGE(PG8_SA(0, 1), a2 + hstepA, voffA);
            PG8_WAIT_V(8); PG8_WAIT_L(0); PG8_BAR; PG8_MMA(0, 0, At, B0); PG8_MMA(0, 1, At, B1); PG8_BAR; PG8_SCHED;
            PG8_LDA(At, 1, 1); PG8_STAGE(PG8_SB(1, 0), b3, voffB); PG8_STAGE(PG8_SB(1, 1), b3 + hstepB, voffB); PG8_STAGE(PG8_SA(1, 0), a3, voffA);
            PG8_WAIT_V(8); PG8_WAIT_L(0); PG8_BAR; PG8_MMA(1, 0, At, B0); PG8_MMA(1, 1, At, B1); PG8_BAR; PG8_SCHED;
            } else {
            PG8_LDB(B0, 0, 0); PG8_SCHED; PG8_LDA(At, 0, 0); PG8_STAGE(PG8_SA(1, 1), a1 + hstepA, voffA);
            PG8_WAIT_L(8); PG8_BAR; PG8_WAIT_L(0); PG8_MMA(0, 0, At, B0); PG8_BAR; PG8_SCHED;
            PG8_LDB(B1, 0, 1); PG8_STAGE(PG8_SB(0, 0), b2, voffB);
            PG8_BAR; PG8_WAIT_L(0); PG8_MMA(0, 1, At, B1); PG8_BAR;
            PG8_LDA(At, 0, 1); PG8_STAGE(PG8_SA(0, 0), a2, voffA);
            PG8_BAR; PG8_WAIT_L(0); PG8_MMA(1, 0, At, B0); PG8_BAR; PG8_SCHED;
            PG8_STAGE(PG8_SB(0, 1), b2 + hstepB, voffB);
            PG8_WAIT_V(6); PG8_BAR; PG8_MMA(1, 1, At, B1); PG8_BAR;
            PG8_LDB(B0, 1, 0); PG8_SCHED; PG8_LDA(At, 1, 0); PG8_STAGE(PG8_SA(0, 1), a2 + hstepA, voffA);
            PG8_WAIT_L(8); PG8_BAR; PG8_WAIT_L(0); PG8_MMA(0, 0, At, B0); PG8_BAR; PG8_SCHED;
            PG8_LDB(B1, 1, 1); PG8_STAGE(PG8_SB(1, 0), b3, voffB);
            PG8_BAR; PG8_WAIT_L(0); PG8_MMA(0, 1, At, B1); PG8_BAR;
            PG8_LDA(At, 1, 1); PG8_STAGE(PG8_SA(1, 0), a3, voffA);
            PG8_BAR; PG8_WAIT_L(0); PG8_MMA(1, 0, At, B0); PG8_BAR; PG8_SCHED;
            PG8_STAGE(PG8_SB(1, 1), b3 + hstepB, voffB);
            PG8_WAIT_V(6); PG8_BAR; PG8_MMA(1, 1, At, B1); PG8_BAR;
            }
        }
        if constexpr (ALIGN_EPI) { if (wr == 0) PG8_BAR; }
        if constexpr (!Epi::AFTER_DRAIN) { E(acc, cur, wr, wc, fr, fq); S.done(cur); }
        if (!has_next) break;
#pragma unroll
        for (int a = 0; a < 2; ++a)
#pragma unroll
            for (int b = 0; b < 2; ++b)
#pragma unroll
                for (int m = 0; m < 4; ++m)
#pragma unroll
                    for (int n = 0; n < 2; ++n) acc[a][b][m][n] = (f32x4){0.f, 0.f, 0.f, 0.f};
        cur = nxt; cA = nA; cB = nB; ++ui;
        if constexpr (ALIGN_EPI) { if (wr == 1) PG8_BAR; }
    }
    PG8_WAIT_V(0);
    if constexpr (!ALIGN_EPI) { if (wr == 0) PG8_BAR; }
    PG8_BAR;
    if constexpr (Epi::AFTER_DRAIN) { E.fused(acc, cur, wr, wc, fr, fq, lds, wid, lane); S.done(cur); }
#undef PG8_SA
#undef PG8_SB
#undef PG8_STAGE
#undef PG8_LDA
#undef PG8_LDB
#undef PG8_MMA
#undef PG8_WAIT_V
#undef PG8_WAIT_L
#undef PG8_BAR
#undef PG8_SCHED
}
}

constexpr int D = 2048, NTOK = 12288, NPROMPT = 4096, DFF = 5632, PW = 7680  , CPA = 3488;
constexpr int NWAVES = 8, NTHR = 512;
constexpr int PC_GDN = 3072, PC_Z = 6144, PC_LORA = 7168, PC_BETA = 7584, PC_ALPHA = 7600;
constexpr float RMS_EPS = 1e-6f, GN_EPS = 64e-5f;

constexpr size_t MiB = 1u << 20;
constexpr size_t WS_CTL = 0, CTL_ZERO_BYTES = 1 * MiB;
constexpr size_t WS_MOD = 1 * MiB;
constexpr size_t WS_WIN = 3 * MiB;
constexpr size_t WS_WOUT = 63 * MiB;
constexpr size_t WS_WGU = 79 * MiB;
constexpr size_t WS_WDN = 255 * MiB;
constexpr size_t WS_WPOOL = 343 * MiB;
constexpr size_t WS_H = 347 * MiB;
constexpr size_t WS_O = 395 * MiB;
constexpr size_t WS_P = 443 * MiB;
constexpr size_t WS_SC = 623 * MiB;
constexpr size_t SC_ONE = 48 * MiB;
constexpr size_t WS_Y = 1247 * MiB;
constexpr size_t WS_SMALL = 1439 * MiB;
constexpr size_t WS_END = 1443 * MiB;
constexpr int CW_BAR = 4096;

constexpr int LDS_STAGE = 131072, LDS_MISC = LDS_STAGE + 320, LDS_BYTES = 147456;

#define GAS __attribute__((address_space(1)))
#define LAS __attribute__((address_space(3)))
typedef unsigned short bf16;
typedef unsigned v4u __attribute__((ext_vector_type(4)));
typedef unsigned v2u __attribute__((ext_vector_type(2)));
typedef float f32x4 __attribute__((ext_vector_type(4)));
typedef float f32x2 __attribute__((ext_vector_type(2)));
#define LDS_WAIT() asm volatile("s_waitcnt lgkmcnt(0)" ::: "memory")

__device__ __forceinline__ unsigned f2bf(float f) { unsigned u = __builtin_bit_cast(unsigned, f); return (u + 0x7fffu + ((u >> 16) & 1u)) >> 16; }
__device__ __forceinline__ unsigned pk2(float lo, float hi) { return f2bf(lo) | (f2bf(hi) << 16); }
__device__ __forceinline__ float bf2f(bf16 b) { return __builtin_bit_cast(float, (unsigned)b << 16); }
__device__ __forceinline__ float bflo(unsigned w) { return __builtin_bit_cast(float, w << 16); }
__device__ __forceinline__ float bfhi(unsigned w) { return __builtin_bit_cast(float, w & 0xffff0000u); }
__device__ __forceinline__ float sigmoidf_(float x) { return 1.0f / (1.0f + __expf(-x)); }
__device__ __forceinline__ float siluf_(float x) { return x / (1.0f + __expf(-x)); }
__device__ __forceinline__ float softplusf_(float x) { return x > 20.f ? x : log1pf(__expf(x)); }
__device__ __forceinline__ float wave_sum(float v) {
#pragma unroll
    for (int o = 1; o < 64; o <<= 1) v += __shfl_xor(v, o);
    return v;
}
__device__ __forceinline__ float rdl(float v, int k) { return __builtin_bit_cast(float, __builtin_amdgcn_readlane(__builtin_bit_cast(int, v), k)); }

#define XB_TMO      128
#define XB_XCNT(j)  (256  + 64 * (j))
#define XB_XSUB(j)  (1280 + 64 * (j))
#define XB_XGEN(j)  (2304 + 64 * (j))
#define XB_TOP      3328
#define XB_TOPGEN   3392
#define XCD_BAR_WORDS 3456
#define XB_SPIN_CAP (1u << 18)
__device__ __forceinline__ unsigned xb_ld(unsigned* p)              { return __hip_atomic_load(p, __ATOMIC_RELAXED, __HIP_MEMORY_SCOPE_AGENT); }
__device__ __forceinline__ unsigned xb_add(unsigned* p, unsigned v) { return __hip_atomic_fetch_add(p, v, __ATOMIC_RELAXED, __HIP_MEMORY_SCOPE_AGENT); }
__device__ __forceinline__ unsigned xb_xcc_id() { return (unsigned)__builtin_amdgcn_s_getreg((3 << 11) | 20) & 0xFu; }
#define XB_SPIN(cond, bar) do { unsigned _sp = 0; while (cond) { __builtin_amdgcn_s_sleep(1); \
    if ((++_sp & 255u) == 0u) { if (xb_ld(&(bar)[XB_TMO])) break; if (_sp > XB_SPIN_CAP) { atomicAdd(&(bar)[XB_TMO], 1u); break; } } } } while (0)
struct XcdBarrier { unsigned* bar; unsigned x; volatile LAS unsigned* st; };
__device__ __forceinline__ XcdBarrier xcd_barrier_post(unsigned* bar, volatile LAS unsigned* st) {
    XcdBarrier b; b.bar = bar; b.x = xb_xcc_id(); b.st = st;
    if (threadIdx.x == 0) (void)xb_add(&bar[XB_XCNT(b.x)], 1u);
    return b;
}
__device__ __forceinline__ void xcd_barrier_complete(unsigned* bar, unsigned x, unsigned& nloc, unsigned& nx) {
    const unsigned G = gridDim.x * gridDim.y * gridDim.z;
    unsigned sum, cnt, mine, sp = 0u;
    for (;;) {
        sum = 0u; cnt = 0u; mine = 0u;
#pragma unroll
        for (unsigned j = 0; j < 16; ++j) { const unsigned c = xb_ld(&bar[XB_XCNT(j)]); sum += c; cnt += (c > 0u) ? 1u : 0u; mine = (j == x) ? c : mine; }
        if (sum == G) break;
        __builtin_amdgcn_s_sleep(1);
        if ((++sp & 255u) == 0u) { if (xb_ld(&bar[XB_TMO])) break; if (sp > XB_SPIN_CAP) { atomicAdd(&bar[XB_TMO], 1u); break; } }
    }
    nloc = mine > 0u ? mine : 1u; nx = cnt > 0u ? cnt : 1u;
}
__device__ __forceinline__ void xcd_barrier(const XcdBarrier& b) {
    asm volatile("s_waitcnt vmcnt(0)" ::: "memory");
    __syncthreads();
    if (threadIdx.x == 0) {
        unsigned* bar = b.bar;
        __builtin_amdgcn_s_waitcnt(0);
        unsigned nloc = b.st[0], nx = b.st[1];
        if (nloc == 0u) { xcd_barrier_complete(bar, b.x, nloc, nx); b.st[0] = nloc; b.st[1] = nx; }
        const unsigned old = xb_add(&bar[XB_XSUB(b.x)], 1u);
        const unsigned gen = old / nloc;
        if (old + 1u == (gen + 1u) * nloc) {
            __builtin_amdgcn_fence(__ATOMIC_RELEASE, "agent");
            asm volatile("s_waitcnt vmcnt(0)" ::: "memory");
            const unsigned og = xb_add(&bar[XB_TOP], 1u);
            const unsigned tg = og / nx;
            if (og + 1u == (tg + 1u) * nx) xb_add(&bar[XB_TOPGEN], 1u);
            else XB_SPIN(xb_ld(&bar[XB_TOPGEN]) == tg, bar);
            __builtin_amdgcn_fence(__ATOMIC_ACQUIRE, "agent");
            xb_add(&bar[XB_XGEN(b.x)], 1u);
            asm volatile("s_waitcnt vmcnt(0)" ::: "memory");
        } else {
            XB_SPIN(xb_ld(&bar[XB_XGEN(b.x)]) == gen, bar);
            __builtin_amdgcn_fence(__ATOMIC_ACQUIRE, "agent");
            asm volatile("s_waitcnt vmcnt(0)" ::: "memory");
        }
    }
    __syncthreads();
}

enum { I_XP = 0, I_XS, I_SRW, I_SDL, I_C, I_CCTX, I_MODW, I_MODB, I_NMIX, I_NFFN, I_NFIN, I_WIN, I_WOUT, I_MU, I_W0, I_W2, I_A0, I_A2, I_G2, I_KK, I_KA, I_RK, I_LNW, I_LNB,
       I_CONVW, I_ALOG, I_DTB, I_GNW, I_POOLW, I_POOLS, I_WG, I_WU, I_WD, N_IN };
struct Args { const float* in[N_IN]; float* out; unsigned char* ws; int ph_lo, ph_hi; };
constexpr size_t OUT_SRW = (size_t)NTOK * D, OUT_SDL = OUT_SRW + (size_t)16 * 2 * 2 * 16 * 64 * 64;

__device__ __forceinline__ void conv_item(const float* W, int K, int N, bf16* WT, int drow0, LAS float* scr, int kb, int nb, int lane) {
    const int k0 = 64 * kb, n0 = 32 * nb;
#pragma unroll 8
    for (int i = 0; i < 32; ++i) { const int kk = 2 * i + (lane >> 5); scr[kk * 33 + (lane & 31)] = W[(size_t)(k0 + kk) * N + n0 + (lane & 31)]; }
    LDS_WAIT(); asm volatile("" ::: "memory");
    const int c = lane & 7;
#pragma unroll
    for (int j = 0; j < 4; ++j) { const int n = (lane >> 3) + 8 * j; const LAS float* s = scr + (8 * c) * 33 + n;
        v4u o; o.x = pk2(s[0 * 33], s[1 * 33]); o.y = pk2(s[2 * 33], s[3 * 33]); o.z = pk2(s[4 * 33], s[5 * 33]); o.w = pk2(s[6 * 33], s[7 * 33]);
        *(v4u*)(WT + (size_t)(drow0 + n) * K + k0 + 8 * c) = o; }
    LDS_WAIT(); asm volatile("" ::: "memory");
}
__device__ __forceinline__ int win_row(int n) { return n < 3072 ? n : (n < CPA ? PC_LORA + (n - 3072) : (n < CPA + 4096 ? PC_GDN + (n - CPA) : n)); }

__device__ __forceinline__ void ph_pre(const Args& a, LAS unsigned char* lds) {
    const int tid = threadIdx.x, lane = tid & 63, wave = __builtin_amdgcn_readfirstlane(tid >> 6);
    const int G = gridDim.x;
    LAS float* ca = (LAS float*)lds;
    LAS float* red = (LAS float*)(lds + 2048 * 9 * 4);
    for (int i = tid; i < 9 * 2048; i += NTHR) { const int c = i / 2048, k = i - c * 2048; const float v = c == 0 ? a.in[I_CCTX][k] : a.in[I_C][(c - 1) * 2048 + k]; ca[k * 9 + c] = siluf_(v); }
    __syncthreads();
    float* MOD = (float*)(a.ws + WS_MOD);
    for (int task = blockIdx.x; task < 4 * 96; task += G) {
        const int l = task / 96, cb = task - l * 96;
        const float* wp = a.in[I_MODW] + ((size_t)l * 2048 + wave * 256) * 12288 + cb * 128 + lane * 2;
        float acc[9][2];
#pragma unroll
        for (int c = 0; c < 9; ++c) { acc[c][0] = 0.f; acc[c][1] = 0.f; }
        for (int k8 = 0; k8 < 256; k8 += 8) {
            f32x2 wv[8];
#pragma unroll
            for (int j = 0; j < 8; ++j) wv[j] = *(const f32x2*)(wp + (size_t)(k8 + j) * 12288);
#pragma unroll
            for (int j = 0; j < 8; ++j) { const LAS float* cp = ca + (wave * 256 + k8 + j) * 9;
#pragma unroll
                for (int c = 0; c < 9; ++c) { const float s = cp[c]; acc[c][0] += s * wv[j].x; acc[c][1] += s * wv[j].y; } }
        }
#pragma unroll
        for (int c = 0; c < 9; ++c) { red[(wave * 18 + c * 2) * 64 + lane] = acc[c][0]; red[(wave * 18 + c * 2 + 1) * 64 + lane] = acc[c][1]; }
        __syncthreads();
        for (int o = tid; o < 9 * 128; o += NTHR) { const int c = o >> 7, col = o & 127, ln = col >> 1, j = col & 1; float s = a.in[I_MODB][l * 12288 + cb * 128 + col];
#pragma unroll
            for (int w = 0; w < 8; ++w) s += red[(w * 18 + c * 2 + j) * 64 + ln];
            MOD[((size_t)l * 9 + c) * 12288 + cb * 128 + col] = s; }
        __syncthreads();
    }
    __syncthreads();
    LAS float* scr = (LAS float*)(lds + wave * 16384);
    const int gw = blockIdx.x * NWAVES + wave, NGW = G * NWAVES;
    bf16* WIN = (bf16*)(a.ws + WS_WIN); bf16* WOUT = (bf16*)(a.ws + WS_WOUT); bf16* WGU = (bf16*)(a.ws + WS_WGU); bf16* WDN = (bf16*)(a.ws + WS_WDN); bf16* WPOOL = (bf16*)(a.ws + WS_WPOOL);
    constexpr int IT_WIN = 32 * 238, IT_WOUT = 32 * 64, IT_GU = 32 * 176, IT_DN = 88 * 64, IT_POOL = 8 * 16;
    constexpr int NITEMS = 2 * IT_WIN + 2 * IT_WOUT + 8 * IT_GU + 4 * IT_DN + 8 * IT_POOL;
    for (int it = gw; it < NITEMS; it += NGW) {
        int r = it;
        if (r < 2 * IT_WIN) { const int i = r / IT_WIN; r -= i * IT_WIN; const int kb = r / 238, nb = r - kb * 238;
            conv_item(a.in[I_WIN] + (size_t)i * 2048 * 7616, 2048, 7616, WIN + (size_t)i * PW * 2048, win_row(32 * nb), scr, kb, nb, lane); continue; } r -= 2 * IT_WIN;
        if (r < 2 * IT_WOUT) { const int i = r / IT_WOUT; r -= i * IT_WOUT; const int kb = r / 64, nb = r - kb * 64;
            conv_item(a.in[I_WOUT] + (size_t)i * 2048 * 2048, 2048, 2048, WOUT + (size_t)i * 2048 * 2048, 32 * nb, scr, kb, nb, lane); continue; } r -= 2 * IT_WOUT;
        if (r < 8 * IT_GU) { const int li = r / IT_GU; r -= li * IT_GU; const int l = li >> 1, up = li & 1; const int kb = r / 176, nb = r - kb * 176; const int n0 = 32 * nb;
            conv_item(a.in[up ? I_WU : I_WG] + (size_t)l * 2048 * DFF, 2048, DFF, WGU + (size_t)l * 11264 * 2048, (n0 >> 7) * 256 + up * 128 + (n0 & 127), scr, kb, nb, lane); continue; } r -= 8 * IT_GU;
        if (r < 4 * IT_DN) { const int l = r / IT_DN; r -= l * IT_DN; const int kb = r / 64, nb = r - kb * 64;
            conv_item(a.in[I_WD] + (size_t)l * DFF * 2048, DFF, 2048, WDN + (size_t)l * 2048 * DFF, 32 * nb, scr, kb, nb, lane); continue; } r -= 4 * IT_DN;
        { const int ig = r / IT_POOL; r -= ig * IT_POOL; const int kb = r / 16, nb = r - kb * 16;
            conv_item(a.in[I_POOLW] + (size_t)ig * 512 * 512, 512, 512, WPOOL + (size_t)ig * 512 * 512, 32 * nb, scr, kb, nb, lane); }
    }
    for (int r = gw; r < 128; r += NGW) { bf16* row = WIN + ((size_t)(r >> 6) * PW + 7616 + (r & 63)) * 2048; const v4u z = {0u, 0u, 0u, 0u};
#pragma unroll
        for (int j = 0; j < 4; ++j) *(v4u*)(row + (j * 64 + lane) * 8) = z; }
}

__device__ __forceinline__ void ph_norm(const Args& a, int l, int which) {
    const int tid = threadIdx.x, lane = tid & 63, wave = __builtin_amdgcn_readfirstlane(tid >> 6);
    const int gw = blockIdx.x * NWAVES + wave, NGW = gridDim.x * NWAVES;
    const float* nw = a.in[which ? I_NFFN : I_NMIX] + l * 2048;
    const float* MOD = (const float*)(a.ws + WS_MOD) + (size_t)l * 9 * 12288;
    bf16* H = (bf16*)(a.ws + WS_H);
    const bool from_in = (l == 0 && which == 0);
    for (int m = gw; m < NTOK; m += NGW) {
        const float* xr = from_in ? (m < NPROMPT ? a.in[I_XP] + (size_t)m * D : a.in[I_XS] + (size_t)(m - NPROMPT) * D) : a.out + (size_t)m * D;
        const int cond = m < NPROMPT ? 0 : 1 + ((m - NPROMPT) >> 10);
        const float* sh = MOD + (size_t)cond * 12288 + (which ? 3 : 0) * 2048; const float* sc = sh + 2048;
        f32x4 v[8]; float s = 0.f;
#pragma unroll
        for (int j = 0; j < 8; ++j) { v[j] = *(const f32x4*)(xr + 4 * lane + 256 * j); s += (v[j].x * v[j].x + v[j].y * v[j].y) + (v[j].z * v[j].z + v[j].w * v[j].w); }
        const float rstd = 1.0f / sqrtf(wave_sum(s) * (1.0f / D) + RMS_EPS);
#pragma unroll
        for (int j = 0; j < 8; ++j) { const int c = 4 * lane + 256 * j; const f32x4 w = *(const f32x4*)(nw + c), s1 = *(const f32x4*)(sc + c), s0 = *(const f32x4*)(sh + c);
            const f32x4 y = (v[j] * rstd) * w * (s1 + 1.0f) + s0;
            v2u o; o.x = pk2(y.x, y.y); o.y = pk2(y.z, y.w); *(v2u*)(H + (size_t)m * D + c) = o; }
    }
}
__device__ __forceinline__ void ph_final(const Args& a) {
    const int tid = threadIdx.x, lane = tid & 63, wave = __builtin_amdgcn_readfirstlane(tid >> 6);
    const int gw = blockIdx.x * NWAVES + wave, NGW = gridDim.x * NWAVES;
    const float* nw = a.in[I_NFIN];
    for (int m = gw; m < NTOK; m += NGW) {
        float* xr = a.out + (size_t)m * D;
        f32x4 v[8]; float s = 0.f;
#pragma unroll
        for (int j = 0; j < 8; ++j) { v[j] = *(const f32x4*)(xr + 4 * lane + 256 * j); s += (v[j].x * v[j].x + v[j].y * v[j].y) + (v[j].z * v[j].z + v[j].w * v[j].w); }
        const float rstd = 1.0f / sqrtf(wave_sum(s) * (1.0f / D) + RMS_EPS);
#pragma unroll
        for (int j = 0; j < 8; ++j) { const int c = 4 * lane + 256 * j; const f32x4 w = *(const f32x4*)(nw + c); *(f32x4*)(xr + c) = (v[j] * rstd) * w; }
    }
}
__device__ __forceinline__ void ph_pool(const Args& a) {
    const int tid = threadIdx.x, lane = tid & 63, wave = __builtin_amdgcn_readfirstlane(tid >> 6);
    const int gw = blockIdx.x * NWAVES + wave, NGW = gridDim.x * NWAVES;
    const bf16* H = (const bf16*)(a.ws + WS_H); bf16* O = (bf16*)(a.ws + WS_O);
    for (int m = gw; m < NTOK; m += NGW) {
        const bool samp = m >= NPROMPT; const int T = samp ? 1024 : 256; const int base = samp ? NPROMPT + (((m - NPROMPT) >> 10) << 10) : (m >> 8) << 8; const int t = m - base;
#pragma unroll
        for (int g = 0; g < 4; ++g) {
            const int win = 2 << g; int lo = t - win / 2, hi = lo + win; lo = lo < 0 ? 0 : lo; hi = hi > T ? T : hi;
            const int c = g * 512 + lane * 8;
            float s[8];
#pragma unroll
            for (int e = 0; e < 8; ++e) s[e] = 0.f;
            for (int r = lo; r < hi; ++r) { const v4u w = *(const v4u*)(H + (size_t)(base + r) * D + c);
                s[0] += bflo(w.x); s[1] += bfhi(w.x); s[2] += bflo(w.y); s[3] += bfhi(w.y); s[4] += bflo(w.z); s[5] += bfhi(w.z); s[6] += bflo(w.w); s[7] += bfhi(w.w); }
            const float inv = 1.0f / (float)(hi - lo);
            const v4u w = *(const v4u*)(H + (size_t)m * D + c);
            v4u o; o.x = pk2(s[0] * inv - bflo(w.x), s[1] * inv - bfhi(w.x)); o.y = pk2(s[2] * inv - bflo(w.y), s[3] * inv - bfhi(w.y));
            o.z = pk2(s[4] * inv - bflo(w.z), s[5] * inv - bfhi(w.z)); o.w = pk2(s[6] * inv - bflo(w.w), s[7] * inv - bfhi(w.w));
            *(v4u*)(O + (size_t)m * D + c) = o;
        }
    }
}

__device__ __forceinline__ void ph_prep(const Args& a, LAS unsigned char* lds, int i) {
    const int tid = threadIdx.x, lane = tid & 63, wave = __builtin_amdgcn_readfirstlane(tid >> 6);
    const bf16* P = (const bf16*)(a.ws + WS_P);
    float* SC = (float*)(a.ws + WS_SC); constexpr size_t S1 = (size_t)NTOK * 1024;
    float *Rb = SC, *Vb = SC + S1, *Ab = SC + 2 * S1, *Wb = SC + 3 * S1, *Kb = SC + 5 * S1, *Bb = SC + 7 * S1, *GT = SC + 9 * S1, *Qb = SC + 10 * S1, *KDb = SC + 11 * S1, *VDb = SC + 12 * S1;
    float* BON = (float*)(a.ws + WS_SMALL); float* BETA = BON + (size_t)NTOK * 32; float* GG = BETA + (size_t)NTOK * 16;
    const float* MU = a.in[I_MU] + i * CPA;
    LAS float* pa = (LAS float*)lds;
    for (int tile = blockIdx.x; tile < NTOK / 8; tile += gridDim.x) {
        const int m0 = tile * 8; const bool samp = m0 >= NPROMPT; const int T = samp ? 1024 : 256;
        const int base = samp ? NPROMPT + (((m0 - NPROMPT) >> 10) << 10) : (m0 >> 8) << 8; const int t0 = m0 - base;
        for (int idx = tid; idx < 8 * CPA; idx += NTHR) {
            const int tt = idx / CPA, j = idx - tt * CPA; const int c = j < 3072 ? j : j + (PC_LORA - 3072); const int t = t0 + tt, m = m0 + tt;
            int dt; bool valid;
            if (!samp) { if (j & 1) { dt = 1; valid = t + 1 < T; } else { dt = -1; valid = t > 0; } }
            else { const int q = j & 3, col = t & 63, row = t >> 6;
                if (q == 0) { dt = -1; valid = col > 0; } else if (q == 1) { dt = 1; valid = col < 63; } else if (q == 2) { dt = -64; valid = row > 0; } else { dt = 64; valid = row < 15; } }
            const float x = bf2f(P[(size_t)m * PW + c]); const float xs = valid ? bf2f(P[(size_t)(m + dt) * PW + c]) : 0.f;
            float v = x + (xs - x) * MU[j];
            if (j >= 3072 && j < 3200) v = tanhf(v); else if (j >= 3328) v = sigmoidf_(v);
            pa[tt * CPA + j] = v;
        }
        __syncthreads();
        for (int cc = 0; cc < 2; ++cc) {
            const int c = tid + cc * 512; const int head = c >> 6;
            float wl[2][8], al[2][8], gl[8];
#pragma unroll
            for (int tt = 0; tt < 8; ++tt) { wl[0][tt] = wl[1][tt] = al[0][tt] = al[1][tt] = gl[tt] = 0.f; }
#pragma unroll
            for (int d = 0; d < 2; ++d) {
                const float* w2 = a.in[I_W2] + ((size_t)(i * 2 + d) * 64) * 1024 + c; const float* a2 = a.in[I_A2] + ((size_t)(i * 2 + d) * 64) * 1024 + c;
                for (int r = 0; r < 64; ++r) { const float w2v = w2[(size_t)r * 1024], a2v = a2[(size_t)r * 1024];
#pragma unroll
                    for (int tt = 0; tt < 8; ++tt) { wl[d][tt] += pa[tt * CPA + 3072 + d * 64 + r] * w2v; al[d][tt] += pa[tt * CPA + 3200 + d * 64 + r] * a2v; } }
            }
            { const float* g2 = a.in[I_G2] + (size_t)i * 160 * 1024 + c;
                for (int r = 0; r < 160; ++r) { const float g2v = g2[(size_t)r * 1024];
#pragma unroll
                    for (int tt = 0; tt < 8; ++tt) gl[tt] += pa[tt * CPA + 3328 + r] * g2v; } }
            const float kkw = a.in[I_KK][i * 1024 + c], kaw = a.in[I_KA][i * 1024 + c], rkw = a.in[I_RK][i * 1024 + c];
            const float w0v[2] = {a.in[I_W0][(i * 2 + 0) * 1024 + c], a.in[I_W0][(i * 2 + 1) * 1024 + c]}, a0v[2] = {a.in[I_A0][(i * 2 + 0) * 1024 + c], a.in[I_A0][(i * 2 + 1) * 1024 + c]};
#pragma unroll
            for (int tt = 0; tt < 8; ++tt) {
                const size_t o = (size_t)(m0 + tt) * 1024 + c;
                const float r_ = pa[tt * CPA + c], k_ = pa[tt * CPA + 1024 + c], v_ = pa[tt * CPA + 2048 + c];
                const float kkr = k_ * kkw; const float ss = wave_sum(kkr * kkr); const float kk = kkr * (1.0f / sqrtf(ss + 1e-12f));
                Rb[o] = r_; Vb[o] = v_; Ab[o] = -kk; GT[o] = gl[tt];
#pragma unroll
                for (int d = 0; d < 2; ++d) {
                    const float u = w0v[d] + wl[d][tt]; const float w = __expf(-0.6065306597f * sigmoidf_(u)); const float ic = sigmoidf_(a0v[d] + al[d][tt]);
                    const float kd = k_ * (1.0f + (ic - 1.0f) * kaw);
                    Wb[d * S1 + o] = w; Kb[d * S1 + o] = kd; Bb[d * S1 + o] = kk * ic;
                    const float bon = wave_sum(r_ * kd * rkw);
                    if (lane == 0) BON[((size_t)(m0 + tt) * 2 + d) * 16 + head] = bon;
                }
            }
        }
        {
            const int h = wave; const float* cw = a.in[I_CONVW] + (size_t)i * 3 * 3072;
            for (int tt = 0; tt < 8; ++tt) {
                const int m = m0 + tt, t = t0 + tt; float val[3][2];
#pragma unroll
                for (int part = 0; part < 3; ++part)
#pragma unroll
                    for (int e = 0; e < 2; ++e) { const int ch = part * 1024 + h * 128 + lane + 64 * e;
                        const float x0 = t > 0 ? bf2f(P[(size_t)(m - 1) * PW + PC_GDN + ch]) : 0.f, x1 = bf2f(P[(size_t)m * PW + PC_GDN + ch]), x2 = t + 1 < T ? bf2f(P[(size_t)(m + 1) * PW + PC_GDN + ch]) : 0.f;
                        val[part][e] = siluf_(x0 * cw[ch] + x1 * cw[3072 + ch] + x2 * cw[2 * 3072 + ch]); }
                const float qs = 1.0f / sqrtf(wave_sum(val[0][0] * val[0][0] + val[0][1] * val[0][1]) + 1e-6f), ks = 1.0f / sqrtf(wave_sum(val[1][0] * val[1][0] + val[1][1] * val[1][1]) + 1e-6f);
#pragma unroll
                for (int e = 0; e < 2; ++e) { const size_t o = (size_t)m * 1024 + h * 128 + lane + 64 * e; Qb[o] = val[0][e] * qs; KDb[o] = val[1][e] * ks; VDb[o] = val[2][e]; }
            }
            if (tid < 128) { const int tt = tid >> 4, dh = tid & 15; const int m = m0 + tt;
                BETA[(size_t)m * 16 + dh] = sigmoidf_(bf2f(P[(size_t)m * PW + PC_BETA + dh]));
                GG[(size_t)m * 16 + dh] = -__expf(a.in[I_ALOG][i * 16 + dh]) * softplusf_(bf2f(P[(size_t)m * PW + PC_ALPHA + dh]) + a.in[I_DTB][i * 16 + dh]); }
        }
        __syncthreads();
    }
}

__device__ __forceinline__ void rwkv_task(const Args& a, int i, int s, int h, int d, int lane) {
    const float* SC = (const float*)(a.ws + WS_SC); constexpr size_t S1 = (size_t)NTOK * 1024;
    const float *Rb = SC, *Vb = SC + S1, *Ab = SC + 2 * S1, *Wb = SC + 3 * S1 + d * S1, *Kb = SC + 5 * S1 + d * S1, *Bb = SC + 7 * S1 + d * S1;
    float* Y = (float*)(a.ws + WS_Y) + d * S1;
    const int T = s < 16 ? 256 : 1024; const int row0 = s < 16 ? s * 256 : NPROMPT + (s - 16) * 1024;
    float S[64];
    if (s >= 16) { const float* s0 = a.in[I_SRW] + ((((size_t)(s - 16) * 2 + i) * 2 + d) * 16 + h) * 4096 + lane * 64;
#pragma unroll
        for (int k = 0; k < 64; k += 4) { const f32x4 v = *(const f32x4*)(s0 + k); S[k] = v.x; S[k + 1] = v.y; S[k + 2] = v.z; S[k + 3] = v.w; } }
    else {
#pragma unroll
        for (int k = 0; k < 64; ++k) S[k] = 0.f; }
    size_t o = (size_t)(row0 + (d ? T - 1 : 0)) * 1024 + h * 64 + lane; const long step = d ? -1024 : 1024;
    float av = Ab[o], wv = Wb[o], bv = Bb[o], kv = Kb[o], rv = Rb[o], vv = Vb[o];
    for (int n = 0; n < T; ++n) {
        const size_t on = (n + 1 < T) ? o + step : o;
        const float av2 = Ab[on], wv2 = Wb[on], bv2 = Bb[on], kv2 = Kb[on], rv2 = Rb[on], vv2 = Vb[on];
        float sa = 0.f;
#pragma unroll
        for (int k = 0; k < 64; ++k) sa += S[k] * rdl(av, k);
        float y = 0.f;
#pragma unroll
        for (int k = 0; k < 64; ++k) { S[k] = S[k] * rdl(wv, k) + (sa * rdl(bv, k) + vv * rdl(kv, k)); y += S[k] * rdl(rv, k); }
        Y[o] = y;
        o = on; av = av2; wv = wv2; bv = bv2; kv = kv2; rv = rv2; vv = vv2;
    }
    if (s < 16) { float* so = a.out + OUT_SRW + ((((size_t)s * 2 + i) * 2 + d) * 16 + h) * 4096 + lane * 64;
#pragma unroll
        for (int k = 0; k < 64; k += 4) *(f32x4*)(so + k) = (f32x4){S[k], S[k + 1], S[k + 2], S[k + 3]}; }
}
__device__ __forceinline__ void gdn_task(const Args& a, int i, int s, int h, int d, int half, int lane) {
    const float* SC = (const float*)(a.ws + WS_SC); constexpr size_t S1 = (size_t)NTOK * 1024;
    const float *Qb = SC + 10 * S1, *KDb = SC + 11 * S1, *VDb = SC + 12 * S1;
    const float* BETA = (const float*)(a.ws + WS_SMALL) + (size_t)NTOK * 32; const float* GG = BETA + (size_t)NTOK * 16;
    float* O = (float*)(a.ws + WS_Y) + 2 * S1 + d * S1;
    const int T = s < 16 ? 256 : 1024; const int row0 = s < 16 ? s * 256 : NPROMPT + (s - 16) * 1024;
    float S[128];
    if (s >= 16) { const float* s0 = a.in[I_SDL] + ((((size_t)(s - 16) * 2 + i) * 2 + d) * 8 + h) * 16384 + half * 64 + lane;
#pragma unroll
        for (int k = 0; k < 128; ++k) S[k] = s0[k * 128]; }
    else {
#pragma unroll
        for (int k = 0; k < 128; ++k) S[k] = 0.f; }
    int m = row0 + (d ? T - 1 : 0); const int step = d ? -1 : 1;
    size_t o = (size_t)m * 1024 + h * 128 + lane;
    float k0 = KDb[o], k1 = KDb[o + 64], q0 = Qb[o], q1 = Qb[o + 64], vv = VDb[o + half * 64], be = BETA[(size_t)m * 16 + d * 8 + h], gg = GG[(size_t)m * 16 + d * 8 + h];
    for (int n = 0; n < T; ++n) {
        const int mn = (n + 1 < T) ? m + step : m; const size_t on = (size_t)mn * 1024 + h * 128 + lane;
        const float k0n = KDb[on], k1n = KDb[on + 64], q0n = Qb[on], q1n = Qb[on + 64], vvn = VDb[on + half * 64], ben = BETA[(size_t)mn * 16 + d * 8 + h], ggn = GG[(size_t)mn * 16 + d * 8 + h];
        const float eg = __expf(gg);
        float ks = 0.f;
#pragma unroll
        for (int k = 0; k < 64; ++k) { ks += S[k] * rdl(k0, k); }
#pragma unroll
        for (int k = 0; k < 64; ++k) { ks += S[64 + k] * rdl(k1, k); }
        const float vn = be * (vv - eg * ks);
        float oo = 0.f;
#pragma unroll
        for (int k = 0; k < 64; ++k) { S[k] = eg * S[k] + rdl(k0, k) * vn; oo += S[k] * rdl(q0, k); }
#pragma unroll
        for (int k = 0; k < 64; ++k) { S[64 + k] = eg * S[64 + k] + rdl(k1, k) * vn; oo += S[64 + k] * rdl(q1, k); }
        O[(size_t)m * 1024 + h * 128 + half * 64 + lane] = oo * 0.08838834764831845f;
        m = mn; k0 = k0n; k1 = k1n; q0 = q0n; q1 = q1n; vv = vvn; be = ben; gg = ggn;
    }
    if (s < 16) { float* so = a.out + OUT_SDL + ((((size_t)s * 2 + i) * 2 + d) * 8 + h) * 16384 + half * 64 + lane;
#pragma unroll
        for (int k = 0; k < 128; ++k) so[k * 128] = S[k]; }
}
__device__ __forceinline__ void ph_scan(const Args& a, int i) {
    const int tid = threadIdx.x, lane = tid & 63, wave = __builtin_amdgcn_readfirstlane(tid >> 6);
    const int G = gridDim.x;
    for (int task = wave * G + blockIdx.x; task < 1536; task += NWAVES * G) {
        if (task < 768) { int s, r; if (task < 256) { s = 16 + (task >> 5); r = task & 31; } else { s = (task - 256) >> 5; r = (task - 256) & 31; }
            rwkv_task(a, i, s, r >> 1, r & 1, lane); }
        else { const int tk = task - 768; int s, r; if (tk < 256) { s = 16 + (tk >> 5); r = tk & 31; } else { s = (tk - 256) >> 5; r = (tk - 256) & 31; }
            gdn_task(a, i, s, r >> 2, (r >> 1) & 1, r & 1, lane); }
    }
}
__device__ __forceinline__ void ph_post(const Args& a, int i) {
    const int tid = threadIdx.x, lane = tid & 63, wave = __builtin_amdgcn_readfirstlane(tid >> 6);
    const int gw = blockIdx.x * NWAVES + wave, NGW = gridDim.x * NWAVES;
    const float* SC = (const float*)(a.ws + WS_SC); constexpr size_t S1 = (size_t)NTOK * 1024;
    const float *Vb = SC + S1, *GT = SC + 9 * S1; const float* Y = (const float*)(a.ws + WS_Y); const float* OG = Y + 2 * S1;
    const float* BON = (const float*)(a.ws + WS_SMALL); const bf16* P = (const bf16*)(a.ws + WS_P); bf16* O = (bf16*)(a.ws + WS_O);
    const float* lnw = a.in[I_LNW] + i * 1024; const float* lnb = a.in[I_LNB] + i * 1024; const float* gnw = a.in[I_GNW] + i * 128;
    for (int m = gw; m < NTOK; m += NGW) {
        for (int h = 0; h < 16; ++h) { const size_t o = (size_t)m * 1024 + h * 64 + lane; const float v = Vb[o]; float acc = 0.f;
#pragma unroll
            for (int d = 0; d < 2; ++d) { const float y = Y[d * S1 + o]; const float mu = wave_sum(y) * (1.0f / 64.0f); const float dy = y - mu; const float var = wave_sum(dy * dy) * (1.0f / 64.0f);
                acc += dy * (1.0f / sqrtf(var + GN_EPS)) * lnw[h * 64 + lane] + lnb[h * 64 + lane] + BON[((size_t)m * 2 + d) * 16 + h] * v; }
            O[(size_t)m * D + h * 64 + lane] = (bf16)f2bf(acc * GT[o]); }
        for (int h = 0; h < 8; ++h) { float ov[2]; float ss = 0.f;
#pragma unroll
            for (int e = 0; e < 2; ++e) { const size_t o = (size_t)m * 1024 + h * 128 + lane + 64 * e; ov[e] = OG[o] + OG[S1 + o]; ss += ov[e] * ov[e]; }
            const float rs = 1.0f / sqrtf(wave_sum(ss) * (1.0f / 128.0f) + RMS_EPS);
#pragma unroll
            for (int e = 0; e < 2; ++e) { const int j = lane + 64 * e; const float z = bf2f(P[(size_t)m * PW + PC_Z + h * 128 + j]);
                O[(size_t)m * D + 1024 + h * 128 + j] = (bf16)f2bf(ov[e] * rs * gnw[j] * siluf_(z)); } }
    }
}

constexpr int PH_PER_LAYER = 9, N_PHASES = 2 + 4 * PH_PER_LAYER;
__host__ __device__ inline bool phase_exists(int ph) { if (ph == 0 || ph == N_PHASES - 1) return true; const int l = (ph - 1) / PH_PER_LAYER, k = (ph - 1) % PH_PER_LAYER; return (l & 1) ? !(k == 2 || k == 3 || k == 4) : true; }

#define RUN(ph) (a.ph_lo <= (ph) && (ph) < a.ph_hi)
#define SEAM(ph) do { if ((ph) + 1 < a.ph_hi) xcd_barrier(bar); } while (0)
template <int L> __device__ __forceinline__ void run_layer(const Args& a, LAS unsigned char* lds, const XcdBarrier& bar) {
    constexpr int l = L, pb = 1 + PH_PER_LAYER * L, i = L >> 1;
    const int G = gridDim.x, bx = blockIdx.x;
    bf16* H = (bf16*)(a.ws + WS_H); bf16* O = (bf16*)(a.ws + WS_O); bf16* P = (bf16*)(a.ws + WS_P);
    const float* modl = (const float*)(a.ws + WS_MOD) + (size_t)l * 9 * 12288;
    if (RUN(pb + 0)) { ph_norm(a, l, 0); SEAM(pb + 0); }
    if constexpr ((L & 1) == 0) {
        if (RUN(pb + 1)) { pg8::Gemm g{H, (const bf16*)(a.ws + WS_WIN) + (size_t)i * PW * 2048, NTOK, PW, 2048, 2048, 2048, 0, 0}; pg8::StaticOrder S; S.init(NTOK, PW, G, bx);
            pg8::EpiBf16 E{P, PW}; pg8::gemm_phase<pg8::EpiBf16, pg8::StaticOrder, true, true>(lds, g, S, E); SEAM(pb + 1); }
        if (RUN(pb + 2)) { ph_prep(a, lds, i); SEAM(pb + 2); }
        if (RUN(pb + 3)) { ph_scan(a, i); SEAM(pb + 3); }
        if (RUN(pb + 4)) { ph_post(a, i); SEAM(pb + 4); }
        if (RUN(pb + 5)) { pg8::Gemm g{O, (const bf16*)(a.ws + WS_WOUT) + (size_t)i * 2048 * 2048, NTOK, 2048, 2048, 2048, 2048, 0, 0}; pg8::StaticOrder S; S.init(NTOK, 2048, G, bx);
            pg8::EpiResid E{l == 0 ? a.in[I_XP] : nullptr, a.in[I_XS], a.out, modl + 2 * 2048, nullptr};
            pg8::gemm_phase<pg8::EpiResid, pg8::StaticOrder, true, true>(lds, g, S, E); SEAM(pb + 5); }
    } else {
        if (RUN(pb + 1)) { ph_pool(a); SEAM(pb + 1); }
        if (RUN(pb + 5)) { pg8::Gemm g{O, (const bf16*)(a.ws + WS_WPOOL) + (size_t)i * 2048 * 512, NTOK, 2048, 512, 2048, 512, 1, 512}; pg8::StaticOrder S; S.init(NTOK, 2048, G, bx);
            pg8::EpiResid E{nullptr, nullptr, a.out, modl + 2 * 2048, a.in[I_POOLS] + i * 2048};
            pg8::gemm_phase<pg8::EpiResid, pg8::StaticOrder, true, true>(lds, g, S, E); SEAM(pb + 5); }
    }
    if (RUN(pb + 6)) { ph_norm(a, l, 1); SEAM(pb + 6); }
    if (RUN(pb + 7)) { pg8::Gemm g{H, (const bf16*)(a.ws + WS_WGU) + (size_t)l * 11264 * 2048, NTOK, 11264, 2048, 2048, 2048, 0, 0}; pg8::StaticOrder S; S.init(NTOK, 11264, G, bx);
        pg8::EpiSwiGLU E{P, DFF}; pg8::gemm_phase<pg8::EpiSwiGLU, pg8::StaticOrder, true, true>(lds, g, S, E); SEAM(pb + 7); }
    if (RUN(pb + 8)) { pg8::Gemm g{P, (const bf16*)(a.ws + WS_WDN) + (size_t)l * 2048 * DFF, NTOK, 2048, DFF, DFF, DFF, 0, 0}; pg8::StaticOrder S; S.init(NTOK, 2048, G, bx);
        pg8::EpiResid E{nullptr, nullptr, a.out, modl + 5 * 2048, nullptr};
        pg8::gemm_phase<pg8::EpiResid, pg8::StaticOrder, true, true>(lds, g, S, E); SEAM(pb + 8); }
}

__global__ void __launch_bounds__(NTHR, 2) fwd(Args a) {
    extern __shared__ __attribute__((aligned(16))) unsigned char lds_raw[];
    LAS unsigned char* lds = (LAS unsigned char*)lds_raw;
    const int tid = threadIdx.x;
    volatile LAS unsigned* MISC = (volatile LAS unsigned*)(lds + LDS_MISC);
    for (int u = tid; u < (LDS_BYTES - LDS_STAGE) / 4; u += NTHR) ((LAS unsigned*)(lds + LDS_STAGE))[u] = 0u;
    __syncthreads();
    XcdBarrier bar; bar.bar = (unsigned*)(a.ws + WS_CTL) + CW_BAR; bar.x = 0; bar.st = nullptr;
    const bool multi = a.ph_hi - a.ph_lo > 1;
    if (multi) bar = xcd_barrier_post((unsigned*)(a.ws + WS_CTL) + CW_BAR, MISC + 8);
    if (RUN(0)) { ph_pre(a, lds); SEAM(0); }
    run_layer<0>(a, lds, bar);
    run_layer<1>(a, lds, bar);
    run_layer<2>(a, lds, bar);
    run_layer<3>(a, lds, bar);
    if (RUN(N_PHASES - 1)) ph_final(a);
}
#undef RUN
#undef SEAM

#ifndef MK_ONE_LAUNCH
#define MK_ONE_LAUNCH 0
#endif
extern "C" void kernel_launch(void* const* d_in, const int* in_sizes, int n_in, void* d_out, int out_size, void* d_ws, size_t ws_size, hipStream_t stream) {
    static int grid = 0;
    if (grid == 0) {
        if (n_in != N_IN || ws_size < WS_END) { fprintf(stderr, "kernel_launch: expected %d inputs and >= %zu bytes of workspace; got %d, %zu\n", (int)N_IN, (size_t)WS_END, n_in, ws_size); grid = -1; return; }
        int dev = 0, cus = 0, per_cu = 0;
        if (hipGetDevice(&dev) != hipSuccess || hipDeviceGetAttribute(&cus, hipDeviceAttributeMultiprocessorCount, dev) != hipSuccess) { grid = -1; return; }
        if (hipFuncSetAttribute((const void*)fwd, hipFuncAttributeMaxDynamicSharedMemorySize, LDS_BYTES) != hipSuccess) { fprintf(stderr, "kernel_launch: hipFuncSetAttribute failed\n"); grid = -1; return; }
        if (hipOccupancyMaxActiveBlocksPerMultiprocessor(&per_cu, (const void*)fwd, NTHR, LDS_BYTES) != hipSuccess || per_cu < 1) fprintf(stderr, "kernel_launch: occupancy query reports %d\n", per_cu);
        (void)hipGetLastError();
        grid = cus;
    }
    if (grid < 0) return;
    if (hipMemsetAsync((char*)d_ws + WS_CTL, 0, CTL_ZERO_BYTES, stream) != hipSuccess) return;
    Args a{};
    for (int i = 0; i < N_IN; ++i) a.in[i] = (const float*)d_in[i];
    a.out = (float*)d_out; a.ws = (unsigned char*)d_ws;
#if MK_ONE_LAUNCH
    a.ph_lo = 0; a.ph_hi = N_PHASES;
    hipLaunchKernelGGL(fwd, dim3(grid), dim3(NTHR), LDS_BYTES, stream, a);
#else
    for (int ph = 0; ph < N_PHASES; ++ph) { if (!phase_exists(ph)) continue; a.ph_lo = ph; a.ph_hi = ph + 1; hipLaunchKernelGGL(fwd, dim3(grid), dim3(NTHR), LDS_BYTES, stream, a); }
#endif
}
```

```cpp
#include <hip/hip_runtime.h>
#include <cstdio>
#include <cstdint>

namespace pg8 {
#define PG8_LAS __attribute__((address_space(3)))
typedef unsigned short bf16_t;
typedef short bf16x8 __attribute__((ext_vector_type(8)));
typedef float f32x4 __attribute__((ext_vector_type(4)));
typedef unsigned u32x4 __attribute__((ext_vector_type(4)));
constexpr int BM = 256, BK = 64, HALF = 128, HTB = HALF * BK * 2  , STAGE_BYTES = 8 * HTB, NXCD = 8, WGM = 8;

__host__ __device__ __forceinline__ int lds_byte(int r, int c) { const int st = (r >> 4) * 2 + (c >> 5), rr = r & 15, cc = c & 31, ob = rr * 64 + cc * 2; return st * 1024 + (ob ^ (((ob >> 9) & 1) << 5)); }
__host__ __device__ __forceinline__ void stage_rc(int b, int& R, int& C) { const int st = b / 1024, sb = b % 1024, swz = sb ^ (((sb >> 9) & 1) << 5); R = (st >> 1) * 16 + swz / 64; C = (st & 1) * 32 + (swz % 64) / 2; }
__host__ __device__ __forceinline__ int perm32(int rho) { const int n = rho >> 4, i = rho & 15; return 8 * (i >> 2) + 4 * n + (i & 3); }

struct Unit { int pm, pn; };
struct Gemm { const bf16_t* A; const bf16_t* Bt; int M, N, K, lda, ldb, gsh, gk; };

struct StaticOrder {
    int nM, nN, nwg, G, c;
    __host__ __device__ void init(int M, int N, int G_, int c_) { nM = M / BM; nN = N / BM; nwg = nM * nN; G = G_; c = c_; }
    __host__ __device__ bool next(int i, Unit& u) const {
        const long L = (long)i * G + c; if (L >= nwg) return false;
        int wgid = (int)L; { const int q = nwg / NXCD, r = nwg % NXCD, xcd = wgid % NXCD, off = wgid / NXCD; wgid = (xcd < r ? xcd * (q + 1) : r * (q + 1) + (xcd - r) * q) + off; }
        const int nig = WGM * nN, gid = wgid / nig, fm = gid * WGM, gsz = (nM - fm) < WGM ? (nM - fm) : WGM;
        u.pm = fm + ((wgid % nig) % gsz); u.pn = (wgid % nig) / gsz; return true;
    }
    __device__ __forceinline__ void a_ready(const Unit&) const {}
    __device__ __forceinline__ void done(const Unit&) const {}
};

__device__ __forceinline__ unsigned cvt_pk_bf16(float lo, float hi) { unsigned r; asm volatile("v_cvt_pk_bf16_f32 %0, %1, %2" : "=v"(r) : "v"(lo), "v"(hi)); return r; }

__device__ __forceinline__ int cond_of_panel(int pm) { return pm < 16 ? 0 : 1 + ((pm - 16) >> 2); }

struct EpiBf16 {
    static constexpr bool PERM = true, AFTER_DRAIN = false;
    bf16_t* O; int ldc;
    __device__ __forceinline__ void operator()(const f32x4 (&acc)[2][2][4][2], const Unit& u, int wr, int wc, int fr, int fq) const {
        const int row0 = u.pm * BM + wr * 64 + fr; const int col0 = u.pn * BM + wc * 32 + 8 * fq;
#pragma unroll
        for (int ai = 0; ai < 2; ++ai)
#pragma unroll
            for (int m = 0; m < 4; ++m) { bf16_t* rowp = O + (size_t)(row0 + ai * HALF + m * 16) * ldc + col0;
#pragma unroll
                for (int bj = 0; bj < 2; ++bj) { const f32x4 v0 = acc[ai][bj][m][0], v1 = acc[ai][bj][m][1];
                    u32x4 w; w.x = cvt_pk_bf16(v0[0], v0[1]); w.y = cvt_pk_bf16(v0[2], v0[3]); w.z = cvt_pk_bf16(v1[0], v1[1]); w.w = cvt_pk_bf16(v1[2], v1[3]);
                    *(u32x4*)(rowp + bj * HALF) = w; } }
    }
};
struct EpiSwiGLU {
    static constexpr bool PERM = true, AFTER_DRAIN = false;
    bf16_t* O; int ldc;
    __device__ __forceinline__ void operator()(const f32x4 (&acc)[2][2][4][2], const Unit& u, int wr, int wc, int fr, int fq) const {
        const int row0 = u.pm * BM + wr * 64 + fr; const int col0 = u.pn * HALF + wc * 32 + 8 * fq;
#pragma unroll
        for (int ai = 0; ai < 2; ++ai)
#pragma unroll
            for (int m = 0; m < 4; ++m) { bf16_t* rowp = O + (size_t)(row0 + ai * HALF + m * 16) * ldc + col0;
                float o[8];
#pragma unroll
                for (int n = 0; n < 2; ++n)
#pragma unroll
                    for (int e = 0; e < 4; ++e) { const float gte = acc[ai][0][m][n][e], up = acc[ai][1][m][n][e]; o[n * 4 + e] = gte * __builtin_amdgcn_rcpf(1.0f + __expf(-gte)) * up; }
                u32x4 w; w.x = cvt_pk_bf16(o[0], o[1]); w.y = cvt_pk_bf16(o[2], o[3]); w.z = cvt_pk_bf16(o[4], o[5]); w.w = cvt_pk_bf16(o[6], o[7]);
                *(u32x4*)rowp = w; }
    }
};
struct EpiResid {
    static constexpr bool PERM = false, AFTER_DRAIN = false;
    const float* xin_p; const float* xin_s; float* xout; const float* gate  ; const float* cscale;
    __device__ __forceinline__ void operator()(const f32x4 (&acc)[2][2][4][2], const Unit& u, int wr, int wc, int fr, int fq) const {
        const int row0 = u.pm * BM + wr * 64 + fr, col0 = u.pn * BM + wc * 32 + 4 * fq;
        const float* gp = gate + (size_t)cond_of_panel(u.pm) * 12288 + col0;
        f32x4 gv[2][2];
#pragma unroll
        for (int bj = 0; bj < 2; ++bj)
#pragma unroll
            for (int n = 0; n < 2; ++n) { gv[bj][n] = *(const f32x4*)(gp + bj * HALF + n * 16); if (cscale) gv[bj][n] = gv[bj][n] * *(const f32x4*)(cscale + col0 + bj * HALF + n * 16); }
#pragma unroll
        for (int ai = 0; ai < 2; ++ai)
#pragma unroll
            for (int m = 0; m < 4; ++m) { const int row = row0 + ai * HALF + m * 16;
                const float* xi = xin_p ? (row < 4096 ? xin_p + (size_t)row * 2048 : xin_s + (size_t)(row - 4096) * 2048) : xout + (size_t)row * 2048;
                float* xo = xout + (size_t)row * 2048;
#pragma unroll
                for (int bj = 0; bj < 2; ++bj)
#pragma unroll
                    for (int n = 0; n < 2; ++n) { const f32x4 xv = *(const f32x4*)(xi + col0 + bj * HALF + n * 16); *(f32x4*)(xo + col0 + bj * HALF + n * 16) = xv + gv[bj][n] * acc[ai][bj][m][n]; } }
    }
};

template <class Epi, class Sched, bool ALIGN_EPI = false, bool SP2 = false>
__device__ __forceinline__ void gemm_phase(PG8_LAS unsigned char* lds, const Gemm g, const Sched& S, const Epi& E) {
    const int tid = threadIdx.x, wid = __builtin_amdgcn_readfirstlane(tid >> 6), lane = tid & 63, wr = wid >> 2, wc = wid & 3, fr = lane & 15, fq = lane >> 4;
    const int K = g.K, nt = K / BK;
    unsigned voffA[2], voffB[2];
#pragma unroll
    for (int i = 0; i < 2; ++i) { int R, C; stage_rc(tid * 16 + i * 8192, R, C); const int Rb = Epi::PERM ? ((R & ~31) + perm32(R & 31)) : R;
        voffA[i] = (unsigned)(R * g.lda + C) * 2u; voffB[i] = (unsigned)(Rb * g.ldb + C) * 2u; }
    const size_t kstep = (size_t)(BK * 2);
    const size_t hstepA = (size_t)HALF * g.lda * 2, hstepB = (size_t)HALF * g.ldb * 2;
    const size_t tstepA = 2 * hstepA, tstepB = 2 * hstepB;
    const unsigned ldsw = (unsigned)wid * 1024u;
    const int aoff = lds_byte(wr * 64 + fr, fq * 8), boff = lds_byte(wc * 32 + fr, fq * 8);
#define PG8_SA(b, h) (((b) * 2 + (h)) * HTB)
#define PG8_SB(b, h) ((4 + (b) * 2 + (h)) * HTB)
#define PG8_STAGE(bufoff, gbase, voff) do { _Pragma("unroll") for (int _i = 0; _i < 2; ++_i) \
        __builtin_amdgcn_global_load_lds((const unsigned*)((const char*)(gbase) + (voff)[_i]), (PG8_LAS unsigned*)(lds + (bufoff) + ldsw + _i * 8192), 16, 0, 0); } while (0)
#define PG8_LDA(dst, b, h) do { _Pragma("unroll") for (int m = 0; m < 4; ++m) _Pragma("unroll") for (int k = 0; k < 2; ++k) dst[m][k] = *(const PG8_LAS bf16x8*)(lds + PG8_SA(b, h) + aoff + m * 2048 + k * 1024); } while (0)
#define PG8_LDB(dst, b, h) do { _Pragma("unroll") for (int n = 0; n < 2; ++n) _Pragma("unroll") for (int k = 0; k < 2; ++k) dst[n][k] = *(const PG8_LAS bf16x8*)(lds + PG8_SB(b, h) + boff + n * 2048 + k * 1024); } while (0)
#define PG8_MMA(ai, bj, At, Bt) do { __builtin_amdgcn_s_setprio(1); _Pragma("unroll") for (int m = 0; m < 4; ++m) _Pragma("unroll") for (int n = 0; n < 2; ++n) _Pragma("unroll") for (int k = 0; k < 2; ++k) \
        acc[ai][bj][m][n] = __builtin_amdgcn_mfma_f32_16x16x32_bf16(Bt[n][k], At[m][k], acc[ai][bj][m][n], 0, 0, 0); __builtin_amdgcn_s_setprio(0); } while (0)
#define PG8_WAIT_V(n) asm volatile("s_waitcnt vmcnt(" #n ")" ::: "memory")
#define PG8_WAIT_L(n) asm volatile("s_waitcnt lgkmcnt(" #n ")" ::: "memory")
#define PG8_BAR __builtin_amdgcn_s_barrier()
#define PG8_SCHED __builtin_amdgcn_sched_barrier(0)
    Unit cur, nxt; int ui = 0;
    if (!S.next(0, cur)) return;
    f32x4 acc[2][2][4][2];
#pragma unroll
    for (int a = 0; a < 2; ++a)
#pragma unroll
        for (int b = 0; b < 2; ++b)
#pragma unroll
            for (int m = 0; m < 4; ++m)
#pragma unroll
                for (int n = 0; n < 2; ++n) acc[a][b][m][n] = (f32x4){0.f, 0.f, 0.f, 0.f};
    bf16x8 At[4][2], B0[2][2], B1[2][2];
    const char* cA = (const char*)g.A + (size_t)cur.pm * tstepA + (size_t)((cur.pn >> g.gsh) * g.gk) * 2; const char* cB = (const char*)g.Bt + (size_t)cur.pn * tstepB;
    S.a_ready(cur);
    if constexpr (SP2) {
        PG8_STAGE(PG8_SB(0, 0), cB, voffB); PG8_STAGE(PG8_SB(0, 1), cB + hstepB, voffB); PG8_STAGE(PG8_SA(0, 0), cA, voffA); PG8_STAGE(PG8_SA(0, 1), cA + hstepA, voffA);
        if (wr == 1) PG8_BAR;
        PG8_WAIT_V(2); PG8_BAR;
        PG8_STAGE(PG8_SB(1, 0), cB + kstep, voffB); PG8_STAGE(PG8_SA(1, 0), cA + kstep, voffA); PG8_STAGE(PG8_SB(1, 1), cB + hstepB + kstep, voffB);
        PG8_WAIT_V(6); PG8_BAR;
    } else {
        PG8_STAGE(PG8_SB(0, 0), cB, voffB); PG8_STAGE(PG8_SA(0, 0), cA, voffA); PG8_STAGE(PG8_SB(0, 1), cB + hstepB, voffB); PG8_STAGE(PG8_SA(0, 1), cA + hstepA, voffA);
        if (wr == 1) PG8_BAR;
        PG8_WAIT_V(4); PG8_BAR;
        PG8_STAGE(PG8_SB(1, 0), cB + kstep, voffB); PG8_STAGE(PG8_SA(1, 0), cA + kstep, voffA); PG8_STAGE(PG8_SB(1, 1), cB + hstepB + kstep, voffB);
        PG8_WAIT_V(6); PG8_BAR;
    }
    for (;;) {
        const bool has_next = S.next(ui + 1, nxt);
        const char* nA = has_next ? (const char*)g.A + (size_t)nxt.pm * tstepA + (size_t)((nxt.pn >> g.gsh) * g.gk) * 2 : cA; const char* nB = has_next ? (const char*)g.Bt + (size_t)nxt.pn * tstepB : cB;
        for (int t = 0; t < nt; t += 2) {
            const bool last = (t == nt - 2);
            const char* a1 = cA + (size_t)(t + 1) * kstep;
            const char* a2 = last ? nA : cA + (size_t)(t + 2) * kstep; const char* b2 = last ? nB : cB + (size_t)(t + 2) * kstep;
            const char* a3 = a2 + kstep; const char* b3 = b2 + kstep;
            if (last && has_next) S.a_ready(nxt);
            if constexpr (SP2) {
            PG8_LDB(B0, 0, 0); PG8_LDB(B1, 0, 1); PG8_SCHED; PG8_LDA(At, 0, 0); PG8_STAGE(PG8_SA(1, 1), a1 + hstepA, voffA);
            PG8_WAIT_V(8); PG8_WAIT_L(0); PG8_BAR; PG8_MMA(0, 0, At, B0); PG8_MMA(0, 1, At, B1); PG8_BAR; PG8_SCHED;
            PG8_LDA(At, 0, 1); PG8_STAGE(PG8_SB(0, 0), b2, voffB); PG8_STAGE(PG8_SB(0, 1), b2 + hstepB, voffB); PG8_STAGE(PG8_SA(0, 0), a2, voffA);
            PG8_WAIT_V(8); PG8_WAIT_L(0); PG8_BAR; PG8_MMA(1, 0, At, B0); PG8_MMA(1, 1, At, B1); PG8_BAR; PG8_SCHED;
            PG8_LDB(B0, 1, 0); PG8_LDB(B1, 1, 1); PG8_SCHED; PG8_LDA(At, 1, 0); PG8_STAGE(PG8_SA(0, 1), a2 + hstepA, voffA);
            PG8_WAIT_V(8); PG8_WAIT_L(0); PG8_BAR; PG8_MMA(0, 0, At, B0); PG8_MMA(0, 1, At, B1); PG8_BAR; PG8_SCHED;
            PG8_LDA(At, 1, 1); PG8_STAGE(PG8_SB(1, 0), b3, voffB); PG8_STAGE(PG8_SB(1, 1), b3 + hstepB, voffB); PG8_STAGE(PG8_SA(1, 0), a3, voffA);
            PG8_WAIT_V(8); PG8_WAIT_L(0); PG8_BAR; PG8_MMA(1, 0, At, B0); PG8_MMA(1, 1, At, B1); PG8_BAR; PG8_SCHED;
            } else {
            PG8_LDB(B0, 0, 0); PG8_SCHED; PG8_LDA(At, 0, 0); PG8_STAGE(PG8_SA(1, 1), a1 + hstepA, voffA);
            PG8_WAIT_L(8); PG8_BAR; PG8_WAIT_L(0); PG8_MMA(0, 0, At, B0); PG8_BAR; PG8_SCHED;
            PG8_LDB(B1, 0, 1); PG8_STAGE(PG8_SB(0, 0), b2, voffB);
            PG8_BAR; PG8_WAIT_L(0); PG8_MMA(0, 1, At, B1); PG8_BAR;
            PG8_LDA(At, 0, 1); PG8_STAGE(PG8_SA(0, 0), a2, voffA);
            PG8_BAR; PG8_WAIT_L(0); PG8_MMA(1, 0, At, B0); PG8_BAR; PG8_SCHED;
            PG8_STAGE(PG8_SB(0, 1), b2 + hstepB, voffB);
            PG8_WAIT_V(6); PG8_BAR; PG8_MMA(1, 1, At, B1); PG8_BAR;
            PG8_LDB(B0, 1, 0); PG8_SCHED; PG8_LDA(At, 1, 0); PG8_STAGE(PG8_SA(0, 1), a2 + hstepA, voffA);
            PG8_WAIT_L(8); PG8_BAR; PG8_WAIT_L(0); PG8_MMA(0, 0, At, B0); PG8_BAR; PG8_SCHED;
            PG8_LDB(B1, 1, 1); PG8_STAGE(PG8_SB(1, 0), b3, voffB);
            PG8_BAR; PG8_WAIT_L(0); PG8_MMA(0, 1, At, B1); PG8_BAR;
            PG8_LDA(At, 1, 1); PG8_STAGE(PG8_SA(1, 0), a3, voffA);
            PG8_BAR; PG8_WAIT_L(0); PG8_MMA(1, 0, At, B0); PG8_BAR; PG8_SCHED;
            PG8_STAGE(PG8_SB(1, 1), b3 + hstepB, voffB);
            PG8_WAIT_V(6); PG8_BAR; PG8_MMA(1, 1, At, B1); PG8_BAR;
            }
        }
        if constexpr (ALIGN_EPI) { if (wr == 0) PG8_BAR; }
        if constexpr (!Epi::AFTER_DRAIN) { E(acc, cur, wr, wc, fr, fq); S.done(cur); }
        if (!has_next) break;
#pragma unroll
        for (int a = 0; a < 2; ++a)
#pragma unroll
            for (int b = 0; b < 2; ++b)
#pragma unroll
                for (int m = 0; m < 4; ++m)
#pragma unroll
                    for (int n = 0; n < 2; ++n) acc[a][b][m][n] = (f32x4){0.f, 0.f, 0.f, 0.f};
        cur = nxt; cA = nA; cB = nB; ++ui;
        if constexpr (ALIGN_EPI) { if (wr == 1) PG8_BAR; }
    }
    PG8_WAIT_V(0);
    if constexpr (!ALIGN_EPI) { if (wr == 0) PG8_BAR; }
    PG8_BAR;
    if constexpr (Epi::AFTER_DRAIN) { E.fused(acc, cur, wr, wc, fr, fq, lds, wid, lane); S.done(cur); }
#undef PG8_SA
#undef PG8_SB
#undef PG8_STAGE
#undef PG8_LDA
#undef PG8_LDB
#undef PG8_MMA
#undef PG8_WAIT_V
#undef PG8_WAIT_L
#undef PG8_BAR
#undef PG8_SCHED
}
}

constexpr int D = 2048, NTOK = 12288, NPROMPT = 4096, DFF = 5632, PW = 7680  , CPA = 3488;
constexpr int NWAVES = 8, NTHR = 512;
constexpr int PC_GDN = 3072, PC_Z = 6144, PC_LORA = 7168, PC_BETA = 7584, PC_ALPHA = 7600;
constexpr float RMS_EPS = 1e-6f, GN_EPS = 64e-5f;

constexpr size_t MiB = 1u << 20;
constexpr size_t WS_CTL = 0, CTL_ZERO_BYTES = 1 * MiB;
constexpr size_t WS_MOD = 1 * MiB;
constexpr size_t WS_WIN = 3 * MiB;
constexpr size_t WS_WOUT = 63 * MiB;
constexpr size_t WS_WGU = 79 * MiB;
constexpr size_t WS_WDN = 255 * MiB;
constexpr size_t WS_WPOOL = 343 * MiB;
constexpr size_t WS_H = 347 * MiB;
constexpr size_t WS_O = 395 * MiB;
constexpr size_t WS_P = 443 * MiB;
constexpr size_t WS_SC = 623 * MiB;
constexpr size_t SC_ONE = 48 * MiB;
constexpr size_t WS_Y = 1247 * MiB;
constexpr size_t WS_SMALL = 1439 * MiB;
constexpr size_t WS_END = 1443 * MiB;
constexpr int CW_BAR = 4096;

constexpr int LDS_STAGE = 131072, LDS_MISC = LDS_STAGE + 320, LDS_BYTES = 147456;

#define GAS __attribute__((address_space(1)))
#define LAS __attribute__((address_space(3)))
typedef unsigned short bf16;
typedef unsigned v4u __attribute__((ext_vector_type(4)));
typedef unsigned v2u __attribute__((ext_vector_type(2)));
typedef float f32x4 __attribute__((ext_vector_type(4)));
typedef float f32x2 __attribute__((ext_vector_type(2)));
#define LDS_WAIT() asm volatile("s_waitcnt lgkmcnt(0)" ::: "memory")

__device__ __forceinline__ unsigned f2bf(float f) { unsigned u = __builtin_bit_cast(unsigned, f); return (u + 0x7fffu + ((u >> 16) & 1u)) >> 16; }
__device__ __forceinline__ unsigned pk2(float lo, float hi) { return f2bf(lo) | (f2bf(hi) << 16); }
__device__ __forceinline__ float bf2f(bf16 b) { return __builtin_bit_cast(float, (unsigned)b << 16); }
__device__ __forceinline__ float bflo(unsigned w) { return __builtin_bit_cast(float, w << 16); }
__device__ __forceinline__ float bfhi(unsigned w) { return __builtin_bit_cast(float, w & 0xffff0000u); }
__device__ __forceinline__ float sigmoidf_(float x) { return 1.0f / (1.0f + __expf(-x)); }
__device__ __forceinline__ float siluf_(float x) { return x / (1.0f + __expf(-x)); }
__device__ __forceinline__ float softplusf_(float x) { return x > 20.f ? x : log1pf(__expf(x)); }
__device__ __forceinline__ float wave_sum(float v) {
#pragma unroll
    for (int o = 1; o < 64; o <<= 1) v += __shfl_xor(v, o);
    return v;
}
__device__ __forceinline__ float rdl(float v, int k) { return __builtin_bit_cast(float, __builtin_amdgcn_readlane(__builtin_bit_cast(int, v), k)); }

#define XB_TMO      128
#define XB_XCNT(j)  (256  + 64 * (j))
#define XB_XSUB(j)  (1280 + 64 * (j))
#define XB_XGEN(j)  (2304 + 64 * (j))
#define XB_TOP      3328
#define XB_TOPGEN   3392
#define XCD_BAR_WORDS 3456
#define XB_SPIN_CAP (1u << 18)
__device__ __forceinline__ unsigned xb_ld(unsigned* p)              { return __hip_atomic_load(p, __ATOMIC_RELAXED, __HIP_MEMORY_SCOPE_AGENT); }
__device__ __forceinline__ unsigned xb_add(unsigned* p, unsigned v) { return __hip_atomic_fetch_add(p, v, __ATOMIC_RELAXED, __HIP_MEMORY_SCOPE_AGENT); }
__device__ __forceinline__ unsigned xb_xcc_id() { return (unsigned)__builtin_amdgcn_s_getreg((3 << 11) | 20) & 0xFu; }
#define XB_SPIN(cond, bar) do { unsigned _sp = 0; while (cond) { __builtin_amdgcn_s_sleep(1); \
    if ((++_sp & 255u) == 0u) { if (xb_ld(&(bar)[XB_TMO])) break; if (_sp > XB_SPIN_CAP) { atomicAdd(&(bar)[XB_TMO], 1u); break; } } } } while (0)
struct XcdBarrier { unsigned* bar; unsigned x; volatile LAS unsigned* st; };
__device__ __forceinline__ XcdBarrier xcd_barrier_post(unsigned* bar, volatile LAS unsigned* st) {
    XcdBarrier b; b.bar = bar; b.x = xb_xcc_id(); b.st = st;
    if (threadIdx.x == 0) (void)xb_add(&bar[XB_XCNT(b.x)], 1u);
    return b;
}
__device__ __forceinline__ void xcd_barrier_complete(unsigned* bar, unsigned x, unsigned& nloc, unsigned& nx) {
    const unsigned G = gridDim.x * gridDim.y * gridDim.z;
    unsigned sum, cnt, mine, sp = 0u;
    for (;;) {
        sum = 0u; cnt = 0u; mine = 0u;
#pragma unroll
        for (unsigned j = 0; j < 16; ++j) { const unsigned c = xb_ld(&bar[XB_XCNT(j)]); sum += c; cnt += (c > 0u) ? 1u : 0u; mine = (j == x) ? c : mine; }
        if (sum == G) break;
        __builtin_amdgcn_s_sleep(1);
        if ((++sp & 255u) == 0u) { if (xb_ld(&bar[XB_TMO])) break; if (sp > XB_SPIN_CAP) { atomicAdd(&bar[XB_TMO], 1u); break; } }
    }
    nloc = mine > 0u ? mine : 1u; nx = cnt > 0u ? cnt : 1u;
}
__device__ __forceinline__ void xcd_barrier(const XcdBarrier& b) {
    asm volatile("s_waitcnt vmcnt(0)" ::: "memory");
    __syncthreads();
    if (threadIdx.x == 0) {
        unsigned* bar = b.bar;
        __builtin_amdgcn_s_waitcnt(0);
        unsigned nloc = b.st[0], nx = b.st[1];
        if (nloc == 0u) { xcd_barrier_complete(bar, b.x, nloc, nx); b.st[0] = nloc; b.st[1] = nx; }
        const unsigned old = xb_add(&bar[XB_XSUB(b.x)], 1u);
        const unsigned gen = old / nloc;
        if (old + 1u == (gen + 1u) * nloc) {
            __builtin_amdgcn_fence(__ATOMIC_RELEASE, "agent");
            asm volatile("s_waitcnt vmcnt(0)" ::: "memory");
            const unsigned og = xb_add(&bar[XB_TOP], 1u);
            const unsigned tg = og / nx;
            if (og + 1u == (tg + 1u) * nx) xb_add(&bar[XB_TOPGEN], 1u);
            else XB_SPIN(xb_ld(&bar[XB_TOPGEN]) == tg, bar);
            __builtin_amdgcn_fence(__ATOMIC_ACQUIRE, "agent");
            xb_add(&bar[XB_XGEN(b.x)], 1u);
            asm volatile("s_waitcnt vmcnt(0)" ::: "memory");
        } else {
            XB_SPIN(xb_ld(&bar[XB_XGEN(b.x)]) == gen, bar);
            __builtin_amdgcn_fence(__ATOMIC_ACQUIRE, "agent");
            asm volatile("s_waitcnt vmcnt(0)" ::: "memory");
        }
    }
    __syncthreads();
}

enum { I_XP = 0, I_XS, I_SRW, I_SDL, I_C, I_CCTX, I_MODW, I_MODB, I_NMIX, I_NFFN, I_NFIN, I_WIN, I_WOUT, I_MU, I_W0, I_W2, I_A0, I_A2, I_G2, I_KK, I_KA, I_RK, I_LNW, I_LNB,
       I_CONVW, I_ALOG, I_DTB, I_GNW, I_POOLW, I_POOLS, I_WG, I_WU, I_WD, N_IN };
struct Args { const float* in[N_IN]; float* out; unsigned char* ws; int ph_lo, ph_hi; };
constexpr size_t OUT_SRW = (size_t)NTOK * D, OUT_SDL = OUT_SRW + (size_t)16 * 2 * 2 * 16 * 64 * 64;

__device__ __forceinline__ void conv_item(const float* W, int K, int N, bf16* WT, int drow0, LAS float* scr, int kb, int nb, int lane) {
    const int k0 = 64 * kb, n0 = 32 * nb;
#pragma unroll 8
    for (int i = 0; i < 32; ++i) { const int kk = 2 * i + (lane >> 5); scr[kk * 33 + (lane & 31)] = W[(size_t)(k0 + kk) * N + n0 + (lane & 31)]; }
    LDS_WAIT(); asm volatile("" ::: "memory");
    const int c = lane & 7;
#pragma unroll
    for (int j = 0; j < 4; ++j) { const int n = (lane >> 3) + 8 * j; const LAS float* s = scr + (8 * c) * 33 + n;
        v4u o; o.x = pk2(s[0 * 33], s[1 * 33]); o.y = pk2(s[2 * 33], s[3 * 33]); o.z = pk2(s[4 * 33], s[5 * 33]); o.w = pk2(s[6 * 33], s[7 * 33]);
        *(v4u*)(WT + (size_t)(drow0 + n) * K + k0 + 8 * c) = o; }
    LDS_WAIT(); asm volatile("" ::: "memory");
}
__device__ __forceinline__ int win_row(int n) { return n < 3072 ? n : (n < CPA ? PC_LORA + (n - 3072) : (n < CPA + 4096 ? PC_GDN + (n - CPA) : n)); }

__device__ __forceinline__ void ph_pre(const Args& a, LAS unsigned char* lds) {
    const int tid = threadIdx.x, lane = tid & 63, wave = __builtin_amdgcn_readfirstlane(tid >> 6);
    const int G = gridDim.x;
    LAS float* ca = (LAS float*)lds;
    LAS float* red = (LAS float*)(lds + 2048 * 9 * 4);
    for (int i = tid; i < 9 * 2048; i += NTHR) { const int c = i / 2048, k = i - c * 2048; const float v = c == 0 ? a.in[I_CCTX][k] : a.in[I_C][(c - 1) * 2048 + k]; ca[k * 9 + c] = siluf_(v); }
    __syncthreads();
    float* MOD = (float*)(a.ws + WS_MOD);
    for (int task = blockIdx.x; task < 4 * 96; task += G) {
        const int l = task / 96, cb = task - l * 96;
        const float* wp = a.in[I_MODW] + ((size_t)l * 2048 + wave * 256) * 12288 + cb * 128 + lane * 2;
        float acc[9][2];
#pragma unroll
        for (int c = 0; c < 9; ++c) { acc[c][0] = 0.f; acc[c][1] = 0.f; }
        for (int k8 = 0; k8 < 256; k8 += 8) {
            f32x2 wv[8];
#pragma unroll
            for (int j = 0; j < 8; ++j) wv[j] = *(const f32x2*)(wp + (size_t)(k8 + j) * 12288);
#pragma unroll
            for (int j = 0; j < 8; ++j) { const LAS float* cp = ca + (wave * 256 + k8 + j) * 9;
#pragma unroll
                for (int c = 0; c < 9; ++c) { const float s = cp[c]; acc[c][0] += s * wv[j].x; acc[c][1] += s * wv[j].y; } }
        }
#pragma unroll
        for (int c = 0; c < 9; ++c) { red[(wave * 18 + c * 2) * 64 + lane] = acc[c][0]; red[(wave * 18 + c * 2 + 1) * 64 + lane] = acc[c][1]; }
        __syncthreads();
        for (int o = tid; o < 9 * 128; o += NTHR) { const int c = o >> 7, col = o & 127, ln = col >> 1, j = col & 1; float s = a.in[I_MODB][l * 12288 + cb * 128 + col];
#pragma unroll
            for (int w = 0; w < 8; ++w) s += red[(w * 18 + c * 2 + j) * 64 + ln];
            MOD[((size_t)l * 9 + c) * 12288 + cb * 128 + col] = s; }
        __syncthreads();
    }
    __syncthreads();
    LAS float* scr = (LAS float*)(lds + wave * 16384);
    const int gw = blockIdx.x * NWAVES + wave, NGW = G * NWAVES;
    bf16* WIN = (bf16*)(a.ws + WS_WIN); bf16* WOUT = (bf16*)(a.ws + WS_WOUT); bf16* WGU = (bf16*)(a.ws + WS_WGU); bf16* WDN = (bf16*)(a.ws + WS_WDN); bf16* WPOOL = (bf16*)(a.ws + WS_WPOOL);
    constexpr int IT_WIN = 32 * 238, IT_WOUT = 32 * 64, IT_GU = 32 * 176, IT_DN = 88 * 64, IT_POOL = 8 * 16;
    constexpr int NITEMS = 2 * IT_WIN + 2 * IT_WOUT + 8 * IT_GU + 4 * IT_DN + 8 * IT_POOL;
    for (int it = gw; it < NITEMS; it += NGW) {
        int r = it;
        if (r < 2 * IT_WIN) { const int i = r / IT_WIN; r -= i * IT_WIN; const int kb = r / 238, nb = r - kb * 238;
            conv_item(a.in[I_WIN] + (size_t)i * 2048 * 7616, 2048, 7616, WIN + (size_t)i * PW * 2048, win_row(32 * nb), scr, kb, nb, lane); continue; } r -= 2 * IT_WIN;
        if (r < 2 * IT_WOUT) { const int i = r / IT_WOUT; r -= i * IT_WOUT; const int kb = r / 64, nb = r - kb * 64;
            conv_item(a.in[I_WOUT] + (size_t)i * 2048 * 2048, 2048, 2048, WOUT + (size_t)i * 2048 * 2048, 32 * nb, scr, kb, nb, lane); continue; } r -= 2 * IT_WOUT;
        if (r < 8 * IT_GU) { const int li = r / IT_GU; r -= li * IT_GU; const int l = li >> 1, up = li & 1; const int kb = r / 176, nb = r - kb * 176; const int n0 = 32 * nb;
            conv_item(a.in[up ? I_WU : I_WG] + (size_t)l * 2048 * DFF, 2048, DFF, WGU + (size_t)l * 11264 * 2048, (n0 >> 7) * 256 + up * 128 + (n0 & 127), scr, kb, nb, lane); continue; } r -= 8 * IT_GU;
        if (r < 4 * IT_DN) { const int l = r / IT_DN; r -= l * IT_DN; const int kb = r / 64, nb = r - kb * 64;
            conv_item(a.in[I_WD] + (size_t)l * DFF * 2048, DFF, 2048, WDN + (size_t)l * 2048 * DFF, 32 * nb, scr, kb, nb, lane); continue; } r -= 4 * IT_DN;
        { const int ig = r / IT_POOL; r -= ig * IT_POOL; const int kb = r / 16, nb = r - kb * 16;
            conv_item(a.in[I_POOLW] + (size_t)ig * 512 * 512, 512, 512, WPOOL + (size_t)ig * 512 * 512, 32 * nb, scr, kb, nb, lane); }
    }
    for (int r = gw; r < 128; r += NGW) { bf16* row = WIN + ((size_t)(r >> 6) * PW + 7616 + (r & 63)) * 2048; const v4u z = {0u, 0u, 0u, 0u};
#pragma unroll
        for (int j = 0; j < 4; ++j) *(v4u*)(row + (j * 64 + lane) * 8) = z; }
}

__device__ __forceinline__ void ph_norm(const Args& a, int l, int which) {
    const int tid = threadIdx.x, lane = tid & 63, wave = __builtin_amdgcn_readfirstlane(tid >> 6);
    const int gw = blockIdx.x * NWAVES + wave, NGW = gridDim.x * NWAVES;
    const float* nw = a.in[which ? I_NFFN : I_NMIX] + l * 2048;
    const float* MOD = (const float*)(a.ws + WS_MOD) + (size_t)l * 9 * 12288;
    bf16* H = (bf16*)(a.ws + WS_H);
    const bool from_in = (l == 0 && which == 0);
    for (int m = gw; m < NTOK; m += NGW) {
        const float* xr = from_in ? (m < NPROMPT ? a.in[I_XP] + (size_t)m * D : a.in[I_XS] + (size_t)(m - NPROMPT) * D) : a.out + (size_t)m * D;
        const int cond = m < NPROMPT ? 0 : 1 + ((m - NPROMPT) >> 10);
        const float* sh = MOD + (size_t)cond * 12288 + (which ? 3 : 0) * 2048; const float* sc = sh + 2048;
        f32x4 v[8]; float s = 0.f;
#pragma unroll
        for (int j = 0; j < 8; ++j) { v[j] = *(const f32x4*)(xr + 4 * lane + 256 * j); s += (v[j].x * v[j].x + v[j].y * v[j].y) + (v[j].z * v[j].z + v[j].w * v[j].w); }
        const float rstd = 1.0f / sqrtf(wave_sum(s) * (1.0f / D) + RMS_EPS);
#pragma unroll
        for (int j = 0; j < 8; ++j) { const int c = 4 * lane + 256 * j; const f32x4 w = *(const f32x4*)(nw + c), s1 = *(const f32x4*)(sc + c), s0 = *(const f32x4*)(sh + c);
            const f32x4 y = (v[j] * rstd) * w * (s1 + 1.0f) + s0;
            v2u o; o.x = pk2(y.x, y.y); o.y = pk2(y.z, y.w); *(v2u*)(H + (size_t)m * D + c) = o; }
    }
}
__device__ __forceinline__ void ph_final(const Args& a) {
    const int tid = threadIdx.x, lane = tid & 63, wave = __builtin_amdgcn_readfirstlane(tid >> 6);
    const int gw = blockIdx.x * NWAVES + wave, NGW = gridDim.x * NWAVES;
    const float* nw = a.in[I_NFIN];
    for (int m = gw; m < NTOK; m += NGW) {
        float* xr = a.out + (size_t)m * D;
        f32x4 v[8]; float s = 0.f;
#pragma unroll
        for (int j = 0; j < 8; ++j) { v[j] = *(const f32x4*)(xr + 4 * lane + 256 * j); s += (v[j].x * v[j].x + v[j].y * v[j].y) + (v[j].z * v[j].z + v[j].w * v[j].w); }
        const float rstd = 1.0f / sqrtf(wave_sum(s) * (1.0f / D) + RMS_EPS);
#pragma unroll
        for (int j = 0; j < 8; ++j) { const int c = 4 * lane + 256 * j; const f32x4 w = *(const f32x4*)(nw + c); *(f32x4*)(xr + c) = (v[j] * rstd) * w; }
    }
}
__device__ __forceinline__ void ph_pool(const Args& a) {
    const int tid = threadIdx.x, lane = tid & 63, wave = __builtin_amdgcn_readfirstlane(tid >> 6);
    const int gw = blockIdx.x * NWAVES + wave, NGW = gridDim.x * NWAVES;
    const bf16* H = (const bf16*)(a.ws + WS_H); bf16* O = (bf16*)(a.ws + WS_O);
    for (int m = gw; m < NTOK; m += NGW) {
        const bool samp = m >= NPROMPT; const int T = samp ? 1024 : 256; const int base = samp ? NPROMPT + (((m - NPROMPT) >> 10) << 10) : (m >> 8) << 8; const int t = m - base;
#pragma unroll
        for (int g = 0; g < 4; ++g) {
            const int win = 2 << g; int lo = t - win / 2, hi = lo + win; lo = lo < 0 ? 0 : lo; hi = hi > T ? T : hi;
            const int c = g * 512 + lane * 8;
            float s[8];
#pragma unroll
            for (int e = 0; e < 8; ++e) s[e] = 0.f;
            for (int r = lo; r < hi; ++r) { const v4u w = *(const v4u*)(H + (size_t)(base + r) * D + c);
                s[0] += bflo(w.x); s[1] += bfhi(w.x); s[2] += bflo(w.y); s[3] += bfhi(w.y); s[4] += bflo(w.z); s[5] += bfhi(w.z); s[6] += bflo(w.w); s[7] += bfhi(w.w); }
            const float inv = 1.0f / (float)(hi - lo);
            const v4u w = *(const v4u*)(H + (size_t)m * D + c);
            v4u o; o.x = pk2(s[0] * inv - bflo(w.x), s[1] * inv - bfhi(w.x)); o.y = pk2(s[2] * inv - bflo(w.y), s[3] * inv - bfhi(w.y));
            o.z = pk2(s[4] * inv - bflo(w.z), s[5] * inv - bfhi(w.z)); o.w = pk2(s[6] * inv - bflo(w.w), s[7] * inv - bfhi(w.w));
            *(v4u*)(O + (size_t)m * D + c) = o;
        }
    }
}

__device__ __forceinline__ void ph_prep(const Args& a, LAS unsigned char* lds, int i) {
    const int tid = threadIdx.x, lane = tid & 63, wave = __builtin_amdgcn_readfirstlane(tid >> 6);
    const bf16* P = (const bf16*)(a.ws + WS_P);
    float* SC = (float*)(a.ws + WS_SC); constexpr size_t S1 = (size_t)NTOK * 1024;
    float *Rb = SC, *Vb = SC + S1, *Ab = SC + 2 * S1, *Wb = SC + 3 * S1, *Kb = SC + 5 * S1, *Bb = SC + 7 * S1, *GT = SC + 9 * S1, *Qb = SC + 10 * S1, *KDb = SC + 11 * S1, *VDb = SC + 12 * S1;
    float* BON = (float*)(a.ws + WS_SMALL); float* BETA = BON + (size_t)NTOK * 32; float* GG = BETA + (size_t)NTOK * 16;
    const float* MU = a.in[I_MU] + i * CPA;
    LAS float* pa = (LAS float*)lds;
    for (int tile = blockIdx.x; tile < NTOK / 8; tile += gridDim.x) {
        const int m0 = tile * 8; const bool samp = m0 >= NPROMPT; const int T = samp ? 1024 : 256;
        const int base = samp ? NPROMPT + (((m0 - NPROMPT) >> 10) << 10) : (m0 >> 8) << 8; const int t0 = m0 - base;
        for (int idx = tid; idx < 8 * CPA; idx += NTHR) {
            const int tt = idx / CPA, j = idx - tt * CPA; const int c = j < 3072 ? j : j + (PC_LORA - 3072); const int t = t0 + tt, m = m0 + tt;
            int dt; bool valid;
            if (!samp) { if (j & 1) { dt = 1; valid = t + 1 < T; } else { dt = -1; valid = t > 0; } }
            else { const int q = j & 3, col = t & 63, row = t >> 6;
                if (q == 0) { dt = -1; valid = col > 0; } else if (q == 1) { dt = 1; valid = col < 63; } else if (q == 2) { dt = -64; valid = row > 0; } else { dt = 64; valid = row < 15; } }
            const float x = bf2f(P[(size_t)m * PW + c]); const float xs = valid ? bf2f(P[(size_t)(m + dt) * PW + c]) : 0.f;
            float v = x + (xs - x) * MU[j];
            if (j >= 3072 && j < 3200) v = tanhf(v); else if (j >= 3328) v = sigmoidf_(v);
            pa[tt * CPA + j] = v;
        }
        __syncthreads();
        for (int cc = 0; cc < 2; ++cc) {
            const int c = tid + cc * 512; const int head = c >> 6;
            float wl[2][8], al[2][8], gl[8];
#pragma unroll
            for (int tt = 0; tt < 8; ++tt) { wl[0][tt] = wl[1][tt] = al[0][tt] = al[1][tt] = gl[tt] = 0.f; }
#pragma unroll
            for (int d = 0; d < 2; ++d) {
                const float* w2 = a.in[I_W2] + ((size_t)(i * 2 + d) * 64) * 1024 + c; const float* a2 = a.in[I_A2] + ((size_t)(i * 2 + d) * 64) * 1024 + c;
                for (int r = 0; r < 64; ++r) { const float w2v = w2[(size_t)r * 1024], a2v = a2[(size_t)r * 1024];
#pragma unroll
                    for (int tt = 0; tt < 8; ++tt) { wl[d][tt] += pa[tt * CPA + 3072 + d * 64 + r] * w2v; al[d][tt] += pa[tt * CPA + 3200 + d * 64 + r] * a2v; } }
            }
            { const float* g2 = a.in[I_G2] + (size_t)i * 160 * 1024 + c;
                for (int r = 0; r < 160; ++r) { const float g2v = g2[(size_t)r * 1024];
#pragma unroll
                    for (int tt = 0; tt < 8; ++tt) gl[tt] += pa[tt * CPA + 3328 + r] * g2v; } }
            const float kkw = a.in[I_KK][i * 1024 + c], kaw = a.in[I_KA][i * 1024 + c], rkw = a.in[I_RK][i * 1024 + c];
            const float w0v[2] = {a.in[I_W0][(i * 2 + 0) * 1024 + c], a.in[I_W0][(i * 2 + 1) * 1024 + c]}, a0v[2] = {a.in[I_A0][(i * 2 + 0) * 1024 + c], a.in[I_A0][(i * 2 + 1) * 1024 + c]};
#pragma unroll
            for (int tt = 0; tt < 8; ++tt) {
                const size_t o = (size_t)(m0 + tt) * 1024 + c;
                const float r_ = pa[tt * CPA + c], k_ = pa[tt * CPA + 1024 + c], v_ = pa[tt * CPA + 2048 + c];
                const float kkr = k_ * kkw; const float ss = wave_sum(kkr * kkr); const float kk = kkr * (1.0f / sqrtf(ss + 1e-12f));
                Rb[o] = r_; Vb[o] = v_; Ab[o] = -kk; GT[o] = gl[tt];
#pragma unroll
                for (int d = 0; d < 2; ++d) {
                    const float u = w0v[d] + wl[d][tt]; const float w = __expf(-0.6065306597f * sigmoidf_(u)); const float ic = sigmoidf_(a0v[d] + al[d][tt]);
                    const float kd = k_ * (1.0f + (ic - 1.0f) * kaw);
                    Wb[d * S1 + o] = w; Kb[d * S1 + o] = kd; Bb[d * S1 + o] = kk * ic;
                    const float bon = wave_sum(r_ * kd * rkw);
                    if (lane == 0) BON[((size_t)(m0 + tt) * 2 + d) * 16 + head] = bon;
                }
            }
        }
        {
            const int h = wave; const float* cw = a.in[I_CONVW] + (size_t)i * 3 * 3072;
            for (int tt = 0; tt < 8; ++tt) {
                const int m = m0 + tt, t = t0 + tt; float val[3][2];
#pragma unroll
                for (int part = 0; part < 3; ++part)
#pragma unroll
                    for (int e = 0; e < 2; ++e) { const int ch = part * 1024 + h * 128 + lane + 64 * e;
                        const float x0 = t > 0 ? bf2f(P[(size_t)(m - 1) * PW + PC_GDN + ch]) : 0.f, x1 = bf2f(P[(size_t)m * PW + PC_GDN + ch]), x2 = t + 1 < T ? bf2f(P[(size_t)(m + 1) * PW + PC_GDN + ch]) : 0.f;
                        val[part][e] = siluf_(x0 * cw[ch] + x1 * cw[3072 + ch] + x2 * cw[2 * 3072 + ch]); }
                const float qs = 1.0f / sqrtf(wave_sum(val[0][0] * val[0][0] + val[0][1] * val[0][1]) + 1e-6f), ks = 1.0f / sqrtf(wave_sum(val[1][0] * val[1][0] + val[1][1] * val[1][1]) + 1e-6f);
#pragma unroll
                for (int e = 0; e < 2; ++e) { const size_t o = (size_t)m * 1024 + h * 128 + lane + 64 * e; Qb[o] = val[0][e] * qs; KDb[o] = val[1][e] * ks; VDb[o] = val[2][e]; }
            }
            if (tid < 128) { const int tt = tid >> 4, dh = tid & 15; const int m = m0 + tt;
                BETA[(size_t)m * 16 + dh] = sigmoidf_(bf2f(P[(size_t)m * PW + PC_BETA + dh]));
                GG[(size_t)m * 16 + dh] = -__expf(a.in[I_ALOG][i * 16 + dh]) * softplusf_(bf2f(P[(size_t)m * PW + PC_ALPHA + dh]) + a.in[I_DTB][i * 16 + dh]); }
        }
        __syncthreads();
    }
}

__device__ __forceinline__ void rwkv_task(const Args& a, int i, int s, int h, int d, int lane) {
    const float* SC = (const float*)(a.ws + WS_SC); constexpr size_t S1 = (size_t)NTOK * 1024;
    const float *Rb = SC, *Vb = SC + S1, *Ab = SC + 2 * S1, *Wb = SC + 3 * S1 + d * S1, *Kb = SC + 5 * S1 + d * S1, *Bb = SC + 7 * S1 + d * S1;
    float* Y = (float*)(a.ws + WS_Y) + d * S1;
    const int T = s < 16 ? 256 : 1024; const int row0 = s < 16 ? s * 256 : NPROMPT + (s - 16) * 1024;
    float S[64];
    if (s >= 16) { const float* s0 = a.in[I_SRW] + ((((size_t)(s - 16) * 2 + i) * 2 + d) * 16 + h) * 4096 + lane * 64;
#pragma unroll
        for (int k = 0; k < 64; k += 4) { const f32x4 v = *(const f32x4*)(s0 + k); S[k] = v.x; S[k + 1] = v.y; S[k + 2] = v.z; S[k + 3] = v.w; } }
    else {
#pragma unroll
        for (int k = 0; k < 64; ++k) S[k] = 0.f; }
    size_t o = (size_t)(row0 + (d ? T - 1 : 0)) * 1024 + h * 64 + lane; const long step = d ? -1024 : 1024;
    float av = Ab[o], wv = Wb[o], bv = Bb[o], kv = Kb[o], rv = Rb[o], vv = Vb[o];
    for (int n = 0; n < T; ++n) {
        const size_t on = (n + 1 < T) ? o + step : o;
        const float av2 = Ab[on], wv2 = Wb[on], bv2 = Bb[on], kv2 = Kb[on], rv2 = Rb[on], vv2 = Vb[on];
        float sa = 0.f;
#pragma unroll
        for (int k = 0; k < 64; ++k) sa += S[k] * rdl(av, k);
        float y = 0.f;
#pragma unroll
        for (int k = 0; k < 64; ++k) { S[k] = S[k] * rdl(wv, k) + (sa * rdl(bv, k) + vv * rdl(kv, k)); y += S[k] * rdl(rv, k); }
        Y[o] = y;
        o = on; av = av2; wv = wv2; bv = bv2; kv = kv2; rv = rv2; vv = vv2;
    }
    if (s < 16) { float* so = a.out + OUT_SRW + ((((size_t)s * 2 + i) * 2 + d) * 16 + h) * 4096 + lane * 64;
#pragma unroll
        for (int k = 0; k < 64; k += 4) *(f32x4*)(so + k) = (f32x4){S[k], S[k + 1], S[k + 2], S[k + 3]}; }
}
__device__ __forceinline__ void gdn_task(const Args& a, int i, int s, int h, int d, int half, int lane) {
    const float* SC = (const float*)(a.ws + WS_SC); constexpr size_t S1 = (size_t)NTOK * 1024;
    const float *Qb = SC + 10 * S1, *KDb = SC + 11 * S1, *VDb = SC + 12 * S1;
    const float* BETA = (const float*)(a.ws + WS_SMALL) + (size_t)NTOK * 32; const float* GG = BETA + (size_t)NTOK * 16;
    float* O = (float*)(a.ws + WS_Y) + 2 * S1 + d * S1;
    const int T = s < 16 ? 256 : 1024; const int row0 = s < 16 ? s * 256 : NPROMPT + (s - 16) * 1024;
    float S[128];
    if (s >= 16) { const float* s0 = a.in[I_SDL] + ((((size_t)(s - 16) * 2 + i) * 2 + d) * 8 + h) * 16384 + half * 64 + lane;
#pragma unroll
        for (int k = 0; k < 128; ++k) S[k] = s0[k * 128]; }
    else {
#pragma unroll
        for (int k = 0; k < 128; ++k) S[k] = 0.f; }
    int m = row0 + (d ? T - 1 : 0); const int step = d ? -1 : 1;
    size_t o = (size_t)m * 1024 + h * 128 + lane;
    float k0 = KDb[o], k1 = KDb[o + 64], q0 = Qb[o], q1 = Qb[o + 64], vv = VDb[o + half * 64], be = BETA[(size_t)m * 16 + d * 8 + h], gg = GG[(size_t)m * 16 + d * 8 + h];
    for (int n = 0; n < T; ++n) {
        const int mn = (n + 1 < T) ? m + step : m; const size_t on = (size_t)mn * 1024 + h * 128 + lane;
        const float k0n = KDb[on], k1n = KDb[on + 64], q0n = Qb[on], q1n = Qb[on + 64], vvn = VDb[on + half * 64], ben = BETA[(size_t)mn * 16 + d * 8 + h], ggn = GG[(size_t)mn * 16 + d * 8 + h];
        const float eg = __expf(gg);
        float ks = 0.f;
#pragma unroll
        for (int k = 0; k < 64; ++k) { ks += S[k] * rdl(k0, k); }
#pragma unroll
        for (int k = 0; k < 64; ++k) { ks += S[64 + k] * rdl(k1, k); }
        const float vn = be * (vv - eg * ks);
        float oo = 0.f;
#pragma unroll
        for (int k = 0; k < 64; ++k) { S[k] = eg * S[k] + rdl(k0, k) * vn; oo += S[k] * rdl(q0, k); }
#pragma unroll
        for (int k = 0; k < 64; ++k) { S[64 + k] = eg * S[64 + k] + rdl(k1, k) * vn; oo += S[64 + k] * rdl(q1, k); }
        O[(size_t)m * 1024 + h * 128 + half * 64 + lane] = oo * 0.08838834764831845f;
        m = mn; k0 = k0n; k1 = k1n; q0 = q0n; q1 = q1n; vv = vvn; be = ben; gg = ggn;
    }
    if (s < 16) { float* so = a.out + OUT_SDL + ((((size_t)s * 2 + i) * 2 + d) * 8 + h) * 16384 + half * 64 + lane;
#pragma unroll
        for (int k = 0; k < 128; ++k) so[k * 128] = S[k]; }
}
__device__ __forceinline__ void ph_scan(const Args& a, int i) {
    const int tid = threadIdx.x, lane = tid & 63, wave = __builtin_amdgcn_readfirstlane(tid >> 6);
    const int G = gridDim.x;
    for (int task = wave * G + blockIdx.x; task < 1536; task += NWAVES * G) {
        if (task < 768) { int s, r; if (task < 256) { s = 16 + (task >> 5); r = task & 31; } else { s = (task - 256) >> 5; r = (task - 256) & 31; }
            rwkv_task(a, i, s, r >> 1, r & 1, lane); }
        else { const int tk = task - 768; int s, r; if (tk < 256) { s = 16 + (tk >> 5); r = tk & 31; } else { s = (tk - 256) >> 5; r = (tk - 256) & 31; }
            gdn_task(a, i, s, r >> 2, (r >> 1) & 1, r & 1, lane); }
    }
}
__device__ __forceinline__ void ph_post(const Args& a, int i) {
    const int tid = threadIdx.x, lane = tid & 63, wave = __builtin_amdgcn_readfirstlane(tid >> 6);
    const int gw = blockIdx.x * NWAVES + wave, NGW = gridDim.x * NWAVES;
    const float* SC = (const float*)(a.ws + WS_SC); constexpr size_t S1 = (size_t)NTOK * 1024;
    const float *Vb = SC + S1, *GT = SC + 9 * S1; const float* Y = (const float*)(a.ws + WS_Y); const float* OG = Y + 2 * S1;
    const float* BON = (const float*)(a.ws + WS_SMALL); const bf16* P = (const bf16*)(a.ws + WS_P); bf16* O = (bf16*)(a.ws + WS_O);
    const float* lnw = a.in[I_LNW] + i * 1024; const float* lnb = a.in[I_LNB] + i * 1024; const float* gnw = a.in[I_GNW] + i * 128;
    for (int m = gw; m < NTOK; m += NGW) {
        for (int h = 0; h < 16; ++h) { const size_t o = (size_t)m * 1024 + h * 64 + lane; const float v = Vb[o]; float acc = 0.f;
#pragma unroll
            for (int d = 0; d < 2; ++d) { const float y = Y[d * S1 + o]; const float mu = wave_sum(y) * (1.0f / 64.0f); const float dy = y - mu; const float var = wave_sum(dy * dy) * (1.0f / 64.0f);
                acc += dy * (1.0f / sqrtf(var + GN_EPS)) * lnw[h * 64 + lane] + lnb[h * 64 + lane] + BON[((size_t)m * 2 + d) * 16 + h] * v; }
            O[(size_t)m * D + h * 64 + lane] = (bf16)f2bf(acc * GT[o]); }
        for (int h = 0; h < 8; ++h) { float ov[2]; float ss = 0.f;
#pragma unroll
            for (int e = 0; e < 2; ++e) { const size_t o = (size_t)m * 1024 + h * 128 + lane + 64 * e; ov[e] = OG[o] + OG[S1 + o]; ss += ov[e] * ov[e]; }
            const float rs = 1.0f / sqrtf(wave_sum(ss) * (1.0f / 128.0f) + RMS_EPS);
#pragma unroll
            for (int e = 0; e < 2; ++e) { const int j = lane + 64 * e; const float z = bf2f(P[(size_t)m * PW + PC_Z + h * 128 + j]);
                O[(size_t)m * D + 1024 + h * 128 + j] = (bf16)f2bf(ov[e] * rs * gnw[j] * siluf_(z)); } }
    }
}

constexpr int PH_PER_LAYER = 9, N_PHASES = 2 + 4 * PH_PER_LAYER;
__host__ __device__ inline bool phase_exists(int ph) { if (ph == 0 || ph == N_PHASES - 1) return true; const int l = (ph - 1) / PH_PER_LAYER, k = (ph - 1) % PH_PER_LAYER; return (l & 1) ? !(k == 2 || k == 3 || k == 4) : true; }

#define RUN(ph) (a.ph_lo <= (ph) && (ph) < a.ph_hi)
#define SEAM(ph) do { if ((ph) + 1 < a.ph_hi) xcd_barrier(bar); } while (0)
template <int L> __device__ __forceinline__ void run_layer(const Args& a, LAS unsigned char* lds, const XcdBarrier& bar) {
    constexpr int l = L, pb = 1 + PH_PER_LAYER * L, i = L >> 1;
    const int G = gridDim.x, bx = blockIdx.x;
    bf16* H = (bf16*)(a.ws + WS_H); bf16* O = (bf16*)(a.ws + WS_O); bf16* P = (bf16*)(a.ws + WS_P);
    const float* modl = (const float*)(a.ws + WS_MOD) + (size_t)l * 9 * 12288;
    if (RUN(pb + 0)) { ph_norm(a, l, 0); SEAM(pb + 0); }
    if constexpr ((L & 1) == 0) {
        if (RUN(pb + 1)) { pg8::Gemm g{H, (const bf16*)(a.ws + WS_WIN) + (size_t)i * PW * 2048, NTOK, PW, 2048, 2048, 2048, 0, 0}; pg8::StaticOrder S; S.init(NTOK, PW, G, bx);
            pg8::EpiBf16 E{P, PW}; pg8::gemm_phase<pg8::EpiBf16, pg8::StaticOrder, true, true>(lds, g, S, E); SEAM(pb + 1); }
        if (RUN(pb + 2)) { ph_prep(a, lds, i); SEAM(pb + 2); }
        if (RUN(pb + 3)) { ph_scan(a, i); SEAM(pb + 3); }
        if (RUN(pb + 4)) { ph_post(a, i); SEAM(pb + 4); }
        if (RUN(pb + 5)) { pg8::Gemm g{O, (const bf16*)(a.ws + WS_WOUT) + (size_t)i * 2048 * 2048, NTOK, 2048, 2048, 2048, 2048, 0, 0}; pg8::StaticOrder S; S.init(NTOK, 2048, G, bx);
            pg8::EpiResid E{l == 0 ? a.in[I_XP] : nullptr, a.in[I_XS], a.out, modl + 2 * 2048, nullptr};
            pg8::gemm_phase<pg8::EpiResid, pg8::StaticOrder, true, true>(lds, g, S, E); SEAM(pb + 5); }
    } else {
        if (RUN(pb + 1)) { ph_pool(a); SEAM(pb + 1); }
        if (RUN(pb + 5)) { pg8::Gemm g{O, (const bf16*)(a.ws + WS_WPOOL) + (size_t)i * 2048 * 512, NTOK, 2048, 512, 2048, 512, 1, 512}; pg8::StaticOrder S; S.init(NTOK, 2048, G, bx);
            pg8::EpiResid E{nullptr, nullptr, a.out, modl + 2 * 2048, a.in[I_POOLS] + i * 2048};
            pg8::gemm_phase<pg8::EpiResid, pg8::StaticOrder, true, true>(lds, g, S, E); SEAM(pb + 5); }
    }
    if (RUN(pb + 6)) { ph_norm(a, l, 1); SEAM(pb + 6); }
    if (RUN(pb + 7)) { pg8::Gemm g{H, (const bf16*)(a.ws + WS_WGU) + (size_t)l * 11264 * 2048, NTOK, 11264, 2048, 2048, 2048, 0, 0}; pg8::StaticOrder S; S.init(NTOK, 11264, G, bx);
        pg8::EpiSwiGLU E{P, DFF}; pg8::gemm_phase<pg8::EpiSwiGLU, pg8::StaticOrder, true, true>(lds, g, S, E); SEAM(pb + 7); }
    if (RUN(pb + 8)) { pg8::Gemm g{P, (const bf16*)(a.ws + WS_WDN) + (size_t)l * 2048 * DFF, NTOK, 2048, DFF, DFF, DFF, 0, 0}; pg8::StaticOrder S; S.init(NTOK, 2048, G, bx);
        pg8::EpiResid E{nullptr, nullptr, a.out, modl + 5 * 2048, nullptr};
        pg8::gemm_phase<pg8::EpiResid, pg8::StaticOrder, true, true>(lds, g, S, E); SEAM(pb + 8); }
}

__global__ void __launch_bounds__(NTHR, 2) fwd(Args a) {
    extern __shared__ __attribute__((aligned(16))) unsigned char lds_raw[];
    LAS unsigned char* lds = (LAS unsigned char*)lds_raw;
    const int tid = threadIdx.x;
    volatile LAS unsigned* MISC = (volatile LAS unsigned*)(lds + LDS_MISC);
    for (int u = tid; u < (LDS_BYTES - LDS_STAGE) / 4; u += NTHR) ((LAS unsigned*)(lds + LDS_STAGE))[u] = 0u;
    __syncthreads();
    XcdBarrier bar; bar.bar = (unsigned*)(a.ws + WS_CTL) + CW_BAR; bar.x = 0; bar.st = nullptr;
    const bool multi = a.ph_hi - a.ph_lo > 1;
    if (multi) bar = xcd_barrier_post((unsigned*)(a.ws + WS_CTL) + CW_BAR, MISC + 8);
    if (RUN(0)) { ph_pre(a, lds); SEAM(0); }
    run_layer<0>(a, lds, bar);
    run_layer<1>(a, lds, bar);
    run_layer<2>(a, lds, bar);
    run_layer<3>(a, lds, bar);
    if (RUN(N_PHASES - 1)) ph_final(a);
}
#undef RUN
#undef SEAM

#ifndef MK_ONE_LAUNCH
#define MK_ONE_LAUNCH 1
#endif
extern "C" void kernel_launch(void* const* d_in, const int* in_sizes, int n_in, void* d_out, int out_size, void* d_ws, size_t ws_size, hipStream_t stream) {
    static int grid = 0;
    if (grid == 0) {
        if (n_in != N_IN || ws_size < WS_END) { fprintf(stderr, "kernel_launch: expected %d inputs and >= %zu bytes of workspace; got %d, %zu\n", (int)N_IN, (size_t)WS_END, n_in, ws_size); grid = -1; return; }
        int dev = 0, cus = 0, per_cu = 0;
        if (hipGetDevice(&dev) != hipSuccess || hipDeviceGetAttribute(&cus, hipDeviceAttributeMultiprocessorCount, dev) != hipSuccess) { grid = -1; return; }
        if (hipFuncSetAttribute((const void*)fwd, hipFuncAttributeMaxDynamicSharedMemorySize, LDS_BYTES) != hipSuccess) { fprintf(stderr, "kernel_launch: hipFuncSetAttribute failed\n"); grid = -1; return; }
        if (hipOccupancyMaxActiveBlocksPerMultiprocessor(&per_cu, (const void*)fwd, NTHR, LDS_BYTES) != hipSuccess || per_cu < 1) fprintf(stderr, "kernel_launch: occupancy query reports %d\n", per_cu);
        (void)hipGetLastError();
        grid = cus;
    }
    if (grid < 0) return;
    if (hipMemsetAsync((char*)d_ws + WS_CTL, 0, CTL_ZERO_BYTES, stream) != hipSuccess) return;
    Args a{};
    for (int i = 0; i < N_IN; ++i) a.in[i] = (const float*)d_in[i];
    a.out = (float*)d_out; a.ws = (unsigned char*)d_ws;
#if MK_ONE_LAUNCH
    a.ph_lo = 0; a.ph_hi = N_PHASES;
    hipLaunchKernelGGL(fwd, dim3(grid), dim3(NTHR), LDS_BYTES, stream, a);
#else
    for (int ph = 0; ph < N_PHASES; ++ph) { if (!phase_exists(ph)) continue; a.ph_lo = ph; a.ph_hi = ph + 1; hipLaunchKernelGGL(fwd, dim3(grid), dim3(NTHR), LDS_BYTES, stream, a); }
#endif
}
```

```cpp
#include <hip/hip_runtime.h>
#include <cstdio>
#include <cstdint>

namespace pg8 {
#define PG8_LAS __attribute__((address_space(3)))
typedef unsigned short bf16_t;
typedef short bf16x8 __attribute__((ext_vector_type(8)));
typedef float f32x4 __attribute__((ext_vector_type(4)));
typedef unsigned u32x4 __attribute__((ext_vector_type(4)));
constexpr int BM = 256, BK = 64, HALF = 128, HTB = HALF * BK * 2  , STAGE_BYTES = 8 * HTB, NXCD = 8, WGM = 8;

__host__ __device__ __forceinline__ int lds_byte(int r, int c) { const int st = (r >> 4) * 2 + (c >> 5), rr = r & 15, cc = c & 31, ob = rr * 64 + cc * 2; return st * 1024 + (ob ^ (((ob >> 9) & 1) << 5)); }
__host__ __device__ __forceinline__ void stage_rc(int b, int& R, int& C) { const int st = b / 1024, sb = b % 1024, swz = sb ^ (((sb >> 9) & 1) << 5); R = (st >> 1) * 16 + swz / 64; C = (st & 1) * 32 + (swz % 64) / 2; }
__host__ __device__ __forceinline__ int perm32(int rho) { const int n = rho >> 4, i = rho & 15; return 8 * (i >> 2) + 4 * n + (i & 3); }

struct Unit { int pm, pn; };
struct Gemm { const bf16_t* A; const bf16_t* Bt; int M, N, K, lda, ldb, gsh, gk; };

struct StaticOrder {
    int nM, nN, nwg, G, c;
    __host__ __device__ void init(int M, int N, int G_, int c_) { nM = M / BM; nN = N / BM; nwg = nM * nN; G = G_; c = c_; }
    __host__ __device__ bool next(int i, Unit& u) const {
        const long L = (long)i * G + c; if (L >= nwg) return false;
        int wgid = (int)L; { const int q = nwg / NXCD, r = nwg % NXCD, xcd = wgid % NXCD, off = wgid / NXCD; wgid = (xcd < r ? xcd * (q + 1) : r * (q + 1) + (xcd - r) * q) + off; }
        const int nig = WGM * nN, gid = wgid / nig, fm = gid * WGM, gsz = (nM - fm) < WGM ? (nM - fm) : WGM;
        u.pm = fm + ((wgid % nig) % gsz); u.pn = (wgid % nig) / gsz; return true;
    }
    __device__ __forceinline__ void a_ready(const Unit&) const {}
    __device__ __forceinline__ void done(const Unit&) const {}
};

__device__ __forceinline__ unsigned cvt_pk_bf16(float lo, float hi) { unsigned r; asm volatile("v_cvt_pk_bf16_f32 %0, %1, %2" : "=v"(r) : "v"(lo), "v"(hi)); return r; }

__device__ __forceinline__ int cond_of_panel(int pm) { return pm < 16 ? 0 : 1 + ((pm - 16) >> 2); }

struct EpiBf16 {
    static constexpr bool PERM = true, AFTER_DRAIN = false;
    bf16_t* O; int ldc;
    __device__ __forceinline__ void operator()(const f32x4 (&acc)[2][2][4][2], const Unit& u, int wr, int wc, int fr, int fq) const {
        const int row0 = u.pm * BM + wr * 64 + fr; const int col0 = u.pn * BM + wc * 32 + 8 * fq;
#pragma unroll
        for (int ai = 0; ai < 2; ++ai)
#pragma unroll
            for (int m = 0; m < 4; ++m) { bf16_t* rowp = O + (size_t)(row0 + ai * HALF + m * 16) * ldc + col0;
#pragma unroll
                for (int bj = 0; bj < 2; ++bj) { const f32x4 v0 = acc[ai][bj][m][0], v1 = acc[ai][bj][m][1];
                    u32x4 w; w.x = cvt_pk_bf16(v0[0], v0[1]); w.y = cvt_pk_bf16(v0[2], v0[3]); w.z = cvt_pk_bf16(v1[0], v1[1]); w.w = cvt_pk_bf16(v1[2], v1[3]);
                    *(u32x4*)(rowp + bj * HALF) = w; } }
    }
};
struct EpiSwiGLU {
    static constexpr bool PERM = true, AFTER_DRAIN = false;
    bf16_t* O; int ldc;
    __device__ __forceinline__ void operator()(const f32x4 (&acc)[2][2][4][2], const Unit& u, int wr, int wc, int fr, int fq) const {
        const int row0 = u.pm * BM + wr * 64 + fr; const int col0 = u.pn * HALF + wc * 32 + 8 * fq;
#pragma unroll
        for (int ai = 0; ai < 2; ++ai)
#pragma unroll
            for (int m = 0; m < 4; ++m) { bf16_t* rowp = O + (size_t)(row0 + ai * HALF + m * 16) * ldc + col0;
                float o[8];
#pragma unroll
                for (int n = 0; n < 2; ++n)
#pragma unroll
                    for (int e = 0; e < 4; ++e) { const float gte = acc[ai][0][m][n][e], up = acc[ai][1][m][n][e]; o[n * 4 + e] = gte * __builtin_amdgcn_rcpf(1.0f + __expf(-gte)) * up; }
                u32x4 w; w.x = cvt_pk_bf16(o[0], o[1]); w.y = cvt_pk_bf16(o[2], o[3]); w.z = cvt_pk_bf16(o[4], o[5]); w.w = cvt_pk_bf16(o[6], o[7]);
                *(u32x4*)rowp = w; }
    }
};
struct EpiResid {
    static constexpr bool PERM = false, AFTER_DRAIN = false;
    const float* xin_p; const float* xin_s; float* xout; const float* gate  ; const float* cscale;
    __device__ __forceinline__ void operator()(const f32x4 (&acc)[2][2][4][2], const Unit& u, int wr, int wc, int fr, int fq) const {
        const int row0 = u.pm * BM + wr * 64 + fr, col0 = u.pn * BM + wc * 32 + 4 * fq;
        const float* gp = gate + (size_t)cond_of_panel(u.pm) * 12288 + col0;
        f32x4 gv[2][2];
#pragma unroll
        for (int bj = 0; bj < 2; ++bj)
#pragma unroll
            for (int n = 0; n < 2; ++n) { gv[bj][n] = *(const f32x4*)(gp + bj * HALF + n * 16); if (cscale) gv[bj][n] = gv[bj][n] * *(const f32x4*)(cscale + col0 + bj * HALF + n * 16); }
#pragma unroll
        for (int ai = 0; ai < 2; ++ai)
#pragma unroll
            for (int m = 0; m < 4; ++m) { const int row = row0 + ai * HALF + m * 16;
                const float* xi = xin_p ? (row < 4096 ? xin_p + (size_t)row * 2048 : xin_s + (size_t)(row - 4096) * 2048) : xout + (size_t)row * 2048;
                float* xo = xout + (size_t)row * 2048;
#pragma unroll
                for (int bj = 0; bj < 2; ++bj)
#pragma unroll
                    for (int n = 0; n < 2; ++n) { const f32x4 xv = *(const f32x4*)(xi + col0 + bj * HALF + n * 16); *(f32x4*)(xo + col0 + bj * HALF + n * 16) = xv + gv[bj][n] * acc[ai][bj][m][n]; } }
    }
};

template <class Epi, class Sched, bool ALIGN_EPI = false, bool SP2 = false>
__device__ __forceinline__ void gemm_phase(PG8_LAS unsigned char* lds, const Gemm g, const Sched& S, const Epi& E) {
    const int tid = threadIdx.x, wid = __builtin_amdgcn_readfirstlane(tid >> 6), lane = tid & 63, wr = wid >> 2, wc = wid & 3, fr = lane & 15, fq = lane >> 4;
    const int K = g.K, nt = K / BK;
    unsigned voffA[2], voffB[2];
#pragma unroll
    for (int i = 0; i < 2; ++i) { int R, C; stage_rc(tid * 16 + i * 8192, R, C); const int Rb = Epi::PERM ? ((R & ~31) + perm32(R & 31)) : R;
        voffA[i] = (unsigned)(R * g.lda + C) * 2u; voffB[i] = (unsigned)(Rb * g.ldb + C) * 2u; }
    const size_t kstep = (size_t)(BK * 2);
    const size_t hstepA = (size_t)HALF * g.lda * 2, hstepB = (size_t)HALF * g.ldb * 2;
    const size_t tstepA = 2 * hstepA, tstepB = 2 * hstepB;
    const unsigned ldsw = (unsigned)wid * 1024u;
    const int aoff = lds_byte(wr * 64 + fr, fq * 8), boff = lds_byte(wc * 32 + fr, fq * 8);
#define PG8_SA(b, h) (((b) * 2 + (h)) * HTB)
#define PG8_SB(b, h) ((4 + (b) * 2 + (h)) * HTB)
#define PG8_STAGE(bufoff, gbase, voff) do { _Pragma("unroll") for (int _i = 0; _i < 2; ++_i) \
        __builtin_amdgcn_global_load_lds((const unsigned*)((const char*)(gbase) + (voff)[_i]), (PG8_LAS unsigned*)(lds + (bufoff) + ldsw + _i * 8192), 16, 0, 0); } while (0)
#define PG8_LDA(dst, b, h) do { _Pragma("unroll") for (int m = 0; m < 4; ++m) _Pragma("unroll") for (int k = 0; k < 2; ++k) dst[m][k] = *(const PG8_LAS bf16x8*)(lds + PG8_SA(b, h) + aoff + m * 2048 + k * 1024); } while (0)
#define PG8_LDB(dst, b, h) do { _Pragma("unroll") for (int n = 0; n < 2; ++n) _Pragma("unroll") for (int k = 0; k < 2; ++k) dst[n][k] = *(const PG8_LAS bf16x8*)(lds + PG8_SB(b, h) + boff + n * 2048 + k * 1024); } while (0)
#define PG8_MMA(ai, bj, At, Bt) do { __builtin_amdgcn_s_setprio(1); _Pragma("unroll") for (int m = 0; m < 4; ++m) _Pragma("unroll") for (int n = 0; n < 2; ++n) _Pragma("unroll") for (int k = 0; k < 2; ++k) \
        acc[ai][bj][m][n] = __builtin_amdgcn_mfma_f32_16x16x32_bf16(Bt[n][k], At[m][k], acc[ai][bj][m][n], 0, 0, 0); __builtin_amdgcn_s_setprio(0); } while (0)
#define PG8_WAIT_V(n) asm volatile("s_waitcnt vmcnt(" #n ")" ::: "memory")
#define PG8_WAIT_L(n) asm volatile("s_waitcnt lgkmcnt(" #n ")" ::: "memory")
#define PG8_BAR __builtin_amdgcn_s_barrier()
#define PG8_SCHED __builtin_amdgcn_sched_barrier(0)
    Unit cur, nxt; int ui = 0;
    if (!S.next(0, cur)) return;
    f32x4 acc[2][2][4][2];
#pragma unroll
    for (int a = 0; a < 2; ++a)
#pragma unroll
        for (int b = 0; b < 2; ++b)
#pragma unroll
            for (int m = 0; m < 4; ++m)
#pragma unroll
                for (int n = 0; n < 2; ++n) acc[a][b][m][n] = (f32x4){0.f, 0.f, 0.f, 0.f};
    bf16x8 At[4][2], B0[2][2], B1[2][2];
    const char* cA = (const char*)g.A + (size_t)cur.pm * tstepA + (size_t)((cur.pn >> g.gsh) * g.gk) * 2; const char* cB = (const char*)g.Bt + (size_t)cur.pn * tstepB;
    S.a_ready(cur);
    if constexpr (SP2) {
        PG8_STAGE(PG8_SB(0, 0), cB, voffB); PG8_STAGE(PG8_SB(0, 1), cB + hstepB, voffB); PG8_STAGE(PG8_SA(0, 0), cA, voffA); PG8_STAGE(PG8_SA(0, 1), cA + hstepA, voffA);
        if (wr == 1) PG8_BAR;
        PG8_WAIT_V(2); PG8_BAR;
        PG8_STAGE(PG8_SB(1, 0), cB + kstep, voffB); PG8_STAGE(PG8_SA(1, 0), cA + kstep, voffA); PG8_STAGE(PG8_SB(1, 1), cB + hstepB + kstep, voffB);
        PG8_WAIT_V(6); PG8_BAR;
    } else {
        PG8_STAGE(PG8_SB(0, 0), cB, voffB); PG8_STAGE(PG8_SA(0, 0), cA, voffA); PG8_STAGE(PG8_SB(0, 1), cB + hstepB, voffB); PG8_STAGE(PG8_SA(0, 1), cA + hstepA, voffA);
        if (wr == 1) PG8_BAR;
        PG8_WAIT_V(4); PG8_BAR;
        PG8_STAGE(PG8_SB(1, 0), cB + kstep, voffB); PG8_STAGE(PG8_SA(1, 0), cA + kstep, voffA); PG8_STAGE(PG8_SB(1, 1), cB + hstepB + kstep, voffB);
        PG8_WAIT_V(6); PG8_BAR;
    }
    for (;;) {
        const bool has_next = S.next(ui + 1, nxt);
        const char* nA = has_next ? (const char*)g.A + (size_t)nxt.pm * tstepA + (size_t)((nxt.pn >> g.gsh) * g.gk) * 2 : cA; const char* nB = has_next ? (const char*)g.Bt + (size_t)nxt.pn * tstepB : cB;
        for (int t = 0; t < nt; t += 2) {
            const bool last = (t == nt - 2);
            const char* a1 = cA + (size_t)(t + 1) * kstep;
            const char* a2 = last ? nA : cA + (size_t)(t + 2) * kstep; const char* b2 = last ? nB : cB + (size_t)(t + 2) * kstep;
            const char* a3 = a2 + kstep; const char* b3 = b2 + kstep;
            if (last && has_next) S.a_ready(nxt);
            if constexpr (SP2) {
            PG8_LDB(B0, 0, 0); PG8_LDB(B1, 0, 1); PG8_SCHED; PG8_LDA(At, 0, 0); PG8_STAGE(PG8_SA(1, 1), a1 + hstepA, voffA);
            PG8_WAIT_V(8); PG8_WAIT_L(0); PG8_BAR; PG8_MMA(0, 0, At, B0); PG8_MMA(0, 1, At, B1); PG8_BAR; PG8_SCHED;
            PG8_LDA(At, 0, 1); PG8_STAGE(PG8_SB(0, 0), b2, voffB); PG8_STAGE(PG8_SB(0, 1), b2 + hstepB, voffB); PG8_STAGE(PG8_SA(0, 0), a2, voffA);
            PG8_WAIT_V(8); PG8_WAIT_L(0); PG8_BAR; PG8_MMA(1, 0, At, B0); PG8_MMA(1, 1, At, B1); PG8_BAR; PG8_SCHED;
            PG8_LDB(B0, 1, 0); PG8_LDB(B1, 1, 1); PG8_SCHED; PG8_LDA(At, 1, 0); PG8_STAGE(PG8_SA(0, 1), a2 + hstepA, voffA);
            PG8_WAIT_V(8); PG8_WAIT_L(0); PG8_BAR; PG8_MMA(0, 0, At, B0); PG8_MMA(0, 1, At, B1); PG8_BAR; PG8_SCHED;
            PG8_LDA(At, 1, 1); PG8_STAGE(PG8_SB(1, 0), b3, voffB); PG8_STAGE(PG8_SB(1, 1), b3 + hstepB, voffB); PG8_STAGE(PG8_SA(1, 0), a3, voffA);
            PG8_WAIT_V(8); PG8_WAIT_L(0); PG8_BAR; PG8_MMA(1, 0, At, B0); PG8_MMA(1, 1, At, B1); PG8_BAR; PG8_SCHED;
            } else {
            PG8_LDB(B0, 0, 0); PG8_SCHED; PG8_LDA(At, 0, 0); PG8_STAGE(PG8_SA(1, 1), a1 + hstepA, voffA);
            PG8_WAIT_L(8); PG8_BAR; PG8_WAIT_L(0); PG8_MMA(0, 0, At, B0); PG8_BAR; PG8_SCHED;
            PG8_LDB(B1, 0, 1); PG8_STAGE(PG8_SB(0, 0), b2, voffB);
            PG8_BAR; PG8_WAIT_L(0); PG8_MMA(0, 1, At, B1); PG8_BAR;
            PG8_LDA(At, 0, 1); PG8_STAGE(PG8_SA(0, 0), a2, voffA);
            PG8_BAR; PG8_WAIT_L(0); PG8_MMA(1, 0, At, B0); PG8_BAR; PG8_SCHED;
            PG8_STAGE(PG8_SB(0, 1), b2 + hstepB, voffB);
            PG8_WAIT_V(6); PG8_BAR; PG8_MMA(1, 1, At, B1); PG8_BAR;
            PG8_LDB(B0, 1, 0); PG8_SCHED; PG8_LDA(At, 1, 0); PG8_STAGE(PG8_SA(0, 1), a2 + hstepA, voffA);
            PG8_WAIT_L(8); PG8_BAR; PG8_WAIT_L(0); PG8_MMA(0, 0, At, B0); PG8_BAR; PG8_SCHED;
            PG8_LDB(B1, 1, 1); PG8_STAGE(PG8_SB(1, 0), b3, voffB);
            PG8_BAR; PG8_WAIT_L(0); PG8_MMA(0, 1, At, B1); PG8_BAR;
            PG8_LDA(At, 1, 1); PG8_STAGE(PG8_SA(1, 0), a3, voffA);
            PG8_BAR; PG8_WAIT_L(0); PG8_MMA(1, 0, At, B0); PG8_BAR; PG8_SCHED;
            PG8_STAGE(PG8_SB(1, 1), b3 + hstepB, voffB);
            PG8_WAIT_V(6); PG8_BAR; PG8_MMA(1, 1, At, B1); PG8_BAR;
            }
        }
        if constexpr (ALIGN_EPI) { if (wr == 0) PG8_BAR; }
        if constexpr (!Epi::AFTER_DRAIN) { E(acc, cur, wr, wc, fr, fq); S.done(cur); }
        if (!has_next) break;
#pragma unroll
        for (int a = 0; a < 2; ++a)
#pragma unroll
            for (int b = 0; b < 2; ++b)
#pragma unroll
                for (int m = 0; m < 4; ++m)
#pragma unroll
                    for (int n = 0; n < 2; ++n) acc[a][b][m][n] = (f32x4){0.f, 0.f, 0.f, 0.f};
        cur = nxt; cA = nA; cB = nB; ++ui;
        if constexpr (ALIGN_EPI) { if (wr == 1) PG8_BAR; }
    }
    PG8_WAIT_V(0);
    if constexpr (!ALIGN_EPI) { if (wr == 0) PG8_BAR; }
    PG8_BAR;
    if constexpr (Epi::AFTER_DRAIN) { E.fused(acc, cur, wr, wc, fr, fq, lds, wid, lane); S.done(cur); }
#undef PG8_SA
#undef PG8_SB
#undef PG8_STAGE
#undef PG8_LDA
#undef PG8_LDB
#undef PG8_MMA
#undef PG8_WAIT_V
#undef PG8_WAIT_L
#undef PG8_BAR
#undef PG8_SCHED
}
}

constexpr int D = 2048, NTOK = 12288, NPROMPT = 4096, DFF = 5632, PW = 7680  , CPA = 3488;
constexpr int NWAVES = 8, NTHR = 512;
constexpr int PC_GDN = 3072, PC_Z = 6144, PC_LORA = 7168, PC_BETA = 7584, PC_ALPHA = 7600;
constexpr float RMS_EPS = 1e-6f, GN_EPS = 64e-5f;

constexpr size_t MiB = 1u << 20;
constexpr size_t WS_CTL = 0, CTL_ZERO_BYTES = 1 * MiB;
constexpr size_t WS_MOD = 1 * MiB;
constexpr size_t WS_WIN = 3 * MiB;
constexpr size_t WS_WOUT = 63 * MiB;
constexpr size_t WS_WGU = 79 * MiB;
constexpr size_t WS_WDN = 255 * MiB;
constexpr size_t WS_WPOOL = 343 * MiB;
constexpr size_t WS_H = 347 * MiB;
constexpr size_t WS_O = 395 * MiB;
constexpr size_t WS_P = 443 * MiB;
constexpr size_t WS_SC = 623 * MiB;
constexpr size_t SC_ONE = 48 * MiB;
constexpr size_t WS_Y = 1247 * MiB;
constexpr size_t WS_SMALL = 1439 * MiB;
constexpr size_t WS_END = 1443 * MiB;
constexpr int CW_BAR = 4096;

constexpr int LDS_STAGE = 131072, LDS_MISC = LDS_STAGE + 320, LDS_BYTES = 147456;

#define GAS __attribute__((address_space(1)))
#define LAS __attribute__((address_space(3)))
typedef unsigned short bf16;
typedef unsigned v4u __attribute__((ext_vector_type(4)));
typedef unsigned v2u __attribute__((ext_vector_type(2)));
typedef float f32x4 __attribute__((ext_vector_type(4)));
typedef float f32x2 __attribute__((ext_vector_type(2)));
#define LDS_WAIT() asm volatile("s_waitcnt lgkmcnt(0)" ::: "memory")

__device__ __forceinline__ unsigned f2bf(float f) { unsigned u = __builtin_bit_cast(unsigned, f); return (u + 0x7fffu + ((u >> 16) & 1u)) >> 16; }
__device__ __forceinline__ unsigned pk2(float lo, float hi) { return f2bf(lo) | (f2bf(hi) << 16); }
__device__ __forceinline__ float bf2f(bf16 b) { return __builtin_bit_cast(float, (unsigned)b << 16); }
__device__ __forceinline__ float bflo(unsigned w) { return __builtin_bit_cast(float, w << 16); }
__device__ __forceinline__ float bfhi(unsigned w) { return __builtin_bit_cast(float, w & 0xffff0000u); }
__device__ __forceinline__ float sigmoidf_(float x) { return 1.0f / (1.0f + __expf(-x)); }
__device__ __forceinline__ float siluf_(float x) { return x / (1.0f + __expf(-x)); }
__device__ __forceinline__ float softplusf_(float x) { return x > 20.f ? x : log1pf(__expf(x)); }
__device__ __forceinline__ float wave_sum(float v) {
#pragma unroll
    for (int o = 1; o < 64; o <<= 1) v += __shfl_xor(v, o);
    return v;
}
__device__ __forceinline__ int opaque_tid() { int t = threadIdx.x; asm volatile("" : "+v"(t)); return t; }
__device__ __forceinline__ float rdl(float v, int k) { return __builtin_bit_cast(float, __builtin_amdgcn_readlane(__builtin_bit_cast(int, v), k)); }

#define XB_TMO      128
#define XB_XCNT(j)  (256  + 64 * (j))
#define XB_XSUB(j)  (1280 + 64 * (j))
#define XB_XGEN(j)  (2304 + 64 * (j))
#define XB_TOP      3328
#define XB_TOPGEN   3392
#define XCD_BAR_WORDS 3456
#define XB_SPIN_CAP (1u << 18)
__device__ __forceinline__ unsigned xb_ld(unsigned* p)              { return __hip_atomic_load(p, __ATOMIC_RELAXED, __HIP_MEMORY_SCOPE_AGENT); }
__device__ __forceinline__ unsigned xb_add(unsigned* p, unsigned v) { return __hip_atomic_fetch_add(p, v, __ATOMIC_RELAXED, __HIP_MEMORY_SCOPE_AGENT); }
__device__ __forceinline__ unsigned xb_xcc_id() { return (unsigned)__builtin_amdgcn_s_getreg((3 << 11) | 20) & 0xFu; }
#define XB_SPIN(cond, bar) do { unsigned _sp = 0; while (cond) { __builtin_amdgcn_s_sleep(1); \
    if ((++_sp & 255u) == 0u) { if (xb_ld(&(bar)[XB_TMO])) break; if (_sp > XB_SPIN_CAP) { atomicAdd(&(bar)[XB_TMO], 1u); break; } } } } while (0)
struct XcdBarrier { unsigned* bar; unsigned x; volatile LAS unsigned* st; };
__device__ __forceinline__ XcdBarrier xcd_barrier_post(unsigned* bar, volatile LAS unsigned* st) {
    XcdBarrier b; b.bar = bar; b.x = xb_xcc_id(); b.st = st;
    if (threadIdx.x == 0) (void)xb_add(&bar[XB_XCNT(b.x)], 1u);
    return b;
}
__device__ __forceinline__ void xcd_barrier_complete(unsigned* bar, unsigned x, unsigned& nloc, unsigned& nx) {
    const unsigned G = gridDim.x * gridDim.y * gridDim.z;
    unsigned sum, cnt, mine, sp = 0u;
    for (;;) {
        sum = 0u; cnt = 0u; mine = 0u;
#pragma unroll
        for (unsigned j = 0; j < 16; ++j) { const unsigned c = xb_ld(&bar[XB_XCNT(j)]); sum += c; cnt += (c > 0u) ? 1u : 0u; mine = (j == x) ? c : mine; }
        if (sum == G) break;
        __builtin_amdgcn_s_sleep(1);
        if ((++sp & 255u) == 0u) { if (xb_ld(&bar[XB_TMO])) break; if (sp > XB_SPIN_CAP) { atomicAdd(&bar[XB_TMO], 1u); break; } }
    }
    nloc = mine > 0u ? mine : 1u; nx = cnt > 0u ? cnt : 1u;
}
__device__ __forceinline__ void xcd_barrier(const XcdBarrier& b) {
    asm volatile("s_waitcnt vmcnt(0)" ::: "memory");
    __syncthreads();
    if (threadIdx.x == 0) {
        unsigned* bar = b.bar;
        __builtin_amdgcn_s_waitcnt(0);
        unsigned nloc = b.st[0], nx = b.st[1];
        if (nloc == 0u) { xcd_barrier_complete(bar, b.x, nloc, nx); b.st[0] = nloc; b.st[1] = nx; }
        const unsigned old = xb_add(&bar[XB_XSUB(b.x)], 1u);
        const unsigned gen = old / nloc;
        if (old + 1u == (gen + 1u) * nloc) {
            __builtin_amdgcn_fence(__ATOMIC_RELEASE, "agent");
            asm volatile("s_waitcnt vmcnt(0)" ::: "memory");
            const unsigned og = xb_add(&bar[XB_TOP], 1u);
            const unsigned tg = og / nx;
            if (og + 1u == (tg + 1u) * nx) xb_add(&bar[XB_TOPGEN], 1u);
            else XB_SPIN(xb_ld(&bar[XB_TOPGEN]) == tg, bar);
            __builtin_amdgcn_fence(__ATOMIC_ACQUIRE, "agent");
            xb_add(&bar[XB_XGEN(b.x)], 1u);
            asm volatile("s_waitcnt vmcnt(0)" ::: "memory");
        } else {
            XB_SPIN(xb_ld(&bar[XB_XGEN(b.x)]) == gen, bar);
            __builtin_amdgcn_fence(__ATOMIC_ACQUIRE, "agent");
            asm volatile("s_waitcnt vmcnt(0)" ::: "memory");
        }
    }
    __syncthreads();
}

enum { I_XP = 0, I_XS, I_SRW, I_SDL, I_C, I_CCTX, I_MODW, I_MODB, I_NMIX, I_NFFN, I_NFIN, I_WIN, I_WOUT, I_MU, I_W0, I_W2, I_A0, I_A2, I_G2, I_KK, I_KA, I_RK, I_LNW, I_LNB,
       I_CONVW, I_ALOG, I_DTB, I_GNW, I_POOLW, I_POOLS, I_WG, I_WU, I_WD, N_IN };
struct Args { const float* in[N_IN]; float* out; unsigned char* ws; int ph_lo, ph_hi; };
constexpr size_t OUT_SRW = (size_t)NTOK * D, OUT_SDL = OUT_SRW + (size_t)16 * 2 * 2 * 16 * 64 * 64;

__device__ __forceinline__ void conv_item(const float* W, int K, int N, bf16* WT, int drow0, LAS float* scr, int kb, int nb, int lane) {
    const int k0 = 64 * kb, n0 = 32 * nb;
#pragma unroll 8
    for (int i = 0; i < 32; ++i) { const int kk = 2 * i + (lane >> 5); scr[kk * 33 + (lane & 31)] = W[(size_t)(k0 + kk) * N + n0 + (lane & 31)]; }
    LDS_WAIT(); asm volatile("" ::: "memory");
    const int c = lane & 7;
#pragma unroll
    for (int j = 0; j < 4; ++j) { const int n = (lane >> 3) + 8 * j; const LAS float* s = scr + (8 * c) * 33 + n;
        v4u o; o.x = pk2(s[0 * 33], s[1 * 33]); o.y = pk2(s[2 * 33], s[3 * 33]); o.z = pk2(s[4 * 33], s[5 * 33]); o.w = pk2(s[6 * 33], s[7 * 33]);
        *(v4u*)(WT + (size_t)(drow0 + n) * K + k0 + 8 * c) = o; }
    LDS_WAIT(); asm volatile("" ::: "memory");
}
__device__ __forceinline__ int win_row(int n) { return n < 3072 ? n : (n < CPA ? PC_LORA + (n - 3072) : (n < CPA + 4096 ? PC_GDN + (n - CPA) : n)); }

__device__ __forceinline__ void ph_pre(const Args& a, LAS unsigned char* lds) {
    const int tid = opaque_tid(), lane = tid & 63, wave = __builtin_amdgcn_readfirstlane(tid >> 6);
    const int G = gridDim.x;
    LAS float* ca = (LAS float*)lds;
    LAS float* red = (LAS float*)(lds + 2048 * 9 * 4);
    for (int i = tid; i < 9 * 2048; i += NTHR) { const int c = i / 2048, k = i - c * 2048; const float v = c == 0 ? a.in[I_CCTX][k] : a.in[I_C][(c - 1) * 2048 + k]; ca[k * 9 + c] = siluf_(v); }
    __syncthreads();
    float* MOD = (float*)(a.ws + WS_MOD);
    for (int task = blockIdx.x; task < 4 * 96; task += G) {
        const int l = task / 96, cb = task - l * 96;
        const float* wp = a.in[I_MODW] + ((size_t)l * 2048 + wave * 256) * 12288 + cb * 128 + lane * 2;
        float acc[9][2];
#pragma unroll
        for (int c = 0; c < 9; ++c) { acc[c][0] = 0.f; acc[c][1] = 0.f; }
        for (int k8 = 0; k8 < 256; k8 += 8) {
            f32x2 wv[8];
#pragma unroll
            for (int j = 0; j < 8; ++j) wv[j] = *(const f32x2*)(wp + (size_t)(k8 + j) * 12288);
#pragma unroll
            for (int j = 0; j < 8; ++j) { const LAS float* cp = ca + (wave * 256 + k8 + j) * 9;
#pragma unroll
                for (int c = 0; c < 9; ++c) { const float s = cp[c]; acc[c][0] += s * wv[j].x; acc[c][1] += s * wv[j].y; } }
        }
#pragma unroll
        for (int c = 0; c < 9; ++c) { red[(wave * 18 + c * 2) * 64 + lane] = acc[c][0]; red[(wave * 18 + c * 2 + 1) * 64 + lane] = acc[c][1]; }
        __syncthreads();
        for (int o = tid; o < 9 * 128; o += NTHR) { const int c = o >> 7, col = o & 127, ln = col >> 1, j = col & 1; float s = a.in[I_MODB][l * 12288 + cb * 128 + col];
#pragma unroll
            for (int w = 0; w < 8; ++w) s += red[(w * 18 + c * 2 + j) * 64 + ln];
            MOD[((size_t)l * 9 + c) * 12288 + cb * 128 + col] = s; }
        __syncthreads();
    }
    __syncthreads();
    LAS float* scr = (LAS float*)(lds + wave * 16384);
    const int gw = blockIdx.x * NWAVES + wave, NGW = G * NWAVES;
    bf16* WIN = (bf16*)(a.ws + WS_WIN); bf16* WOUT = (bf16*)(a.ws + WS_WOUT); bf16* WGU = (bf16*)(a.ws + WS_WGU); bf16* WDN = (bf16*)(a.ws + WS_WDN); bf16* WPOOL = (bf16*)(a.ws + WS_WPOOL);
    constexpr int IT_WIN = 32 * 238, IT_WOUT = 32 * 64, IT_GU = 32 * 176, IT_DN = 88 * 64, IT_POOL = 8 * 16;
    constexpr int NITEMS = 2 * IT_WIN + 2 * IT_WOUT + 8 * IT_GU + 4 * IT_DN + 8 * IT_POOL;
    for (int it = gw; it < NITEMS; it += NGW) {
        int r = it;
        if (r < 2 * IT_WIN) { const int i = r / IT_WIN; r -= i * IT_WIN; const int kb = r / 238, nb = r - kb * 238;
            conv_item(a.in[I_WIN] + (size_t)i * 2048 * 7616, 2048, 7616, WIN + (size_t)i * PW * 2048, win_row(32 * nb), scr, kb, nb, lane); continue; } r -= 2 * IT_WIN;
        if (r < 2 * IT_WOUT) { const int i = r / IT_WOUT; r -= i * IT_WOUT; const int kb = r / 64, nb = r - kb * 64;
            conv_item(a.in[I_WOUT] + (size_t)i * 2048 * 2048, 2048, 2048, WOUT + (size_t)i * 2048 * 2048, 32 * nb, scr, kb, nb, lane); continue; } r -= 2 * IT_WOUT;
        if (r < 8 * IT_GU) { const int li = r / IT_GU; r -= li * IT_GU; const int l = li >> 1, up = li & 1; const int kb = r / 176, nb = r - kb * 176; const int n0 = 32 * nb;
            conv_item(a.in[up ? I_WU : I_WG] + (size_t)l * 2048 * DFF, 2048, DFF, WGU + (size_t)l * 11264 * 2048, (n0 >> 7) * 256 + up * 128 + (n0 & 127), scr, kb, nb, lane); continue; } r -= 8 * IT_GU;
        if (r < 4 * IT_DN) { const int l = r / IT_DN; r -= l * IT_DN; const int kb = r / 64, nb = r - kb * 64;
            conv_item(a.in[I_WD] + (size_t)l * DFF * 2048, DFF, 2048, WDN + (size_t)l * 2048 * DFF, 32 * nb, scr, kb, nb, lane); continue; } r -= 4 * IT_DN;
        { const int ig = r / IT_POOL; r -= ig * IT_POOL; const int kb = r / 16, nb = r - kb * 16;
            conv_item(a.in[I_POOLW] + (size_t)ig * 512 * 512, 512, 512, WPOOL + (size_t)ig * 512 * 512, 32 * nb, scr, kb, nb, lane); }
    }
    for (int r = gw; r < 128; r += NGW) { bf16* row = WIN + ((size_t)(r >> 6) * PW + 7616 + (r & 63)) * 2048; const v4u z = {0u, 0u, 0u, 0u};
#pragma unroll
        for (int j = 0; j < 4; ++j) *(v4u*)(row + (j * 64 + lane) * 8) = z; }
}

__device__ __forceinline__ void ph_norm(const Args& a, int l, int which) {
    const int tid = opaque_tid(), lane = tid & 63, wave = __builtin_amdgcn_readfirstlane(tid >> 6);
    const int gw = blockIdx.x * NWAVES + wave, NGW = gridDim.x * NWAVES;
    const float* nw = a.in[which ? I_NFFN : I_NMIX] + l * 2048;
    const float* MOD = (const float*)(a.ws + WS_MOD) + (size_t)l * 9 * 12288;
    bf16* H = (bf16*)(a.ws + WS_H);
    const bool from_in = (l == 0 && which == 0);
    for (int m = gw; m < NTOK; m += NGW) {
        const float* xr = from_in ? (m < NPROMPT ? a.in[I_XP] + (size_t)m * D : a.in[I_XS] + (size_t)(m - NPROMPT) * D) : a.out + (size_t)m * D;
        const int cond = m < NPROMPT ? 0 : 1 + ((m - NPROMPT) >> 10);
        const float* sh = MOD + (size_t)cond * 12288 + (which ? 3 : 0) * 2048; const float* sc = sh + 2048;
        f32x4 v[8]; float s = 0.f;
#pragma unroll
        for (int j = 0; j < 8; ++j) { v[j] = *(const f32x4*)(xr + 4 * lane + 256 * j); s += (v[j].x * v[j].x + v[j].y * v[j].y) + (v[j].z * v[j].z + v[j].w * v[j].w); }
        const float rstd = 1.0f / sqrtf(wave_sum(s) * (1.0f / D) + RMS_EPS);
#pragma unroll
        for (int j = 0; j < 8; ++j) { const int c = 4 * lane + 256 * j; const f32x4 w = *(const f32x4*)(nw + c), s1 = *(const f32x4*)(sc + c), s0 = *(const f32x4*)(sh + c);
            const f32x4 y = (v[j] * rstd) * w * (s1 + 1.0f) + s0;
            v2u o; o.x = pk2(y.x, y.y); o.y = pk2(y.z, y.w); *(v2u*)(H + (size_t)m * D + c) = o; }
    }
}
__device__ __forceinline__ void ph_final(const Args& a) {
    const int tid = opaque_tid(), lane = tid & 63, wave = __builtin_amdgcn_readfirstlane(tid >> 6);
    const int gw = blockIdx.x * NWAVES + wave, NGW = gridDim.x * NWAVES;
    const float* nw = a.in[I_NFIN];
    for (int m = gw; m < NTOK; m += NGW) {
        float* xr = a.out + (size_t)m * D;
        f32x4 v[8]; float s = 0.f;
#pragma unroll
        for (int j = 0; j < 8; ++j) { v[j] = *(const f32x4*)(xr + 4 * lane + 256 * j); s += (v[j].x * v[j].x + v[j].y * v[j].y) + (v[j].z * v[j].z + v[j].w * v[j].w); }
        const float rstd = 1.0f / sqrtf(wave_sum(s) * (1.0f / D) + RMS_EPS);
#pragma unroll
        for (int j = 0; j < 8; ++j) { const int c = 4 * lane + 256 * j; const f32x4 w = *(const f32x4*)(nw + c); *(f32x4*)(xr + c) = (v[j] * rstd) * w; }
    }
}
__device__ __forceinline__ void ph_pool(const Args& a) {
    const int tid = opaque_tid(), lane = tid & 63, wave = __builtin_amdgcn_readfirstlane(tid >> 6);
    const int gw = blockIdx.x * NWAVES + wave, NGW = gridDim.x * NWAVES;
    const bf16* H = (const bf16*)(a.ws + WS_H); bf16* O = (bf16*)(a.ws + WS_O);
    for (int m = gw; m < NTOK; m += NGW) {
        const bool samp = m >= NPROMPT; const int T = samp ? 1024 : 256; const int base = samp ? NPROMPT + (((m - NPROMPT) >> 10) << 10) : (m >> 8) << 8; const int t = m - base;
#pragma unroll
        for (int g = 0; g < 4; ++g) {
            const int win = 2 << g; int lo = t - win / 2, hi = lo + win; lo = lo < 0 ? 0 : lo; hi = hi > T ? T : hi;
            const int c = g * 512 + lane * 8;
            float s[8];
#pragma unroll
            for (int e = 0; e < 8; ++e) s[e] = 0.f;
            for (int r = lo; r < hi; ++r) { const v4u w = *(const v4u*)(H + (size_t)(base + r) * D + c);
                s[0] += bflo(w.x); s[1] += bfhi(w.x); s[2] += bflo(w.y); s[3] += bfhi(w.y); s[4] += bflo(w.z); s[5] += bfhi(w.z); s[6] += bflo(w.w); s[7] += bfhi(w.w); }
            const float inv = 1.0f / (float)(hi - lo);
            const v4u w = *(const v4u*)(H + (size_t)m * D + c);
            v4u o; o.x = pk2(s[0] * inv - bflo(w.x), s[1] * inv - bfhi(w.x)); o.y = pk2(s[2] * inv - bflo(w.y), s[3] * inv - bfhi(w.y));
            o.z = pk2(s[4] * inv - bflo(w.z), s[5] * inv - bfhi(w.z)); o.w = pk2(s[6] * inv - bflo(w.w), s[7] * inv - bfhi(w.w));
            *(v4u*)(O + (size_t)m * D + c) = o;
        }
    }
}

__device__ __forceinline__ void ph_prep(const Args& a, LAS unsigned char* lds, int i) {
    const int tid = opaque_tid(), lane = tid & 63, wave = __builtin_amdgcn_readfirstlane(tid >> 6);
    const bf16* P = (const bf16*)(a.ws + WS_P);
    bf16* SC = (bf16*)(a.ws + WS_SC); constexpr size_t S1 = (size_t)NTOK * 1024;
    bf16 *Rb = SC, *Ab = SC + S1, *Vb = SC + 2 * S1, *Kb = SC + 3 * S1, *Bb = SC + 5 * S1, *Wb = SC + 7 * S1, *Qb = SC + 9 * S1, *KDb = SC + 10 * S1, *VDb = SC + 11 * S1;
    float* GT = (float*)(SC + 12 * S1);
    float* BON = (float*)(a.ws + WS_SMALL); float* BETA = BON + (size_t)NTOK * 32; float* GG = BETA + (size_t)NTOK * 16;
    const float* MU = a.in[I_MU] + i * CPA;
    LAS float* pa = (LAS float*)lds;
    for (int tile = blockIdx.x; tile < NTOK / 8; tile += gridDim.x) {
        const int m0 = tile * 8; const bool samp = m0 >= NPROMPT; const int T = samp ? 1024 : 256;
        const int base = samp ? NPROMPT + (((m0 - NPROMPT) >> 10) << 10) : (m0 >> 8) << 8; const int t0 = m0 - base;
        for (int idx = tid; idx < 8 * CPA; idx += NTHR) {
            const int tt = idx / CPA, j = idx - tt * CPA; const int c = j < 3072 ? j : j + (PC_LORA - 3072); const int t = t0 + tt, m = m0 + tt;
            int dt; bool valid;
            if (!samp) { if (j & 1) { dt = 1; valid = t + 1 < T; } else { dt = -1; valid = t > 0; } }
            else { const int q = j & 3, col = t & 63, row = t >> 6;
                if (q == 0) { dt = -1; valid = col > 0; } else if (q == 1) { dt = 1; valid = col < 63; } else if (q == 2) { dt = -64; valid = row > 0; } else { dt = 64; valid = row < 15; } }
            const float x = bf2f(P[(size_t)m * PW + c]); const float xs = valid ? bf2f(P[(size_t)(m + dt) * PW + c]) : 0.f;
            float v = x + (xs - x) * MU[j];
            if (j >= 3072 && j < 3200) v = tanhf(v); else if (j >= 3328) v = sigmoidf_(v);
            pa[tt * CPA + j] = v;
        }
        __syncthreads();
        for (int cc = 0; cc < 2; ++cc) {
            const int c = tid + cc * 512; const int head = c >> 6;
            float wl[2][8], al[2][8], gl[8];
#pragma unroll
            for (int tt = 0; tt < 8; ++tt) { wl[0][tt] = wl[1][tt] = al[0][tt] = al[1][tt] = gl[tt] = 0.f; }
#pragma unroll
            for (int d = 0; d < 2; ++d) {
                const float* w2 = a.in[I_W2] + ((size_t)(i * 2 + d) * 64) * 1024 + c; const float* a2 = a.in[I_A2] + ((size_t)(i * 2 + d) * 64) * 1024 + c;
                for (int r = 0; r < 64; ++r) { const float w2v = w2[(size_t)r * 1024], a2v = a2[(size_t)r * 1024];
#pragma unroll
                    for (int tt = 0; tt < 8; ++tt) { wl[d][tt] += pa[tt * CPA + 3072 + d * 64 + r] * w2v; al[d][tt] += pa[tt * CPA + 3200 + d * 64 + r] * a2v; } }
            }
            { const float* g2 = a.in[I_G2] + (size_t)i * 160 * 1024 + c;
                for (int r = 0; r < 160; ++r) { const float g2v = g2[(size_t)r * 1024];
#pragma unroll
                    for (int tt = 0; tt < 8; ++tt) gl[tt] += pa[tt * CPA + 3328 + r] * g2v; } }
            const float kkw = a.in[I_KK][i * 1024 + c], kaw = a.in[I_KA][i * 1024 + c], rkw = a.in[I_RK][i * 1024 + c];
            const float w0v[2] = {a.in[I_W0][(i * 2 + 0) * 1024 + c], a.in[I_W0][(i * 2 + 1) * 1024 + c]}, a0v[2] = {a.in[I_A0][(i * 2 + 0) * 1024 + c], a.in[I_A0][(i * 2 + 1) * 1024 + c]};
#pragma unroll
            for (int tt = 0; tt < 8; ++tt) {
                const size_t o = (size_t)(m0 + tt) * 1024 + c;
                const float r_ = pa[tt * CPA + c], k_ = pa[tt * CPA + 1024 + c], v_ = pa[tt * CPA + 2048 + c];
                const float kkr = k_ * kkw; const float ss = wave_sum(kkr * kkr); const float kk = kkr * (1.0f / sqrtf(ss + 1e-12f));
                Rb[o] = (bf16)f2bf(r_); Vb[o] = (bf16)f2bf(v_); Ab[o] = (bf16)f2bf(-kk); GT[o] = gl[tt];
#pragma unroll
                for (int d = 0; d < 2; ++d) {
                    const float u = w0v[d] + wl[d][tt]; const float w = -0.6065306597f * 1.4426950409f * sigmoidf_(u); const float ic = sigmoidf_(a0v[d] + al[d][tt]);
                    const float kd = k_ * (1.0f + (ic - 1.0f) * kaw);
                    Wb[d * S1 + o] = (bf16)f2bf(w); Kb[d * S1 + o] = (bf16)f2bf(kd); Bb[d * S1 + o] = (bf16)f2bf(kk * ic);
                    const float bon = wave_sum(r_ * kd * rkw);
                    if (lane == 0) BON[((size_t)(m0 + tt) * 2 + d) * 16 + head] = bon;
                }
            }
        }
        {
            const int h = wave; const float* cw = a.in[I_CONVW] + (size_t)i * 3 * 3072;
            for (int tt = 0; tt < 8; ++tt) {
                const int m = m0 + tt, t = t0 + tt; float val[3][2];
#pragma unroll
                for (int part = 0; part < 3; ++part)
#pragma unroll
                    for (int e = 0; e < 2; ++e) { const int ch = part * 1024 + h * 128 + lane + 64 * e;
                        const float x0 = t > 0 ? bf2f(P[(size_t)(m - 1) * PW + PC_GDN + ch]) : 0.f, x1 = bf2f(P[(size_t)m * PW + PC_GDN + ch]), x2 = t + 1 < T ? bf2f(P[(size_t)(m + 1) * PW + PC_GDN + ch]) : 0.f;
                        val[part][e] = siluf_(x0 * cw[ch] + x1 * cw[3072 + ch] + x2 * cw[2 * 3072 + ch]); }
                const float qs = 1.0f / sqrtf(wave_sum(val[0][0] * val[0][0] + val[0][1] * val[0][1]) + 1e-6f), ks = 1.0f / sqrtf(wave_sum(val[1][0] * val[1][0] + val[1][1] * val[1][1]) + 1e-6f);
#pragma unroll
                for (int e = 0; e < 2; ++e) { const size_t o = (size_t)m * 1024 + h * 128 + lane + 64 * e; Qb[o] = (bf16)f2bf(val[0][e] * qs); KDb[o] = (bf16)f2bf(val[1][e] * ks); VDb[o] = (bf16)f2bf(val[2][e]); }
            }
            if (tid < 128) { const int tt = tid >> 4, dh = tid & 15; const int m = m0 + tt;
                BETA[(size_t)m * 16 + dh] = sigmoidf_(bf2f(P[(size_t)m * PW + PC_BETA + dh]));
                GG[(size_t)m * 16 + dh] = -1.4426950409f * __expf(a.in[I_ALOG][i * 16 + dh]) * softplusf_(bf2f(P[(size_t)m * PW + PC_ALPHA + dh]) + a.in[I_DTB][i * 16 + dh]); }
        }
        __syncthreads();
    }
}

typedef short sfrag __attribute__((ext_vector_type(8)));
union Frag { sfrag v; unsigned u[4]; };
typedef __bf16 bf16x2_t __attribute__((ext_vector_type(2)));
__device__ __forceinline__ unsigned cvtpk(float lo, float hi) { const f32x2 v = {lo, hi}; return __builtin_bit_cast(unsigned, __builtin_convertvector(v, bf16x2_t)); }
__device__ __forceinline__ f32x4 mma(const Frag& A, const Frag& B, f32x4 C) { return __builtin_amdgcn_mfma_f32_16x16x32_bf16(A.v, B.v, C, 0, 0, 0); }
__device__ __forceinline__ Frag feed1(f32x4 d0) { Frag f; f.u[0] = cvtpk(d0.x, d0.y); f.u[1] = cvtpk(d0.z, d0.w); f.u[2] = 0u; f.u[3] = 0u; return f; }
__device__ __forceinline__ Frag feed2(f32x4 d0, f32x4 d1) { Frag f; f.u[0] = cvtpk(d0.x, d0.y); f.u[1] = cvtpk(d0.z, d0.w); f.u[2] = cvtpk(d1.x, d1.y); f.u[3] = cvtpk(d1.z, d1.w); return f; }
#define DPP_SHR(x, n, fill) __builtin_bit_cast(float, __builtin_amdgcn_update_dpp(__builtin_bit_cast(int, (float)(fill)), __builtin_bit_cast(int, (float)(x)), 0x110 + (n), 0xf, 0xf, false))
__device__ __forceinline__ float row_scan16(float x) { x += DPP_SHR(x, 1, 0.f); x += DPP_SHR(x, 2, 0.f); x += DPP_SHR(x, 4, 0.f); x += DPP_SHR(x, 8, 0.f); return x; }
__device__ __forceinline__ float lane_get(float x, int src) { return __builtin_bit_cast(float, __builtin_amdgcn_ds_bpermute(src << 2, __builtin_bit_cast(int, x))); }
constexpr f32x4 F4Z = {0.f, 0.f, 0.f, 0.f};
__device__ __forceinline__ f32x4 tri_inv_T(f32x4 dL, f32x4 dLT, f32x4 eye) {
    const Frag fL = feed1(dL), fLT = feed1(dLT);
    const f32x4 L2 = mma(fLT, fL, F4Z), L2T = mma(fL, fLT, F4Z);
    const Frag f2 = feed1(L2), f2T = feed1(L2T);
    const f32x4 L4 = mma(f2T, f2, F4Z), L4T = mma(f2, f2T, F4Z);
    const f32x4 L8 = mma(feed1(L4T), feed1(L4), F4Z);
    const f32x4 R1 = mma(feed1(L2 + eye), feed1(dLT + eye), F4Z);
    const f32x4 R2 = mma(feed1(L4 + eye), feed1(R1), F4Z);
    return mma(feed1(L8 + eye), feed1(R2), F4Z);
}

__device__ __forceinline__ void rwkv_task(const Args& a, int i, int s, int h, int d, int lane, LAS float* wscr) {
    constexpr size_t S1 = (size_t)NTOK * 1024;
    const bf16* SCb = (const bf16*)(a.ws + WS_SC);
    const bf16 *Rb = SCb, *Ab = SCb + S1, *Vb = SCb + 2 * S1, *Kb = SCb + (3 + d) * S1, *Bb = SCb + (5 + d) * S1, *LWb = SCb + (7 + d) * S1;
    float* Y = (float*)(a.ws + WS_Y) + d * S1;
    const int T = s < 16 ? 256 : 1024; const int row0 = s < 16 ? s * 256 : NPROMPT + (s - 16) * 1024;
    const int c = lane & 15, q = lane >> 4;
    f32x4 S[4][4];
    if (s >= 16) { const float* s0 = a.in[I_SRW] + ((((size_t)(s - 16) * 2 + i) * 2 + d) * 16 + h) * 4096;
#pragma unroll
        for (int kt = 0; kt < 4; ++kt)
#pragma unroll
            for (int vt = 0; vt < 4; ++vt) S[kt][vt] = *(const f32x4*)(s0 + (16 * vt + c) * 64 + 16 * kt + 4 * q); }
    else {
#pragma unroll
        for (int kt = 0; kt < 4; ++kt)
#pragma unroll
            for (int vt = 0; vt < 4; ++vt) S[kt][vt] = F4Z; }
    Frag sel[2];
#pragma unroll
    for (int p = 0; p < 2; ++p)
#pragma unroll
        for (int j = 0; j < 4; ++j) { const int e0 = 2 * j - 4 * p; const bool on = ((lane >> 2) & 3) == q && (e0 == (lane & 3) || e0 + 1 == (lane & 3)) && (j >> 1) == p;
            sel[p].u[j] = on ? (((lane & 1) == 0) ? 0x00003F80u : 0x3F800000u) : 0u; }
    bool mlt[4], mle[4]; f32x4 eye;
#pragma unroll
    for (int n = 0; n < 4; ++n) { mlt[n] = (4 * q + n) < c; mle[n] = (4 * q + n) <= c; eye[n] = (4 * q + n) == c ? 1.f : 0.f; }
    const int nch = T >> 4;
    const size_t hoff = (size_t)h * 64 + 4 * q;
    v2u nr[4], na[4], nk[4], nb[4], nlw[4], nv[4];
    for (int ch = 0; ch < nch; ++ch) {
        { const int tok = d ? T - 1 - (16 * ch + c) : 16 * ch + c; const size_t o = (size_t)(row0 + tok) * 1024 + hoff;
#pragma unroll
            for (int g = 0; g < 4; ++g) { nr[g] = *(const v2u*)(Rb + o + 16 * g); na[g] = *(const v2u*)(Ab + o + 16 * g); nk[g] = *(const v2u*)(Kb + o + 16 * g); nb[g] = *(const v2u*)(Bb + o + 16 * g); nlw[g] = *(const v2u*)(LWb + o + 16 * g); nv[g] = *(const v2u*)(Vb + o + 16 * g); } }
        Frag f_at[2], f_rt[2], f_bt[2], f_kt[2], f_bh[2], f_kh[2], f_v[2];
#pragma unroll
        for (int g = 0; g < 4; ++g) {
            const int ks = g >> 1, hf = g & 1;
            float lw_[4] = {bflo(nlw[g].x), bfhi(nlw[g].x), bflo(nlw[g].y), bfhi(nlw[g].y)};
            float r_[4] = {bflo(nr[g].x), bfhi(nr[g].x), bflo(nr[g].y), bfhi(nr[g].y)}, a_[4] = {bflo(na[g].x), bfhi(na[g].x), bflo(na[g].y), bfhi(na[g].y)};
            float k_[4] = {bflo(nk[g].x), bfhi(nk[g].x), bflo(nk[g].y), bfhi(nk[g].y)}, b_[4] = {bflo(nb[g].x), bfhi(nb[g].x), bflo(nb[g].y), bfhi(nb[g].y)};
            float at[4], rt[4], bt[4], kt[4], bh[4], kh[4];
#pragma unroll
            for (int n = 0; n < 4; ++n) {
                const float G = row_scan16(lw_[n]); const float E1 = __builtin_amdgcn_exp2f(G), E2 = __builtin_amdgcn_rcpf(E1); const float E3 = DPP_SHR(E1, 1, 1.0f);
                const float ec = lane_get(E1, (lane & 48) | 15); wscr[(g * 4 + n) * 64 + lane] = ec;
                at[n] = a_[n] * E3; rt[n] = r_[n] * E1; bt[n] = b_[n] * E2; kt[n] = k_[n] * E2; bh[n] = bt[n] * ec; kh[n] = kt[n] * ec;
            }
            f_at[ks].u[2 * hf] = cvtpk(at[0], at[1]); f_at[ks].u[2 * hf + 1] = cvtpk(at[2], at[3]); f_rt[ks].u[2 * hf] = cvtpk(rt[0], rt[1]); f_rt[ks].u[2 * hf + 1] = cvtpk(rt[2], rt[3]);
            f_bt[ks].u[2 * hf] = cvtpk(bt[0], bt[1]); f_bt[ks].u[2 * hf + 1] = cvtpk(bt[2], bt[3]); f_kt[ks].u[2 * hf] = cvtpk(kt[0], kt[1]); f_kt[ks].u[2 * hf + 1] = cvtpk(kt[2], kt[3]);
            f_bh[ks].u[2 * hf] = cvtpk(bh[0], bh[1]); f_bh[ks].u[2 * hf + 1] = cvtpk(bh[2], bh[3]); f_kh[ks].u[2 * hf] = cvtpk(kh[0], kh[1]); f_kh[ks].u[2 * hf + 1] = cvtpk(kh[2], kh[3]);
            f_v[ks].u[2 * hf] = nv[g].x; f_v[ks].u[2 * hf + 1] = nv[g].y;
            __builtin_amdgcn_sched_barrier(0);
        }
        v2u pV[4]; LAS v4u* sBK = (LAS v4u*)(wscr + 1024);
#pragma unroll
        for (int g = 0; g < 4; ++g) { const f32x4 dv = mma(f_v[g >> 1], sel[g & 1], F4Z); pV[g].x = cvtpk(dv.x, dv.y); pV[g].y = cvtpk(dv.z, dv.w);
            const Frag fb = feed2(mma(f_bh[g >> 1], sel[g & 1], F4Z), mma(f_kh[g >> 1], sel[g & 1], F4Z)); sBK[g * 64 + lane] = (v4u){fb.u[0], fb.u[1], fb.u[2], fb.u[3]}; }
        __builtin_amdgcn_sched_barrier(0);
        f32x4 dLab = mma(f_at[1], f_bt[1], mma(f_at[0], f_bt[0], F4Z));
        f32x4 dLabT = mma(f_bt[1], f_at[1], mma(f_bt[0], f_at[0], F4Z));
        f32x4 dLakT = mma(f_kt[1], f_at[1], mma(f_kt[0], f_at[0], F4Z));
        f32x4 dArbT = mma(f_bt[1], f_rt[1], mma(f_bt[0], f_rt[0], F4Z));
        f32x4 dArkT = mma(f_kt[1], f_rt[1], mma(f_kt[0], f_rt[0], F4Z));
#pragma unroll
        for (int n = 0; n < 4; ++n) { dLab[n] = (c < 4 * q + n) ? dLab[n] : 0.f; dLabT[n] = mlt[n] ? dLabT[n] : 0.f; dLakT[n] = mlt[n] ? dLakT[n] : 0.f; dArbT[n] = mle[n] ? dArbT[n] : 0.f; dArkT[n] = mle[n] ? dArkT[n] : 0.f; }
        const Frag fTT = feed1(tri_inv_T(dLab, dLabT, eye)), fLakT = feed1(dLakT), fArbT = feed1(dArbT), fArkT = feed1(dArkT);
        __builtin_amdgcn_sched_barrier(0);
        v2u pSA[4];
        const int tokbase = 16 * ch + 4 * q;
#pragma unroll
        for (int vt = 0; vt < 4; ++vt) {
            const Frag fS0 = feed2(S[0][vt], S[1][vt]), fS1 = feed2(S[2][vt], S[3][vt]); Frag fV; fV.u[0] = pV[vt].x; fV.u[1] = pV[vt].y; fV.u[2] = 0u; fV.u[3] = 0u;
            f32x4 rhs = mma(f_at[1], fS1, mma(f_at[0], fS0, F4Z)); rhs = mma(fLakT, fV, rhs);
            const f32x4 sa = mma(fTT, feed1(rhs), F4Z); pSA[vt].x = cvtpk(sa.x, sa.y); pSA[vt].y = cvtpk(sa.z, sa.w);
            Frag fSA; fSA.u[0] = pSA[vt].x; fSA.u[1] = pSA[vt].y; fSA.u[2] = 0u; fSA.u[3] = 0u;
            f32x4 y = mma(f_rt[1], fS1, mma(f_rt[0], fS0, F4Z)); y = mma(fArbT, fSA, y); y = mma(fArkT, fV, y);
#pragma unroll
            for (int n = 0; n < 4; ++n) { const int t = tokbase + n; const int tok = d ? T - 1 - t : t; Y[(size_t)(row0 + tok) * 1024 + h * 64 + 16 * vt + c] = y[n]; }
            __builtin_amdgcn_sched_barrier(0);
        }
#pragma unroll
        for (int vt = 0; vt < 4; ++vt) { Frag fB; fB.u[0] = pSA[vt].x; fB.u[1] = pSA[vt].y; fB.u[2] = pV[vt].x; fB.u[3] = pV[vt].y;
#pragma unroll
            for (int kt = 0; kt < 4; ++kt) { f32x4 cin;
#pragma unroll
                for (int n = 0; n < 4; ++n) cin[n] = S[kt][vt][n] * wscr[(kt * 4 + n) * 64 + lane];
                const v4u w = sBK[kt * 64 + lane]; Frag fbk; fbk.u[0] = w.x; fbk.u[1] = w.y; fbk.u[2] = w.z; fbk.u[3] = w.w;
                S[kt][vt] = mma(fbk, fB, cin); } }
    }
    if (s < 16) { float* so = a.out + OUT_SRW + ((((size_t)s * 2 + i) * 2 + d) * 16 + h) * 4096;
#pragma unroll
        for (int kt = 0; kt < 4; ++kt)
#pragma unroll
            for (int vt = 0; vt < 4; ++vt) *(f32x4*)(so + (16 * vt + c) * 64 + 16 * kt + 4 * q) = S[kt][vt]; }
}

__device__ __forceinline__ Frag scale_frag(const Frag& x, float sc) { Frag f;
#pragma unroll
    for (int j = 0; j < 4; ++j) f.u[j] = cvtpk(bflo(x.u[j]) * sc, bfhi(x.u[j]) * sc);
    return f; }
__device__ __forceinline__ void gdn_task(const Args& a, int i, int s, int h, int d, int vb, int lane, LAS float* wscr) {
    constexpr size_t S1 = (size_t)NTOK * 1024;
    const bf16* SCb = (const bf16*)(a.ws + WS_SC);
    const bf16 *Qb = SCb + 9 * S1, *KDb = SCb + 10 * S1, *VDb = SCb + 11 * S1;
    const float* BETA = (const float*)(a.ws + WS_SMALL) + (size_t)NTOK * 32; const float* GG = BETA + (size_t)NTOK * 16;
    float* O = (float*)(a.ws + WS_Y) + 2 * S1 + d * S1;
    const int T = s < 16 ? 256 : 1024; const int row0 = s < 16 ? s * 256 : NPROMPT + (s - 16) * 1024;
    const int c = lane & 15, q = lane >> 4;
    f32x4 S[8][2];
    if (s >= 16) { const float* s0 = a.in[I_SDL] + ((((size_t)(s - 16) * 2 + i) * 2 + d) * 8 + h) * 16384 + 32 * vb + c;
#pragma unroll
        for (int kt = 0; kt < 8; ++kt)
#pragma unroll
            for (int vt = 0; vt < 2; ++vt)
#pragma unroll
                for (int n = 0; n < 4; ++n) S[kt][vt][n] = s0[(16 * kt + 4 * q + n) * 128 + 16 * vt]; }
    else {
#pragma unroll
        for (int kt = 0; kt < 8; ++kt) { S[kt][0] = F4Z; S[kt][1] = F4Z; } }
    Frag sel[2];
#pragma unroll
    for (int p = 0; p < 2; ++p)
#pragma unroll
        for (int j = 0; j < 4; ++j) { const int e0 = 2 * j - 4 * p; const bool on = ((lane >> 2) & 3) == q && (e0 == (lane & 3) || e0 + 1 == (lane & 3)) && (j >> 1) == p;
            sel[p].u[j] = on ? (((lane & 1) == 0) ? 0x00003F80u : 0x3F800000u) : 0u; }
    f32x4 eye;
#pragma unroll
    for (int n = 0; n < 4; ++n) eye[n] = (4 * q + n) == c ? 1.f : 0.f;
    const int nch = T >> 4;
    Frag nk[4], nq[4], nv; float nbeta, ng;
    { const int tok = d ? T - 1 - c : c; const size_t row = row0 + tok; const size_t o = row * 1024 + h * 128 + 4 * q;
#pragma unroll
        for (int ks = 0; ks < 4; ++ks) { const v2u k0 = *(const v2u*)(KDb + o + 32 * ks), k1 = *(const v2u*)(KDb + o + 32 * ks + 16), q0 = *(const v2u*)(Qb + o + 32 * ks), q1 = *(const v2u*)(Qb + o + 32 * ks + 16);
            nk[ks].u[0] = k0.x; nk[ks].u[1] = k0.y; nk[ks].u[2] = k1.x; nk[ks].u[3] = k1.y; nq[ks].u[0] = q0.x; nq[ks].u[1] = q0.y; nq[ks].u[2] = q1.x; nq[ks].u[3] = q1.y; }
        { const v2u v0 = *(const v2u*)(VDb + o + 32 * vb), v1 = *(const v2u*)(VDb + o + 32 * vb + 16); nv.u[0] = v0.x; nv.u[1] = v0.y; nv.u[2] = v1.x; nv.u[3] = v1.y; }
        nbeta = BETA[row * 16 + d * 8 + h]; ng = GG[row * 16 + d * 8 + h]; }
    for (int ch = 0; ch < nch; ++ch) {
        const float beta = nbeta, gl = ng;
        const float G = row_scan16(gl); const float GC = lane_get(G, (lane & 48) | 15);
        float Grow[4], Brow[4];
#pragma unroll
        for (int n = 0; n < 4; ++n) { Grow[n] = lane_get(G, (lane & 48) | (4 * q + n)); Brow[n] = lane_get(beta, (lane & 48) | (4 * q + n)); }
        const float eG = __builtin_amdgcn_exp2f(G), eGCG = __builtin_amdgcn_exp2f(GC - G), eGC = __builtin_amdgcn_exp2f(GC);
        f32x4 dKK = F4Z, dKQ = F4Z;
#pragma unroll
        for (int ks = 0; ks < 4; ++ks) { dKK = mma(nk[ks], nk[ks], dKK); dKQ = mma(nk[ks], nq[ks], dKQ); }
        f32x4 dL, dLT, dAtT;
#pragma unroll
        for (int n = 0; n < 4; ++n) { const int r = 4 * q + n;
            const float eij = __builtin_amdgcn_exp2f(fminf(Grow[n] - G, 0.f)), eji = __builtin_amdgcn_exp2f(fminf(G - Grow[n], 0.f));
            dL[n] = (c < r) ? -Brow[n] * dKK[n] * eij : 0.f;
            dLT[n] = (r < c) ? -beta * dKK[n] * eji : 0.f;
            dAtT[n] = (r <= c) ? dKQ[n] * eji * 0.08838834764831845f : 0.f; }
        const Frag fTT = feed1(tri_inv_T(dL, dLT, eye)), fAtT = feed1(dAtT);
        f32x4 dV[2]; dV[0] = mma(nv, sel[0], F4Z); dV[1] = mma(nv, sel[1], F4Z);
        LAS v2u* sKd = (LAS v2u*)wscr;
#pragma unroll
        for (int ks = 0; ks < 4; ++ks) { const Frag kd = scale_frag(nk[ks], eGCG); const f32x4 t0 = mma(kd, sel[0], F4Z), t1 = mma(kd, sel[1], F4Z);
            sKd[(2 * ks) * 64 + lane] = (v2u){cvtpk(t0.x, t0.y), cvtpk(t0.z, t0.w)}; sKd[(2 * ks + 1) * 64 + lane] = (v2u){cvtpk(t1.x, t1.y), cvtpk(t1.z, t1.w)}; }
        Frag fX[4], fQg[4];
#pragma unroll
        for (int ks = 0; ks < 4; ++ks) { fX[ks] = scale_frag(nk[ks], beta * eG); fQg[ks] = scale_frag(nq[ks], eG * 0.08838834764831845f); }
        const int tokbase = 16 * ch + 4 * q;
#pragma unroll
        for (int vt = 0; vt < 2; ++vt) {
            f32x4 M = F4Z, o = F4Z;
#pragma unroll
            for (int ks = 0; ks < 4; ++ks) { const Frag fS = feed2(S[2 * ks][vt], S[2 * ks + 1][vt]); M = mma(fX[ks], fS, M); o = mma(fQg[ks], fS, o); }
            f32x4 rhs;
#pragma unroll
            for (int n = 0; n < 4; ++n) rhs[n] = Brow[n] * dV[vt][n] - M[n];
            const Frag fVn = feed1(mma(fTT, feed1(rhs), F4Z));
            o = mma(fAtT, fVn, o);
#pragma unroll
            for (int n = 0; n < 4; ++n) { const int t = tokbase + n; const int tok = d ? T - 1 - t : t; O[(size_t)(row0 + tok) * 1024 + h * 128 + 32 * vb + 16 * vt + c] = o[n]; }
#pragma unroll
            for (int kt = 0; kt < 8; ++kt) { const v2u w = sKd[kt * 64 + lane]; Frag fK; fK.u[0] = w.x; fK.u[1] = w.y; fK.u[2] = 0u; fK.u[3] = 0u; S[kt][vt] = mma(fK, fVn, S[kt][vt] * eGC); }
        }
        asm volatile("" ::: "memory");
        { const int chn = ch + 1 < nch ? ch + 1 : ch; const int tok = d ? T - 1 - (16 * chn + c) : 16 * chn + c; const size_t row = row0 + tok; const size_t o = row * 1024 + h * 128 + 4 * q;
#pragma unroll
            for (int ks = 0; ks < 4; ++ks) { const v2u k0 = *(const v2u*)(KDb + o + 32 * ks), k1 = *(const v2u*)(KDb + o + 32 * ks + 16), q0 = *(const v2u*)(Qb + o + 32 * ks), q1 = *(const v2u*)(Qb + o + 32 * ks + 16);
                nk[ks].u[0] = k0.x; nk[ks].u[1] = k0.y; nk[ks].u[2] = k1.x; nk[ks].u[3] = k1.y; nq[ks].u[0] = q0.x; nq[ks].u[1] = q0.y; nq[ks].u[2] = q1.x; nq[ks].u[3] = q1.y; }
            { const v2u v0 = *(const v2u*)(VDb + o + 32 * vb), v1 = *(const v2u*)(VDb + o + 32 * vb + 16); nv.u[0] = v0.x; nv.u[1] = v0.y; nv.u[2] = v1.x; nv.u[3] = v1.y; }
            nbeta = BETA[row * 16 + d * 8 + h]; ng = GG[row * 16 + d * 8 + h]; }
    }
    if (s < 16) { float* so = a.out + OUT_SDL + ((((size_t)s * 2 + i) * 2 + d) * 8 + h) * 16384 + 32 * vb + c;
#pragma unroll
        for (int kt = 0; kt < 8; ++kt)
#pragma unroll
            for (int vt = 0; vt < 2; ++vt)
#pragma unroll
                for (int n = 0; n < 4; ++n) so[(16 * kt + 4 * q + n) * 128 + 16 * vt] = S[kt][vt][n]; }
}
__device__ __forceinline__ void ph_scan(const Args& a, LAS unsigned char* lds, int i) {
    const int tid = opaque_tid(), lane = tid & 63, wave = __builtin_amdgcn_readfirstlane(tid >> 6);
    LAS float* wscr = (LAS float*)(lds + wave * 8192);
    const int G = gridDim.x;
    for (int task = wave * G + blockIdx.x; task < 2304; task += NWAVES * G) {
        if (task >= 256 && task < 512) { const int t = task - 256; rwkv_task(a, i, 16 + (t >> 5), (t & 31) >> 1, t & 1, lane, wscr); }
        else if (task >= 1024 && task < 1536) { const int t = task - 1024; rwkv_task(a, i, t >> 5, (t & 31) >> 1, t & 1, lane, wscr); }
    }
    asm volatile("" ::: "memory");
    for (int task = wave * G + blockIdx.x; task < 2304; task += NWAVES * G) {
        if (task < 256 || task >= 1536) { const int t = task < 256 ? task : task - 1536 + 256; const int s = t >> 6, r = t & 63; gdn_task(a, i, s, r >> 3, (r >> 2) & 1, r & 3, lane, wscr); }
        else if (task >= 512 && task < 1024) { const int t = task - 512; const int s = 16 + (t >> 6), r = t & 63; gdn_task(a, i, s, r >> 3, (r >> 2) & 1, r & 3, lane, wscr); }
    }
}
__device__ __forceinline__ void ph_post(const Args& a, int i) {
    const int tid = opaque_tid(), lane = tid & 63, wave = __builtin_amdgcn_readfirstlane(tid >> 6);
    const int gw = blockIdx.x * NWAVES + wave, NGW = gridDim.x * NWAVES;
    const bf16* SC = (const bf16*)(a.ws + WS_SC); constexpr size_t S1 = (size_t)NTOK * 1024;
    const bf16* Vb = SC + 2 * S1; const float* GT = (const float*)(SC + 12 * S1); const float* Y = (const float*)(a.ws + WS_Y); const float* OG = Y + 2 * S1;
    const float* BON = (const float*)(a.ws + WS_SMALL); const bf16* P = (const bf16*)(a.ws + WS_P); bf16* O = (bf16*)(a.ws + WS_O);
    const float* lnw = a.in[I_LNW] + i * 1024; const float* lnb = a.in[I_LNB] + i * 1024; const float* gnw = a.in[I_GNW] + i * 128;
    for (int m = gw; m < NTOK; m += NGW) {
        for (int h = 0; h < 16; ++h) { const size_t o = (size_t)m * 1024 + h * 64 + lane; const float v = bf2f(Vb[o]); float acc = 0.f;
#pragma unroll
            for (int d = 0; d < 2; ++d) { const float y = Y[d * S1 + o]; const float mu = wave_sum(y) * (1.0f / 64.0f); const float dy = y - mu; const float var = wave_sum(dy * dy) * (1.0f / 64.0f);
                acc += dy * (1.0f / sqrtf(var + GN_EPS)) * lnw[h * 64 + lane] + lnb[h * 64 + lane] + BON[((size_t)m * 2 + d) * 16 + h] * v; }
            O[(size_t)m * D + h * 64 + lane] = (bf16)f2bf(acc * GT[o]); }
        for (int h = 0; h < 8; ++h) { float ov[2]; float ss = 0.f;
#pragma unroll
            for (int e = 0; e < 2; ++e) { const size_t o = (size_t)m * 1024 + h * 128 + lane + 64 * e; ov[e] = OG[o] + OG[S1 + o]; ss += ov[e] * ov[e]; }
            const float rs = 1.0f / sqrtf(wave_sum(ss) * (1.0f / 128.0f) + RMS_EPS);
#pragma unroll
            for (int e = 0; e < 2; ++e) { const int j = lane + 64 * e; const float z = bf2f(P[(size_t)m * PW + PC_Z + h * 128 + j]);
                O[(size_t)m * D + 1024 + h * 128 + j] = (bf16)f2bf(ov[e] * rs * gnw[j] * siluf_(z)); } }
    }
}

constexpr int PH_PER_LAYER = 9, N_PHASES = 2 + 4 * PH_PER_LAYER;
__host__ __device__ inline bool phase_exists(int ph) { if (ph == 0 || ph == N_PHASES - 1) return true; const int l = (ph - 1) / PH_PER_LAYER, k = (ph - 1) % PH_PER_LAYER; return (l & 1) ? !(k == 2 || k == 3 || k == 4) : true; }

#define RUN(ph) (a.ph_lo <= (ph) && (ph) < a.ph_hi)
#define SEAM(ph) do { if ((ph) + 1 < a.ph_hi) xcd_barrier(bar); } while (0)
template <int L> __device__ __forceinline__ void run_layer(const Args& a, LAS unsigned char* lds, const XcdBarrier& bar) {
    constexpr int l = L, pb = 1 + PH_PER_LAYER * L, i = L >> 1;
    const int G = gridDim.x, bx = blockIdx.x;
    bf16* H = (bf16*)(a.ws + WS_H); bf16* O = (bf16*)(a.ws + WS_O); bf16* P = (bf16*)(a.ws + WS_P);
    const float* modl = (const float*)(a.ws + WS_MOD) + (size_t)l * 9 * 12288;
    if (RUN(pb + 0)) { ph_norm(a, l, 0); SEAM(pb + 0); }
    if constexpr ((L & 1) == 0) {
        if (RUN(pb + 1)) { pg8::Gemm g{H, (const bf16*)(a.ws + WS_WIN) + (size_t)i * PW * 2048, NTOK, PW, 2048, 2048, 2048, 0, 0}; pg8::StaticOrder S; S.init(NTOK, PW, G, bx);
            pg8::EpiBf16 E{P, PW}; pg8::gemm_phase<pg8::EpiBf16, pg8::StaticOrder, true, true>(lds, g, S, E); SEAM(pb + 1); }
        if (RUN(pb + 2)) { ph_prep(a, lds, i); SEAM(pb + 2); }
        if (RUN(pb + 3)) { ph_scan(a, lds, i); SEAM(pb + 3); }
        if (RUN(pb + 4)) { ph_post(a, i); SEAM(pb + 4); }
        if (RUN(pb + 5)) { pg8::Gemm g{O, (const bf16*)(a.ws + WS_WOUT) + (size_t)i * 2048 * 2048, NTOK, 2048, 2048, 2048, 2048, 0, 0}; pg8::StaticOrder S; S.init(NTOK, 2048, G, bx);
            pg8::EpiResid E{l == 0 ? a.in[I_XP] : nullptr, a.in[I_XS], a.out, modl + 2 * 2048, nullptr};
            pg8::gemm_phase<pg8::EpiResid, pg8::StaticOrder, true, true>(lds, g, S, E); SEAM(pb + 5); }
    } else {
        if (RUN(pb + 1)) { ph_pool(a); SEAM(pb + 1); }
        if (RUN(pb + 5)) { pg8::Gemm g{O, (const bf16*)(a.ws + WS_WPOOL) + (size_t)i * 2048 * 512, NTOK, 2048, 512, 2048, 512, 1, 512}; pg8::StaticOrder S; S.init(NTOK, 2048, G, bx);
            pg8::EpiResid E{nullptr, nullptr, a.out, modl + 2 * 2048, a.in[I_POOLS] + i * 2048};
            pg8::gemm_phase<pg8::EpiResid, pg8::StaticOrder, true, true>(lds, g, S, E); SEAM(pb + 5); }
    }
    if (RUN(pb + 6)) { ph_norm(a, l, 1); SEAM(pb + 6); }
    if (RUN(pb + 7)) { pg8::Gemm g{H, (const bf16*)(a.ws + WS_WGU) + (size_t)l * 11264 * 2048, NTOK, 11264, 2048, 2048, 2048, 0, 0}; pg8::StaticOrder S; S.init(NTOK, 11264, G, bx);
        pg8::EpiSwiGLU E{P, DFF}; pg8::gemm_phase<pg8::EpiSwiGLU, pg8::StaticOrder, true, true>(lds, g, S, E); SEAM(pb + 7); }
    if (RUN(pb + 8)) { pg8::Gemm g{P, (const bf16*)(a.ws + WS_WDN) + (size_t)l * 2048 * DFF, NTOK, 2048, DFF, DFF, DFF, 0, 0}; pg8::StaticOrder S; S.init(NTOK, 2048, G, bx);
        pg8::EpiResid E{nullptr, nullptr, a.out, modl + 5 * 2048, nullptr};
        pg8::gemm_phase<pg8::EpiResid, pg8::StaticOrder, true, true>(lds, g, S, E); SEAM(pb + 8); }
}

__global__ void __launch_bounds__(NTHR, 2) fwd(Args a) {
    extern __shared__ __attribute__((aligned(16))) unsigned char lds_raw[];
    LAS unsigned char* lds = (LAS unsigned char*)lds_raw;
    const int tid = threadIdx.x;
    volatile LAS unsigned* MISC = (volatile LAS unsigned*)(lds + LDS_MISC);
    for (int u = tid; u < (LDS_BYTES - LDS_STAGE) / 4; u += NTHR) ((LAS unsigned*)(lds + LDS_STAGE))[u] = 0u;
    __syncthreads();
    XcdBarrier bar; bar.bar = (unsigned*)(a.ws + WS_CTL) + CW_BAR; bar.x = 0; bar.st = nullptr;
    const bool multi = a.ph_hi - a.ph_lo > 1;
    if (multi) bar = xcd_barrier_post((unsigned*)(a.ws + WS_CTL) + CW_BAR, MISC + 8);
    if (RUN(0)) { ph_pre(a, lds); SEAM(0); }
    run_layer<0>(a, lds, bar);
    run_layer<1>(a, lds, bar);
    run_layer<2>(a, lds, bar);
    run_layer<3>(a, lds, bar);
    if (RUN(N_PHASES - 1)) ph_final(a);
}
#undef RUN
#undef SEAM

#ifndef MK_ONE_LAUNCH
#define MK_ONE_LAUNCH 1
#endif
extern "C" void kernel_launch(void* const* d_in, const int* in_sizes, int n_in, void* d_out, int out_size, void* d_ws, size_t ws_size, hipStream_t stream) {
    static int grid = 0;
    if (grid == 0) {
        if (n_in != N_IN || ws_size < WS_END) { fprintf(stderr, "kernel_launch: expected %d inputs and >= %zu bytes of workspace; got %d, %zu\n", (int)N_IN, (size_t)WS_END, n_in, ws_size); grid = -1; return; }
        int dev = 0, cus = 0, per_cu = 0;
        if (hipGetDevice(&dev) != hipSuccess || hipDeviceGetAttribute(&cus, hipDeviceAttributeMultiprocessorCount, dev) != hipSuccess) { grid = -1; return; }
        if (hipFuncSetAttribute((const void*)fwd, hipFuncAttributeMaxDynamicSharedMemorySize, LDS_BYTES) != hipSuccess) { fprintf(stderr, "kernel_launch: hipFuncSetAttribute failed\n"); grid = -1; return; }
        if (hipOccupancyMaxActiveBlocksPerMultiprocessor(&per_cu, (const void*)fwd, NTHR, LDS_BYTES) != hipSuccess || per_cu < 1) fprintf(stderr, "kernel_launch: occupancy query reports %d\n", per_cu);
        (void)hipGetLastError();
        grid = cus;
    }
    if (grid < 0) return;
    if (hipMemsetAsync((char*)d_ws + WS_CTL, 0, CTL_ZERO_BYTES, stream) != hipSuccess) return;
    Args a{};
    for (int i = 0; i < N_IN; ++i) a.in[i] = (const float*)d_in[i];
    a.out = (float*)d_out; a.ws = (unsigned char*)d_ws;
#if MK_ONE_LAUNCH
    a.ph_lo = 0; a.ph_hi = N_PHASES;
    hipLaunchKernelGGL(fwd, dim3(grid), dim3(NTHR), LDS_BYTES, stream, a);
#else
    for (int ph = 0; ph < N_PHASES; ++ph) { if (!phase_exists(ph)) continue; a.ph_lo = ph; a.ph_hi = ph + 1; hipLaunchKernelGGL(fwd, dim3(grid), dim3(NTHR), LDS_BYTES, stream, a); }
#endif
}
```

```cpp
#include <hip/hip_runtime.h>
#include <cstdio>
#include <cstdint>

namespace pg8 {
#define PG8_LAS __attribute__((address_space(3)))
typedef unsigned short bf16_t;
typedef short bf16x8 __attribute__((ext_vector_type(8)));
typedef float f32x4 __attribute__((ext_vector_type(4)));
typedef unsigned u32x4 __attribute__((ext_vector_type(4)));
constexpr int BM = 256, BK = 64, HALF = 128, HTB = HALF * BK * 2  , STAGE_BYTES = 8 * HTB, NXCD = 8, WGM = 8;

__host__ __device__ __forceinline__ int lds_byte(int r, int c) { const int st = (r >> 4) * 2 + (c >> 5), rr = r & 15, cc = c & 31, ob = rr * 64 + cc * 2; return st * 1024 + (ob ^ (((ob >> 9) & 1) << 5)); }
__host__ __device__ __forceinline__ void stage_rc(int b, int& R, int& C) { const int st = b / 1024, sb = b % 1024, swz = sb ^ (((sb >> 9) & 1) << 5); R = (st >> 1) * 16 + swz / 64; C = (st & 1) * 32 + (swz % 64) / 2; }
__host__ __device__ __forceinline__ int perm32(int rho) { const int n = rho >> 4, i = rho & 15; return 8 * (i >> 2) + 4 * n + (i & 3); }

struct Unit { int pm, pn; };
struct Gemm { const bf16_t* A; const bf16_t* Bt; int M, N, K, lda, ldb, gsh, gk; };

struct StaticOrder {
    int nM, nN, nwg, G, c;
    __host__ __device__ void init(int M, int N, int G_, int c_) { nM = M / BM; nN = N / BM; nwg = nM * nN; G = G_; c = c_; }
    __host__ __device__ bool next(int i, Unit& u) const {
        const long L = (long)i * G + c; if (L >= nwg) return false;
        int wgid = (int)L; { const int q = nwg / NXCD, r = nwg % NXCD, xcd = wgid % NXCD, off = wgid / NXCD; wgid = (xcd < r ? xcd * (q + 1) : r * (q + 1) + (xcd - r) * q) + off; }
        const int nig = WGM * nN, gid = wgid / nig, fm = gid * WGM, gsz = (nM - fm) < WGM ? (nM - fm) : WGM;
        u.pm = fm + ((wgid % nig) % gsz); u.pn = (wgid % nig) / gsz; return true;
    }
    __device__ __forceinline__ void a_ready(const Unit&) const {}
    __device__ __forceinline__ void done(const Unit&) const {}
};

__device__ __forceinline__ unsigned cvt_pk_bf16(float lo, float hi) { unsigned r; asm volatile("v_cvt_pk_bf16_f32 %0, %1, %2" : "=v"(r) : "v"(lo), "v"(hi)); return r; }

__device__ __forceinline__ int cond_of_panel(int pm) { return pm < 16 ? 0 : 1 + ((pm - 16) >> 2); }

struct EpiBf16 {
    static constexpr bool PERM = true, AFTER_DRAIN = false;
    bf16_t* O; int ldc;
    __device__ __forceinline__ void operator()(const f32x4 (&acc)[2][2][4][2], const Unit& u, int wr, int wc, int fr, int fq) const {
        const int row0 = u.pm * BM + wr * 64 + fr; const int col0 = u.pn * BM + wc * 32 + 8 * fq;
#pragma unroll
        for (int ai = 0; ai < 2; ++ai)
#pragma unroll
            for (int m = 0; m < 4; ++m) { bf16_t* rowp = O + (size_t)(row0 + ai * HALF + m * 16) * ldc + col0;
#pragma unroll
                for (int bj = 0; bj < 2; ++bj) { const f32x4 v0 = acc[ai][bj][m][0], v1 = acc[ai][bj][m][1];
                    u32x4 w; w.x = cvt_pk_bf16(v0[0], v0[1]); w.y = cvt_pk_bf16(v0[2], v0[3]); w.z = cvt_pk_bf16(v1[0], v1[1]); w.w = cvt_pk_bf16(v1[2], v1[3]);
                    *(u32x4*)(rowp + bj * HALF) = w; } }
    }
};
struct EpiSwiGLU {
    static constexpr bool PERM = true, AFTER_DRAIN = false;
    bf16_t* O; int ldc;
    __device__ __forceinline__ void operator()(const f32x4 (&acc)[2][2][4][2], const Unit& u, int wr, int wc, int fr, int fq) const {
        const int row0 = u.pm * BM + wr * 64 + fr; const int col0 = u.pn * HALF + wc * 32 + 8 * fq;
#pragma unroll
        for (int ai = 0; ai < 2; ++ai)
#pragma unroll
            for (int m = 0; m < 4; ++m) { bf16_t* rowp = O + (size_t)(row0 + ai * HALF + m * 16) * ldc + col0;
                float o[8];
#pragma unroll
                for (int n = 0; n < 2; ++n)
#pragma unroll
                    for (int e = 0; e < 4; ++e) { const float gte = acc[ai][0][m][n][e], up = acc[ai][1][m][n][e]; o[n * 4 + e] = gte * __builtin_amdgcn_rcpf(1.0f + __expf(-gte)) * up; }
                u32x4 w; w.x = cvt_pk_bf16(o[0], o[1]); w.y = cvt_pk_bf16(o[2], o[3]); w.z = cvt_pk_bf16(o[4], o[5]); w.w = cvt_pk_bf16(o[6], o[7]);
                *(u32x4*)rowp = w; }
    }
};
struct EpiResid {
    static constexpr bool PERM = false, AFTER_DRAIN = false;
    const float* xin_p; const float* xin_s; float* xout; const float* gate  ; const float* cscale;
    __device__ __forceinline__ void operator()(const f32x4 (&acc)[2][2][4][2], const Unit& u, int wr, int wc, int fr, int fq) const {
        const int row0 = u.pm * BM + wr * 64 + fr, col0 = u.pn * BM + wc * 32 + 4 * fq;
        const float* gp = gate + (size_t)cond_of_panel(u.pm) * 12288 + col0;
        f32x4 gv[2][2];
#pragma unroll
        for (int bj = 0; bj < 2; ++bj)
#pragma unroll
            for (int n = 0; n < 2; ++n) { gv[bj][n] = *(const f32x4*)(gp + bj * HALF + n * 16); if (cscale) gv[bj][n] = gv[bj][n] * *(const f32x4*)(cscale + col0 + bj * HALF + n * 16); }
#pragma unroll
        for (int ai = 0; ai < 2; ++ai)
#pragma unroll
            for (int m = 0; m < 4; ++m) { const int row = row0 + ai * HALF + m * 16;
                const float* xi = xin_p ? (row < 4096 ? xin_p + (size_t)row * 2048 : xin_s + (size_t)(row - 4096) * 2048) : xout + (size_t)row * 2048;
                float* xo = xout + (size_t)row * 2048;
#pragma unroll
                for (int bj = 0; bj < 2; ++bj)
#pragma unroll
                    for (int n = 0; n < 2; ++n) { const f32x4 xv = *(const f32x4*)(xi + col0 + bj * HALF + n * 16); *(f32x4*)(xo + col0 + bj * HALF + n * 16) = xv + gv[bj][n] * acc[ai][bj][m][n]; } }
    }
};

template <class Epi, class Sched, bool ALIGN_EPI = false, bool SP2 = false>
__device__ __forceinline__ void gemm_phase(PG8_LAS unsigned char* lds, const Gemm g, const Sched& S, const Epi& E) {
    const int tid = threadIdx.x, wid = __builtin_amdgcn_readfirstlane(tid >> 6), lane = tid & 63, wr = wid >> 2, wc = wid & 3, fr = lane & 15, fq = lane >> 4;
    const int K = g.K, nt = K / BK;
    unsigned voffA[2], voffB[2];
#pragma unroll
    for (int i = 0; i < 2; ++i) { int R, C; stage_rc(tid * 16 + i * 8192, R, C); const int Rb = Epi::PERM ? ((R & ~31) + perm32(R & 31)) : R;
        voffA[i] = (unsigned)(R * g.lda + C) * 2u; voffB[i] = (unsigned)(Rb * g.ldb + C) * 2u; }
    const size_t kstep = (size_t)(BK * 2);
    const size_t hstepA = (size_t)HALF * g.lda * 2, hstepB = (size_t)HALF * g.ldb * 2;
    const size_t tstepA = 2 * hstepA, tstepB = 2 * hstepB;
    const unsigned ldsw = (unsigned)wid * 1024u;
    const int aoff = lds_byte(wr * 64 + fr, fq * 8), boff = lds_byte(wc * 32 + fr, fq * 8);
#define PG8_SA(b, h) (((b) * 2 + (h)) * HTB)
#define PG8_SB(b, h) ((4 + (b) * 2 + (h)) * HTB)
#define PG8_STAGE(bufoff, gbase, voff) do { _Pragma("unroll") for (int _i = 0; _i < 2; ++_i) \
        __builtin_amdgcn_global_load_lds((const unsigned*)((const char*)(gbase) + (voff)[_i]), (PG8_LAS unsigned*)(lds + (bufoff) + ldsw + _i * 8192), 16, 0, 0); } while (0)
#define PG8_LDA(dst, b, h) do { _Pragma("unroll") for (int m = 0; m < 4; ++m) _Pragma("unroll") for (int k = 0; k < 2; ++k) dst[m][k] = *(const PG8_LAS bf16x8*)(lds + PG8_SA(b, h) + aoff + m * 2048 + k * 1024); } while (0)
#define PG8_LDB(dst, b, h) do { _Pragma("unroll") for (int n = 0; n < 2; ++n) _Pragma("unroll") for (int k = 0; k < 2; ++k) dst[n][k] = *(const PG8_LAS bf16x8*)(lds + PG8_SB(b, h) + boff + n * 2048 + k * 1024); } while (0)
#define PG8_MMA(ai, bj, At, Bt) do { __builtin_amdgcn_s_setprio(1); _Pragma("unroll") for (int m = 0; m < 4; ++m) _Pragma("unroll") for (int n = 0; n < 2; ++n) _Pragma("unroll") for (int k = 0; k < 2; ++k) \
        acc[ai][bj][m][n] = __builtin_amdgcn_mfma_f32_16x16x32_bf16(Bt[n][k], At[m][k], acc[ai][bj][m][n], 0, 0, 0); __builtin_amdgcn_s_setprio(0); } while (0)
#define PG8_WAIT_V(n) asm volatile("s_waitcnt vmcnt(" #n ")" ::: "memory")
#define PG8_WAIT_L(n) asm volatile("s_waitcnt lgkmcnt(" #n ")" ::: "memory")
#define PG8_BAR __builtin_amdgcn_s_barrier()
#define PG8_SCHED __builtin_amdgcn_sched_barrier(0)
    Unit cur, nxt; int ui = 0;
    if (!S.next(0, cur)) return;
    f32x4 acc[2][2][4][2];
#pragma unroll
    for (int a = 0; a < 2; ++a)
#pragma unroll
        for (int b = 0; b < 2; ++b)
#pragma unroll
            for (int m = 0; m < 4; ++m)
#pragma unroll
                for (int n = 0; n < 2; ++n) acc[a][b][m][n] = (f32x4){0.f, 0.f, 0.f, 0.f};
    bf16x8 At[4][2], B0[2][2], B1[2][2];
    const char* cA = (const char*)g.A + (size_t)cur.pm * tstepA + (size_t)((cur.pn >> g.gsh) * g.gk) * 2; const char* cB = (const char*)g.Bt + (size_t)cur.pn * tstepB;
    S.a_ready(cur);
    if constexpr (SP2) {
        PG8_STAGE(PG8_SB(0, 0), cB, voffB); PG8_STAGE(PG8_SB(0, 1), cB + hstepB, voffB); PG8_STAGE(PG8_SA(0, 0), cA, voffA); PG8_STAGE(PG8_SA(0, 1), cA + hstepA, voffA);
        if (wr == 1) PG8_BAR;
        PG8_WAIT_V(2); PG8_BAR;
        PG8_STAGE(PG8_SB(1, 0), cB + kstep, voffB); PG8_STAGE(PG8_SA(1, 0), cA + kstep, voffA); PG8_STAGE(PG8_SB(1, 1), cB + hstepB + kstep, voffB);
        PG8_WAIT_V(6); PG8_BAR;
    } else {
        PG8_STAGE(PG8_SB(0, 0), cB, voffB); PG8_STAGE(PG8_SA(0, 0), cA, voffA); PG8_STAGE(PG8_SB(0, 1), cB + hstepB, voffB); PG8_STAGE(PG8_SA(0, 1), cA + hstepA, voffA);
        if (wr == 1) PG8_BAR;
        PG8_WAIT_V(4); PG8_BAR;
        PG8_STAGE(PG8_SB(1, 0), cB + kstep, voffB); PG8_STAGE(PG8_SA(1, 0), cA + kstep, voffA); PG8_STAGE(PG8_SB(1, 1), cB + hstepB + kstep, voffB);
        PG8_WAIT_V(6); PG8_BAR;
    }
    for (;;) {
        const bool has_next = S.next(ui + 1, nxt);
        const char* nA = has_next ? (const char*)g.A + (size_t)nxt.pm * tstepA + (size_t)((nxt.pn >> g.gsh) * g.gk) * 2 : cA; const char* nB = has_next ? (const char*)g.Bt + (size_t)nxt.pn * tstepB : cB;
        for (int t = 0; t < nt; t += 2) {
            const bool last = (t == nt - 2);
            const char* a1 = cA + (size_t)(t + 1) * kstep;
            const char* a2 = last ? nA : cA + (size_t)(t + 2) * kstep; const char* b2 = last ? nB : cB + (size_t)(t + 2) * kstep;
            const char* a3 = a2 + kstep; const char* b3 = b2 + kstep;
            if (last && has_next) S.a_ready(nxt);
            if constexpr (SP2) {
            PG8_LDB(B0, 0, 0); PG8_LDB(B1, 0, 1); PG8_SCHED; PG8_LDA(At, 0, 0); PG8_STAGE(PG8_SA(1, 1), a1 + hstepA, voffA);
            PG8_WAIT_V(8); PG8_WAIT_L(0); PG8_BAR; PG8_MMA(0, 0, At, B0); PG8_MMA(0, 1, At, B1); PG8_BAR; PG8_SCHED;
            PG8_LDA(At, 0, 1); PG8_STAGE(PG8_SB(0, 0), b2, voffB); PG8_STAGE(PG8_SB(0, 1), b2 + hstepB, voffB); PG8_STAGE(PG8_SA(0, 0), a2, voffA);
            PG8_WAIT_V(8); PG8_WAIT_L(0); PG8_BAR; PG8_MMA(1, 0, At, B0); PG8_MMA(1, 1, At, B1); PG8_BAR; PG8_SCHED;
            PG8_LDB(B0, 1, 0); PG8_LDB(B1, 1, 1); PG8_SCHED; PG8_LDA(At, 1, 0); PG8_STAGE(PG8_SA(0, 1), a2 + hstepA, voffA);
            PG8_WAIT_V(8); PG8_WAIT_L(0); PG8_BAR; PG8_MMA(0, 0, At, B0); PG8_MMA(0, 1, At, B1); PG8_BAR; PG8_SCHED;
            PG8_LDA(At, 1, 1); PG8_STAGE(PG8_SB(1, 0), b3, voffB); PG8_STAGE(PG8_SB(1, 1), b3 + hstepB, voffB); PG8_STAGE(PG8_SA(1, 0), a3, voffA);
            PG8_WAIT_V(8); PG8_WAIT_L(0); PG8_BAR; PG8_MMA(1, 0, At, B0); PG8_MMA(1, 1, At, B1); PG8_BAR; PG8_SCHED;
            } else {
            PG8_LDB(B0, 0, 0); PG8_SCHED; PG8_LDA(At, 0, 0); PG8_STAGE(PG8_SA(1, 1), a1 + hstepA, voffA);
            PG8_WAIT_L(8); PG8_BAR; PG8_WAIT_L(0); PG8_MMA(0, 0, At, B0); PG8_BAR; PG8_SCHED;
            PG8_LDB(B1, 0, 1); PG8_STAGE(PG8_SB(0, 0), b2, voffB);
            PG8_BAR; PG8_WAIT_L(0); PG8_MMA(0, 1, At, B1); PG8_BAR;
            PG8_LDA(At, 0, 1); PG8_STAGE(PG8_SA(0, 0), a2, voffA);
            PG8_BAR; PG8_WAIT_L(0); PG8_MMA(1, 0, At, B0); PG8_BAR; PG8_SCHED;
            PG8_STAGE(PG8_SB(0, 1), b2 + hstepB, voffB);
            PG8_WAIT_V(6); PG8_BAR; PG8_MMA(1, 1, At, B1); PG8_BAR;
            PG8_LDB(B0, 1, 0); PG8_SCHED; PG8_LDA(At, 1, 0); PG8_STAGE(PG8_SA(0, 1), a2 + hstepA, voffA);
            PG8_WAIT_L(8); PG8_BAR; PG8_WAIT_L(0); PG8_MMA(0, 0, At, B0); PG8_BAR; PG8_SCHED;
            PG8_LDB(B1, 1, 1); PG8_STAGE(PG8_SB(1, 0), b3, voffB);
            PG8_BAR; PG8_WAIT_L(0); PG8_MMA(0, 1, At, B1); PG8_BAR;
            PG8_LDA(At, 1, 1); PG8_STAGE(PG8_SA(1, 0), a3, voffA);
            PG8_BAR; PG8_WAIT_L(0); PG8_MMA(1, 0, At, B0); PG8_BAR; PG8_SCHED;
            PG8_STAGE(PG8_SB(1, 1), b3 + hstepB, voffB);
            PG8_WAIT_V(6); PG8_BAR; PG8_MMA(1, 1, At, B1); PG8_BAR;
            }
        }
        if constexpr (ALIGN_EPI) { if (wr == 0) PG8_BAR; }
        if constexpr (!Epi::AFTER_DRAIN) { E(acc, cur, wr, wc, fr, fq); S.done(cur); }
        if (!has_next) break;
#pragma unroll
        for (int a = 0; a < 2; ++a)
#pragma unroll
            for (int b = 0; b < 2; ++b)
#pragma unroll
                for (int m = 0; m < 4; ++m)
#pragma unroll
                    for (int n = 0; n < 2; ++n) acc[a][b][m][n] = (f32x4){0.f, 0.f, 0.f, 0.f};
        cur = nxt; cA = nA; cB = nB; ++ui;
        if constexpr (ALIGN_EPI) { if (wr == 1) PG8_BAR; }
    }
    PG8_WAIT_V(0);
    if constexpr (!ALIGN_EPI) { if (wr == 0) PG8_BAR; }
    PG8_BAR;
    if constexpr (Epi::AFTER_DRAIN) { E.fused(acc, cur, wr, wc, fr, fq, lds, wid, lane); S.done(cur); }
#undef PG8_SA
#undef PG8_SB
#undef PG8_STAGE
#undef PG8_LDA
#undef PG8_LDB
#undef PG8_MMA
#undef PG8_WAIT_V
#undef PG8_WAIT_L
#undef PG8_BAR
#undef PG8_SCHED
}
}

constexpr int D = 2048, NTOK = 12288, NPROMPT = 4096, DFF = 5632, PW = 7680  , CPA = 3488;
constexpr int NWAVES = 8, NTHR = 512;
constexpr int PC_GDN = 3072, PC_Z = 6144, PC_LORA = 7168, PC_BETA = 7584, PC_ALPHA = 7600;
constexpr float RMS_EPS = 1e-6f, GN_EPS = 64e-5f;

constexpr size_t MiB = 1u << 20;
constexpr size_t WS_CTL = 0, CTL_ZERO_BYTES = 1 * MiB;
constexpr size_t WS_MOD = 1 * MiB;
constexpr size_t WS_WIN = 3 * MiB;
constexpr size_t WS_WOUT = 63 * MiB;
constexpr size_t WS_WGU = 79 * MiB;
constexpr size_t WS_WDN = 255 * MiB;
constexpr size_t WS_WPOOL = 343 * MiB;
constexpr size_t WS_H = 347 * MiB;
constexpr size_t WS_O = 395 * MiB;
constexpr size_t WS_P = 443 * MiB;
constexpr size_t WS_SC = 623 * MiB;
constexpr size_t SC_ONE = 48 * MiB;
constexpr size_t WS_Y = 1247 * MiB;
constexpr size_t WS_SMALL = 1439 * MiB;
constexpr size_t WS_LORA = 1443 * MiB;
constexpr size_t WS_END = 1445 * MiB;
constexpr int CW_BAR = 4096;

constexpr int LDS_STAGE = 131072, LDS_MISC = LDS_STAGE + 320, LDS_BYTES = 147456;

#define GAS __attribute__((address_space(1)))
#define LAS __attribute__((address_space(3)))
typedef unsigned short bf16;
typedef unsigned v4u __attribute__((ext_vector_type(4)));
typedef unsigned v2u __attribute__((ext_vector_type(2)));
typedef float f32x4 __attribute__((ext_vector_type(4)));
typedef float f32x2 __attribute__((ext_vector_type(2)));
#define LDS_WAIT() asm volatile("s_waitcnt lgkmcnt(0)" ::: "memory")

__device__ __forceinline__ unsigned f2bf(float f) { unsigned u = __builtin_bit_cast(unsigned, f); return (u + 0x7fffu + ((u >> 16) & 1u)) >> 16; }
__device__ __forceinline__ unsigned pk2(float lo, float hi) { return f2bf(lo) | (f2bf(hi) << 16); }
__device__ __forceinline__ float bf2f(bf16 b) { return __builtin_bit_cast(float, (unsigned)b << 16); }
__device__ __forceinline__ float bflo(unsigned w) { return __builtin_bit_cast(float, w << 16); }
__device__ __forceinline__ float bfhi(unsigned w) { return __builtin_bit_cast(float, w & 0xffff0000u); }
__device__ __forceinline__ float sigmoidf_(float x) { return 1.0f / (1.0f + __expf(-x)); }
__device__ __forceinline__ float siluf_(float x) { return x / (1.0f + __expf(-x)); }
__device__ __forceinline__ float softplusf_(float x) { return x > 20.f ? x : log1pf(__expf(x)); }
__device__ __forceinline__ float wave_sum(float v) {
#pragma unroll
    for (int o = 1; o < 64; o <<= 1) v += __shfl_xor(v, o);
    return v;
}
__device__ __forceinline__ int opaque_tid() { int t = threadIdx.x; asm volatile("" : "+v"(t)); return t; }
__device__ __forceinline__ float rdl(float v, int k) { return __builtin_bit_cast(float, __builtin_amdgcn_readlane(__builtin_bit_cast(int, v), k)); }

#define XB_TMO      128
#define XB_XCNT(j)  (256  + 64 * (j))
#define XB_XSUB(j)  (1280 + 64 * (j))
#define XB_XGEN(j)  (2304 + 64 * (j))
#define XB_TOP      3328
#define XB_TOPGEN   3392
#define XCD_BAR_WORDS 3456
#define XB_SPIN_CAP (1u << 18)
__device__ __forceinline__ unsigned xb_ld(unsigned* p)              { return __hip_atomic_load(p, __ATOMIC_RELAXED, __HIP_MEMORY_SCOPE_AGENT); }
__device__ __forceinline__ unsigned xb_add(unsigned* p, unsigned v) { return __hip_atomic_fetch_add(p, v, __ATOMIC_RELAXED, __HIP_MEMORY_SCOPE_AGENT); }
__device__ __forceinline__ unsigned xb_xcc_id() { return (unsigned)__builtin_amdgcn_s_getreg((3 << 11) | 20) & 0xFu; }
#define XB_SPIN(cond, bar) do { unsigned _sp = 0; while (cond) { __builtin_amdgcn_s_sleep(1); \
    if ((++_sp & 255u) == 0u) { if (xb_ld(&(bar)[XB_TMO])) break; if (_sp > XB_SPIN_CAP) { atomicAdd(&(bar)[XB_TMO], 1u); break; } } } } while (0)
struct XcdBarrier { unsigned* bar; unsigned x; volatile LAS unsigned* st; };
__device__ __forceinline__ XcdBarrier xcd_barrier_post(unsigned* bar, volatile LAS unsigned* st) {
    XcdBarrier b; b.bar = bar; b.x = xb_xcc_id(); b.st = st;
    if (threadIdx.x == 0) (void)xb_add(&bar[XB_XCNT(b.x)], 1u);
    return b;
}
__device__ __forceinline__ void xcd_barrier_complete(unsigned* bar, unsigned x, unsigned& nloc, unsigned& nx) {
    const unsigned G = gridDim.x * gridDim.y * gridDim.z;
    unsigned sum, cnt, mine, sp = 0u;
    for (;;) {
        sum = 0u; cnt = 0u; mine = 0u;
#pragma unroll
        for (unsigned j = 0; j < 16; ++j) { const unsigned c = xb_ld(&bar[XB_XCNT(j)]); sum += c; cnt += (c > 0u) ? 1u : 0u; mine = (j == x) ? c : mine; }
        if (sum == G) break;
        __builtin_amdgcn_s_sleep(1);
        if ((++sp & 255u) == 0u) { if (xb_ld(&bar[XB_TMO])) break; if (sp > XB_SPIN_CAP) { atomicAdd(&bar[XB_TMO], 1u); break; } }
    }
    nloc = mine > 0u ? mine : 1u; nx = cnt > 0u ? cnt : 1u;
}
__device__ __forceinline__ void xcd_barrier(const XcdBarrier& b) {
    asm volatile("s_waitcnt vmcnt(0)" ::: "memory");
    __syncthreads();
    if (threadIdx.x == 0) {
        unsigned* bar = b.bar;
        __builtin_amdgcn_s_waitcnt(0);
        unsigned nloc = b.st[0], nx = b.st[1];
        if (nloc == 0u) { xcd_barrier_complete(bar, b.x, nloc, nx); b.st[0] = nloc; b.st[1] = nx; }
        const unsigned old = xb_add(&bar[XB_XSUB(b.x)], 1u);
        const unsigned gen = old / nloc;
        if (old + 1u == (gen + 1u) * nloc) {
            __builtin_amdgcn_fence(__ATOMIC_RELEASE, "agent");
            asm volatile("s_waitcnt vmcnt(0)" ::: "memory");
            const unsigned og = xb_add(&bar[XB_TOP], 1u);
            const unsigned tg = og / nx;
            if (og + 1u == (tg + 1u) * nx) xb_add(&bar[XB_TOPGEN], 1u);
            else XB_SPIN(xb_ld(&bar[XB_TOPGEN]) == tg, bar);
            __builtin_amdgcn_fence(__ATOMIC_ACQUIRE, "agent");
            xb_add(&bar[XB_XGEN(b.x)], 1u);
            asm volatile("s_waitcnt vmcnt(0)" ::: "memory");
        } else {
            XB_SPIN(xb_ld(&bar[XB_XGEN(b.x)]) == gen, bar);
            __builtin_amdgcn_fence(__ATOMIC_ACQUIRE, "agent");
            asm volatile("s_waitcnt vmcnt(0)" ::: "memory");
        }
    }
    __syncthreads();
}

enum { I_XP = 0, I_XS, I_SRW, I_SDL, I_C, I_CCTX, I_MODW, I_MODB, I_NMIX, I_NFFN, I_NFIN, I_WIN, I_WOUT, I_MU, I_W0, I_W2, I_A0, I_A2, I_G2, I_KK, I_KA, I_RK, I_LNW, I_LNB,
       I_CONVW, I_ALOG, I_DTB, I_GNW, I_POOLW, I_POOLS, I_WG, I_WU, I_WD, N_IN };
struct Args { const float* in[N_IN]; float* out; unsigned char* ws; int ph_lo, ph_hi; };
constexpr size_t OUT_SRW = (size_t)NTOK * D, OUT_SDL = OUT_SRW + (size_t)16 * 2 * 2 * 16 * 64 * 64;

__device__ __forceinline__ void conv_item(const float* W, int K, int N, bf16* WT, int drow0, LAS float* scr, int kb, int nb, int lane) {
    const int k0 = 64 * kb, n0 = 32 * nb;
#pragma unroll 8
    for (int i = 0; i < 32; ++i) { const int kk = 2 * i + (lane >> 5); scr[kk * 33 + (lane & 31)] = W[(size_t)(k0 + kk) * N + n0 + (lane & 31)]; }
    LDS_WAIT(); asm volatile("" ::: "memory");
    const int c = lane & 7;
#pragma unroll
    for (int j = 0; j < 4; ++j) { const int n = (lane >> 3) + 8 * j; const LAS float* s = scr + (8 * c) * 33 + n;
        v4u o; o.x = pk2(s[0 * 33], s[1 * 33]); o.y = pk2(s[2 * 33], s[3 * 33]); o.z = pk2(s[4 * 33], s[5 * 33]); o.w = pk2(s[6 * 33], s[7 * 33]);
        *(v4u*)(WT + (size_t)(drow0 + n) * K + k0 + 8 * c) = o; }
    LDS_WAIT(); asm volatile("" ::: "memory");
}
__device__ __forceinline__ int win_row(int n) { return n < 3072 ? n : (n < CPA ? PC_LORA + (n - 3072) : (n < CPA + 4096 ? PC_GDN + (n - CPA) : n)); }

__device__ __forceinline__ void ph_pre(const Args& a, LAS unsigned char* lds) {
    const int tid = opaque_tid(), lane = tid & 63, wave = __builtin_amdgcn_readfirstlane(tid >> 6);
    const int G = gridDim.x;
    LAS float* ca = (LAS float*)lds;
    LAS float* red = (LAS float*)(lds + 2048 * 9 * 4);
    for (int i = tid; i < 9 * 2048; i += NTHR) { const int c = i / 2048, k = i - c * 2048; const float v = c == 0 ? a.in[I_CCTX][k] : a.in[I_C][(c - 1) * 2048 + k]; ca[k * 9 + c] = siluf_(v); }
    __syncthreads();
    float* MOD = (float*)(a.ws + WS_MOD);
    for (int task = blockIdx.x; task < 4 * 96; task += G) {
        const int l = task / 96, cb = task - l * 96;
        const float* wp = a.in[I_MODW] + ((size_t)l * 2048 + wave * 256) * 12288 + cb * 128 + lane * 2;
        float acc[9][2];
#pragma unroll
        for (int c = 0; c < 9; ++c) { acc[c][0] = 0.f; acc[c][1] = 0.f; }
        for (int k8 = 0; k8 < 256; k8 += 8) {
            f32x2 wv[8];
#pragma unroll
            for (int j = 0; j < 8; ++j) wv[j] = *(const f32x2*)(wp + (size_t)(k8 + j) * 12288);
#pragma unroll
            for (int j = 0; j < 8; ++j) { const LAS float* cp = ca + (wave * 256 + k8 + j) * 9;
#pragma unroll
                for (int c = 0; c < 9; ++c) { const float s = cp[c]; acc[c][0] += s * wv[j].x; acc[c][1] += s * wv[j].y; } }
        }
#pragma unroll
        for (int c = 0; c < 9; ++c) { red[(wave * 18 + c * 2) * 64 + lane] = acc[c][0]; red[(wave * 18 + c * 2 + 1) * 64 + lane] = acc[c][1]; }
        __syncthreads();
        for (int o = tid; o < 9 * 128; o += NTHR) { const int c = o >> 7, col = o & 127, ln = col >> 1, j = col & 1; float s = a.in[I_MODB][l * 12288 + cb * 128 + col];
#pragma unroll
            for (int w = 0; w < 8; ++w) s += red[(w * 18 + c * 2 + j) * 64 + ln];
            MOD[((size_t)l * 9 + c) * 12288 + cb * 128 + col] = s; }
        __syncthreads();
    }
    __syncthreads();
    LAS float* scr = (LAS float*)(lds + wave * 16384);
    const int gw = blockIdx.x * NWAVES + wave, NGW = G * NWAVES;
    bf16* WIN = (bf16*)(a.ws + WS_WIN); bf16* WOUT = (bf16*)(a.ws + WS_WOUT); bf16* WGU = (bf16*)(a.ws + WS_WGU); bf16* WDN = (bf16*)(a.ws + WS_WDN); bf16* WPOOL = (bf16*)(a.ws + WS_WPOOL);
    constexpr int IT_WIN = 32 * 238, IT_WOUT = 32 * 64, IT_GU = 32 * 176, IT_DN = 88 * 64, IT_POOL = 8 * 16;
    constexpr int NITEMS = 2 * IT_WIN + 2 * IT_WOUT + 8 * IT_GU + 4 * IT_DN + 8 * IT_POOL;
    for (int it = gw; it < NITEMS; it += NGW) {
        int r = it;
        if (r < 2 * IT_WIN) { const int i = r / IT_WIN; r -= i * IT_WIN; const int kb = r / 238, nb = r - kb * 238;
            conv_item(a.in[I_WIN] + (size_t)i * 2048 * 7616, 2048, 7616, WIN + (size_t)i * PW * 2048, win_row(32 * nb), scr, kb, nb, lane); continue; } r -= 2 * IT_WIN;
        if (r < 2 * IT_WOUT) { const int i = r / IT_WOUT; r -= i * IT_WOUT; const int kb = r / 64, nb = r - kb * 64;
            conv_item(a.in[I_WOUT] + (size_t)i * 2048 * 2048, 2048, 2048, WOUT + (size_t)i * 2048 * 2048, 32 * nb, scr, kb, nb, lane); continue; } r -= 2 * IT_WOUT;
        if (r < 8 * IT_GU) { const int li = r / IT_GU; r -= li * IT_GU; const int l = li >> 1, up = li & 1; const int kb = r / 176, nb = r - kb * 176; const int n0 = 32 * nb;
            conv_item(a.in[up ? I_WU : I_WG] + (size_t)l * 2048 * DFF, 2048, DFF, WGU + (size_t)l * 11264 * 2048, (n0 >> 7) * 256 + up * 128 + (n0 & 127), scr, kb, nb, lane); continue; } r -= 8 * IT_GU;
        if (r < 4 * IT_DN) { const int l = r / IT_DN; r -= l * IT_DN; const int kb = r / 64, nb = r - kb * 64;
            conv_item(a.in[I_WD] + (size_t)l * DFF * 2048, DFF, 2048, WDN + (size_t)l * 2048 * DFF, 32 * nb, scr, kb, nb, lane); continue; } r -= 4 * IT_DN;
        { const int ig = r / IT_POOL; r -= ig * IT_POOL; const int kb = r / 16, nb = r - kb * 16;
            conv_item(a.in[I_POOLW] + (size_t)ig * 512 * 512, 512, 512, WPOOL + (size_t)ig * 512 * 512, 32 * nb, scr, kb, nb, lane); }
    }
    { bf16* LW = (bf16*)(a.ws + WS_LORA); const int gt = blockIdx.x * NTHR + tid, NGT = G * NTHR;
        for (int idx = gt; idx < 8 * 65536; idx += NGT) { const int mat = idx >> 16, n = (idx >> 6) & 1023, k = idx & 63;
            const float v = (mat < 4 ? a.in[I_W2] : a.in[I_A2])[((size_t)(mat & 3) * 64 + k) * 1024 + n]; LW[idx] = (bf16)f2bf(v); }
        for (int idx = gt; idx < 2 * 1024 * 160; idx += NGT) { const int i2 = idx / (1024 * 160), r = idx - i2 * 1024 * 160, n = r / 160, k = r - n * 160;
            LW[8 * 65536 + idx] = (bf16)f2bf(a.in[I_G2][((size_t)i2 * 160 + k) * 1024 + n]); } }
    for (int r = gw; r < 128; r += NGW) { bf16* row = WIN + ((size_t)(r >> 6) * PW + 7616 + (r & 63)) * 2048; const v4u z = {0u, 0u, 0u, 0u};
#pragma unroll
        for (int j = 0; j < 4; ++j) *(v4u*)(row + (j * 64 + lane) * 8) = z; }
}

__device__ __forceinline__ void ph_norm(const Args& a, int l, int which) {
    const int tid = opaque_tid(), lane = tid & 63, wave = __builtin_amdgcn_readfirstlane(tid >> 6);
    const int gw = blockIdx.x * NWAVES + wave, NGW = gridDim.x * NWAVES;
    const float* nw = a.in[which ? I_NFFN : I_NMIX] + l * 2048;
    const float* MOD = (const float*)(a.ws + WS_MOD) + (size_t)l * 9 * 12288;
    bf16* H = (bf16*)(a.ws + WS_H);
    const bool from_in = (l == 0 && which == 0);
    for (int m = gw; m < NTOK; m += NGW) {
        const float* xr = from_in ? (m < NPROMPT ? a.in[I_XP] + (size_t)m * D : a.in[I_XS] + (size_t)(m - NPROMPT) * D) : a.out + (size_t)m * D;
        const int cond = m < NPROMPT ? 0 : 1 + ((m - NPROMPT) >> 10);
        const float* sh = MOD + (size_t)cond * 12288 + (which ? 3 : 0) * 2048; const float* sc = sh + 2048;
        f32x4 v[8]; float s = 0.f;
#pragma unroll
        for (int j = 0; j < 8; ++j) { v[j] = *(const f32x4*)(xr + 4 * lane + 256 * j); s += (v[j].x * v[j].x + v[j].y * v[j].y) + (v[j].z * v[j].z + v[j].w * v[j].w); }
        const float rstd = 1.0f / sqrtf(wave_sum(s) * (1.0f / D) + RMS_EPS);
#pragma unroll
        for (int j = 0; j < 8; ++j) { const int c = 4 * lane + 256 * j; const f32x4 w = *(const f32x4*)(nw + c), s1 = *(const f32x4*)(sc + c), s0 = *(const f32x4*)(sh + c);
            const f32x4 y = (v[j] * rstd) * w * (s1 + 1.0f) + s0;
            v2u o; o.x = pk2(y.x, y.y); o.y = pk2(y.z, y.w); *(v2u*)(H + (size_t)m * D + c) = o; }
    }
}
__device__ __forceinline__ void ph_final(const Args& a) {
    const int tid = opaque_tid(), lane = tid & 63, wave = __builtin_amdgcn_readfirstlane(tid >> 6);
    const int gw = blockIdx.x * NWAVES + wave, NGW = gridDim.x * NWAVES;
    const float* nw = a.in[I_NFIN];
    for (int m = gw; m < NTOK; m += NGW) {
        float* xr = a.out + (size_t)m * D;
        f32x4 v[8]; float s = 0.f;
#pragma unroll
        for (int j = 0; j < 8; ++j) { v[j] = *(const f32x4*)(xr + 4 * lane + 256 * j); s += (v[j].x * v[j].x + v[j].y * v[j].y) + (v[j].z * v[j].z + v[j].w * v[j].w); }
        const float rstd = 1.0f / sqrtf(wave_sum(s) * (1.0f / D) + RMS_EPS);
#pragma unroll
        for (int j = 0; j < 8; ++j) { const int c = 4 * lane + 256 * j; const f32x4 w = *(const f32x4*)(nw + c); *(f32x4*)(xr + c) = (v[j] * rstd) * w; }
    }
}
__device__ __forceinline__ void ph_pool(const Args& a) {
    const int tid = opaque_tid(), lane = tid & 63, wave = __builtin_amdgcn_readfirstlane(tid >> 6);
    const int gw = blockIdx.x * NWAVES + wave, NGW = gridDim.x * NWAVES;
    const bf16* H = (const bf16*)(a.ws + WS_H); bf16* O = (bf16*)(a.ws + WS_O);
    for (int m = gw; m < NTOK; m += NGW) {
        const bool samp = m >= NPROMPT; const int T = samp ? 1024 : 256; const int base = samp ? NPROMPT + (((m - NPROMPT) >> 10) << 10) : (m >> 8) << 8; const int t = m - base;
#pragma unroll
        for (int g = 0; g < 4; ++g) {
            const int win = 2 << g; int lo = t - win / 2, hi = lo + win; lo = lo < 0 ? 0 : lo; hi = hi > T ? T : hi;
            const int c = g * 512 + lane * 8;
            float s[8];
#pragma unroll
            for (int e = 0; e < 8; ++e) s[e] = 0.f;
            for (int r = lo; r < hi; ++r) { const v4u w = *(const v4u*)(H + (size_t)(base + r) * D + c);
                s[0] += bflo(w.x); s[1] += bfhi(w.x); s[2] += bflo(w.y); s[3] += bfhi(w.y); s[4] += bflo(w.z); s[5] += bfhi(w.z); s[6] += bflo(w.w); s[7] += bfhi(w.w); }
            const float inv = 1.0f / (float)(hi - lo);
            const v4u w = *(const v4u*)(H + (size_t)m * D + c);
            v4u o; o.x = pk2(s[0] * inv - bflo(w.x), s[1] * inv - bfhi(w.x)); o.y = pk2(s[2] * inv - bflo(w.y), s[3] * inv - bfhi(w.y));
            o.z = pk2(s[4] * inv - bflo(w.z), s[5] * inv - bfhi(w.z)); o.w = pk2(s[6] * inv - bflo(w.w), s[7] * inv - bfhi(w.w));
            *(v4u*)(O + (size_t)m * D + c) = o;
        }
    }
}

typedef short sfrag __attribute__((ext_vector_type(8)));
union Frag { sfrag v; unsigned u[4]; };
typedef __bf16 bf16x2_t __attribute__((ext_vector_type(2)));
__device__ __forceinline__ unsigned cvtpk(float lo, float hi) { const f32x2 v = {lo, hi}; return __builtin_bit_cast(unsigned, __builtin_convertvector(v, bf16x2_t)); }
__device__ __forceinline__ f32x4 mma(const Frag& A, const Frag& B, f32x4 C) { return __builtin_amdgcn_mfma_f32_16x16x32_bf16(A.v, B.v, C, 0, 0, 0); }
__device__ __forceinline__ Frag feed1(f32x4 d0) { Frag f; f.u[0] = cvtpk(d0.x, d0.y); f.u[1] = cvtpk(d0.z, d0.w); f.u[2] = 0u; f.u[3] = 0u; return f; }
__device__ __forceinline__ Frag feed2(f32x4 d0, f32x4 d1) { Frag f; f.u[0] = cvtpk(d0.x, d0.y); f.u[1] = cvtpk(d0.z, d0.w); f.u[2] = cvtpk(d1.x, d1.y); f.u[3] = cvtpk(d1.z, d1.w); return f; }
#define DPP_SHR(x, n, fill) __builtin_bit_cast(float, __builtin_amdgcn_update_dpp(__builtin_bit_cast(int, (float)(fill)), __builtin_bit_cast(int, (float)(x)), 0x110 + (n), 0xf, 0xf, false))
__device__ __forceinline__ float row_scan16(float x) { x += DPP_SHR(x, 1, 0.f); x += DPP_SHR(x, 2, 0.f); x += DPP_SHR(x, 4, 0.f); x += DPP_SHR(x, 8, 0.f); return x; }
__device__ __forceinline__ float lane_get(float x, int src) { return __builtin_bit_cast(float, __builtin_amdgcn_ds_bpermute(src << 2, __builtin_bit_cast(int, x))); }
constexpr f32x4 F4Z = {0.f, 0.f, 0.f, 0.f};
__device__ __forceinline__ f32x4 tri_inv_T(f32x4 dL, f32x4 dLT, f32x4 eye) {
    const Frag fL = feed1(dL), fLT = feed1(dLT);
    const f32x4 L2 = mma(fLT, fL, F4Z), L2T = mma(fL, fLT, F4Z);
    const Frag f2 = feed1(L2), f2T = feed1(L2T);
    const f32x4 L4 = mma(f2T, f2, F4Z), L4T = mma(f2, f2T, F4Z);
    const f32x4 L8 = mma(feed1(L4T), feed1(L4), F4Z);
    const f32x4 R1 = mma(feed1(L2 + eye), feed1(dLT + eye), F4Z);
    const f32x4 R2 = mma(feed1(L4 + eye), feed1(R1), F4Z);
    return mma(feed1(L8 + eye), feed1(R2), F4Z);
}

__device__ __forceinline__ void rwkv_task(const Args& a, int i, int s, int h, int d, int lane, LAS float* wscr) {
    constexpr size_t S1 = (size_t)NTOK * 1024;
    const bf16* SCb = (const bf16*)(a.ws + WS_SC);
    const bf16 *Rb = SCb, *Ab = SCb + S1, *Vb = SCb + 2 * S1, *Kb = SCb + (3 + d) * S1, *Bb = SCb + (5 + d) * S1, *LWb = SCb + (7 + d) * S1;
    float* Y = (float*)(a.ws + WS_Y) + d * S1;
    const int T = s < 16 ? 256 : 1024; const int row0 = s < 16 ? s * 256 : NPROMPT + (s - 16) * 1024;
    const int c = lane & 15, q = lane >> 4;
    f32x4 S[4][4];
    if (s >= 16) { const float* s0 = a.in[I_SRW] + ((((size_t)(s - 16) * 2 + i) * 2 + d) * 16 + h) * 4096;
#pragma unroll
        for (int kt = 0; kt < 4; ++kt)
#pragma unroll
            for (int vt = 0; vt < 4; ++vt) S[kt][vt] = *(const f32x4*)(s0 + (16 * vt + c) * 64 + 16 * kt + 4 * q); }
    else {
#pragma unroll
        for (int kt = 0; kt < 4; ++kt)
#pragma unroll
            for (int vt = 0; vt < 4; ++vt) S[kt][vt] = F4Z; }
    Frag sel[2];
#pragma unroll
    for (int p = 0; p < 2; ++p)
#pragma unroll
        for (int j = 0; j < 4; ++j) { const int e0 = 2 * j - 4 * p; const bool on = ((lane >> 2) & 3) == q && (e0 == (lane & 3) || e0 + 1 == (lane & 3)) && (j >> 1) == p;
            sel[p].u[j] = on ? (((lane & 1) == 0) ? 0x00003F80u : 0x3F800000u) : 0u; }
    bool mlt[4], mle[4]; f32x4 eye;
#pragma unroll
    for (int n = 0; n < 4; ++n) { mlt[n] = (4 * q + n) < c; mle[n] = (4 * q + n) <= c; eye[n] = (4 * q + n) == c ? 1.f : 0.f; }
    const int nch = T >> 4;
    const size_t hoff = (size_t)h * 64 + 4 * q;
    v2u nr[4], na[4], nk[4], nb[4], nlw[4], nv[4];
    for (int ch = 0; ch < nch; ++ch) {
        { const int tok = d ? T - 1 - (16 * ch + c) : 16 * ch + c; const size_t o = (size_t)(row0 + tok) * 1024 + hoff;
#pragma unroll
            for (int g = 0; g < 4; ++g) { nr[g] = *(const v2u*)(Rb + o + 16 * g); na[g] = *(const v2u*)(Ab + o + 16 * g); nk[g] = *(const v2u*)(Kb + o + 16 * g); nb[g] = *(const v2u*)(Bb + o + 16 * g); nlw[g] = *(const v2u*)(LWb + o + 16 * g); nv[g] = *(const v2u*)(Vb + o + 16 * g); } }
        Frag f_at[2], f_rt[2], f_bt[2], f_kt[2], f_bh[2], f_kh[2], f_v[2];
#pragma unroll
        for (int g = 0; g < 4; ++g) {
            const int ks = g >> 1, hf = g & 1;
            float lw_[4] = {bflo(nlw[g].x), bfhi(nlw[g].x), bflo(nlw[g].y), bfhi(nlw[g].y)};
            float r_[4] = {bflo(nr[g].x), bfhi(nr[g].x), bflo(nr[g].y), bfhi(nr[g].y)}, a_[4] = {bflo(na[g].x), bfhi(na[g].x), bflo(na[g].y), bfhi(na[g].y)};
            float k_[4] = {bflo(nk[g].x), bfhi(nk[g].x), bflo(nk[g].y), bfhi(nk[g].y)}, b_[4] = {bflo(nb[g].x), bfhi(nb[g].x), bflo(nb[g].y), bfhi(nb[g].y)};
            float at[4], rt[4], bt[4], kt[4], bh[4], kh[4];
#pragma unroll
            for (int n = 0; n < 4; ++n) {
                const float G = row_scan16(lw_[n]); const float E1 = __builtin_amdgcn_exp2f(G), E2 = __builtin_amdgcn_rcpf(E1); const float E3 = DPP_SHR(E1, 1, 1.0f);
                const float ec = lane_get(E1, (lane & 48) | 15); wscr[(g * 4 + n) * 64 + lane] = ec;
                at[n] = a_[n] * E3; rt[n] = r_[n] * E1; bt[n] = b_[n] * E2; kt[n] = k_[n] * E2; bh[n] = bt[n] * ec; kh[n] = kt[n] * ec;
            }
            f_at[ks].u[2 * hf] = cvtpk(at[0], at[1]); f_at[ks].u[2 * hf + 1] = cvtpk(at[2], at[3]); f_rt[ks].u[2 * hf] = cvtpk(rt[0], rt[1]); f_rt[ks].u[2 * hf + 1] = cvtpk(rt[2], rt[3]);
            f_bt[ks].u[2 * hf] = cvtpk(bt[0], bt[1]); f_bt[ks].u[2 * hf + 1] = cvtpk(bt[2], bt[3]); f_kt[ks].u[2 * hf] = cvtpk(kt[0], kt[1]); f_kt[ks].u[2 * hf + 1] = cvtpk(kt[2], kt[3]);
            f_bh[ks].u[2 * hf] = cvtpk(bh[0], bh[1]); f_bh[ks].u[2 * hf + 1] = cvtpk(bh[2], bh[3]); f_kh[ks].u[2 * hf] = cvtpk(kh[0], kh[1]); f_kh[ks].u[2 * hf + 1] = cvtpk(kh[2], kh[3]);
            f_v[ks].u[2 * hf] = nv[g].x; f_v[ks].u[2 * hf + 1] = nv[g].y;
            __builtin_amdgcn_sched_barrier(0);
        }
        v2u pV[4]; LAS v4u* sBK = (LAS v4u*)(wscr + 1024);
#pragma unroll
        for (int g = 0; g < 4; ++g) { const f32x4 dv = mma(f_v[g >> 1], sel[g & 1], F4Z); pV[g].x = cvtpk(dv.x, dv.y); pV[g].y = cvtpk(dv.z, dv.w);
            const Frag fb = feed2(mma(f_bh[g >> 1], sel[g & 1], F4Z), mma(f_kh[g >> 1], sel[g & 1], F4Z)); sBK[g * 64 + lane] = (v4u){fb.u[0], fb.u[1], fb.u[2], fb.u[3]}; }
        __builtin_amdgcn_sched_barrier(0);
        f32x4 dLab = mma(f_at[1], f_bt[1], mma(f_at[0], f_bt[0], F4Z));
        f32x4 dLabT = mma(f_bt[1], f_at[1], mma(f_bt[0], f_at[0], F4Z));
        f32x4 dLakT = mma(f_kt[1], f_at[1], mma(f_kt[0], f_at[0], F4Z));
        f32x4 dArbT = mma(f_bt[1], f_rt[1], mma(f_bt[0], f_rt[0], F4Z));
        f32x4 dArkT = mma(f_kt[1], f_rt[1], mma(f_kt[0], f_rt[0], F4Z));
#pragma unroll
        for (int n = 0; n < 4; ++n) { dLab[n] = (c < 4 * q + n) ? dLab[n] : 0.f; dLabT[n] = mlt[n] ? dLabT[n] : 0.f; dLakT[n] = mlt[n] ? dLakT[n] : 0.f; dArbT[n] = mle[n] ? dArbT[n] : 0.f; dArkT[n] = mle[n] ? dArkT[n] : 0.f; }
        const Frag fTT = feed1(tri_inv_T(dLab, dLabT, eye)), fLakT = feed1(dLakT), fArbT = feed1(dArbT), fArkT = feed1(dArkT);
        __builtin_amdgcn_sched_barrier(0);
        v2u pSA[4];
        const int tokbase = 16 * ch + 4 * q;
#pragma unroll
        for (int vt = 0; vt < 4; ++vt) {
            const Frag fS0 = feed2(S[0][vt], S[1][vt]), fS1 = feed2(S[2][vt], S[3][vt]); Frag fV; fV.u[0] = pV[vt].x; fV.u[1] = pV[vt].y; fV.u[2] = 0u; fV.u[3] = 0u;
            f32x4 rhs = mma(f_at[1], fS1, mma(f_at[0], fS0, F4Z)); rhs = mma(fLakT, fV, rhs);
            const f32x4 sa = mma(fTT, feed1(rhs), F4Z); pSA[vt].x = cvtpk(sa.x, sa.y); pSA[vt].y = cvtpk(sa.z, sa.w);
            Frag fSA; fSA.u[0] = pSA[vt].x; fSA.u[1] = pSA[vt].y; fSA.u[2] = 0u; fSA.u[3] = 0u;
            f32x4 y = mma(f_rt[1], fS1, mma(f_rt[0], fS0, F4Z)); y = mma(fArbT, fSA, y); y = mma(fArkT, fV, y);
#pragma unroll
            for (int n = 0; n < 4; ++n) { const int t = tokbase + n; const int tok = d ? T - 1 - t : t; Y[(size_t)(row0 + tok) * 1024 + h * 64 + 16 * vt + c] = y[n]; }
            __builtin_amdgcn_sched_barrier(0);
        }
#pragma unroll
        for (int vt = 0; vt < 4; ++vt) { Frag fB; fB.u[0] = pSA[vt].x; fB.u[1] = pSA[vt].y; fB.u[2] = pV[vt].x; fB.u[3] = pV[vt].y;
#pragma unroll
            for (int kt = 0; kt < 4; ++kt) { f32x4 cin;
#pragma unroll
                for (int n = 0; n < 4; ++n) cin[n] = S[kt][vt][n] * wscr[(kt * 4 + n) * 64 + lane];
                const v4u w = sBK[kt * 64 + lane]; Frag fbk; fbk.u[0] = w.x; fbk.u[1] = w.y; fbk.u[2] = w.z; fbk.u[3] = w.w;
                S[kt][vt] = mma(fbk, fB, cin); } }
    }
    if (s < 16) { float* so = a.out + OUT_SRW + ((((size_t)s * 2 + i) * 2 + d) * 16 + h) * 4096;
#pragma unroll
        for (int kt = 0; kt < 4; ++kt)
#pragma unroll
            for (int vt = 0; vt < 4; ++vt) *(f32x4*)(so + (16 * vt + c) * 64 + 16 * kt + 4 * q) = S[kt][vt]; }
}

__device__ __forceinline__ Frag scale_frag(const Frag& x, float sc) { Frag f;
#pragma unroll
    for (int j = 0; j < 4; ++j) f.u[j] = cvtpk(bflo(x.u[j]) * sc, bfhi(x.u[j]) * sc);
    return f; }
__device__ __forceinline__ void gdn_task(const Args& a, int i, int s, int h, int d, int vb, int lane, LAS float* wscr) {
    constexpr size_t S1 = (size_t)NTOK * 1024;
    const bf16* SCb = (const bf16*)(a.ws + WS_SC);
    const bf16 *Qb = SCb + 9 * S1, *KDb = SCb + 10 * S1, *VDb = SCb + 11 * S1;
    const float* BETA = (const float*)(a.ws + WS_SMALL) + (size_t)NTOK * 32; const float* GG = BETA + (size_t)NTOK * 16;
    float* O = (float*)(a.ws + WS_Y) + 2 * S1 + d * S1;
    const int T = s < 16 ? 256 : 1024; const int row0 = s < 16 ? s * 256 : NPROMPT + (s - 16) * 1024;
    const int c = lane & 15, q = lane >> 4;
    f32x4 S[8][2];
    if (s >= 16) { const float* s0 = a.in[I_SDL] + ((((size_t)(s - 16) * 2 + i) * 2 + d) * 8 + h) * 16384 + 32 * vb + c;
#pragma unroll
        for (int kt = 0; kt < 8; ++kt)
#pragma unroll
            for (int vt = 0; vt < 2; ++vt)
#pragma unroll
                for (int n = 0; n < 4; ++n) S[kt][vt][n] = s0[(16 * kt + 4 * q + n) * 128 + 16 * vt]; }
    else {
#pragma unroll
        for (int kt = 0; kt < 8; ++kt) { S[kt][0] = F4Z; S[kt][1] = F4Z; } }
    Frag sel[2];
#pragma unroll
    for (int p = 0; p < 2; ++p)
#pragma unroll
        for (int j = 0; j < 4; ++j) { const int e0 = 2 * j - 4 * p; const bool on = ((lane >> 2) & 3) == q && (e0 == (lane & 3) || e0 + 1 == (lane & 3)) && (j >> 1) == p;
            sel[p].u[j] = on ? (((lane & 1) == 0) ? 0x00003F80u : 0x3F800000u) : 0u; }
    f32x4 eye;
#pragma unroll
    for (int n = 0; n < 4; ++n) eye[n] = (4 * q + n) == c ? 1.f : 0.f;
    const int nch = T >> 4;
    Frag nk[4], nq[4], nv; float nbeta, ng;
    { const int tok = d ? T - 1 - c : c; const size_t row = row0 + tok; const size_t o = row * 1024 + h * 128 + 4 * q;
#pragma unroll
        for (int ks = 0; ks < 4; ++ks) { const v2u k0 = *(const v2u*)(KDb + o + 32 * ks), k1 = *(const v2u*)(KDb + o + 32 * ks + 16), q0 = *(const v2u*)(Qb + o + 32 * ks), q1 = *(const v2u*)(Qb + o + 32 * ks + 16);
            nk[ks].u[0] = k0.x; nk[ks].u[1] = k0.y; nk[ks].u[2] = k1.x; nk[ks].u[3] = k1.y; nq[ks].u[0] = q0.x; nq[ks].u[1] = q0.y; nq[ks].u[2] = q1.x; nq[ks].u[3] = q1.y; }
        { const v2u v0 = *(const v2u*)(VDb + o + 32 * vb), v1 = *(const v2u*)(VDb + o + 32 * vb + 16); nv.u[0] = v0.x; nv.u[1] = v0.y; nv.u[2] = v1.x; nv.u[3] = v1.y; }
        nbeta = BETA[row * 16 + d * 8 + h]; ng = GG[row * 16 + d * 8 + h]; }
    for (int ch = 0; ch < nch; ++ch) {
        const float beta = nbeta, gl = ng;
        const float G = row_scan16(gl); const float GC = lane_get(G, (lane & 48) | 15);
        float Grow[4], Brow[4];
#pragma unroll
        for (int n = 0; n < 4; ++n) { Grow[n] = lane_get(G, (lane & 48) | (4 * q + n)); Brow[n] = lane_get(beta, (lane & 48) | (4 * q + n)); }
        const float eG = __builtin_amdgcn_exp2f(G), eGCG = __builtin_amdgcn_exp2f(GC - G), eGC = __builtin_amdgcn_exp2f(GC);
        f32x4 dKK = F4Z, dKQ = F4Z;
#pragma unroll
        for (int ks = 0; ks < 4; ++ks) { dKK = mma(nk[ks], nk[ks], dKK); dKQ = mma(nk[ks], nq[ks], dKQ); }
        f32x4 dL, dLT, dAtT;
#pragma unroll
        for (int n = 0; n < 4; ++n) { const int r = 4 * q + n;
            const float eij = __builtin_amdgcn_exp2f(fminf(Grow[n] - G, 0.f)), eji = __builtin_amdgcn_exp2f(fminf(G - Grow[n], 0.f));
            dL[n] = (c < r) ? -Brow[n] * dKK[n] * eij : 0.f;
            dLT[n] = (r < c) ? -beta * dKK[n] * eji : 0.f;
            dAtT[n] = (r <= c) ? dKQ[n] * eji * 0.08838834764831845f : 0.f; }
        const Frag fTT = feed1(tri_inv_T(dL, dLT, eye)), fAtT = feed1(dAtT);
        f32x4 dV[2]; dV[0] = mma(nv, sel[0], F4Z); dV[1] = mma(nv, sel[1], F4Z);
        LAS v2u* sKd = (LAS v2u*)wscr;
#pragma unroll
        for (int ks = 0; ks < 4; ++ks) { const Frag kd = scale_frag(nk[ks], eGCG); const f32x4 t0 = mma(kd, sel[0], F4Z), t1 = mma(kd, sel[1], F4Z);
            sKd[(2 * ks) * 64 + lane] = (v2u){cvtpk(t0.x, t0.y), cvtpk(t0.z, t0.w)}; sKd[(2 * ks + 1) * 64 + lane] = (v2u){cvtpk(t1.x, t1.y), cvtpk(t1.z, t1.w)}; }
        Frag fX[4], fQg[4];
#pragma unroll
        for (int ks = 0; ks < 4; ++ks) { fX[ks] = scale_frag(nk[ks], beta * eG); fQg[ks] = scale_frag(nq[ks], eG * 0.08838834764831845f); }
        const int tokbase = 16 * ch + 4 * q;
#pragma unroll
        for (int vt = 0; vt < 2; ++vt) {
            f32x4 M = F4Z, o = F4Z;
#pragma unroll
            for (int ks = 0; ks < 4; ++ks) { const Frag fS = feed2(S[2 * ks][vt], S[2 * ks + 1][vt]); M = mma(fX[ks], fS, M); o = mma(fQg[ks], fS, o); }
            f32x4 rhs;
#pragma unroll
            for (int n = 0; n < 4; ++n) rhs[n] = Brow[n] * dV[vt][n] - M[n];
            const Frag fVn = feed1(mma(fTT, feed1(rhs), F4Z));
            o = mma(fAtT, fVn, o);
#pragma unroll
            for (int n = 0; n < 4; ++n) { const int t = tokbase + n; const int tok = d ? T - 1 - t : t; O[(size_t)(row0 + tok) * 1024 + h * 128 + 32 * vb + 16 * vt + c] = o[n]; }
#pragma unroll
            for (int kt = 0; kt < 8; ++kt) { const v2u w = sKd[kt * 64 + lane]; Frag fK; fK.u[0] = w.x; fK.u[1] = w.y; fK.u[2] = 0u; fK.u[3] = 0u; S[kt][vt] = mma(fK, fVn, S[kt][vt] * eGC); }
        }
        asm volatile("" ::: "memory");
        { const int chn = ch + 1 < nch ? ch + 1 : ch; const int tok = d ? T - 1 - (16 * chn + c) : 16 * chn + c; const size_t row = row0 + tok; const size_t o = row * 1024 + h * 128 + 4 * q;
#pragma unroll
            for (int ks = 0; ks < 4; ++ks) { const v2u k0 = *(const v2u*)(KDb + o + 32 * ks), k1 = *(const v2u*)(KDb + o + 32 * ks + 16), q0 = *(const v2u*)(Qb + o + 32 * ks), q1 = *(const v2u*)(Qb + o + 32 * ks + 16);
                nk[ks].u[0] = k0.x; nk[ks].u[1] = k0.y; nk[ks].u[2] = k1.x; nk[ks].u[3] = k1.y; nq[ks].u[0] = q0.x; nq[ks].u[1] = q0.y; nq[ks].u[2] = q1.x; nq[ks].u[3] = q1.y; }
            { const v2u v0 = *(const v2u*)(VDb + o + 32 * vb), v1 = *(const v2u*)(VDb + o + 32 * vb + 16); nv.u[0] = v0.x; nv.u[1] = v0.y; nv.u[2] = v1.x; nv.u[3] = v1.y; }
            nbeta = BETA[row * 16 + d * 8 + h]; ng = GG[row * 16 + d * 8 + h]; }
    }
    if (s < 16) { float* so = a.out + OUT_SDL + ((((size_t)s * 2 + i) * 2 + d) * 8 + h) * 16384 + 32 * vb + c;
#pragma unroll
        for (int kt = 0; kt < 8; ++kt)
#pragma unroll
            for (int vt = 0; vt < 2; ++vt)
#pragma unroll
                for (int n = 0; n < 4; ++n) so[(16 * kt + 4 * q + n) * 128 + 16 * vt] = S[kt][vt][n]; }
}
__device__ __forceinline__ void ph_scan(const Args& a, LAS unsigned char* lds, int i) {
    const int tid = opaque_tid(), lane = tid & 63, wave = __builtin_amdgcn_readfirstlane(tid >> 6);
    LAS float* wscr = (LAS float*)(lds + wave * 8192);
    const int G = gridDim.x;
    for (int task = wave * G + blockIdx.x; task < 2304; task += NWAVES * G) {
        if (task >= 256 && task < 512) { const int t = task - 256; rwkv_task(a, i, 16 + (t >> 5), (t & 31) >> 1, t & 1, lane, wscr); }
        else if (task >= 1024 && task < 1536) { const int t = task - 1024; rwkv_task(a, i, t >> 5, (t & 31) >> 1, t & 1, lane, wscr); }
    }
    asm volatile("" ::: "memory");
    for (int task = wave * G + blockIdx.x; task < 2304; task += NWAVES * G) {
        if (task < 256 || task >= 1536) { const int t = task < 256 ? task : task - 1536 + 256; const int s = t >> 6, r = t & 63; gdn_task(a, i, s, r >> 3, (r >> 2) & 1, r & 3, lane, wscr); }
        else if (task >= 512 && task < 1024) { const int t = task - 512; const int s = 16 + (t >> 6), r = t & 63; gdn_task(a, i, s, r >> 3, (r >> 2) & 1, r & 3, lane, wscr); }
    }
}
__device__ __forceinline__ void tok_info(int m, bool& samp, int& T, int& t) { samp = m >= NPROMPT; T = samp ? 1024 : 256; t = samp ? ((m - NPROMPT) & 1023) : (m & 255); }
__device__ __forceinline__ void shift_nb(bool samp, int T, int t, int n, int& dt, bool& valid) {
    if (!samp) { if (n & 1) { dt = 1; valid = t + 1 < T; } else { dt = -1; valid = t > 0; } }
    else { const int col = t & 63, row = t >> 6;
        if (n == 0) { dt = -1; valid = col > 0; } else if (n == 1) { dt = 1; valid = col < 63; } else if (n == 2) { dt = -64; valid = row > 0; } else { dt = 64; valid = row < 15; } }
}
constexpr int LA_LD = 424;
__device__ __forceinline__ void ph_prep(const Args& a, LAS unsigned char* lds, int i) {
    const int tid = opaque_tid(), lane = tid & 63, wave = __builtin_amdgcn_readfirstlane(tid >> 6);
    const int c = lane & 15, q = lane >> 4;
    const bf16* P = (const bf16*)(a.ws + WS_P);
    bf16* SC = (bf16*)(a.ws + WS_SC); constexpr size_t S1 = (size_t)NTOK * 1024;
    bf16 *Rb = SC, *Ab = SC + S1, *Vb = SC + 2 * S1, *Kb = SC + 3 * S1, *Bb = SC + 5 * S1, *Wb = SC + 7 * S1, *Qb = SC + 9 * S1, *KDb = SC + 10 * S1, *VDb = SC + 11 * S1;
    float* GT = (float*)(SC + 12 * S1);
    float* BON = (float*)(a.ws + WS_SMALL); float* BETA = BON + (size_t)NTOK * 32; float* GG = BETA + (size_t)NTOK * 16;
    const float* MU = a.in[I_MU] + i * CPA;
    const bf16* W2T = (const bf16*)(a.ws + WS_LORA) + (size_t)i * 2 * 1024 * 64;
    const bf16* A2T = (const bf16*)(a.ws + WS_LORA) + (size_t)4 * 1024 * 64 + (size_t)i * 2 * 1024 * 64;
    const bf16* G2T = (const bf16*)(a.ws + WS_LORA) + (size_t)8 * 1024 * 64 + (size_t)i * 1024 * 160;
    LAS bf16* la = (LAS bf16*)lds;
    for (int tile = blockIdx.x; tile < NTOK / 48; tile += gridDim.x) {
        const int m0 = tile * 48;
        for (int idx = tid; idx < 48 * 416; idx += NTHR) {
            const int tt = idx / 416, jj = idx - tt * 416; const int m = m0 + tt; bool samp; int T, t; tok_info(m, samp, T, t);
            int dt; bool valid; shift_nb(samp, T, t, jj & 3, dt, valid);
            const float x = bf2f(P[(size_t)m * PW + PC_LORA + jj]); const float xs = valid ? bf2f(P[(size_t)(m + dt) * PW + PC_LORA + jj]) : 0.f;
            float v = x + (xs - x) * MU[3072 + jj];
            if (jj < 128) v = tanhf(v); else if (jj >= 256) v = sigmoidf_(v);
            la[tt * LA_LD + jj] = (bf16)f2bf(v);
        }
        __syncthreads();
#pragma unroll 1
        for (int u = 0; u < 6; ++u) {
            const int hd = wave * 2 + u / 3, mt = u % 3; const int m = m0 + 16 * mt + c; bool samp; int T, t; tok_info(m, samp, T, t);
            int dtn[4]; bool vn[4];
#pragma unroll
            for (int n = 0; n < 4; ++n) shift_nb(samp, T, t, n, dtn[n], vn[n]);
            float ss = 0.f;
#pragma unroll 1
            for (int nt = 0; nt < 4; ++nt) { const int ch = hd * 64 + 16 * nt + 4 * q; const bf16* pk = P + (size_t)m * PW + 1024 + ch;
                const v2u wk = *(const v2u*)pk; const f32x4 muk = *(const f32x4*)(MU + 1024 + ch), kkw = *(const f32x4*)(a.in[I_KK] + i * 1024 + ch);
                const float xk[4] = {bflo(wk.x), bfhi(wk.x), bflo(wk.y), bfhi(wk.y)};
#pragma unroll
                for (int n = 0; n < 4; ++n) { const float nk = vn[n] ? bf2f(pk[(long)dtn[n] * PW + n]) : 0.f; const float kkr = (xk[n] + (nk - xk[n]) * muk[n]) * kkw[n]; ss += kkr * kkr; } }
            ss += __shfl_xor(ss, 16); ss += __shfl_xor(ss, 32);
            const float kn = 1.0f / sqrtf(ss + 1e-12f);
            float bon0 = 0.f, bon1 = 0.f;
            const LAS bf16* lrow = la + (16 * mt + c) * LA_LD + 8 * q;
#pragma unroll 1
            for (int nt = 0; nt < 4; ++nt) {
                f32x4 wl0 = F4Z, wl1 = F4Z, al0 = F4Z, al1 = F4Z, gl = F4Z;
#pragma unroll
                for (int ks = 0; ks < 2; ++ks) {
                    const size_t wo = ((size_t)hd * 64 + 16 * nt + c) * 64 + 32 * ks + 8 * q;
                    Frag b, w; v4u x;
                    x = *(const LAS v4u*)(lrow + 32 * ks); b.u[0] = x.x; b.u[1] = x.y; b.u[2] = x.z; b.u[3] = x.w; x = *(const v4u*)(W2T + wo); w.u[0] = x.x; w.u[1] = x.y; w.u[2] = x.z; w.u[3] = x.w; wl0 = mma(w, b, wl0);
                    x = *(const LAS v4u*)(lrow + 64 + 32 * ks); b.u[0] = x.x; b.u[1] = x.y; b.u[2] = x.z; b.u[3] = x.w; x = *(const v4u*)(W2T + 65536 + wo); w.u[0] = x.x; w.u[1] = x.y; w.u[2] = x.z; w.u[3] = x.w; wl1 = mma(w, b, wl1);
                    x = *(const LAS v4u*)(lrow + 128 + 32 * ks); b.u[0] = x.x; b.u[1] = x.y; b.u[2] = x.z; b.u[3] = x.w; x = *(const v4u*)(A2T + wo); w.u[0] = x.x; w.u[1] = x.y; w.u[2] = x.z; w.u[3] = x.w; al0 = mma(w, b, al0);
                    x = *(const LAS v4u*)(lrow + 192 + 32 * ks); b.u[0] = x.x; b.u[1] = x.y; b.u[2] = x.z; b.u[3] = x.w; x = *(const v4u*)(A2T + 65536 + wo); w.u[0] = x.x; w.u[1] = x.y; w.u[2] = x.z; w.u[3] = x.w; al1 = mma(w, b, al1);
                }
#pragma unroll
                for (int ks = 0; ks < 5; ++ks) { Frag b, w; v4u x = *(const LAS v4u*)(lrow + 256 + 32 * ks); b.u[0] = x.x; b.u[1] = x.y; b.u[2] = x.z; b.u[3] = x.w;
                    x = *(const v4u*)(G2T + ((size_t)hd * 64 + 16 * nt + c) * 160 + 32 * ks + 8 * q); w.u[0] = x.x; w.u[1] = x.y; w.u[2] = x.z; w.u[3] = x.w; gl = mma(w, b, gl); }
                const int ch = hd * 64 + 16 * nt + 4 * q; const size_t o = (size_t)m * 1024 + ch; const bf16* pr = P + (size_t)m * PW + ch;
                const v2u wr = *(const v2u*)pr, wk = *(const v2u*)(pr + 1024), wv = *(const v2u*)(pr + 2048);
                const f32x4 mur = *(const f32x4*)(MU + ch), muk = *(const f32x4*)(MU + 1024 + ch), muv = *(const f32x4*)(MU + 2048 + ch);
                const f32x4 kkw = *(const f32x4*)(a.in[I_KK] + i * 1024 + ch), kaw = *(const f32x4*)(a.in[I_KA] + i * 1024 + ch), rkw = *(const f32x4*)(a.in[I_RK] + i * 1024 + ch);
                const f32x4 w00 = *(const f32x4*)(a.in[I_W0] + (i * 2 + 0) * 1024 + ch), w01 = *(const f32x4*)(a.in[I_W0] + (i * 2 + 1) * 1024 + ch);
                const f32x4 a00 = *(const f32x4*)(a.in[I_A0] + (i * 2 + 0) * 1024 + ch), a01 = *(const f32x4*)(a.in[I_A0] + (i * 2 + 1) * 1024 + ch);
                const float xr[4] = {bflo(wr.x), bfhi(wr.x), bflo(wr.y), bfhi(wr.y)}, xk[4] = {bflo(wk.x), bfhi(wk.x), bflo(wk.y), bfhi(wk.y)}, xv[4] = {bflo(wv.x), bfhi(wv.x), bflo(wv.y), bfhi(wv.y)};
                float r_[4], v_[4], kk[4], lw0[4], lw1[4], kd0[4], kd1[4], b0[4], b1[4];
#pragma unroll
                for (int n = 0; n < 4; ++n) { const bf16* pn = pr + (long)dtn[n] * PW + n;
                    const float nr = vn[n] ? bf2f(pn[0]) : 0.f, nk = vn[n] ? bf2f(pn[1024]) : 0.f, nv = vn[n] ? bf2f(pn[2048]) : 0.f;
                    r_[n] = xr[n] + (nr - xr[n]) * mur[n]; const float k_ = xk[n] + (nk - xk[n]) * muk[n]; v_[n] = xv[n] + (nv - xv[n]) * muv[n];
                    kk[n] = k_ * kkw[n] * kn;
                    const float ic0 = sigmoidf_(a00[n] + al0[n]), ic1 = sigmoidf_(a01[n] + al1[n]);
                    lw0[n] = -0.6065306597f * 1.4426950409f * sigmoidf_(w00[n] + wl0[n]); lw1[n] = -0.6065306597f * 1.4426950409f * sigmoidf_(w01[n] + wl1[n]);
                    kd0[n] = k_ * (1.0f + (ic0 - 1.0f) * kaw[n]); kd1[n] = k_ * (1.0f + (ic1 - 1.0f) * kaw[n]); b0[n] = kk[n] * ic0; b1[n] = kk[n] * ic1;
                    bon0 += r_[n] * kd0[n] * rkw[n]; bon1 += r_[n] * kd1[n] * rkw[n]; }
                *(v2u*)(Rb + o) = (v2u){cvtpk(r_[0], r_[1]), cvtpk(r_[2], r_[3])}; *(v2u*)(Vb + o) = (v2u){cvtpk(v_[0], v_[1]), cvtpk(v_[2], v_[3])};
                *(v2u*)(Ab + o) = (v2u){cvtpk(-kk[0], -kk[1]), cvtpk(-kk[2], -kk[3])};
                *(v2u*)(Kb + o) = (v2u){cvtpk(kd0[0], kd0[1]), cvtpk(kd0[2], kd0[3])}; *(v2u*)(Kb + S1 + o) = (v2u){cvtpk(kd1[0], kd1[1]), cvtpk(kd1[2], kd1[3])};
                *(v2u*)(Bb + o) = (v2u){cvtpk(b0[0], b0[1]), cvtpk(b0[2], b0[3])}; *(v2u*)(Bb + S1 + o) = (v2u){cvtpk(b1[0], b1[1]), cvtpk(b1[2], b1[3])};
                *(v2u*)(Wb + o) = (v2u){cvtpk(lw0[0], lw0[1]), cvtpk(lw0[2], lw0[3])}; *(v2u*)(Wb + S1 + o) = (v2u){cvtpk(lw1[0], lw1[1]), cvtpk(lw1[2], lw1[3])};
                *(f32x4*)(GT + o) = gl;
            }
            bon0 += __shfl_xor(bon0, 16); bon0 += __shfl_xor(bon0, 32); bon1 += __shfl_xor(bon1, 16); bon1 += __shfl_xor(bon1, 32);
            if (q == 0) { BON[((size_t)m * 2 + 0) * 16 + hd] = bon0; BON[((size_t)m * 2 + 1) * 16 + hd] = bon1; }
        }
#pragma unroll 1
        for (int r3 = 0; r3 < 3; ++r3) {
            const int unit = wave + 8 * r3; const int hd = unit / 3, mt = unit - hd * 3; const int m = m0 + 16 * mt + c; bool samp; int T, t; tok_info(m, samp, T, t);
            const bool hp = t > 0, hn = t + 1 < T; const float* cw = a.in[I_CONVW] + (size_t)i * 3 * 3072;
            float sqk[2] = {0.f, 0.f};
#pragma unroll
            for (int pass = 0; pass < 2; ++pass) {
                float scl[2] = {1.f, 1.f};
                if (pass == 1) { sqk[0] += __shfl_xor(sqk[0], 16); sqk[0] += __shfl_xor(sqk[0], 32); sqk[1] += __shfl_xor(sqk[1], 16); sqk[1] += __shfl_xor(sqk[1], 32);
                    scl[0] = 1.0f / sqrtf(sqk[0] + 1e-6f); scl[1] = 1.0f / sqrtf(sqk[1] + 1e-6f); }
#pragma unroll
                for (int part = 0; part < 3; ++part) {
                    if (pass == 0 && part == 2) continue;
                    bf16* dst = part == 0 ? Qb : (part == 1 ? KDb : VDb); const float sc = part < 2 ? scl[part] : 1.f; float acc = 0.f;
#pragma unroll 2
                    for (int g = 0; g < 8; ++g) { const int ch = part * 1024 + hd * 128 + 16 * g + 4 * q; const bf16* pp = P + (size_t)m * PW + PC_GDN + ch;
                        const v2u x1 = *(const v2u*)pp; v2u x0 = {0u, 0u}, x2 = {0u, 0u}; if (hp) x0 = *(const v2u*)(pp - PW); if (hn) x2 = *(const v2u*)(pp + PW);
                        const f32x4 c0 = *(const f32x4*)(cw + ch), c1 = *(const f32x4*)(cw + 3072 + ch), c2 = *(const f32x4*)(cw + 2 * 3072 + ch);
                        float val[4];
                        val[0] = siluf_(bflo(x0.x) * c0[0] + bflo(x1.x) * c1[0] + bflo(x2.x) * c2[0]); val[1] = siluf_(bfhi(x0.x) * c0[1] + bfhi(x1.x) * c1[1] + bfhi(x2.x) * c2[1]);
                        val[2] = siluf_(bflo(x0.y) * c0[2] + bflo(x1.y) * c1[2] + bflo(x2.y) * c2[2]); val[3] = siluf_(bfhi(x0.y) * c0[3] + bfhi(x1.y) * c1[3] + bfhi(x2.y) * c2[3]);
                        if (pass == 0) acc += (val[0] * val[0] + val[1] * val[1]) + (val[2] * val[2] + val[3] * val[3]);
                        else *(v2u*)(dst + (size_t)m * 1024 + hd * 128 + 16 * g + 4 * q) = (v2u){cvtpk(val[0] * sc, val[1] * sc), cvtpk(val[2] * sc, val[3] * sc)}; }
                    if (pass == 0) sqk[part] = acc;
                }
            }
        }
        for (int idx = tid; idx < 48 * 16; idx += NTHR) { const int tt = idx >> 4, dh = idx & 15; const int m = m0 + tt;
            BETA[(size_t)m * 16 + dh] = sigmoidf_(bf2f(P[(size_t)m * PW + PC_BETA + dh]));
            GG[(size_t)m * 16 + dh] = -1.4426950409f * __expf(a.in[I_ALOG][i * 16 + dh]) * softplusf_(bf2f(P[(size_t)m * PW + PC_ALPHA + dh]) + a.in[I_DTB][i * 16 + dh]); }
        __syncthreads();
    }
}
__device__ __forceinline__ void ph_post(const Args& a, int i) {
    const int tid = opaque_tid(), lane = tid & 63, wave = __builtin_amdgcn_readfirstlane(tid >> 6);
    const int gw = blockIdx.x * NWAVES + wave, NGW = gridDim.x * NWAVES;
    const bf16* SC = (const bf16*)(a.ws + WS_SC); constexpr size_t S1 = (size_t)NTOK * 1024;
    const bf16* Vb = SC + 2 * S1; const float* GT = (const float*)(SC + 12 * S1); const float* Y = (const float*)(a.ws + WS_Y); const float* OG = Y + 2 * S1;
    const float* BON = (const float*)(a.ws + WS_SMALL); const bf16* P = (const bf16*)(a.ws + WS_P); bf16* O = (bf16*)(a.ws + WS_O);
    const float* lnw = a.in[I_LNW] + i * 1024; const float* lnb = a.in[I_LNB] + i * 1024; const float* gnw = a.in[I_GNW] + i * 128;
    for (int m = gw; m < NTOK; m += NGW) {
        for (int h = 0; h < 16; ++h) { const size_t o = (size_t)m * 1024 + h * 64 + lane; const float v = bf2f(Vb[o]); float acc = 0.f;
#pragma unroll
            for (int d = 0; d < 2; ++d) { const float y = Y[d * S1 + o]; const float mu = wave_sum(y) * (1.0f / 64.0f); const float dy = y - mu; const float var = wave_sum(dy * dy) * (1.0f / 64.0f);
                acc += dy * (1.0f / sqrtf(var + GN_EPS)) * lnw[h * 64 + lane] + lnb[h * 64 + lane] + BON[((size_t)m * 2 + d) * 16 + h] * v; }
            O[(size_t)m * D + h * 64 + lane] = (bf16)f2bf(acc * GT[o]); }
        for (int h = 0; h < 8; ++h) { float ov[2]; float ss = 0.f;
#pragma unroll
            for (int e = 0; e < 2; ++e) { const size_t o = (size_t)m * 1024 + h * 128 + lane + 64 * e; ov[e] = OG[o] + OG[S1 + o]; ss += ov[e] * ov[e]; }
            const float rs = 1.0f / sqrtf(wave_sum(ss) * (1.0f / 128.0f) + RMS_EPS);
#pragma unroll
            for (int e = 0; e < 2; ++e) { const int j = lane + 64 * e; const float z = bf2f(P[(size_t)m * PW + PC_Z + h * 128 + j]);
                O[(size_t)m * D + 1024 + h * 128 + j] = (bf16)f2bf(ov[e] * rs * gnw[j] * siluf_(z)); } }
    }
}

constexpr int PH_PER_LAYER = 9, N_PHASES = 2 + 4 * PH_PER_LAYER;
__host__ __device__ inline bool phase_exists(int ph) { if (ph == 0 || ph == N_PHASES - 1) return true; const int l = (ph - 1) / PH_PER_LAYER, k = (ph - 1) % PH_PER_LAYER; return (l & 1) ? !(k == 2 || k == 3 || k == 4) : true; }

#define RUN(ph) (a.ph_lo <= (ph) && (ph) < a.ph_hi)
#define SEAM(ph) do { if ((ph) + 1 < a.ph_hi) xcd_barrier(bar); } while (0)
#define SEAMX(ph) xcd_barrier(bar)
template <int L> __device__ __forceinline__ void run_layer(const Args& a, LAS unsigned char* lds, const XcdBarrier& bar) {
    constexpr int l = L, pb = 1 + PH_PER_LAYER * L, i = L >> 1;
    const int G = gridDim.x, bx = blockIdx.x;
    bf16* H = (bf16*)(a.ws + WS_H); bf16* O = (bf16*)(a.ws + WS_O); bf16* P = (bf16*)(a.ws + WS_P);
    const float* modl = (const float*)(a.ws + WS_MOD) + (size_t)l * 9 * 12288;
    if (RUN(pb + 0)) { ph_norm(a, l, 0); SEAM(pb + 0); }
#ifdef DUP_NORM
    if (RUN(pb + 0)) { ph_norm(a, l, 0); SEAMX(pb + 0); }
#endif
    if constexpr ((L & 1) == 0) {
        if (RUN(pb + 1)) { pg8::Gemm g{H, (const bf16*)(a.ws + WS_WIN) + (size_t)i * PW * 2048, NTOK, PW, 2048, 2048, 2048, 0, 0}; pg8::StaticOrder S; S.init(NTOK, PW, G, bx);
            pg8::EpiBf16 E{P, PW}; pg8::gemm_phase<pg8::EpiBf16, pg8::StaticOrder, true, true>(lds, g, S, E); SEAM(pb + 1); }
#ifdef DUP_GIN
        if (RUN(pb + 1)) { pg8::Gemm g{H, (const bf16*)(a.ws + WS_WIN) + (size_t)i * PW * 2048, NTOK, PW, 2048, 2048, 2048, 0, 0}; pg8::StaticOrder S; S.init(NTOK, PW, G, bx);
            pg8::EpiBf16 E{P, PW}; pg8::gemm_phase<pg8::EpiBf16, pg8::StaticOrder, true, true>(lds, g, S, E); SEAMX(pb + 1); }
#endif
        if (RUN(pb + 2)) { ph_prep(a, lds, i); SEAM(pb + 2); }
#ifdef DUP_PREP
        if (RUN(pb + 2)) { ph_prep(a, lds, i); SEAMX(pb + 2); }
#endif
        if (RUN(pb + 3)) { ph_scan(a, lds, i); SEAM(pb + 3); }
#ifdef DUP_SCAN
        if (RUN(pb + 3)) { ph_scan(a, lds, i); SEAMX(pb + 3); }
#endif
        if (RUN(pb + 4)) { ph_post(a, i); SEAM(pb + 4); }
#ifdef DUP_POST
        if (RUN(pb + 4)) { ph_post(a, i); SEAMX(pb + 4); }
#endif
        if (RUN(pb + 5)) { pg8::Gemm g{O, (const bf16*)(a.ws + WS_WOUT) + (size_t)i * 2048 * 2048, NTOK, 2048, 2048, 2048, 2048, 0, 0}; pg8::StaticOrder S; S.init(NTOK, 2048, G, bx);
            pg8::EpiResid E{l == 0 ? a.in[I_XP] : nullptr, a.in[I_XS], a.out, modl + 2 * 2048, nullptr};
            pg8::gemm_phase<pg8::EpiResid, pg8::StaticOrder, true, true>(lds, g, S, E); SEAM(pb + 5); }
    } else {
        if (RUN(pb + 1)) { ph_pool(a); SEAM(pb + 1); }
#ifdef DUP_POOL
        if (RUN(pb + 1)) { ph_pool(a); SEAMX(pb + 1); }
#endif
        if (RUN(pb + 5)) { pg8::Gemm g{O, (const bf16*)(a.ws + WS_WPOOL) + (size_t)i * 2048 * 512, NTOK, 2048, 512, 2048, 512, 1, 512}; pg8::StaticOrder S; S.init(NTOK, 2048, G, bx);
            pg8::EpiResid E{nullptr, nullptr, a.out, modl + 2 * 2048, a.in[I_POOLS] + i * 2048};
            pg8::gemm_phase<pg8::EpiResid, pg8::StaticOrder, true, true>(lds, g, S, E); SEAM(pb + 5); }
    }
    if (RUN(pb + 6)) { ph_norm(a, l, 1); SEAM(pb + 6); }
    if (RUN(pb + 7)) { pg8::Gemm g{H, (const bf16*)(a.ws + WS_WGU) + (size_t)l * 11264 * 2048, NTOK, 11264, 2048, 2048, 2048, 0, 0}; pg8::StaticOrder S; S.init(NTOK, 11264, G, bx);
        pg8::EpiSwiGLU E{P, DFF}; pg8::gemm_phase<pg8::EpiSwiGLU, pg8::StaticOrder, true, true>(lds, g, S, E); SEAM(pb + 7); }
#ifdef DUP_GGU
    if (RUN(pb + 7)) { pg8::Gemm g{H, (const bf16*)(a.ws + WS_WGU) + (size_t)l * 11264 * 2048, NTOK, 11264, 2048, 2048, 2048, 0, 0}; pg8::StaticOrder S; S.init(NTOK, 11264, G, bx);
        pg8::EpiSwiGLU E{P, DFF}; pg8::gemm_phase<pg8::EpiSwiGLU, pg8::StaticOrder, true, true>(lds, g, S, E); SEAMX(pb + 7); }
#endif
    if (RUN(pb + 8)) { pg8::Gemm g{P, (const bf16*)(a.ws + WS_WDN) + (size_t)l * 2048 * DFF, NTOK, 2048, DFF, DFF, DFF, 0, 0}; pg8::StaticOrder S; S.init(NTOK, 2048, G, bx);
        pg8::EpiResid E{nullptr, nullptr, a.out, modl + 5 * 2048, nullptr};
        pg8::gemm_phase<pg8::EpiResid, pg8::StaticOrder, true, true>(lds, g, S, E); SEAM(pb + 8); }
}

__global__ void __launch_bounds__(NTHR, 2) fwd(Args a) {
    extern __shared__ __attribute__((aligned(16))) unsigned char lds_raw[];
    LAS unsigned char* lds = (LAS unsigned char*)lds_raw;
    const int tid = threadIdx.x;
    volatile LAS unsigned* MISC = (volatile LAS unsigned*)(lds + LDS_MISC);
    for (int u = tid; u < (LDS_BYTES - LDS_STAGE) / 4; u += NTHR) ((LAS unsigned*)(lds + LDS_STAGE))[u] = 0u;
    __syncthreads();
    XcdBarrier bar; bar.bar = (unsigned*)(a.ws + WS_CTL) + CW_BAR; bar.x = 0; bar.st = nullptr;
    const bool multi = a.ph_hi - a.ph_lo > 1;
    if (multi) bar = xcd_barrier_post((unsigned*)(a.ws + WS_CTL) + CW_BAR, MISC + 8);
    if (RUN(0)) { ph_pre(a, lds); SEAM(0); }
#ifdef DUP_PRE
    if (RUN(0)) { ph_pre(a, lds); SEAMX(0); }
#endif
    run_layer<0>(a, lds, bar);
    run_layer<1>(a, lds, bar);
    run_layer<2>(a, lds, bar);
    run_layer<3>(a, lds, bar);
    if (RUN(N_PHASES - 1)) ph_final(a);
}
#undef RUN
#undef SEAM
#undef SEAMX

#ifndef MK_ONE_LAUNCH
#define MK_ONE_LAUNCH 1
#endif
extern "C" void kernel_launch(void* const* d_in, const int* in_sizes, int n_in, void* d_out, int out_size, void* d_ws, size_t ws_size, hipStream_t stream) {
    static int grid = 0;
    if (grid == 0) {
        if (n_in != N_IN || ws_size < WS_END) { fprintf(stderr, "kernel_launch: expected %d inputs and >= %zu bytes of workspace; got %d, %zu\n", (int)N_IN, (size_t)WS_END, n_in, ws_size); grid = -1; return; }
        int dev = 0, cus = 0, per_cu = 0;
        if (hipGetDevice(&dev) != hipSuccess || hipDeviceGetAttribute(&cus, hipDeviceAttributeMultiprocessorCount, dev) != hipSuccess) { grid = -1; return; }
        if (hipFuncSetAttribute((const void*)fwd, hipFuncAttributeMaxDynamicSharedMemorySize, LDS_BYTES) != hipSuccess) { fprintf(stderr, "kernel_launch: hipFuncSetAttribute failed\n"); grid = -1; return; }
        if (hipOccupancyMaxActiveBlocksPerMultiprocessor(&per_cu, (const void*)fwd, NTHR, LDS_BYTES) != hipSuccess || per_cu < 1) fprintf(stderr, "kernel_launch: occupancy query reports %d\n", per_cu);
        (void)hipGetLastError();
        grid = cus;
    }
    if (grid < 0) return;
    if (hipMemsetAsync((char*)d_ws + WS_CTL, 0, CTL_ZERO_BYTES, stream) != hipSuccess) return;
    Args a{};
    for (int i = 0; i < N_IN; ++i) a.in[i] = (const float*)d_in[i];
    a.out = (float*)d_out; a.ws = (unsigned char*)d_ws;
#if MK_ONE_LAUNCH
    a.ph_lo = 0; a.ph_hi = N_PHASES;
    hipLaunchKernelGGL(fwd, dim3(grid), dim3(NTHR), LDS_BYTES, stream, a);
#else
    for (int ph = 0; ph < N_PHASES; ++ph) { if (!phase_exists(ph)) continue; a.ph_lo = ph; a.ph_hi = ph + 1; hipLaunchKernelGGL(fwd, dim3(grid), dim3(NTHR), LDS_BYTES, stream, a); }
#endif
}
```

```cpp
#include <hip/hip_runtime.h>
#include <cstdio>
#include <cstdint>

namespace pg8 {
#define PG8_LAS __attribute__((address_space(3)))
typedef unsigned short bf16_t;
typedef short bf16x8 __attribute__((ext_vector_type(8)));
typedef float f32x4 __attribute__((ext_vector_type(4)));
typedef unsigned u32x4 __attribute__((ext_vector_type(4)));
constexpr int BM = 256, BK = 64, HALF = 128, HTB = HALF * BK * 2  , STAGE_BYTES = 8 * HTB, NXCD = 8, WGM = 8;

__host__ __device__ __forceinline__ int lds_byte(int r, int c) { const int st = (r >> 4) * 2 + (c >> 5), rr = r & 15, cc = c & 31, ob = rr * 64 + cc * 2; return st * 1024 + (ob ^ (((ob >> 9) & 1) << 5)); }
__host__ __device__ __forceinline__ void stage_rc(int b, int& R, int& C) { const int st = b / 1024, sb = b % 1024, swz = sb ^ (((sb >> 9) & 1) << 5); R = (st >> 1) * 16 + swz / 64; C = (st & 1) * 32 + (swz % 64) / 2; }
__host__ __device__ __forceinline__ int perm32(int rho) { const int n = rho >> 4, i = rho & 15; return 8 * (i >> 2) + 4 * n + (i & 3); }

struct Unit { int pm, pn; };
struct Gemm { const bf16_t* A; const bf16_t* Bt; int M, N, K, lda, ldb, gsh, gk; };

struct StaticOrder {
    int nM, nN, nwg, G, c;
    __host__ __device__ void init(int M, int N, int G_, int c_) { nM = M / BM; nN = N / BM; nwg = nM * nN; G = G_; c = c_; }
    __host__ __device__ bool next(int i, Unit& u) const {
        const long L = (long)i * G + c; if (L >= nwg) return false;
        int wgid = (int)L; { const int q = nwg / NXCD, r = nwg % NXCD, xcd = wgid % NXCD, off = wgid / NXCD; wgid = (xcd < r ? xcd * (q + 1) : r * (q + 1) + (xcd - r) * q) + off; }
        const int nig = WGM * nN, gid = wgid / nig, fm = gid * WGM, gsz = (nM - fm) < WGM ? (nM - fm) : WGM;
        u.pm = fm + ((wgid % nig) % gsz); u.pn = (wgid % nig) / gsz; return true;
    }
    __device__ __forceinline__ void a_ready(const Unit&) const {}
    __device__ __forceinline__ void done(const Unit&) const {}
};

__device__ __forceinline__ unsigned cvt_pk_bf16(float lo, float hi) { unsigned r; asm volatile("v_cvt_pk_bf16_f32 %0, %1, %2" : "=v"(r) : "v"(lo), "v"(hi)); return r; }

__device__ __forceinline__ int cond_of_panel(int pm) { return pm < 16 ? 0 : 1 + ((pm - 16) >> 2); }

struct EpiBf16 {
    static constexpr bool PERM = true, AFTER_DRAIN = false;
    bf16_t* O; int ldc;
    __device__ __forceinline__ void operator()(const f32x4 (&acc)[2][2][4][2], const Unit& u, int wr, int wc, int fr, int fq) const {
        const int row0 = u.pm * BM + wr * 64 + fr; const int col0 = u.pn * BM + wc * 32 + 8 * fq;
#pragma unroll
        for (int ai = 0; ai < 2; ++ai)
#pragma unroll
            for (int m = 0; m < 4; ++m) { bf16_t* rowp = O + (size_t)(row0 + ai * HALF + m * 16) * ldc + col0;
#pragma unroll
                for (int bj = 0; bj < 2; ++bj) { const f32x4 v0 = acc[ai][bj][m][0], v1 = acc[ai][bj][m][1];
                    u32x4 w; w.x = cvt_pk_bf16(v0[0], v0[1]); w.y = cvt_pk_bf16(v0[2], v0[3]); w.z = cvt_pk_bf16(v1[0], v1[1]); w.w = cvt_pk_bf16(v1[2], v1[3]);
                    *(u32x4*)(rowp + bj * HALF) = w; } }
    }
};
struct EpiSwiGLU {
    static constexpr bool PERM = true, AFTER_DRAIN = false;
    bf16_t* O; int ldc;
    __device__ __forceinline__ void operator()(const f32x4 (&acc)[2][2][4][2], const Unit& u, int wr, int wc, int fr, int fq) const {
        const int row0 = u.pm * BM + wr * 64 + fr; const int col0 = u.pn * HALF + wc * 32 + 8 * fq;
#pragma unroll
        for (int ai = 0; ai < 2; ++ai)
#pragma unroll
            for (int m = 0; m < 4; ++m) { bf16_t* rowp = O + (size_t)(row0 + ai * HALF + m * 16) * ldc + col0;
                float o[8];
#pragma unroll
                for (int n = 0; n < 2; ++n)
#pragma unroll
                    for (int e = 0; e < 4; ++e) { const float gte = acc[ai][0][m][n][e], up = acc[ai][1][m][n][e]; o[n * 4 + e] = gte * __builtin_amdgcn_rcpf(1.0f + __expf(-gte)) * up; }
                u32x4 w; w.x = cvt_pk_bf16(o[0], o[1]); w.y = cvt_pk_bf16(o[2], o[3]); w.z = cvt_pk_bf16(o[4], o[5]); w.w = cvt_pk_bf16(o[6], o[7]);
                *(u32x4*)rowp = w; }
    }
};
struct EpiResid {
    static constexpr bool PERM = false, AFTER_DRAIN = false;
    const float* xin_p; const float* xin_s; float* xout; const float* gate  ; const float* cscale;
    __device__ __forceinline__ void operator()(const f32x4 (&acc)[2][2][4][2], const Unit& u, int wr, int wc, int fr, int fq) const {
        const int row0 = u.pm * BM + wr * 64 + fr, col0 = u.pn * BM + wc * 32 + 4 * fq;
        const float* gp = gate + (size_t)cond_of_panel(u.pm) * 12288 + col0;
        f32x4 gv[2][2];
#pragma unroll
        for (int bj = 0; bj < 2; ++bj)
#pragma unroll
            for (int n = 0; n < 2; ++n) { gv[bj][n] = *(const f32x4*)(gp + bj * HALF + n * 16); if (cscale) gv[bj][n] = gv[bj][n] * *(const f32x4*)(cscale + col0 + bj * HALF + n * 16); }
#pragma unroll
        for (int ai = 0; ai < 2; ++ai)
#pragma unroll
            for (int m = 0; m < 4; ++m) { const int row = row0 + ai * HALF + m * 16;
                const float* xi = xin_p ? (row < 4096 ? xin_p + (size_t)row * 2048 : xin_s + (size_t)(row - 4096) * 2048) : xout + (size_t)row * 2048;
                float* xo = xout + (size_t)row * 2048;
#pragma unroll
                for (int bj = 0; bj < 2; ++bj)
#pragma unroll
                    for (int n = 0; n < 2; ++n) { const f32x4 xv = *(const f32x4*)(xi + col0 + bj * HALF + n * 16); *(f32x4*)(xo + col0 + bj * HALF + n * 16) = xv + gv[bj][n] * acc[ai][bj][m][n]; } }
    }
};

template <class Epi, class Sched, bool ALIGN_EPI = false, bool SP2 = false>
__device__ __forceinline__ void gemm_phase(PG8_LAS unsigned char* lds, const Gemm g, const Sched& S, const Epi& E) {
    const int tid = threadIdx.x, wid = __builtin_amdgcn_readfirstlane(tid >> 6), lane = tid & 63, wr = wid >> 2, wc = wid & 3, fr = lane & 15, fq = lane >> 4;
    const int K = g.K, nt = K / BK;
    unsigned voffA[2], voffB[2];
#pragma unroll
    for (int i = 0; i < 2; ++i) { int R, C; stage_rc(tid * 16 + i * 8192, R, C); const int Rb = Epi::PERM ? ((R & ~31) + perm32(R & 31)) : R;
        voffA[i] = (unsigned)(R * g.lda + C) * 2u; voffB[i] = (unsigned)(Rb * g.ldb + C) * 2u; }
    const size_t kstep = (size_t)(BK * 2);
    const size_t hstepA = (size_t)HALF * g.lda * 2, hstepB = (size_t)HALF * g.ldb * 2;
    const size_t tstepA = 2 * hstepA, tstepB = 2 * hstepB;
    const unsigned ldsw = (unsigned)wid * 1024u;
    const int aoff = lds_byte(wr * 64 + fr, fq * 8), boff = lds_byte(wc * 32 + fr, fq * 8);
#define PG8_SA(b, h) (((b) * 2 + (h)) * HTB)
#define PG8_SB(b, h) ((4 + (b) * 2 + (h)) * HTB)
#define PG8_STAGE(bufoff, gbase, voff) do { _Pragma("unroll") for (int _i = 0; _i < 2; ++_i) \
        __builtin_amdgcn_global_load_lds((const unsigned*)((const char*)(gbase) + (voff)[_i]), (PG8_LAS unsigned*)(lds + (bufoff) + ldsw + _i * 8192), 16, 0, 0); } while (0)
#define PG8_LDA(dst, b, h) do { _Pragma("unroll") for (int m = 0; m < 4; ++m) _Pragma("unroll") for (int k = 0; k < 2; ++k) dst[m][k] = *(const PG8_LAS bf16x8*)(lds + PG8_SA(b, h) + aoff + m * 2048 + k * 1024); } while (0)
#define PG8_LDB(dst, b, h) do { _Pragma("unroll") for (int n = 0; n < 2; ++n) _Pragma("unroll") for (int k = 0; k < 2; ++k) dst[n][k] = *(const PG8_LAS bf16x8*)(lds + PG8_SB(b, h) + boff + n * 2048 + k * 1024); } while (0)
#define PG8_MMA(ai, bj, At, Bt) do { __builtin_amdgcn_s_setprio(1); _Pragma("unroll") for (int m = 0; m < 4; ++m) _Pragma("unroll") for (int n = 0; n < 2; ++n) _Pragma("unroll") for (int k = 0; k < 2; ++k) \
        acc[ai][bj][m][n] = __builtin_amdgcn_mfma_f32_16x16x32_bf16(Bt[n][k], At[m][k], acc[ai][bj][m][n], 0, 0, 0); __builtin_amdgcn_s_setprio(0); } while (0)
#define PG8_WAIT_V(n) asm volatile("s_waitcnt vmcnt(" #n ")" ::: "memory")
#define PG8_WAIT_L(n) asm volatile("s_waitcnt lgkmcnt(" #n ")" ::: "memory")
#define PG8_BAR __builtin_amdgcn_s_barrier()
#define PG8_SCHED __builtin_amdgcn_sched_barrier(0)
    Unit cur, nxt; int ui = 0;
    if (!S.next(0, cur)) return;
    f32x4 acc[2][2][4][2];
#pragma unroll
    for (int a = 0; a < 2; ++a)
#pragma unroll
        for (int b = 0; b < 2; ++b)
#pragma unroll
            for (int m = 0; m < 4; ++m)
#pragma unroll
                for (int n = 0; n < 2; ++n) acc[a][b][m][n] = (f32x4){0.f, 0.f, 0.f, 0.f};
    bf16x8 At[4][2], B0[2][2], B1[2][2];
    const char* cA = (const char*)g.A + (size_t)cur.pm * tstepA + (size_t)((cur.pn >> g.gsh) * g.gk) * 2; const char* cB = (const char*)g.Bt + (size_t)cur.pn * tstepB;
    S.a_ready(cur);
    if constexpr (SP2) {
        PG8_STAGE(PG8_SB(0, 0), cB, voffB); PG8_STAGE(PG8_SB(0, 1), cB + hstepB, voffB); PG8_STAGE(PG8_SA(0, 0), cA, voffA); PG8_STAGE(PG8_SA(0, 1), cA + hstepA, voffA);
        if (wr == 1) PG8_BAR;
        PG8_WAIT_V(2); PG8_BAR;
        PG8_STAGE(PG8_SB(1, 0), cB + kstep, voffB); PG8_STAGE(PG8_SA(1, 0), cA + kstep, voffA); PG8_STAGE(PG8_SB(1, 1), cB + hstepB + kstep, voffB);
        PG8_WAIT_V(6); PG8_BAR;
    } else {
        PG8_STAGE(PG8_SB(0, 0), cB, voffB); PG8_STAGE(PG8_SA(0, 0), cA, voffA); PG8_STAGE(PG8_SB(0, 1), cB + hstepB, voffB); PG8_STAGE(PG8_SA(0, 1), cA + hstepA, voffA);
        if (wr == 1) PG8_BAR;
        PG8_WAIT_V(4); PG8_BAR;
        PG8_STAGE(PG8_SB(1, 0), cB + kstep, voffB); PG8_STAGE(PG8_SA(1, 0), cA + kstep, voffA); PG8_STAGE(PG8_SB(1, 1), cB + hstepB + kstep, voffB);
        PG8_WAIT_V(6); PG8_BAR;
    }
    for (;;) {
        const bool has_next = S.next(ui + 1, nxt);
        const char* nA = has_next ? (const char*)g.A + (size_t)nxt.pm * tstepA + (size_t)((nxt.pn >> g.gsh) * g.gk) * 2 : cA; const char* nB = has_next ? (const char*)g.Bt + (size_t)nxt.pn * tstepB : cB;
        for (int t = 0; t < nt; t += 2) {
            const bool last = (t == nt - 2);
            const char* a1 = cA + (size_t)(t + 1) * kstep;
            const char* a2 = last ? nA : cA + (size_t)(t + 2) * kstep; const char* b2 = last ? nB : cB + (size_t)(t + 2) * kstep;
            const char* a3 = a2 + kstep; const char* b3 = b2 + kstep;
            if (last && has_next) S.a_ready(nxt);
            if constexpr (SP2) {
            PG8_LDB(B0, 0, 0); PG8_LDB(B1, 0, 1); PG8_SCHED; PG8_LDA(At, 0, 0); PG8_STAGE(PG8_SA(1, 1), a1 + hstepA, voffA);
            PG8_WAIT_V(8); PG8_WAIT_L(0); PG8_BAR; PG8_MMA(0, 0, At, B0); PG8_MMA(0, 1, At, B1); PG8_BAR; PG8_SCHED;
            PG8_LDA(At, 0, 1); PG8_STAGE(PG8_SB(0, 0), b2, voffB); PG8_STAGE(PG8_SB(0, 1), b2 + hstepB, voffB); PG8_STAGE(PG8_SA(0, 0), a2, voffA);
            PG8_WAIT_V(8); PG8_WAIT_L(0); PG8_BAR; PG8_MMA(1, 0, At, B0); PG8_MMA(1, 1, At, B1); PG8_BAR; PG8_SCHED;
            PG8_LDB(B0, 1, 0); PG8_LDB(B1, 1, 1); PG8_SCHED; PG8_LDA(At, 1, 0); PG8_STAGE(PG8_SA(0, 1), a2 + hstepA, voffA);
            PG8_WAIT_V(8); PG8_WAIT_L(0); PG8_BAR; PG8_MMA(0, 0, At, B0); PG8_MMA(0, 1, At, B1); PG8_BAR; PG8_SCHED;
            PG8_LDA(At, 1, 1); PG8_STAGE(PG8_SB(1, 0), b3, voffB); PG8_STAGE(PG8_SB(1, 1), b3 + hstepB, voffB); PG8_STAGE(PG8_SA(1, 0), a3, voffA);
            PG8_WAIT_V(8); PG8_WAIT_L(0); PG8_BAR; PG8_MMA(1, 0, At, B0); PG8_MMA(1, 1, At, B1); PG8_BAR; PG8_SCHED;
            } else {
            PG8_LDB(B0, 0, 0); PG8_SCHED; PG8_LDA(At, 0, 0); PG8_STAGE(PG8_SA(1, 1), a1 + hstepA, voffA);
            PG8_WAIT_L(8); PG8_BAR; PG8_WAIT_L(0); PG8_MMA(0, 0, At, B0); PG8_BAR; PG8_SCHED;
            PG8_LDB(B1, 0, 1); PG8_STAGE(PG8_SB(0, 0), b2, voffB);
            PG8_BAR; PG8_WAIT_L(0); PG8_MMA(0, 1, At, B1); PG8_BAR;
            PG8_LDA(At, 0, 1); PG8_STAGE(PG8_SA(0, 0), a2, voffA);
            PG8_BAR; PG8_WAIT_L(0); PG8_MMA(1, 0, At, B0); PG8_BAR; PG8_SCHED;
            PG8_STAGE(PG8_SB(0, 1), b2 + hstepB, voffB);
            PG8_WAIT_V(6); PG8_BAR; PG8_MMA(1, 1, At, B1); PG8_BAR;
            PG8_LDB(B0, 1, 0); PG8_SCHED; PG8_LDA(At, 1, 0); PG8_STAGE(PG8_SA(0, 1), a2 + hstepA, voffA);
            PG8_WAIT_L(8); PG8_BAR; PG8_WAIT_L(0); PG8_MMA(0, 0, At, B0); PG8_BAR; PG8_SCHED;
            PG8_LDB(B1, 1, 1); PG8_STAGE(PG8_SB(1, 0), b3, voffB);
            PG8_BAR; PG8_WAIT_L(0); PG8_MMA(0, 1, At, B1); PG8_BAR;
            PG8_LDA(At, 1, 1); PG8_STAGE(PG8_SA(1, 0), a3, voffA);
            PG8_BAR; PG8_WAIT_L(0); PG8_MMA(1, 0, At, B0); PG8_BAR; PG8_SCHED;
            PG8_STAGE(PG8_SB(1, 1), b3 + hstepB, voffB);
            PG8_WAIT_V(6); PG8_BAR; PG8_MMA(1, 1, At, B1); PG8_BAR;
            }
        }
        if constexpr (ALIGN_EPI) { if (wr == 0) PG8_BAR; }
        if constexpr (!Epi::AFTER_DRAIN) { E(acc, cur, wr, wc, fr, fq); S.done(cur); }
        if (!has_next) break;
#pragma unroll
        for (int a = 0; a < 2; ++a)
#pragma unroll
            for (int b = 0; b < 2; ++b)
#pragma unroll
                for (int m = 0; m < 4; ++m)
#pragma unroll
                    for (int n = 0; n < 2; ++n) acc[a][b][m][n] = (f32x4){0.f, 0.f, 0.f, 0.f};
        cur = nxt; cA = nA; cB = nB; ++ui;
        if constexpr (ALIGN_EPI) { if (wr == 1) PG8_BAR; }
    }
    PG8_WAIT_V(0);
    if constexpr (!ALIGN_EPI) { if (wr == 0) PG8_BAR; }
    PG8_BAR;
    if constexpr (Epi::AFTER_DRAIN) { E.fused(acc, cur, wr, wc, fr, fq, lds, wid, lane); S.done(cur); }
#undef PG8_SA
#undef PG8_SB
#undef PG8_STAGE
#undef PG8_LDA
#undef PG8_LDB
#undef PG8_MMA
#undef PG8_WAIT_V
#undef PG8_WAIT_L
#undef PG8_BAR
#undef PG8_SCHED
}
}

constexpr int D = 2048, NTOK = 12288, NPROMPT = 4096, DFF = 5632, PW = 7680  , CPA = 3488;
constexpr int NWAVES = 8, NTHR = 512;
constexpr int PC_GDN = 3072, PC_Z = 6144, PC_LORA = 7168, PC_BETA = 7584, PC_ALPHA = 7600;
constexpr float RMS_EPS = 1e-6f, GN_EPS = 64e-5f;

constexpr size_t MiB = 1u << 20;
constexpr size_t WS_CTL = 0, CTL_ZERO_BYTES = 1 * MiB;
constexpr size_t WS_MOD = 1 * MiB;
constexpr size_t WS_WIN = 3 * MiB;
constexpr size_t WS_WOUT = 63 * MiB;
constexpr size_t WS_WGU = 79 * MiB;
constexpr size_t WS_WDN = 255 * MiB;
constexpr size_t WS_WPOOL = 343 * MiB;
constexpr size_t WS_H = 347 * MiB;
constexpr size_t WS_O = 395 * MiB;
constexpr size_t WS_P = 443 * MiB;
constexpr size_t WS_SC = 623 * MiB;
constexpr size_t SC_ONE = 48 * MiB;
constexpr size_t WS_Y = 1247 * MiB;
constexpr size_t WS_SMALL = 1439 * MiB;
constexpr size_t WS_LORA = 1443 * MiB;
constexpr size_t WS_END = 1445 * MiB;
constexpr int CW_BAR = 4096;

constexpr int LDS_STAGE = 131072, LDS_MISC = LDS_STAGE + 320, LDS_BYTES = 147456;

#define GAS __attribute__((address_space(1)))
#define LAS __attribute__((address_space(3)))
typedef unsigned short bf16;
typedef unsigned v4u __attribute__((ext_vector_type(4)));
typedef unsigned v2u __attribute__((ext_vector_type(2)));
typedef float f32x4 __attribute__((ext_vector_type(4)));
typedef float f32x2 __attribute__((ext_vector_type(2)));
#define LDS_WAIT() asm volatile("s_waitcnt lgkmcnt(0)" ::: "memory")

__device__ __forceinline__ unsigned f2bf(float f) { unsigned u = __builtin_bit_cast(unsigned, f); return (u + 0x7fffu + ((u >> 16) & 1u)) >> 16; }
__device__ __forceinline__ unsigned pk2(float lo, float hi) { return f2bf(lo) | (f2bf(hi) << 16); }
__device__ __forceinline__ float bf2f(bf16 b) { return __builtin_bit_cast(float, (unsigned)b << 16); }
__device__ __forceinline__ float bflo(unsigned w) { return __builtin_bit_cast(float, w << 16); }
__device__ __forceinline__ float bfhi(unsigned w) { return __builtin_bit_cast(float, w & 0xffff0000u); }
__device__ __forceinline__ float sigmoidf_(float x) { return 1.0f / (1.0f + __expf(-x)); }
__device__ __forceinline__ float siluf_(float x) { return x / (1.0f + __expf(-x)); }
__device__ __forceinline__ float softplusf_(float x) { return x > 20.f ? x : log1pf(__expf(x)); }
__device__ __forceinline__ float wave_sum(float v) {
#pragma unroll
    for (int o = 1; o < 64; o <<= 1) v += __shfl_xor(v, o);
    return v;
}
__device__ __forceinline__ int opaque_tid() { int t = threadIdx.x; asm volatile("" : "+v"(t)); return t; }
__device__ __forceinline__ float rdl(float v, int k) { return __builtin_bit_cast(float, __builtin_amdgcn_readlane(__builtin_bit_cast(int, v), k)); }

#define XB_TMO      128
#define XB_XCNT(j)  (256  + 64 * (j))
#define XB_XSUB(j)  (1280 + 64 * (j))
#define XB_XGEN(j)  (2304 + 64 * (j))
#define XB_TOP      3328
#define XB_TOPGEN   3392
#define XCD_BAR_WORDS 3456
#define XB_SPIN_CAP (1u << 18)
__device__ __forceinline__ unsigned xb_ld(unsigned* p)              { return __hip_atomic_load(p, __ATOMIC_RELAXED, __HIP_MEMORY_SCOPE_AGENT); }
__device__ __forceinline__ unsigned xb_add(unsigned* p, unsigned v) { return __hip_atomic_fetch_add(p, v, __ATOMIC_RELAXED, __HIP_MEMORY_SCOPE_AGENT); }
__device__ __forceinline__ unsigned xb_xcc_id() { return (unsigned)__builtin_amdgcn_s_getreg((3 << 11) | 20) & 0xFu; }
#define XB_SPIN(cond, bar) do { unsigned _sp = 0; while (cond) { __builtin_amdgcn_s_sleep(1); \
    if ((++_sp & 255u) == 0u) { if (xb_ld(&(bar)[XB_TMO])) break; if (_sp > XB_SPIN_CAP) { atomicAdd(&(bar)[XB_TMO], 1u); break; } } } } while (0)
struct XcdBarrier { unsigned* bar; unsigned x; volatile LAS unsigned* st; };
__device__ __forceinline__ XcdBarrier xcd_barrier_post(unsigned* bar, volatile LAS unsigned* st) {
    XcdBarrier b; b.bar = bar; b.x = xb_xcc_id(); b.st = st;
    if (threadIdx.x == 0) (void)xb_add(&bar[XB_XCNT(b.x)], 1u);
    return b;
}
__device__ __forceinline__ void xcd_barrier_complete(unsigned* bar, unsigned x, unsigned& nloc, unsigned& nx) {
    const unsigned G = gridDim.x * gridDim.y * gridDim.z;
    unsigned sum, cnt, mine, sp = 0u;
    for (;;) {
        sum = 0u; cnt = 0u; mine = 0u;
#pragma unroll
        for (unsigned j = 0; j < 16; ++j) { const unsigned c = xb_ld(&bar[XB_XCNT(j)]); sum += c; cnt += (c > 0u) ? 1u : 0u; mine = (j == x) ? c : mine; }
        if (sum == G) break;
        __builtin_amdgcn_s_sleep(1);
        if ((++sp & 255u) == 0u) { if (xb_ld(&bar[XB_TMO])) break; if (sp > XB_SPIN_CAP) { atomicAdd(&bar[XB_TMO], 1u); break; } }
    }
    nloc = mine > 0u ? mine : 1u; nx = cnt > 0u ? cnt : 1u;
}
__device__ __forceinline__ void xcd_barrier(const XcdBarrier& b) {
    asm volatile("s_waitcnt vmcnt(0)" ::: "memory");
    __syncthreads();
    if (threadIdx.x == 0) {
        unsigned* bar = b.bar;
        __builtin_amdgcn_s_waitcnt(0);
        unsigned nloc = b.st[0], nx = b.st[1];
        if (nloc == 0u) { xcd_barrier_complete(bar, b.x, nloc, nx); b.st[0] = nloc; b.st[1] = nx; }
        const unsigned old = xb_add(&bar[XB_XSUB(b.x)], 1u);
        const unsigned gen = old / nloc;
        if (old + 1u == (gen + 1u) * nloc) {
            __builtin_amdgcn_fence(__ATOMIC_RELEASE, "agent");
            asm volatile("s_waitcnt vmcnt(0)" ::: "memory");
            const unsigned og = xb_add(&bar[XB_TOP], 1u);
            const unsigned tg = og / nx;
            if (og + 1u == (tg + 1u) * nx) xb_add(&bar[XB_TOPGEN], 1u);
            else XB_SPIN(xb_ld(&bar[XB_TOPGEN]) == tg, bar);
            __builtin_amdgcn_fence(__ATOMIC_ACQUIRE, "agent");
            xb_add(&bar[XB_XGEN(b.x)], 1u);
            asm volatile("s_waitcnt vmcnt(0)" ::: "memory");
        } else {
            XB_SPIN(xb_ld(&bar[XB_XGEN(b.x)]) == gen, bar);
            __builtin_amdgcn_fence(__ATOMIC_ACQUIRE, "agent");
            asm volatile("s_waitcnt vmcnt(0)" ::: "memory");
        }
    }
    __syncthreads();
}

enum { I_XP = 0, I_XS, I_SRW, I_SDL, I_C, I_CCTX, I_MODW, I_MODB, I_NMIX, I_NFFN, I_NFIN, I_WIN, I_WOUT, I_MU, I_W0, I_W2, I_A0, I_A2, I_G2, I_KK, I_KA, I_RK, I_LNW, I_LNB,
       I_CONVW, I_ALOG, I_DTB, I_GNW, I_POOLW, I_POOLS, I_WG, I_WU, I_WD, N_IN };
struct Args { const float* in[N_IN]; float* out; unsigned char* ws; int ph_lo, ph_hi; };
constexpr size_t OUT_SRW = (size_t)NTOK * D, OUT_SDL = OUT_SRW + (size_t)16 * 2 * 2 * 16 * 64 * 64;

__device__ __forceinline__ void conv_item(const float* W, int K, int N, bf16* WT, int drow0, LAS float* scr, int kb, int nb, int lane) {
    const int k0 = 64 * kb, n0 = 32 * nb;
#pragma unroll 8
    for (int i = 0; i < 32; ++i) { const int kk = 2 * i + (lane >> 5); scr[kk * 33 + (lane & 31)] = W[(size_t)(k0 + kk) * N + n0 + (lane & 31)]; }
    LDS_WAIT(); asm volatile("" ::: "memory");
    const int c = lane & 7;
#pragma unroll
    for (int j = 0; j < 4; ++j) { const int n = (lane >> 3) + 8 * j; const LAS float* s = scr + (8 * c) * 33 + n;
        v4u o; o.x = pk2(s[0 * 33], s[1 * 33]); o.y = pk2(s[2 * 33], s[3 * 33]); o.z = pk2(s[4 * 33], s[5 * 33]); o.w = pk2(s[6 * 33], s[7 * 33]);
        *(v4u*)(WT + (size_t)(drow0 + n) * K + k0 + 8 * c) = o; }
    LDS_WAIT(); asm volatile("" ::: "memory");
}
__device__ __forceinline__ int win_row(int n) { return n < 3072 ? n : (n < CPA ? PC_LORA + (n - 3072) : (n < CPA + 4096 ? PC_GDN + (n - CPA) : n)); }

__device__ __forceinline__ void ph_pre(const Args& a, LAS unsigned char* lds) {
    const int tid = opaque_tid(), lane = tid & 63, wave = __builtin_amdgcn_readfirstlane(tid >> 6);
    const int G = gridDim.x;
    LAS float* ca = (LAS float*)lds;
    LAS float* red = (LAS float*)(lds + 2048 * 9 * 4);
    for (int i = tid; i < 9 * 2048; i += NTHR) { const int c = i / 2048, k = i - c * 2048; const float v = c == 0 ? a.in[I_CCTX][k] : a.in[I_C][(c - 1) * 2048 + k]; ca[k * 9 + c] = siluf_(v); }
    __syncthreads();
    float* MOD = (float*)(a.ws + WS_MOD);
    for (int task = blockIdx.x; task < 4 * 96; task += G) {
        const int l = task / 96, cb = task - l * 96;
        const float* wp = a.in[I_MODW] + ((size_t)l * 2048 + wave * 256) * 12288 + cb * 128 + lane * 2;
        float acc[9][2];
#pragma unroll
        for (int c = 0; c < 9; ++c) { acc[c][0] = 0.f; acc[c][1] = 0.f; }
        for (int k8 = 0; k8 < 256; k8 += 8) {
            f32x2 wv[8];
#pragma unroll
            for (int j = 0; j < 8; ++j) wv[j] = *(const f32x2*)(wp + (size_t)(k8 + j) * 12288);
#pragma unroll
            for (int j = 0; j < 8; ++j) { const LAS float* cp = ca + (wave * 256 + k8 + j) * 9;
#pragma unroll
                for (int c = 0; c < 9; ++c) { const float s = cp[c]; acc[c][0] += s * wv[j].x; acc[c][1] += s * wv[j].y; } }
        }
#pragma unroll
        for (int c = 0; c < 9; ++c) { red[(wave * 18 + c * 2) * 64 + lane] = acc[c][0]; red[(wave * 18 + c * 2 + 1) * 64 + lane] = acc[c][1]; }
        __syncthreads();
        for (int o = tid; o < 9 * 128; o += NTHR) { const int c = o >> 7, col = o & 127, ln = col >> 1, j = col & 1; float s = a.in[I_MODB][l * 12288 + cb * 128 + col];
#pragma unroll
            for (int w = 0; w < 8; ++w) s += red[(w * 18 + c * 2 + j) * 64 + ln];
            MOD[((size_t)l * 9 + c) * 12288 + cb * 128 + col] = s; }
        __syncthreads();
    }
    __syncthreads();
    LAS float* scr = (LAS float*)(lds + wave * 16384);
    const int gw = blockIdx.x * NWAVES + wave, NGW = G * NWAVES;
    bf16* WIN = (bf16*)(a.ws + WS_WIN); bf16* WOUT = (bf16*)(a.ws + WS_WOUT); bf16* WGU = (bf16*)(a.ws + WS_WGU); bf16* WDN = (bf16*)(a.ws + WS_WDN); bf16* WPOOL = (bf16*)(a.ws + WS_WPOOL);
    constexpr int IT_WIN = 32 * 238, IT_WOUT = 32 * 64, IT_GU = 32 * 176, IT_DN = 88 * 64, IT_POOL = 8 * 16;
    constexpr int NITEMS = 2 * IT_WIN + 2 * IT_WOUT + 8 * IT_GU + 4 * IT_DN + 8 * IT_POOL;
    for (int it = gw; it < NITEMS; it += NGW) {
        int r = it;
        if (r < 2 * IT_WIN) { const int i = r / IT_WIN; r -= i * IT_WIN; const int kb = r / 238, nb = r - kb * 238;
            conv_item(a.in[I_WIN] + (size_t)i * 2048 * 7616, 2048, 7616, WIN + (size_t)i * PW * 2048, win_row(32 * nb), scr, kb, nb, lane); continue; } r -= 2 * IT_WIN;
        if (r < 2 * IT_WOUT) { const int i = r / IT_WOUT; r -= i * IT_WOUT; const int kb = r / 64, nb = r - kb * 64;
            conv_item(a.in[I_WOUT] + (size_t)i * 2048 * 2048, 2048, 2048, WOUT + (size_t)i * 2048 * 2048, 32 * nb, scr, kb, nb, lane); continue; } r -= 2 * IT_WOUT;
        if (r < 8 * IT_GU) { const int li = r / IT_GU; r -= li * IT_GU; const int l = li >> 1, up = li & 1; const int kb = r / 176, nb = r - kb * 176; const int n0 = 32 * nb;
            conv_item(a.in[up ? I_WU : I_WG] + (size_t)l * 2048 * DFF, 2048, DFF, WGU + (size_t)l * 11264 * 2048, (n0 >> 7) * 256 + up * 128 + (n0 & 127), scr, kb, nb, lane); continue; } r -= 8 * IT_GU;
        if (r < 4 * IT_DN) { const int l = r / IT_DN; r -= l * IT_DN; const int kb = r / 64, nb = r - kb * 64;
            conv_item(a.in[I_WD] + (size_t)l * DFF * 2048, DFF, 2048, WDN + (size_t)l * 2048 * DFF, 32 * nb, scr, kb, nb, lane); continue; } r -= 4 * IT_DN;
        { const int ig = r / IT_POOL; r -= ig * IT_POOL; const int kb = r / 16, nb = r - kb * 16;
            conv_item(a.in[I_POOLW] + (size_t)ig * 512 * 512, 512, 512, WPOOL + (size_t)ig * 512 * 512, 32 * nb, scr, kb, nb, lane); }
    }
    { bf16* LW = (bf16*)(a.ws + WS_LORA); const int gt = blockIdx.x * NTHR + tid, NGT = G * NTHR;
        for (int idx = gt; idx < 8 * 65536; idx += NGT) { const int mat = idx >> 16, n = (idx >> 6) & 1023, k = idx & 63;
            const float v = (mat < 4 ? a.in[I_W2] : a.in[I_A2])[((size_t)(mat & 3) * 64 + k) * 1024 + n]; LW[idx] = (bf16)f2bf(v); }
        for (int idx = gt; idx < 2 * 1024 * 160; idx += NGT) { const int i2 = idx / (1024 * 160), r = idx - i2 * 1024 * 160, n = r / 160, k = r - n * 160;
            LW[8 * 65536 + idx] = (bf16)f2bf(a.in[I_G2][((size_t)i2 * 160 + k) * 1024 + n]); } }
    for (int r = gw; r < 128; r += NGW) { bf16* row = WIN + ((size_t)(r >> 6) * PW + 7616 + (r & 63)) * 2048; const v4u z = {0u, 0u, 0u, 0u};
#pragma unroll
        for (int j = 0; j < 4; ++j) *(v4u*)(row + (j * 64 + lane) * 8) = z; }
}

__device__ __forceinline__ void ph_norm(const Args& a, int l, int which) {
    const int tid = opaque_tid(), lane = tid & 63, wave = __builtin_amdgcn_readfirstlane(tid >> 6);
    const int gw = blockIdx.x * NWAVES + wave, NGW = gridDim.x * NWAVES;
    const float* nw = a.in[which ? I_NFFN : I_NMIX] + l * 2048;
    const float* MOD = (const float*)(a.ws + WS_MOD) + (size_t)l * 9 * 12288;
    bf16* H = (bf16*)(a.ws + WS_H);
    const bool from_in = (l == 0 && which == 0);
    for (int m = gw; m < NTOK; m += NGW) {
        const float* xr = from_in ? (m < NPROMPT ? a.in[I_XP] + (size_t)m * D : a.in[I_XS] + (size_t)(m - NPROMPT) * D) : a.out + (size_t)m * D;
        const int cond = m < NPROMPT ? 0 : 1 + ((m - NPROMPT) >> 10);
        const float* sh = MOD + (size_t)cond * 12288 + (which ? 3 : 0) * 2048; const float* sc = sh + 2048;
        f32x4 v[8]; float s = 0.f;
#pragma unroll
        for (int j = 0; j < 8; ++j) { v[j] = *(const f32x4*)(xr + 4 * lane + 256 * j); s += (v[j].x * v[j].x + v[j].y * v[j].y) + (v[j].z * v[j].z + v[j].w * v[j].w); }
        const float rstd = 1.0f / sqrtf(wave_sum(s) * (1.0f / D) + RMS_EPS);
#pragma unroll
        for (int j = 0; j < 8; ++j) { const int c = 4 * lane + 256 * j; const f32x4 w = *(const f32x4*)(nw + c), s1 = *(const f32x4*)(sc + c), s0 = *(const f32x4*)(sh + c);
            const f32x4 y = (v[j] * rstd) * w * (s1 + 1.0f) + s0;
            v2u o; o.x = pk2(y.x, y.y); o.y = pk2(y.z, y.w); *(v2u*)(H + (size_t)m * D + c) = o; }
    }
}
__device__ __forceinline__ void ph_final(const Args& a) {
    const int tid = opaque_tid(), lane = tid & 63, wave = __builtin_amdgcn_readfirstlane(tid >> 6);
    const int gw = blockIdx.x * NWAVES + wave, NGW = gridDim.x * NWAVES;
    const float* nw = a.in[I_NFIN];
    for (int m = gw; m < NTOK; m += NGW) {
        float* xr = a.out + (size_t)m * D;
        f32x4 v[8]; float s = 0.f;
#pragma unroll
        for (int j = 0; j < 8; ++j) { v[j] = *(const f32x4*)(xr + 4 * lane + 256 * j); s += (v[j].x * v[j].x + v[j].y * v[j].y) + (v[j].z * v[j].z + v[j].w * v[j].w); }
        const float rstd = 1.0f / sqrtf(wave_sum(s) * (1.0f / D) + RMS_EPS);
#pragma unroll
        for (int j = 0; j < 8; ++j) { const int c = 4 * lane + 256 * j; const f32x4 w = *(const f32x4*)(nw + c); *(f32x4*)(xr + c) = (v[j] * rstd) * w; }
    }
}
__device__ __forceinline__ void ph_pool(const Args& a) {
    const int tid = opaque_tid(), lane = tid & 63, wave = __builtin_amdgcn_readfirstlane(tid >> 6);
    const int gw = blockIdx.x * NWAVES + wave, NGW = gridDim.x * NWAVES;
    const bf16* H = (const bf16*)(a.ws + WS_H); bf16* O = (bf16*)(a.ws + WS_O);
    for (int m = gw; m < NTOK; m += NGW) {
        const bool samp = m >= NPROMPT; const int T = samp ? 1024 : 256; const int base = samp ? NPROMPT + (((m - NPROMPT) >> 10) << 10) : (m >> 8) << 8; const int t = m - base;
#pragma unroll
        for (int g = 0; g < 4; ++g) {
            const int win = 2 << g; int lo = t - win / 2, hi = lo + win; lo = lo < 0 ? 0 : lo; hi = hi > T ? T : hi;
            const int c = g * 512 + lane * 8;
            float s[8];
#pragma unroll
            for (int e = 0; e < 8; ++e) s[e] = 0.f;
            for (int r = lo; r < hi; ++r) { const v4u w = *(const v4u*)(H + (size_t)(base + r) * D + c);
                s[0] += bflo(w.x); s[1] += bfhi(w.x); s[2] += bflo(w.y); s[3] += bfhi(w.y); s[4] += bflo(w.z); s[5] += bfhi(w.z); s[6] += bflo(w.w); s[7] += bfhi(w.w); }
            const float inv = 1.0f / (float)(hi - lo);
            const v4u w = *(const v4u*)(H + (size_t)m * D + c);
            v4u o; o.x = pk2(s[0] * inv - bflo(w.x), s[1] * inv - bfhi(w.x)); o.y = pk2(s[2] * inv - bflo(w.y), s[3] * inv - bfhi(w.y));
            o.z = pk2(s[4] * inv - bflo(w.z), s[5] * inv - bfhi(w.z)); o.w = pk2(s[6] * inv - bflo(w.w), s[7] * inv - bfhi(w.w));
            *(v4u*)(O + (size_t)m * D + c) = o;
        }
    }
}

typedef short sfrag __attribute__((ext_vector_type(8)));
union Frag { sfrag v; unsigned u[4]; };
typedef __bf16 bf16x2_t __attribute__((ext_vector_type(2)));
__device__ __forceinline__ unsigned cvtpk(float lo, float hi) { const f32x2 v = {lo, hi}; return __builtin_bit_cast(unsigned, __builtin_convertvector(v, bf16x2_t)); }
__device__ __forceinline__ f32x4 mma(const Frag& A, const Frag& B, f32x4 C) { return __builtin_amdgcn_mfma_f32_16x16x32_bf16(A.v, B.v, C, 0, 0, 0); }
__device__ __forceinline__ Frag feed1(f32x4 d0) { Frag f; f.u[0] = cvtpk(d0.x, d0.y); f.u[1] = cvtpk(d0.z, d0.w); f.u[2] = 0u; f.u[3] = 0u; return f; }
__device__ __forceinline__ Frag feed2(f32x4 d0, f32x4 d1) { Frag f; f.u[0] = cvtpk(d0.x, d0.y); f.u[1] = cvtpk(d0.z, d0.w); f.u[2] = cvtpk(d1.x, d1.y); f.u[3] = cvtpk(d1.z, d1.w); return f; }
#define DPP_SHR(x, n, fill) __builtin_bit_cast(float, __builtin_amdgcn_update_dpp(__builtin_bit_cast(int, (float)(fill)), __builtin_bit_cast(int, (float)(x)), 0x110 + (n), 0xf, 0xf, false))
__device__ __forceinline__ float row_scan16(float x) { x += DPP_SHR(x, 1, 0.f); x += DPP_SHR(x, 2, 0.f); x += DPP_SHR(x, 4, 0.f); x += DPP_SHR(x, 8, 0.f); return x; }
__device__ __forceinline__ float lane_get(float x, int src) { return __builtin_bit_cast(float, __builtin_amdgcn_ds_bpermute(src << 2, __builtin_bit_cast(int, x))); }
constexpr f32x4 F4Z = {0.f, 0.f, 0.f, 0.f};
__device__ __forceinline__ f32x4 tri_inv_T(f32x4 dL, f32x4 dLT, f32x4 eye) {
    const Frag fL = feed1(dL), fLT = feed1(dLT);
    const f32x4 L2 = mma(fLT, fL, F4Z), L2T = mma(fL, fLT, F4Z);
    const Frag f2 = feed1(L2), f2T = feed1(L2T);
    const f32x4 L4 = mma(f2T, f2, F4Z), L4T = mma(f2, f2T, F4Z);
    const f32x4 L8 = mma(feed1(L4T), feed1(L4), F4Z);
    const f32x4 R1 = mma(feed1(L2 + eye), feed1(dLT + eye), F4Z);
    const f32x4 R2 = mma(feed1(L4 + eye), feed1(R1), F4Z);
    return mma(feed1(L8 + eye), feed1(R2), F4Z);
}

__device__ __forceinline__ void rwkv_task(const Args& a, int i, int s, int h, int d, int lane, LAS float* wscr) {
    constexpr size_t S1 = (size_t)NTOK * 1024;
    const bf16* RW = (const bf16*)(a.ws + WS_SC);
    float* Y = (float*)(a.ws + WS_Y) + d * S1;
    const int T = s < 16 ? 256 : 1024; const int row0 = s < 16 ? s * 256 : NPROMPT + (s - 16) * 1024;
    const int c = lane & 15, q = lane >> 4;
    f32x4 S[4][4];
    if (s >= 16) { const float* s0 = a.in[I_SRW] + ((((size_t)(s - 16) * 2 + i) * 2 + d) * 16 + h) * 4096;
#pragma unroll
        for (int kt = 0; kt < 4; ++kt)
#pragma unroll
            for (int vt = 0; vt < 4; ++vt) S[kt][vt] = *(const f32x4*)(s0 + (16 * vt + c) * 64 + 16 * kt + 4 * q); }
    else {
#pragma unroll
        for (int kt = 0; kt < 4; ++kt)
#pragma unroll
            for (int vt = 0; vt < 4; ++vt) S[kt][vt] = F4Z; }
    Frag sel[2];
#pragma unroll
    for (int p = 0; p < 2; ++p)
#pragma unroll
        for (int j = 0; j < 4; ++j) { const int e0 = 2 * j - 4 * p; const bool on = ((lane >> 2) & 3) == q && (e0 == (lane & 3) || e0 + 1 == (lane & 3)) && (j >> 1) == p;
            sel[p].u[j] = on ? (((lane & 1) == 0) ? 0x00003F80u : 0x3F800000u) : 0u; }
    bool mlt[4], mle[4]; f32x4 eye;
#pragma unroll
    for (int n = 0; n < 4; ++n) { mlt[n] = (4 * q + n) < c; mle[n] = (4 * q + n) <= c; eye[n] = (4 * q + n) == c ? 1.f : 0.f; }
    const int nch = T >> 4;
    const int kof = (3 + d) * 64, bof = (5 + d) * 64, lof = (7 + d) * 64;
    v2u nr[4], na[4], nk[4], nb[4], nlw[4], nv[4];
    for (int ch = 0; ch < nch; ++ch) {
        { const int tok = d ? T - 1 - (16 * ch + c) : 16 * ch + c; const bf16* rw = RW + ((size_t)(row0 + tok) * 16 + h) * 576 + 4 * q;
#pragma unroll
            for (int g = 0; g < 4; ++g) { nr[g] = *(const v2u*)(rw + 16 * g); na[g] = *(const v2u*)(rw + 64 + 16 * g); nk[g] = *(const v2u*)(rw + kof + 16 * g); nb[g] = *(const v2u*)(rw + bof + 16 * g); nlw[g] = *(const v2u*)(rw + lof + 16 * g); nv[g] = *(const v2u*)(rw + 128 + 16 * g); } }
        Frag f_at[2], f_rt[2], f_bt[2], f_kt[2], f_bh[2], f_kh[2], f_v[2];
#pragma unroll
        for (int g = 0; g < 4; ++g) {
            const int ks = g >> 1, hf = g & 1;
            float lw_[4] = {bflo(nlw[g].x), bfhi(nlw[g].x), bflo(nlw[g].y), bfhi(nlw[g].y)};
            float r_[4] = {bflo(nr[g].x), bfhi(nr[g].x), bflo(nr[g].y), bfhi(nr[g].y)}, a_[4] = {bflo(na[g].x), bfhi(na[g].x), bflo(na[g].y), bfhi(na[g].y)};
            float k_[4] = {bflo(nk[g].x), bfhi(nk[g].x), bflo(nk[g].y), bfhi(nk[g].y)}, b_[4] = {bflo(nb[g].x), bfhi(nb[g].x), bflo(nb[g].y), bfhi(nb[g].y)};
            float at[4], rt[4], bt[4], kt[4], bh[4], kh[4];
#pragma unroll
            for (int n = 0; n < 4; ++n) {
                const float G = row_scan16(lw_[n]); const float E1 = __builtin_amdgcn_exp2f(G), E2 = __builtin_amdgcn_rcpf(E1); const float E3 = DPP_SHR(E1, 1, 1.0f);
                const float ec = lane_get(E1, (lane & 48) | 15); wscr[(g * 4 + n) * 64 + lane] = ec;
                at[n] = a_[n] * E3; rt[n] = r_[n] * E1; bt[n] = b_[n] * E2; kt[n] = k_[n] * E2; bh[n] = bt[n] * ec; kh[n] = kt[n] * ec;
            }
            f_at[ks].u[2 * hf] = cvtpk(at[0], at[1]); f_at[ks].u[2 * hf + 1] = cvtpk(at[2], at[3]); f_rt[ks].u[2 * hf] = cvtpk(rt[0], rt[1]); f_rt[ks].u[2 * hf + 1] = cvtpk(rt[2], rt[3]);
            f_bt[ks].u[2 * hf] = cvtpk(bt[0], bt[1]); f_bt[ks].u[2 * hf + 1] = cvtpk(bt[2], bt[3]); f_kt[ks].u[2 * hf] = cvtpk(kt[0], kt[1]); f_kt[ks].u[2 * hf + 1] = cvtpk(kt[2], kt[3]);
            f_bh[ks].u[2 * hf] = cvtpk(bh[0], bh[1]); f_bh[ks].u[2 * hf + 1] = cvtpk(bh[2], bh[3]); f_kh[ks].u[2 * hf] = cvtpk(kh[0], kh[1]); f_kh[ks].u[2 * hf + 1] = cvtpk(kh[2], kh[3]);
            f_v[ks].u[2 * hf] = nv[g].x; f_v[ks].u[2 * hf + 1] = nv[g].y;
            __builtin_amdgcn_sched_barrier(0);
        }
        v2u pV[4]; LAS v4u* sBK = (LAS v4u*)(wscr + 1024);
#pragma unroll
        for (int g = 0; g < 4; ++g) { const f32x4 dv = mma(f_v[g >> 1], sel[g & 1], F4Z); pV[g].x = cvtpk(dv.x, dv.y); pV[g].y = cvtpk(dv.z, dv.w);
            const Frag fb = feed2(mma(f_bh[g >> 1], sel[g & 1], F4Z), mma(f_kh[g >> 1], sel[g & 1], F4Z)); sBK[g * 64 + lane] = (v4u){fb.u[0], fb.u[1], fb.u[2], fb.u[3]}; }
        __builtin_amdgcn_sched_barrier(0);
        f32x4 dLab = mma(f_at[1], f_bt[1], mma(f_at[0], f_bt[0], F4Z));
        f32x4 dLabT = mma(f_bt[1], f_at[1], mma(f_bt[0], f_at[0], F4Z));
        f32x4 dLakT = mma(f_kt[1], f_at[1], mma(f_kt[0], f_at[0], F4Z));
        f32x4 dArbT = mma(f_bt[1], f_rt[1], mma(f_bt[0], f_rt[0], F4Z));
        f32x4 dArkT = mma(f_kt[1], f_rt[1], mma(f_kt[0], f_rt[0], F4Z));
#pragma unroll
        for (int n = 0; n < 4; ++n) { dLab[n] = (c < 4 * q + n) ? dLab[n] : 0.f; dLabT[n] = mlt[n] ? dLabT[n] : 0.f; dLakT[n] = mlt[n] ? dLakT[n] : 0.f; dArbT[n] = mle[n] ? dArbT[n] : 0.f; dArkT[n] = mle[n] ? dArkT[n] : 0.f; }
        const Frag fTT = feed1(tri_inv_T(dLab, dLabT, eye)), fLakT = feed1(dLakT), fArbT = feed1(dArbT), fArkT = feed1(dArkT);
        __builtin_amdgcn_sched_barrier(0);
        v2u pSA[4];
        const int tokbase = 16 * ch + 4 * q;
#pragma unroll
        for (int vt = 0; vt < 4; ++vt) {
            const Frag fS0 = feed2(S[0][vt], S[1][vt]), fS1 = feed2(S[2][vt], S[3][vt]); Frag fV; fV.u[0] = pV[vt].x; fV.u[1] = pV[vt].y; fV.u[2] = 0u; fV.u[3] = 0u;
            f32x4 rhs = mma(f_at[1], fS1, mma(f_at[0], fS0, F4Z)); rhs = mma(fLakT, fV, rhs);
            const f32x4 sa = mma(fTT, feed1(rhs), F4Z); pSA[vt].x = cvtpk(sa.x, sa.y); pSA[vt].y = cvtpk(sa.z, sa.w);
            Frag fSA; fSA.u[0] = pSA[vt].x; fSA.u[1] = pSA[vt].y; fSA.u[2] = 0u; fSA.u[3] = 0u;
            f32x4 y = mma(f_rt[1], fS1, mma(f_rt[0], fS0, F4Z)); y = mma(fArbT, fSA, y); y = mma(fArkT, fV, y);
#pragma unroll
            for (int n = 0; n < 4; ++n) { const int t = tokbase + n; const int tok = d ? T - 1 - t : t; Y[(size_t)(row0 + tok) * 1024 + h * 64 + 16 * vt + c] = y[n]; }
            __builtin_amdgcn_sched_barrier(0);
        }
#pragma unroll
        for (int vt = 0; vt < 4; ++vt) { Frag fB; fB.u[0] = pSA[vt].x; fB.u[1] = pSA[vt].y; fB.u[2] = pV[vt].x; fB.u[3] = pV[vt].y;
#pragma unroll
            for (int kt = 0; kt < 4; ++kt) { f32x4 cin;
#pragma unroll
                for (int n = 0; n < 4; ++n) cin[n] = S[kt][vt][n] * wscr[(kt * 4 + n) * 64 + lane];
                const v4u w = sBK[kt * 64 + lane]; Frag fbk; fbk.u[0] = w.x; fbk.u[1] = w.y; fbk.u[2] = w.z; fbk.u[3] = w.w;
                S[kt][vt] = mma(fbk, fB, cin); } }
    }
    if (s < 16) { float* so = a.out + OUT_SRW + ((((size_t)s * 2 + i) * 2 + d) * 16 + h) * 4096;
#pragma unroll
        for (int kt = 0; kt < 4; ++kt)
#pragma unroll
            for (int vt = 0; vt < 4; ++vt) *(f32x4*)(so + (16 * vt + c) * 64 + 16 * kt + 4 * q) = S[kt][vt]; }
}

__device__ __forceinline__ Frag scale_frag(const Frag& x, float sc) { Frag f;
#pragma unroll
    for (int j = 0; j < 4; ++j) f.u[j] = cvtpk(bflo(x.u[j]) * sc, bfhi(x.u[j]) * sc);
    return f; }
__device__ __forceinline__ void gdn_task(const Args& a, int i, int s, int h, int d, int vb, int lane, LAS float* wscr) {
    constexpr size_t S1 = (size_t)NTOK * 1024;
    const bf16* GD = (const bf16*)(a.ws + WS_SC) + 9 * S1;
    const float* BETA = (const float*)(a.ws + WS_SMALL) + (size_t)NTOK * 32; const float* GG = BETA + (size_t)NTOK * 16;
    float* O = (float*)(a.ws + WS_Y) + 2 * S1 + d * S1;
    const int T = s < 16 ? 256 : 1024; const int row0 = s < 16 ? s * 256 : NPROMPT + (s - 16) * 1024;
    const int c = lane & 15, q = lane >> 4;
    f32x4 S[8][2];
    if (s >= 16) { const float* s0 = a.in[I_SDL] + ((((size_t)(s - 16) * 2 + i) * 2 + d) * 8 + h) * 16384 + 32 * vb + c;
#pragma unroll
        for (int kt = 0; kt < 8; ++kt)
#pragma unroll
            for (int vt = 0; vt < 2; ++vt)
#pragma unroll
                for (int n = 0; n < 4; ++n) S[kt][vt][n] = s0[(16 * kt + 4 * q + n) * 128 + 16 * vt]; }
    else {
#pragma unroll
        for (int kt = 0; kt < 8; ++kt) { S[kt][0] = F4Z; S[kt][1] = F4Z; } }
    Frag sel[2];
#pragma unroll
    for (int p = 0; p < 2; ++p)
#pragma unroll
        for (int j = 0; j < 4; ++j) { const int e0 = 2 * j - 4 * p; const bool on = ((lane >> 2) & 3) == q && (e0 == (lane & 3) || e0 + 1 == (lane & 3)) && (j >> 1) == p;
            sel[p].u[j] = on ? (((lane & 1) == 0) ? 0x00003F80u : 0x3F800000u) : 0u; }
    f32x4 eye;
#pragma unroll
    for (int n = 0; n < 4; ++n) eye[n] = (4 * q + n) == c ? 1.f : 0.f;
    const int nch = T >> 4;
    Frag nk[4], nq[4], nv; float nbeta, ng;
    { const int tok = d ? T - 1 - c : c; const size_t row = row0 + tok; const bf16* gd = GD + (row * 8 + h) * 384 + 4 * q;
#pragma unroll
        for (int ks = 0; ks < 4; ++ks) { const v2u k0 = *(const v2u*)(gd + 128 + 32 * ks), k1 = *(const v2u*)(gd + 128 + 32 * ks + 16), q0 = *(const v2u*)(gd + 32 * ks), q1 = *(const v2u*)(gd + 32 * ks + 16);
            nk[ks].u[0] = k0.x; nk[ks].u[1] = k0.y; nk[ks].u[2] = k1.x; nk[ks].u[3] = k1.y; nq[ks].u[0] = q0.x; nq[ks].u[1] = q0.y; nq[ks].u[2] = q1.x; nq[ks].u[3] = q1.y; }
        { const v2u v0 = *(const v2u*)(gd + 256 + 32 * vb), v1 = *(const v2u*)(gd + 256 + 32 * vb + 16); nv.u[0] = v0.x; nv.u[1] = v0.y; nv.u[2] = v1.x; nv.u[3] = v1.y; }
        nbeta = BETA[row * 16 + d * 8 + h]; ng = GG[row * 16 + d * 8 + h]; }
    for (int ch = 0; ch < nch; ++ch) {
        const float beta = nbeta, gl = ng;
        const float G = row_scan16(gl); const float GC = lane_get(G, (lane & 48) | 15);
        float Grow[4], Brow[4];
#pragma unroll
        for (int n = 0; n < 4; ++n) { Grow[n] = lane_get(G, (lane & 48) | (4 * q + n)); Brow[n] = lane_get(beta, (lane & 48) | (4 * q + n)); }
        const float eG = __builtin_amdgcn_exp2f(G), eGCG = __builtin_amdgcn_exp2f(GC - G), eGC = __builtin_amdgcn_exp2f(GC);
        f32x4 dKK = F4Z, dKQ = F4Z;
#pragma unroll
        for (int ks = 0; ks < 4; ++ks) { dKK = mma(nk[ks], nk[ks], dKK); dKQ = mma(nk[ks], nq[ks], dKQ); }
        f32x4 dL, dLT, dAtT;
#pragma unroll
        for (int n = 0; n < 4; ++n) { const int r = 4 * q + n;
            const float eij = __builtin_amdgcn_exp2f(fminf(Grow[n] - G, 0.f)), eji = __builtin_amdgcn_exp2f(fminf(G - Grow[n], 0.f));
            dL[n] = (c < r) ? -Brow[n] * dKK[n] * eij : 0.f;
            dLT[n] = (r < c) ? -beta * dKK[n] * eji : 0.f;
            dAtT[n] = (r <= c) ? dKQ[n] * eji * 0.08838834764831845f : 0.f; }
        const Frag fTT = feed1(tri_inv_T(dL, dLT, eye)), fAtT = feed1(dAtT);
        f32x4 dV[2]; dV[0] = mma(nv, sel[0], F4Z); dV[1] = mma(nv, sel[1], F4Z);
        LAS v2u* sKd = (LAS v2u*)wscr;
#pragma unroll
        for (int ks = 0; ks < 4; ++ks) { const Frag kd = scale_frag(nk[ks], eGCG); const f32x4 t0 = mma(kd, sel[0], F4Z), t1 = mma(kd, sel[1], F4Z);
            sKd[(2 * ks) * 64 + lane] = (v2u){cvtpk(t0.x, t0.y), cvtpk(t0.z, t0.w)}; sKd[(2 * ks + 1) * 64 + lane] = (v2u){cvtpk(t1.x, t1.y), cvtpk(t1.z, t1.w)}; }
        Frag fX[4], fQg[4];
#pragma unroll
        for (int ks = 0; ks < 4; ++ks) { fX[ks] = scale_frag(nk[ks], beta * eG); fQg[ks] = scale_frag(nq[ks], eG * 0.08838834764831845f); }
        const int tokbase = 16 * ch + 4 * q;
#pragma unroll
        for (int vt = 0; vt < 2; ++vt) {
            f32x4 M = F4Z, o = F4Z;
#pragma unroll
            for (int ks = 0; ks < 4; ++ks) { const Frag fS = feed2(S[2 * ks][vt], S[2 * ks + 1][vt]); M = mma(fX[ks], fS, M); o = mma(fQg[ks], fS, o); }
            f32x4 rhs;
#pragma unroll
            for (int n = 0; n < 4; ++n) rhs[n] = Brow[n] * dV[vt][n] - M[n];
            const Frag fVn = feed1(mma(fTT, feed1(rhs), F4Z));
            o = mma(fAtT, fVn, o);
#pragma unroll
            for (int n = 0; n < 4; ++n) { const int t = tokbase + n; const int tok = d ? T - 1 - t : t; O[(size_t)(row0 + tok) * 1024 + h * 128 + 32 * vb + 16 * vt + c] = o[n]; }
#pragma unroll
            for (int kt = 0; kt < 8; ++kt) { const v2u w = sKd[kt * 64 + lane]; Frag fK; fK.u[0] = w.x; fK.u[1] = w.y; fK.u[2] = 0u; fK.u[3] = 0u; S[kt][vt] = mma(fK, fVn, S[kt][vt] * eGC); }
        }
        asm volatile("" ::: "memory");
        { const int chn = ch + 1 < nch ? ch + 1 : ch; const int tok = d ? T - 1 - (16 * chn + c) : 16 * chn + c; const size_t row = row0 + tok; const bf16* gd = GD + (row * 8 + h) * 384 + 4 * q;
#pragma unroll
            for (int ks = 0; ks < 4; ++ks) { const v2u k0 = *(const v2u*)(gd + 128 + 32 * ks), k1 = *(const v2u*)(gd + 128 + 32 * ks + 16), q0 = *(const v2u*)(gd + 32 * ks), q1 = *(const v2u*)(gd + 32 * ks + 16);
                nk[ks].u[0] = k0.x; nk[ks].u[1] = k0.y; nk[ks].u[2] = k1.x; nk[ks].u[3] = k1.y; nq[ks].u[0] = q0.x; nq[ks].u[1] = q0.y; nq[ks].u[2] = q1.x; nq[ks].u[3] = q1.y; }
            { const v2u v0 = *(const v2u*)(gd + 256 + 32 * vb), v1 = *(const v2u*)(gd + 256 + 32 * vb + 16); nv.u[0] = v0.x; nv.u[1] = v0.y; nv.u[2] = v1.x; nv.u[3] = v1.y; }
            nbeta = BETA[row * 16 + d * 8 + h]; ng = GG[row * 16 + d * 8 + h]; }
    }
    if (s < 16) { float* so = a.out + OUT_SDL + ((((size_t)s * 2 + i) * 2 + d) * 8 + h) * 16384 + 32 * vb + c;
#pragma unroll
        for (int kt = 0; kt < 8; ++kt)
#pragma unroll
            for (int vt = 0; vt < 2; ++vt)
#pragma unroll
                for (int n = 0; n < 4; ++n) so[(16 * kt + 4 * q + n) * 128 + 16 * vt] = S[kt][vt][n]; }
}
__device__ __forceinline__ void ph_scan(const Args& a, LAS unsigned char* lds, int i) {
    const int tid = opaque_tid(), lane = tid & 63, wave = __builtin_amdgcn_readfirstlane(tid >> 6);
    LAS float* wscr = (LAS float*)(lds + wave * 8192);
    const int G = gridDim.x;
    for (int task = wave * G + blockIdx.x; task < 2304; task += NWAVES * G) {
        if (task >= 256 && task < 512) { const int t = task - 256; rwkv_task(a, i, 16 + (t >> 5), (t & 31) >> 1, t & 1, lane, wscr); }
        else if (task >= 1024 && task < 1536) { const int t = task - 1024; rwkv_task(a, i, t >> 5, (t & 31) >> 1, t & 1, lane, wscr); }
    }
    asm volatile("" ::: "memory");
    for (int task = wave * G + blockIdx.x; task < 2304; task += NWAVES * G) {
        if (task < 256 || task >= 1536) { const int t = task < 256 ? task : task - 1536 + 256; const int s = t >> 6, r = t & 63; gdn_task(a, i, s, r >> 3, (r >> 2) & 1, r & 3, lane, wscr); }
        else if (task >= 512 && task < 1024) { const int t = task - 512; const int s = 16 + (t >> 6), r = t & 63; gdn_task(a, i, s, r >> 3, (r >> 2) & 1, r & 3, lane, wscr); }
    }
}
__device__ __forceinline__ void tok_info(int m, bool& samp, int& T, int& t) { samp = m >= NPROMPT; T = samp ? 1024 : 256; t = samp ? ((m - NPROMPT) & 1023) : (m & 255); }
__device__ __forceinline__ void shift_nb(bool samp, int T, int t, int n, int& dt, bool& valid) {
    if (!samp) { if (n & 1) { dt = 1; valid = t + 1 < T; } else { dt = -1; valid = t > 0; } }
    else { const int col = t & 63, row = t >> 6;
        if (n == 0) { dt = -1; valid = col > 0; } else if (n == 1) { dt = 1; valid = col < 63; } else if (n == 2) { dt = -64; valid = row > 0; } else { dt = 64; valid = row < 15; } }
}
constexpr int LA_LD = 424;
__device__ __forceinline__ void ph_prep(const Args& a, LAS unsigned char* lds, int i) {
    const int tid = opaque_tid(), lane = tid & 63, wave = __builtin_amdgcn_readfirstlane(tid >> 6);
    const int c = lane & 15, q = lane >> 4;
    const bf16* P = (const bf16*)(a.ws + WS_P);
    bf16* RW = (bf16*)(a.ws + WS_SC); constexpr size_t S1 = (size_t)NTOK * 1024;
    bf16* GD = RW + 9 * S1; float* GT = (float*)(RW + 12 * S1);
    float* BON = (float*)(a.ws + WS_SMALL); float* BETA = BON + (size_t)NTOK * 32; float* GG = BETA + (size_t)NTOK * 16;
    const float* MU = a.in[I_MU] + i * CPA;
    const bf16* W2T = (const bf16*)(a.ws + WS_LORA) + (size_t)i * 2 * 1024 * 64;
    const bf16* A2T = (const bf16*)(a.ws + WS_LORA) + (size_t)4 * 1024 * 64 + (size_t)i * 2 * 1024 * 64;
    const bf16* G2T = (const bf16*)(a.ws + WS_LORA) + (size_t)8 * 1024 * 64 + (size_t)i * 1024 * 160;
    LAS bf16* la = (LAS bf16*)lds;
    LAS float* lpar = (LAS float*)(lds + 40960);
    LAS float* lcw = (LAS float*)(lds + 40960 + 40960);
    for (int idx = tid; idx < 10 * 1024; idx += NTHR) { const int p = idx >> 10, ch = idx & 1023;
        const float v = p < 3 ? MU[p * 1024 + ch] : (p == 3 ? a.in[I_KK][i * 1024 + ch] : (p == 4 ? a.in[I_KA][i * 1024 + ch] : (p == 5 ? a.in[I_RK][i * 1024 + ch] : (p < 8 ? a.in[I_W0][(i * 2 + p - 6) * 1024 + ch] : a.in[I_A0][(i * 2 + p - 8) * 1024 + ch]))));
        lpar[idx] = v; }
    for (int idx = tid; idx < 3 * 3072; idx += NTHR) lcw[idx] = a.in[I_CONVW][(size_t)i * 3 * 3072 + idx];
    __syncthreads();
    for (int tile = blockIdx.x; tile < NTOK / 48; tile += gridDim.x) {
        const int m0 = tile * 48;
        for (int it = 0; it < 10; ++it) {
            float xv[4], xsv[4]; int jjv[4], ttv[4];
#pragma unroll
            for (int u = 0; u < 4; ++u) { const int idx = tid + NTHR * (4 * it + u); const bool ok = idx < 48 * 416; const int tt = ok ? idx / 416 : 0, jj = ok ? idx - tt * 416 : 0; jjv[u] = ok ? jj : -1; ttv[u] = tt;
                const int m = m0 + tt; bool samp; int T, t; tok_info(m, samp, T, t); int dt; bool valid; shift_nb(samp, T, t, jj & 3, dt, valid);
                xv[u] = bf2f(P[(size_t)m * PW + PC_LORA + jj]); xsv[u] = valid ? bf2f(P[(size_t)(m + dt) * PW + PC_LORA + jj]) : 0.f; }
#pragma unroll
            for (int u = 0; u < 4; ++u) { const int jj = jjv[u]; if (jj >= 0) { float v = xv[u] + (xsv[u] - xv[u]) * MU[3072 + jj];
                if (jj < 128) { const float e = __expf(2.0f * v); v = 1.0f - 2.0f / (e + 1.0f); } else if (jj >= 256) v = sigmoidf_(v);
                la[ttv[u] * LA_LD + jj] = (bf16)f2bf(v); } }
        }
        __syncthreads();
#pragma unroll 1
        for (int u = 0; u < 6; ++u) {
            const int hd = wave * 2 + u / 3, mt = u % 3; const int m = m0 + 16 * mt + c; bool samp; int T, t; tok_info(m, samp, T, t);
            int dtn[4]; bool vn[4];
#pragma unroll
            for (int n = 0; n < 4; ++n) shift_nb(samp, T, t, n, dtn[n], vn[n]);
            float r_[4][4], k_[4][4], v_[4][4]; float ss = 0.f;
#pragma unroll
            for (int nt = 0; nt < 4; ++nt) { const int ch = hd * 64 + 16 * nt + 4 * q; const bf16* pr = P + (size_t)m * PW + ch;
                const v2u wr = *(const v2u*)pr, wk = *(const v2u*)(pr + 1024), wv = *(const v2u*)(pr + 2048);
                const f32x4 mur = *(const LAS f32x4*)(lpar + ch), muk = *(const LAS f32x4*)(lpar + 1024 + ch), muv = *(const LAS f32x4*)(lpar + 2048 + ch), kkw = *(const LAS f32x4*)(lpar + 3072 + ch);
                const float xr[4] = {bflo(wr.x), bfhi(wr.x), bflo(wr.y), bfhi(wr.y)}, xk[4] = {bflo(wk.x), bfhi(wk.x), bflo(wk.y), bfhi(wk.y)}, xv[4] = {bflo(wv.x), bfhi(wv.x), bflo(wv.y), bfhi(wv.y)};
#pragma unroll
                for (int n = 0; n < 4; ++n) { const bf16* pn = pr + (long)dtn[n] * PW + n;
                    const float nr = vn[n] ? bf2f(pn[0]) : 0.f, nk = vn[n] ? bf2f(pn[1024]) : 0.f, nv = vn[n] ? bf2f(pn[2048]) : 0.f;
                    r_[nt][n] = xr[n] + (nr - xr[n]) * mur[n]; k_[nt][n] = xk[n] + (nk - xk[n]) * muk[n]; v_[nt][n] = xv[n] + (nv - xv[n]) * muv[n];
                    const float kkr = k_[nt][n] * kkw[n]; ss += kkr * kkr; } }
            ss += __shfl_xor(ss, 16); ss += __shfl_xor(ss, 32);
            const float kn = 1.0f / sqrtf(ss + 1e-12f);
            float bon0 = 0.f, bon1 = 0.f;
            const LAS bf16* lrow = la + (16 * mt + c) * LA_LD + 8 * q;
#pragma unroll
            for (int nt = 0; nt < 4; ++nt) {
                f32x4 wl0 = F4Z, wl1 = F4Z, al0 = F4Z, al1 = F4Z, gl = F4Z;
#pragma unroll
                for (int ks = 0; ks < 2; ++ks) {
                    const size_t wo = ((size_t)hd * 64 + 16 * nt + c) * 64 + 32 * ks + 8 * q;
                    Frag b, w; v4u x;
                    x = *(const LAS v4u*)(lrow + 32 * ks); b.u[0] = x.x; b.u[1] = x.y; b.u[2] = x.z; b.u[3] = x.w; x = *(const v4u*)(W2T + wo); w.u[0] = x.x; w.u[1] = x.y; w.u[2] = x.z; w.u[3] = x.w; wl0 = mma(w, b, wl0);
                    x = *(const LAS v4u*)(lrow + 64 + 32 * ks); b.u[0] = x.x; b.u[1] = x.y; b.u[2] = x.z; b.u[3] = x.w; x = *(const v4u*)(W2T + 65536 + wo); w.u[0] = x.x; w.u[1] = x.y; w.u[2] = x.z; w.u[3] = x.w; wl1 = mma(w, b, wl1);
                    x = *(const LAS v4u*)(lrow + 128 + 32 * ks); b.u[0] = x.x; b.u[1] = x.y; b.u[2] = x.z; b.u[3] = x.w; x = *(const v4u*)(A2T + wo); w.u[0] = x.x; w.u[1] = x.y; w.u[2] = x.z; w.u[3] = x.w; al0 = mma(w, b, al0);
                    x = *(const LAS v4u*)(lrow + 192 + 32 * ks); b.u[0] = x.x; b.u[1] = x.y; b.u[2] = x.z; b.u[3] = x.w; x = *(const v4u*)(A2T + 65536 + wo); w.u[0] = x.x; w.u[1] = x.y; w.u[2] = x.z; w.u[3] = x.w; al1 = mma(w, b, al1);
                }
#pragma unroll
                for (int ks = 0; ks < 5; ++ks) { Frag b, w; v4u x = *(const LAS v4u*)(lrow + 256 + 32 * ks); b.u[0] = x.x; b.u[1] = x.y; b.u[2] = x.z; b.u[3] = x.w;
                    x = *(const v4u*)(G2T + ((size_t)hd * 64 + 16 * nt + c) * 160 + 32 * ks + 8 * q); w.u[0] = x.x; w.u[1] = x.y; w.u[2] = x.z; w.u[3] = x.w; gl = mma(w, b, gl); }
                const int ch = hd * 64 + 16 * nt + 4 * q; const size_t o = (size_t)m * 1024 + ch;
                bf16* rw = RW + ((size_t)m * 16 + hd) * 576 + 16 * nt + 4 * q;
                const f32x4 kkw = *(const LAS f32x4*)(lpar + 3072 + ch), kaw = *(const LAS f32x4*)(lpar + 4096 + ch), rkw = *(const LAS f32x4*)(lpar + 5120 + ch);
                const f32x4 w00 = *(const LAS f32x4*)(lpar + 6144 + ch), w01 = *(const LAS f32x4*)(lpar + 7168 + ch), a00 = *(const LAS f32x4*)(lpar + 8192 + ch), a01 = *(const LAS f32x4*)(lpar + 9216 + ch);
                float kk[4], lw0[4], lw1[4], kd0[4], kd1[4], b0[4], b1[4];
#pragma unroll
                for (int n = 0; n < 4; ++n) { const float kx = k_[nt][n];
                    kk[n] = kx * kkw[n] * kn;
                    const float ic0 = sigmoidf_(a00[n] + al0[n]), ic1 = sigmoidf_(a01[n] + al1[n]);
                    lw0[n] = -0.6065306597f * 1.4426950409f * sigmoidf_(w00[n] + wl0[n]); lw1[n] = -0.6065306597f * 1.4426950409f * sigmoidf_(w01[n] + wl1[n]);
                    kd0[n] = kx * (1.0f + (ic0 - 1.0f) * kaw[n]); kd1[n] = kx * (1.0f + (ic1 - 1.0f) * kaw[n]); b0[n] = kk[n] * ic0; b1[n] = kk[n] * ic1;
                    bon0 += r_[nt][n] * kd0[n] * rkw[n]; bon1 += r_[nt][n] * kd1[n] * rkw[n]; }
                *(v2u*)(rw) = (v2u){cvtpk(r_[nt][0], r_[nt][1]), cvtpk(r_[nt][2], r_[nt][3])}; *(v2u*)(rw + 128) = (v2u){cvtpk(v_[nt][0], v_[nt][1]), cvtpk(v_[nt][2], v_[nt][3])};
                *(v2u*)(rw + 64) = (v2u){cvtpk(-kk[0], -kk[1]), cvtpk(-kk[2], -kk[3])};
                *(v2u*)(rw + 192) = (v2u){cvtpk(kd0[0], kd0[1]), cvtpk(kd0[2], kd0[3])}; *(v2u*)(rw + 256) = (v2u){cvtpk(kd1[0], kd1[1]), cvtpk(kd1[2], kd1[3])};
                *(v2u*)(rw + 320) = (v2u){cvtpk(b0[0], b0[1]), cvtpk(b0[2], b0[3])}; *(v2u*)(rw + 384) = (v2u){cvtpk(b1[0], b1[1]), cvtpk(b1[2], b1[3])};
                *(v2u*)(rw + 448) = (v2u){cvtpk(lw0[0], lw0[1]), cvtpk(lw0[2], lw0[3])}; *(v2u*)(rw + 512) = (v2u){cvtpk(lw1[0], lw1[1]), cvtpk(lw1[2], lw1[3])};
                *(f32x4*)(GT + o) = gl;
                __builtin_amdgcn_sched_barrier(0);
            }
            bon0 += __shfl_xor(bon0, 16); bon0 += __shfl_xor(bon0, 32); bon1 += __shfl_xor(bon1, 16); bon1 += __shfl_xor(bon1, 32);
            if (q == 0) { BON[((size_t)m * 2 + 0) * 16 + hd] = bon0; BON[((size_t)m * 2 + 1) * 16 + hd] = bon1; }
        }
#pragma unroll 1
        for (int r3 = 0; r3 < 3; ++r3) {
            const int unit = wave + 8 * r3; const int hd = unit / 3, mt = unit - hd * 3; const int m = m0 + 16 * mt + c; bool samp; int T, t; tok_info(m, samp, T, t);
            const bool hp = t > 0, hn = t + 1 < T;
            float sqk[2] = {0.f, 0.f};
#pragma unroll
            for (int pass = 0; pass < 2; ++pass) {
                float scl[2] = {1.f, 1.f};
                if (pass == 1) { sqk[0] += __shfl_xor(sqk[0], 16); sqk[0] += __shfl_xor(sqk[0], 32); sqk[1] += __shfl_xor(sqk[1], 16); sqk[1] += __shfl_xor(sqk[1], 32);
                    scl[0] = 1.0f / sqrtf(sqk[0] + 1e-6f); scl[1] = 1.0f / sqrtf(sqk[1] + 1e-6f); }
#pragma unroll
                for (int part = 0; part < 3; ++part) {
                    if (pass == 0 && part == 2) continue;
                    bf16* dst = GD + ((size_t)m * 8 + hd) * 384 + part * 128 + 4 * q; const float sc = part < 2 ? scl[part] : 1.f; float acc = 0.f;
#pragma unroll 4
                    for (int g = 0; g < 8; ++g) { const int ch = part * 1024 + hd * 128 + 16 * g + 4 * q; const bf16* pp = P + (size_t)m * PW + PC_GDN + ch;
                        const v2u x1 = *(const v2u*)pp; v2u x0 = {0u, 0u}, x2 = {0u, 0u}; if (hp) x0 = *(const v2u*)(pp - PW); if (hn) x2 = *(const v2u*)(pp + PW);
                        const f32x4 c0 = *(const LAS f32x4*)(lcw + ch), c1 = *(const LAS f32x4*)(lcw + 3072 + ch), c2 = *(const LAS f32x4*)(lcw + 2 * 3072 + ch);
                        float val[4];
                        val[0] = siluf_(bflo(x0.x) * c0[0] + bflo(x1.x) * c1[0] + bflo(x2.x) * c2[0]); val[1] = siluf_(bfhi(x0.x) * c0[1] + bfhi(x1.x) * c1[1] + bfhi(x2.x) * c2[1]);
                        val[2] = siluf_(bflo(x0.y) * c0[2] + bflo(x1.y) * c1[2] + bflo(x2.y) * c2[2]); val[3] = siluf_(bfhi(x0.y) * c0[3] + bfhi(x1.y) * c1[3] + bfhi(x2.y) * c2[3]);
                        if (pass == 0) acc += (val[0] * val[0] + val[1] * val[1]) + (val[2] * val[2] + val[3] * val[3]);
                        else *(v2u*)(dst + 16 * g) = (v2u){cvtpk(val[0] * sc, val[1] * sc), cvtpk(val[2] * sc, val[3] * sc)}; }
                    if (pass == 0) sqk[part] = acc;
                }
            }
        }
        for (int idx = tid; idx < 48 * 16; idx += NTHR) { const int tt = idx >> 4, dh = idx & 15; const int m = m0 + tt;
            BETA[(size_t)m * 16 + dh] = sigmoidf_(bf2f(P[(size_t)m * PW + PC_BETA + dh]));
            GG[(size_t)m * 16 + dh] = -1.4426950409f * __expf(a.in[I_ALOG][i * 16 + dh]) * softplusf_(bf2f(P[(size_t)m * PW + PC_ALPHA + dh]) + a.in[I_DTB][i * 16 + dh]); }
        __syncthreads();
    }
}
__device__ __forceinline__ void ph_post(const Args& a, int i) {
    const int tid = opaque_tid(), lane = tid & 63, wave = __builtin_amdgcn_readfirstlane(tid >> 6);
    const int gw = blockIdx.x * NWAVES + wave, NGW = gridDim.x * NWAVES;
    const bf16* SC = (const bf16*)(a.ws + WS_SC); constexpr size_t S1 = (size_t)NTOK * 1024;
    const float* GT = (const float*)(SC + 12 * S1); const float* Y = (const float*)(a.ws + WS_Y); const float* OG = Y + 2 * S1;
    const float* BON = (const float*)(a.ws + WS_SMALL); const bf16* P = (const bf16*)(a.ws + WS_P); bf16* O = (bf16*)(a.ws + WS_O);
    const float* lnw = a.in[I_LNW] + i * 1024; const float* lnb = a.in[I_LNB] + i * 1024; const float* gnw = a.in[I_GNW] + i * 128;
    for (int m = gw; m < NTOK; m += NGW) {
        for (int h = 0; h < 16; ++h) { const size_t o = (size_t)m * 1024 + h * 64 + lane; const float v = bf2f(SC[((size_t)m * 16 + h) * 576 + 128 + lane]); float acc = 0.f;
#pragma unroll
            for (int d = 0; d < 2; ++d) { const float y = Y[d * S1 + o]; const float mu = wave_sum(y) * (1.0f / 64.0f); const float dy = y - mu; const float var = wave_sum(dy * dy) * (1.0f / 64.0f);
                acc += dy * (1.0f / sqrtf(var + GN_EPS)) * lnw[h * 64 + lane] + lnb[h * 64 + lane] + BON[((size_t)m * 2 + d) * 16 + h] * v; }
            O[(size_t)m * D + h * 64 + lane] = (bf16)f2bf(acc * GT[o]); }
        for (int h = 0; h < 8; ++h) { float ov[2]; float ss = 0.f;
#pragma unroll
            for (int e = 0; e < 2; ++e) { const size_t o = (size_t)m * 1024 + h * 128 + lane + 64 * e; ov[e] = OG[o] + OG[S1 + o]; ss += ov[e] * ov[e]; }
            const float rs = 1.0f / sqrtf(wave_sum(ss) * (1.0f / 128.0f) + RMS_EPS);
#pragma unroll
            for (int e = 0; e < 2; ++e) { const int j = lane + 64 * e; const float z = bf2f(P[(size_t)m * PW + PC_Z + h * 128 + j]);
                O[(size_t)m * D + 1024 + h * 128 + j] = (bf16)f2bf(ov[e] * rs * gnw[j] * siluf_(z)); } }
    }
}

constexpr int PH_PER_LAYER = 9, N_PHASES = 2 + 4 * PH_PER_LAYER;
__host__ __device__ inline bool phase_exists(int ph) { if (ph == 0 || ph == N_PHASES - 1) return true; const int l = (ph - 1) / PH_PER_LAYER, k = (ph - 1) % PH_PER_LAYER; return (l & 1) ? !(k == 2 || k == 3 || k == 4) : true; }

#define RUN(ph) (a.ph_lo <= (ph) && (ph) < a.ph_hi)
#define SEAM(ph) do { if ((ph) + 1 < a.ph_hi) xcd_barrier(bar); } while (0)
#define SEAMX(ph) xcd_barrier(bar)
template <int L> __device__ __forceinline__ void run_layer(const Args& a, LAS unsigned char* lds, const XcdBarrier& bar) {
    constexpr int l = L, pb = 1 + PH_PER_LAYER * L, i = L >> 1;
    const int G = gridDim.x, bx = blockIdx.x;
    bf16* H = (bf16*)(a.ws + WS_H); bf16* O = (bf16*)(a.ws + WS_O); bf16* P = (bf16*)(a.ws + WS_P);
    const float* modl = (const float*)(a.ws + WS_MOD) + (size_t)l * 9 * 12288;
    if (RUN(pb + 0)) { ph_norm(a, l, 0); SEAM(pb + 0); }
#ifdef DUP_NORM
    if (RUN(pb + 0)) { ph_norm(a, l, 0); SEAMX(pb + 0); }
#endif
    if constexpr ((L & 1) == 0) {
        if (RUN(pb + 1)) { pg8::Gemm g{H, (const bf16*)(a.ws + WS_WIN) + (size_t)i * PW * 2048, NTOK, PW, 2048, 2048, 2048, 0, 0}; pg8::StaticOrder S; S.init(NTOK, PW, G, bx);
            pg8::EpiBf16 E{P, PW}; pg8::gemm_phase<pg8::EpiBf16, pg8::StaticOrder, true, true>(lds, g, S, E); SEAM(pb + 1); }
#ifdef DUP_GIN
        if (RUN(pb + 1)) { pg8::Gemm g{H, (const bf16*)(a.ws + WS_WIN) + (size_t)i * PW * 2048, NTOK, PW, 2048, 2048, 2048, 0, 0}; pg8::StaticOrder S; S.init(NTOK, PW, G, bx);
            pg8::EpiBf16 E{P, PW}; pg8::gemm_phase<pg8::EpiBf16, pg8::StaticOrder, true, true>(lds, g, S, E); SEAMX(pb + 1); }
#endif
        if (RUN(pb + 2)) { ph_prep(a, lds, i); SEAM(pb + 2); }
#ifdef DUP_PREP
        if (RUN(pb + 2)) { ph_prep(a, lds, i); SEAMX(pb + 2); }
#endif
        if (RUN(pb + 3)) { ph_scan(a, lds, i); SEAM(pb + 3); }
#ifdef DUP_SCAN
        if (RUN(pb + 3)) { ph_scan(a, lds, i); SEAMX(pb + 3); }
#endif
        if (RUN(pb + 4)) { ph_post(a, i); SEAM(pb + 4); }
#ifdef DUP_POST
        if (RUN(pb + 4)) { ph_post(a, i); SEAMX(pb + 4); }
#endif
        if (RUN(pb + 5)) { pg8::Gemm g{O, (const bf16*)(a.ws + WS_WOUT) + (size_t)i * 2048 * 2048, NTOK, 2048, 2048, 2048, 2048, 0, 0}; pg8::StaticOrder S; S.init(NTOK, 2048, G, bx);
            pg8::EpiResid E{l == 0 ? a.in[I_XP] : nullptr, a.in[I_XS], a.out, modl + 2 * 2048, nullptr};
            pg8::gemm_phase<pg8::EpiResid, pg8::StaticOrder, true, true>(lds, g, S, E); SEAM(pb + 5); }
    } else {
        if (RUN(pb + 1)) { ph_pool(a); SEAM(pb + 1); }
#ifdef DUP_POOL
        if (RUN(pb + 1)) { ph_pool(a); SEAMX(pb + 1); }
#endif
        if (RUN(pb + 5)) { pg8::Gemm g{O, (const bf16*)(a.ws + WS_WPOOL) + (size_t)i * 2048 * 512, NTOK, 2048, 512, 2048, 512, 1, 512}; pg8::StaticOrder S; S.init(NTOK, 2048, G, bx);
            pg8::EpiResid E{nullptr, nullptr, a.out, modl + 2 * 2048, a.in[I_POOLS] + i * 2048};
            pg8::gemm_phase<pg8::EpiResid, pg8::StaticOrder, true, true>(lds, g, S, E); SEAM(pb + 5); }
    }
    if (RUN(pb + 6)) { ph_norm(a, l, 1); SEAM(pb + 6); }
    if (RUN(pb + 7)) { pg8::Gemm g{H, (const bf16*)(a.ws + WS_WGU) + (size_t)l * 11264 * 2048, NTOK, 11264, 2048, 2048, 2048, 0, 0}; pg8::StaticOrder S; S.init(NTOK, 11264, G, bx);
        pg8::EpiSwiGLU E{P, DFF}; pg8::gemm_phase<pg8::EpiSwiGLU, pg8::StaticOrder, true, true>(lds, g, S, E); SEAM(pb + 7); }
#ifdef DUP_GGU
    if (RUN(pb + 7)) { pg8::Gemm g{H, (const bf16*)(a.ws + WS_WGU) + (size_t)l * 11264 * 2048, NTOK, 11264, 2048, 2048, 2048, 0, 0}; pg8::StaticOrder S; S.init(NTOK, 11264, G, bx);
        pg8::EpiSwiGLU E{P, DFF}; pg8::gemm_phase<pg8::EpiSwiGLU, pg8::StaticOrder, true, true>(lds, g, S, E); SEAMX(pb + 7); }
#endif
    if (RUN(pb + 8)) { pg8::Gemm g{P, (const bf16*)(a.ws + WS_WDN) + (size_t)l * 2048 * DFF, NTOK, 2048, DFF, DFF, DFF, 0, 0}; pg8::StaticOrder S; S.init(NTOK, 2048, G, bx);
        pg8::EpiResid E{nullptr, nullptr, a.out, modl + 5 * 2048, nullptr};
        pg8::gemm_phase<pg8::EpiResid, pg8::StaticOrder, true, true>(lds, g, S, E); SEAM(pb + 8); }
}

__global__ void __launch_bounds__(NTHR, 2) fwd(Args a) {
    extern __shared__ __attribute__((aligned(16))) unsigned char lds_raw[];
    LAS unsigned char* lds = (LAS unsigned char*)lds_raw;
    const int tid = threadIdx.x;
    volatile LAS unsigned* MISC = (volatile LAS unsigned*)(lds + LDS_MISC);
    for (int u = tid; u < (LDS_BYTES - LDS_STAGE) / 4; u += NTHR) ((LAS unsigned*)(lds + LDS_STAGE))[u] = 0u;
    __syncthreads();
    XcdBarrier bar; bar.bar = (unsigned*)(a.ws + WS_CTL) + CW_BAR; bar.x = 0; bar.st = nullptr;
    const bool multi = a.ph_hi - a.ph_lo > 1;
    if (multi) bar = xcd_barrier_post((unsigned*)(a.ws + WS_CTL) + CW_BAR, MISC + 8);
    if (RUN(0)) { ph_pre(a, lds); SEAM(0); }
#ifdef DUP_PRE
    if (RUN(0)) { ph_pre(a, lds); SEAMX(0); }
#endif
    run_layer<0>(a, lds, bar);
    run_layer<1>(a, lds, bar);
    run_layer<2>(a, lds, bar);
    run_layer<3>(a, lds, bar);
    if (RUN(N_PHASES - 1)) ph_final(a);
}
#undef RUN
#undef SEAM
#undef SEAMX

#ifndef MK_ONE_LAUNCH
#define MK_ONE_LAUNCH 1
#endif
extern "C" void kernel_launch(void* const* d_in, const int* in_sizes, int n_in, void* d_out, int out_size, void* d_ws, size_t ws_size, hipStream_t stream) {
    static int grid = 0;
    if (grid == 0) {
        if (n_in != N_IN || ws_size < WS_END) { fprintf(stderr, "kernel_launch: expected %d inputs and >= %zu bytes of workspace; got %d, %zu\n", (int)N_IN, (size_t)WS_END, n_in, ws_size); grid = -1; return; }
        int dev = 0, cus = 0, per_cu = 0;
        if (hipGetDevice(&dev) != hipSuccess || hipDeviceGetAttribute(&cus, hipDeviceAttributeMultiprocessorCount, dev) != hipSuccess) { grid = -1; return; }
        if (hipFuncSetAttribute((const void*)fwd, hipFuncAttributeMaxDynamicSharedMemorySize, LDS_BYTES) != hipSuccess) { fprintf(stderr, "kernel_launch: hipFuncSetAttribute failed\n"); grid = -1; return; }
        if (hipOccupancyMaxActiveBlocksPerMultiprocessor(&per_cu, (const void*)fwd, NTHR, LDS_BYTES) != hipSuccess || per_cu < 1) fprintf(stderr, "kernel_launch: occupancy query reports %d\n", per_cu);
        (void)hipGetLastError();
        grid = cus;
    }
    if (grid < 0) return;
    if (hipMemsetAsync((char*)d_ws + WS_CTL, 0, CTL_ZERO_BYTES, stream) != hipSuccess) return;
    Args a{};
    for (int i = 0; i < N_IN; ++i) a.in[i] = (const float*)d_in[i];
    a.out = (float*)d_out; a.ws = (unsigned char*)d_ws;
#if MK_ONE_LAUNCH
    a.ph_lo = 0; a.ph_hi = N_PHASES;
    hipLaunchKernelGGL(fwd, dim3(grid), dim3(NTHR), LDS_BYTES, stream, a);
#else
    for (int ph = 0; ph < N_PHASES; ++ph) { if (!phase_exists(ph)) continue; a.ph_lo = ph; a.ph_hi = ph + 1; hipLaunchKernelGGL(fwd, dim3(grid), dim3(NTHR), LDS_BYTES, stream, a); }
#endif
}
```

```cpp
#include <hip/hip_runtime.h>
#include <cstdio>
#include <cstdint>

namespace pg8 {
#define PG8_LAS __attribute__((address_space(3)))
typedef unsigned short bf16_t;
typedef short bf16x8 __attribute__((ext_vector_type(8)));
typedef float f32x4 __attribute__((ext_vector_type(4)));
typedef unsigned u32x4 __attribute__((ext_vector_type(4)));
constexpr int BM = 256, BK = 64, HALF = 128, HTB = HALF * BK * 2  , STAGE_BYTES = 8 * HTB, NXCD = 8, WGM = 8;

__host__ __device__ __forceinline__ int lds_byte(int r, int c) { const int st = (r >> 4) * 2 + (c >> 5), rr = r & 15, cc = c & 31, ob = rr * 64 + cc * 2; return st * 1024 + (ob ^ (((ob >> 9) & 1) << 5)); }
__host__ __device__ __forceinline__ void stage_rc(int b, int& R, int& C) { const int st = b / 1024, sb = b % 1024, swz = sb ^ (((sb >> 9) & 1) << 5); R = (st >> 1) * 16 + swz / 64; C = (st & 1) * 32 + (swz % 64) / 2; }
__host__ __device__ __forceinline__ int perm32(int rho) { const int n = rho >> 4, i = rho & 15; return 8 * (i >> 2) + 4 * n + (i & 3); }

struct Unit { int pm, pn; };
struct Gemm { const bf16_t* A; const bf16_t* Bt; int M, N, K, lda, ldb, gsh, gk; };

struct StaticOrder {
    int nM, nN, nwg, G, c;
    __host__ __device__ void init(int M, int N, int G_, int c_) { nM = M / BM; nN = N / BM; nwg = nM * nN; G = G_; c = c_; }
    __host__ __device__ bool next(int i, Unit& u) const {
        const long L = (long)i * G + c; if (L >= nwg) return false;
        int wgid = (int)L; { const int q = nwg / NXCD, r = nwg % NXCD, xcd = wgid % NXCD, off = wgid / NXCD; wgid = (xcd < r ? xcd * (q + 1) : r * (q + 1) + (xcd - r) * q) + off; }
        const int nig = WGM * nN, gid = wgid / nig, fm = gid * WGM, gsz = (nM - fm) < WGM ? (nM - fm) : WGM;
        u.pm = fm + ((wgid % nig) % gsz); u.pn = (wgid % nig) / gsz; return true;
    }
    __device__ __forceinline__ void a_ready(const Unit&) const {}
    __device__ __forceinline__ void done(const Unit&) const {}
};

__device__ __forceinline__ unsigned cvt_pk_bf16(float lo, float hi) { unsigned r; asm volatile("v_cvt_pk_bf16_f32 %0, %1, %2" : "=v"(r) : "v"(lo), "v"(hi)); return r; }

__device__ __forceinline__ int cond_of_panel(int pm) { return pm < 16 ? 0 : 1 + ((pm - 16) >> 2); }

struct EpiBf16 {
    static constexpr bool PERM = true, AFTER_DRAIN = false;
    bf16_t* O; int ldc;
    __device__ __forceinline__ void operator()(const f32x4 (&acc)[2][2][4][2], const Unit& u, int wr, int wc, int fr, int fq) const {
        const int row0 = u.pm * BM + wr * 64 + fr; const int col0 = u.pn * BM + wc * 32 + 8 * fq;
#pragma unroll
        for (int ai = 0; ai < 2; ++ai)
#pragma unroll
            for (int m = 0; m < 4; ++m) { bf16_t* rowp = O + (size_t)(row0 + ai * HALF + m * 16) * ldc + col0;
#pragma unroll
                for (int bj = 0; bj < 2; ++bj) { const f32x4 v0 = acc[ai][bj][m][0], v1 = acc[ai][bj][m][1];
                    u32x4 w; w.x = cvt_pk_bf16(v0[0], v0[1]); w.y = cvt_pk_bf16(v0[2], v0[3]); w.z = cvt_pk_bf16(v1[0], v1[1]); w.w = cvt_pk_bf16(v1[2], v1[3]);
                    *(u32x4*)(rowp + bj * HALF) = w; } }
    }
};
struct EpiSwiGLU {
    static constexpr bool PERM = true, AFTER_DRAIN = false;
    bf16_t* O; int ldc;
    __device__ __forceinline__ void operator()(const f32x4 (&acc)[2][2][4][2], const Unit& u, int wr, int wc, int fr, int fq) const {
        const int row0 = u.pm * BM + wr * 64 + fr; const int col0 = u.pn * HALF + wc * 32 + 8 * fq;
#pragma unroll
        for (int ai = 0; ai < 2; ++ai)
#pragma unroll
            for (int m = 0; m < 4; ++m) { bf16_t* rowp = O + (size_t)(row0 + ai * HALF + m * 16) * ldc + col0;
                float o[8];
#pragma unroll
                for (int n = 0; n < 2; ++n)
#pragma unroll
                    for (int e = 0; e < 4; ++e) { const float gte = acc[ai][0][m][n][e], up = acc[ai][1][m][n][e]; o[n * 4 + e] = gte * __builtin_amdgcn_rcpf(1.0f + __expf(-gte)) * up; }
                u32x4 w; w.x = cvt_pk_bf16(o[0], o[1]); w.y = cvt_pk_bf16(o[2], o[3]); w.z = cvt_pk_bf16(o[4], o[5]); w.w = cvt_pk_bf16(o[6], o[7]);
                *(u32x4*)rowp = w; }
    }
};
struct EpiResid {
    static constexpr bool PERM = false, AFTER_DRAIN = false;
    const float* xin_p; const float* xin_s; float* xout; const float* gate  ; const float* cscale;
    __device__ __forceinline__ void operator()(const f32x4 (&acc)[2][2][4][2], const Unit& u, int wr, int wc, int fr, int fq) const {
        const int row0 = u.pm * BM + wr * 64 + fr, col0 = u.pn * BM + wc * 32 + 4 * fq;
        const float* gp = gate + (size_t)cond_of_panel(u.pm) * 12288 + col0;
        f32x4 gv[2][2];
#pragma unroll
        for (int bj = 0; bj < 2; ++bj)
#pragma unroll
            for (int n = 0; n < 2; ++n) { gv[bj][n] = *(const f32x4*)(gp + bj * HALF + n * 16); if (cscale) gv[bj][n] = gv[bj][n] * *(const f32x4*)(cscale + col0 + bj * HALF + n * 16); }
#pragma unroll
        for (int ai = 0; ai < 2; ++ai)
#pragma unroll
            for (int m = 0; m < 4; ++m) { const int row = row0 + ai * HALF + m * 16;
                const float* xi = xin_p ? (row < 4096 ? xin_p + (size_t)row * 2048 : xin_s + (size_t)(row - 4096) * 2048) : xout + (size_t)row * 2048;
                float* xo = xout + (size_t)row * 2048;
#pragma unroll
                for (int bj = 0; bj < 2; ++bj)
#pragma unroll
                    for (int n = 0; n < 2; ++n) { const f32x4 xv = *(const f32x4*)(xi + col0 + bj * HALF + n * 16); *(f32x4*)(xo + col0 + bj * HALF + n * 16) = xv + gv[bj][n] * acc[ai][bj][m][n]; } }
    }
};

template <class Epi, class Sched, bool ALIGN_EPI = false, bool SP2 = false>
__device__ __forceinline__ void gemm_phase(PG8_LAS unsigned char* lds, const Gemm g, const Sched& S, const Epi& E) {
    const int tid = threadIdx.x, wid = __builtin_amdgcn_readfirstlane(tid >> 6), lane = tid & 63, wr = wid >> 2, wc = wid & 3, fr = lane & 15, fq = lane >> 4;
    const int K = g.K, nt = K / BK;
    unsigned voffA[2], voffB[2];
#pragma unroll
    for (int i = 0; i < 2; ++i) { int R, C; stage_rc(tid * 16 + i * 8192, R, C); const int Rb = Epi::PERM ? ((R & ~31) + perm32(R & 31)) : R;
        voffA[i] = (unsigned)(R * g.lda + C) * 2u; voffB[i] = (unsigned)(Rb * g.ldb + C) * 2u; }
    const size_t kstep = (size_t)(BK * 2);
    const size_t hstepA = (size_t)HALF * g.lda * 2, hstepB = (size_t)HALF * g.ldb * 2;
    const size_t tstepA = 2 * hstepA, tstepB = 2 * hstepB;
    const unsigned ldsw = (unsigned)wid * 1024u;
    const int aoff = lds_byte(wr * 64 + fr, fq * 8), boff = lds_byte(wc * 32 + fr, fq * 8);
#define PG8_SA(b, h) (((b) * 2 + (h)) * HTB)
#define PG8_SB(b, h) ((4 + (b) * 2 + (h)) * HTB)
#define PG8_STAGE(bufoff, gbase, voff) do { _Pragma("unroll") for (int _i = 0; _i < 2; ++_i) \
        __builtin_amdgcn_global_load_lds((const unsigned*)((const char*)(gbase) + (voff)[_i]), (PG8_LAS unsigned*)(lds + (bufoff) + ldsw + _i * 8192), 16, 0, 0); } while (0)
#define PG8_LDA(dst, b, h) do { _Pragma("unroll") for (int m = 0; m < 4; ++m) _Pragma("unroll") for (int k = 0; k < 2; ++k) dst[m][k] = *(const PG8_LAS bf16x8*)(lds + PG8_SA(b, h) + aoff + m * 2048 + k * 1024); } while (0)
#define PG8_LDB(dst, b, h) do { _Pragma("unroll") for (int n = 0; n < 2; ++n) _Pragma("unroll") for (int k = 0; k < 2; ++k) dst[n][k] = *(const PG8_LAS bf16x8*)(lds + PG8_SB(b, h) + boff + n * 2048 + k * 1024); } while (0)
#define PG8_MMA(ai, bj, At, Bt) do { __builtin_amdgcn_s_setprio(1); _Pragma("unroll") for (int m = 0; m < 4; ++m) _Pragma("unroll") for (int n = 0; n < 2; ++n) _Pragma("unroll") for (int k = 0; k < 2; ++k) \
        acc[ai][bj][m][n] = __builtin_amdgcn_mfma_f32_16x16x32_bf16(Bt[n][k], At[m][k], acc[ai][bj][m][n], 0, 0, 0); __builtin_amdgcn_s_setprio(0); } while (0)
#define PG8_WAIT_V(n) asm volatile("s_waitcnt vmcnt(" #n ")" ::: "memory")
#define PG8_WAIT_L(n) asm volatile("s_waitcnt lgkmcnt(" #n ")" ::: "memory")
#define PG8_BAR __builtin_amdgcn_s_barrier()
#define PG8_SCHED __builtin_amdgcn_sched_barrier(0)
    Unit cur, nxt; int ui = 0;
    if (!S.next(0, cur)) return;
    f32x4 acc[2][2][4][2];
#pragma unroll
    for (int a = 0; a < 2; ++a)
#pragma unroll
        for (int b = 0; b < 2; ++b)
#pragma unroll
            for (int m = 0; m < 4; ++m)
#pragma unroll
                for (int n = 0; n < 2; ++n) acc[a][b][m][n] = (f32x4){0.f, 0.f, 0.f, 0.f};
    bf16x8 At[4][2], B0[2][2], B1[2][2];
    const char* cA = (const char*)g.A + (size_t)cur.pm * tstepA + (size_t)((cur.pn >> g.gsh) * g.gk) * 2; const char* cB = (const char*)g.Bt + (size_t)cur.pn * tstepB;
    S.a_ready(cur);
    if constexpr (SP2) {
        PG8_STAGE(PG8_SB(0, 0), cB, voffB); PG8_STAGE(PG8_SB(0, 1), cB + hstepB, voffB); PG8_STAGE(PG8_SA(0, 0), cA, voffA); PG8_STAGE(PG8_SA(0, 1), cA + hstepA, voffA);
        if (wr == 1) PG8_BAR;
        PG8_WAIT_V(2); PG8_BAR;
        PG8_STAGE(PG8_SB(1, 0), cB + kstep, voffB); PG8_STAGE(PG8_SA(1, 0), cA + kstep, voffA); PG8_STAGE(PG8_SB(1, 1), cB + hstepB + kstep, voffB);
        PG8_WAIT_V(6); PG8_BAR;
    } else {
        PG8_STAGE(PG8_SB(0, 0), cB, voffB); PG8_STAGE(PG8_SA(0, 0), cA, voffA); PG8_STAGE(PG8_SB(0, 1), cB + hstepB, voffB); PG8_STAGE(PG8_SA(0, 1), cA + hstepA, voffA);
        if (wr == 1) PG8_BAR;
        PG8_WAIT_V(4); PG8_BAR;
        PG8_STAGE(PG8_SB(1, 0), cB + kstep, voffB); PG8_STAGE(PG8_SA(1, 0), cA + kstep, voffA); PG8_STAGE(PG8_SB(1, 1), cB + hstepB + kstep, voffB);
        PG8_WAIT_V(6); PG8_BAR;
    }
    for (;;) {
        const bool has_next = S.next(ui + 1, nxt);
        const char* nA = has_next ? (const char*)g.A + (size_t)nxt.pm * tstepA + (size_t)((nxt.pn >> g.gsh) * g.gk) * 2 : cA; const char* nB = has_next ? (const char*)g.Bt + (size_t)nxt.pn * tstepB : cB;
        for (int t = 0; t < nt; t += 2) {
            const bool last = (t == nt - 2);
            const char* a1 = cA + (size_t)(t + 1) * kstep;
            const char* a2 = last ? nA : cA + (size_t)(t + 2) * kstep; const char* b2 = last ? nB : cB + (size_t)(t + 2) * kstep;
            const char* a3 = a2 + kstep; const char* b3 = b2 + kstep;
            if (last && has_next) S.a_ready(nxt);
            if constexpr (SP2) {
            PG8_LDB(B0, 0, 0); PG8_LDB(B1, 0, 1); PG8_SCHED; PG8_LDA(At, 0, 0); PG8_STAGE(PG8_SA(1, 1), a1 + hstepA, voffA);
            PG8_WAIT_V(8); PG8_WAIT_L(0); PG8_BAR; PG8_MMA(0, 0, At, B0); PG8_MMA(0, 1, At, B1); PG8_BAR; PG8_SCHED;
            PG8_LDA(At, 0, 1); PG8_STAGE(PG8_SB(0, 0), b2, voffB); PG8_STAGE(PG8_SB(0, 1), b2 + hstepB, voffB); PG8_STAGE(PG8_SA(0, 0), a2, voffA);
            PG8_WAIT_V(8); PG8_WAIT_L(0); PG8_BAR; PG8_MMA(1, 0, At, B0); PG8_MMA(1, 1, At, B1); PG8_BAR; PG8_SCHED;
            PG8_LDB(B0, 1, 0); PG8_LDB(B1, 1, 1); PG8_SCHED; PG8_LDA(At, 1, 0); PG8_STAGE(PG8_SA(0, 1), a2 + hstepA, voffA);
            PG8_WAIT_V(8); PG8_WAIT_L(0); PG8_BAR; PG8_MMA(0, 0, At, B0); PG8_MMA(0, 1, At, B1); PG8_BAR; PG8_SCHED;
            PG8_LDA(At, 1, 1); PG8_STAGE(PG8_SB(1, 0), b3, voffB); PG8_STAGE(PG8_SB(1, 1), b3 + hstepB, voffB); PG8_STAGE(PG8_SA(1, 0), a3, voffA);
            PG8_WAIT_V(8); PG8_WAIT_L(0); PG8_BAR; PG8_MMA(1, 0, At, B0); PG8_MMA(1, 1, At, B1); PG8_BAR; PG8_SCHED;
            } else {
            PG8_LDB(B0, 0, 0); PG8_SCHED; PG8_LDA(At, 0, 0); PG8_STAGE(PG8_SA(1, 1), a1 + hstepA, voffA);
            PG8_WAIT_L(8); PG8_BAR; PG8_WAIT_L(0); PG8_MMA(0, 0, At, B0); PG8_BAR; PG8_SCHED;
            PG8_LDB(B1, 0, 1); PG8_STAGE(PG8_SB(0, 0), b2, voffB);
            PG8_BAR; PG8_WAIT_L(0); PG8_MMA(0, 1, At, B1); PG8_BAR;
            PG8_LDA(At, 0, 1); PG8_STAGE(PG8_SA(0, 0), a2, voffA);
            PG8_BAR; PG8_WAIT_L(0); PG8_MMA(1, 0, At, B0); PG8_BAR; PG8_SCHED;
            PG8_STAGE(PG8_SB(0, 1), b2 + hstepB, voffB);
            PG8_WAIT_V(6); PG8_BAR; PG8_MMA(1, 1, At, B1); PG8_BAR;
            PG8_LDB(B0, 1, 0); PG8_SCHED; PG8_LDA(At, 1, 0); PG8_STAGE(PG8_SA(0, 1), a2 + hstepA, voffA);
            PG8_WAIT_L(8); PG8_BAR; PG8_WAIT_L(0); PG8_MMA(0, 0, At, B0); PG8_BAR; PG8_SCHED;
            PG8_LDB(B1, 1, 1); PG8_STAGE(PG8_SB(1, 0), b3, voffB);
            PG8_BAR; PG8_WAIT_L(0); PG8_MMA(0, 1, At, B1); PG8_BAR;
            PG8_LDA(At, 1, 1); PG8_STAGE(PG8_SA(1, 0), a3, voffA);
            PG8_BAR; PG8_WAIT_L(0); PG8_MMA(1, 0, At, B0); PG8_BAR; PG8_SCHED;
            PG8_STAGE(PG8_SB(1, 1), b3 + hstepB, voffB);
            PG8_WAIT_V(6); PG8_BAR; PG8_MMA(1, 1, At, B1); PG8_BAR;
            }
        }
        if constexpr (ALIGN_EPI) { if (wr == 0) PG8_BAR; }
        if constexpr (!Epi::AFTER_DRAIN) { E(acc, cur, wr, wc, fr, fq); S.done(cur); }
        if (!has_next) break;
#pragma unroll
        for (int a = 0; a < 2; ++a)
#pragma unroll
            for (int b = 0; b < 2; ++b)
#pragma unroll
                for (int m = 0; m < 4; ++m)
#pragma unroll
                    for (int n = 0; n < 2; ++n) acc[a][b][m][n] = (f32x4){0.f, 0.f, 0.f, 0.f};
        cur = nxt; cA = nA; cB = nB; ++ui;
        if constexpr (ALIGN_EPI) { if (wr == 1) PG8_BAR; }
    }
    PG8_WAIT_V(0);
    if constexpr (!ALIGN_EPI) { if (wr == 0) PG8_BAR; }
    PG8_BAR;
    if constexpr (Epi::AFTER_DRAIN) { E.fused(acc, cur, wr, wc, fr, fq, lds, wid, lane); S.done(cur); }
#undef PG8_SA
#undef PG8_SB
#undef PG8_STAGE
#undef PG8_LDA
#undef PG8_LDB
#undef PG8_MMA
#undef PG8_WAIT_V
#undef PG8_WAIT_L
#undef PG8_BAR
#undef PG8_SCHED
}
}

constexpr int D = 2048, NTOK = 12288, NPROMPT = 4096, DFF = 5632, PW = 7680  , CPA = 3488;
constexpr int NWAVES = 8, NTHR = 512;
constexpr int PC_GDN = 3072, PC_Z = 6144, PC_LORA = 7168, PC_BETA = 7584, PC_ALPHA = 7600;
constexpr float RMS_EPS = 1e-6f, GN_EPS = 64e-5f;

constexpr size_t MiB = 1u << 20;
constexpr size_t WS_CTL = 0, CTL_ZERO_BYTES = 1 * MiB;
constexpr size_t WS_MOD = 1 * MiB;
constexpr size_t WS_WIN = 3 * MiB;
constexpr size_t WS_WOUT = 63 * MiB;
constexpr size_t WS_WGU = 79 * MiB;
constexpr size_t WS_WDN = 255 * MiB;
constexpr size_t WS_WPOOL = 343 * MiB;
constexpr size_t WS_H = 347 * MiB;
constexpr size_t WS_O = 395 * MiB;
constexpr size_t WS_P = 443 * MiB;
constexpr size_t WS_SC = 623 * MiB;
constexpr size_t SC_ONE = 48 * MiB;
constexpr size_t WS_Y = 1247 * MiB;
constexpr size_t WS_SMALL = 1439 * MiB;
constexpr size_t WS_LORA = 1443 * MiB;
constexpr size_t WS_END = 1445 * MiB;
constexpr int CW_BAR = 4096;

constexpr int LDS_STAGE = 131072, LDS_MISC = LDS_STAGE + 320, LDS_BYTES = 147456;

#define GAS __attribute__((address_space(1)))
#define LAS __attribute__((address_space(3)))
typedef unsigned short bf16;
typedef unsigned v4u __attribute__((ext_vector_type(4)));
typedef unsigned v2u __attribute__((ext_vector_type(2)));
typedef float f32x4 __attribute__((ext_vector_type(4)));
typedef float f32x2 __attribute__((ext_vector_type(2)));
#define LDS_WAIT() asm volatile("s_waitcnt lgkmcnt(0)" ::: "memory")

__device__ __forceinline__ unsigned f2bf(float f) { unsigned u = __builtin_bit_cast(unsigned, f); return (u + 0x7fffu + ((u >> 16) & 1u)) >> 16; }
__device__ __forceinline__ unsigned pk2(float lo, float hi) { return f2bf(lo) | (f2bf(hi) << 16); }
__device__ __forceinline__ float bf2f(bf16 b) { return __builtin_bit_cast(float, (unsigned)b << 16); }
__device__ __forceinline__ float bflo(unsigned w) { return __builtin_bit_cast(float, w << 16); }
__device__ __forceinline__ float bfhi(unsigned w) { return __builtin_bit_cast(float, w & 0xffff0000u); }
__device__ __forceinline__ float sigmoidf_(float x) { return 1.0f / (1.0f + __expf(-x)); }
__device__ __forceinline__ float siluf_(float x) { return x / (1.0f + __expf(-x)); }
__device__ __forceinline__ float softplusf_(float x) { return x > 20.f ? x : log1pf(__expf(x)); }
__device__ __forceinline__ float wave_sum(float v) {
#pragma unroll
    for (int o = 1; o < 64; o <<= 1) v += __shfl_xor(v, o);
    return v;
}
__device__ __forceinline__ int opaque_tid() { int t = threadIdx.x; asm volatile("" : "+v"(t)); return t; }
__device__ __forceinline__ float rdl(float v, int k) { return __builtin_bit_cast(float, __builtin_amdgcn_readlane(__builtin_bit_cast(int, v), k)); }

#define XB_TMO      128
#define XB_XCNT(j)  (256  + 64 * (j))
#define XB_XSUB(j)  (1280 + 64 * (j))
#define XB_XGEN(j)  (2304 + 64 * (j))
#define XB_TOP      3328
#define XB_TOPGEN   3392
#define XCD_BAR_WORDS 3456
#define XB_SPIN_CAP (1u << 18)
__device__ __forceinline__ unsigned xb_ld(unsigned* p)              { return __hip_atomic_load(p, __ATOMIC_RELAXED, __HIP_MEMORY_SCOPE_AGENT); }
__device__ __forceinline__ unsigned xb_add(unsigned* p, unsigned v) { return __hip_atomic_fetch_add(p, v, __ATOMIC_RELAXED, __HIP_MEMORY_SCOPE_AGENT); }
__device__ __forceinline__ unsigned xb_xcc_id() { return (unsigned)__builtin_amdgcn_s_getreg((3 << 11) | 20) & 0xFu; }
#define XB_SPIN(cond, bar) do { unsigned _sp = 0; while (cond) { __builtin_amdgcn_s_sleep(1); \
    if ((++_sp & 255u) == 0u) { if (xb_ld(&(bar)[XB_TMO])) break; if (_sp > XB_SPIN_CAP) { atomicAdd(&(bar)[XB_TMO], 1u); break; } } } } while (0)
struct XcdBarrier { unsigned* bar; unsigned x; volatile LAS unsigned* st; };
__device__ __forceinline__ XcdBarrier xcd_barrier_post(unsigned* bar, volatile LAS unsigned* st) {
    XcdBarrier b; b.bar = bar; b.x = xb_xcc_id(); b.st = st;
    if (threadIdx.x == 0) (void)xb_add(&bar[XB_XCNT(b.x)], 1u);
    return b;
}
__device__ __forceinline__ void xcd_barrier_complete(unsigned* bar, unsigned x, unsigned& nloc, unsigned& nx) {
    const unsigned G = gridDim.x * gridDim.y * gridDim.z;
    unsigned sum, cnt, mine, sp = 0u;
    for (;;) {
        sum = 0u; cnt = 0u; mine = 0u;
#pragma unroll
        for (unsigned j = 0; j < 16; ++j) { const unsigned c = xb_ld(&bar[XB_XCNT(j)]); sum += c; cnt += (c > 0u) ? 1u : 0u; mine = (j == x) ? c : mine; }
        if (sum == G) break;
        __builtin_amdgcn_s_sleep(1);
        if ((++sp & 255u) == 0u) { if (xb_ld(&bar[XB_TMO])) break; if (sp > XB_SPIN_CAP) { atomicAdd(&bar[XB_TMO], 1u); break; } }
    }
    nloc = mine > 0u ? mine : 1u; nx = cnt > 0u ? cnt : 1u;
}
__device__ __forceinline__ void xcd_barrier(const XcdBarrier& b) {
    asm volatile("s_waitcnt vmcnt(0)" ::: "memory");
    __syncthreads();
    if (threadIdx.x == 0) {
        unsigned* bar = b.bar;
        __builtin_amdgcn_s_waitcnt(0);
        unsigned nloc = b.st[0], nx = b.st[1];
        if (nloc == 0u) { xcd_barrier_complete(bar, b.x, nloc, nx); b.st[0] = nloc; b.st[1] = nx; }
        const unsigned old = xb_add(&bar[XB_XSUB(b.x)], 1u);
        const unsigned gen = old / nloc;
        if (old + 1u == (gen + 1u) * nloc) {
            __builtin_amdgcn_fence(__ATOMIC_RELEASE, "agent");
            asm volatile("s_waitcnt vmcnt(0)" ::: "memory");
            const unsigned og = xb_add(&bar[XB_TOP], 1u);
            const unsigned tg = og / nx;
            if (og + 1u == (tg + 1u) * nx) xb_add(&bar[XB_TOPGEN], 1u);
            else XB_SPIN(xb_ld(&bar[XB_TOPGEN]) == tg, bar);
            __builtin_amdgcn_fence(__ATOMIC_ACQUIRE, "agent");
            xb_add(&bar[XB_XGEN(b.x)], 1u);
            asm volatile("s_waitcnt vmcnt(0)" ::: "memory");
        } else {
            XB_SPIN(xb_ld(&bar[XB_XGEN(b.x)]) == gen, bar);
            __builtin_amdgcn_fence(__ATOMIC_ACQUIRE, "agent");
            asm volatile("s_waitcnt vmcnt(0)" ::: "memory");
        }
    }
    __syncthreads();
}

enum { I_XP = 0, I_XS, I_SRW, I_SDL, I_C, I_CCTX, I_MODW, I_MODB, I_NMIX, I_NFFN, I_NFIN, I_WIN, I_WOUT, I_MU, I_W0, I_W2, I_A0, I_A2, I_G2, I_KK, I_KA, I_RK, I_LNW, I_LNB,
       I_CONVW, I_ALOG, I_DTB, I_GNW, I_POOLW, I_POOLS, I_WG, I_WU, I_WD, N_IN };
struct Args { const float* in[N_IN]; float* out; unsigned char* ws; int ph_lo, ph_hi; };
constexpr size_t OUT_SRW = (size_t)NTOK * D, OUT_SDL = OUT_SRW + (size_t)16 * 2 * 2 * 16 * 64 * 64;

__device__ __forceinline__ void conv_item(const float* W, int K, int N, bf16* WT, int drow0, LAS float* scr, int kb, int nb, int lane) {
    const int k0 = 64 * kb, n0 = 32 * nb;
#pragma unroll 8
    for (int i = 0; i < 32; ++i) { const int kk = 2 * i + (lane >> 5); scr[kk * 33 + (lane & 31)] = W[(size_t)(k0 + kk) * N + n0 + (lane & 31)]; }
    LDS_WAIT(); asm volatile("" ::: "memory");
    const int c = lane & 7;
#pragma unroll
    for (int j = 0; j < 4; ++j) { const int n = (lane >> 3) + 8 * j; const LAS float* s = scr + (8 * c) * 33 + n;
        v4u o; o.x = pk2(s[0 * 33], s[1 * 33]); o.y = pk2(s[2 * 33], s[3 * 33]); o.z = pk2(s[4 * 33], s[5 * 33]); o.w = pk2(s[6 * 33], s[7 * 33]);
        *(v4u*)(WT + (size_t)(drow0 + n) * K + k0 + 8 * c) = o; }
    LDS_WAIT(); asm volatile("" ::: "memory");
}
__device__ __forceinline__ int win_row(int n) { return n < 3072 ? n : (n < CPA ? PC_LORA + (n - 3072) : (n < CPA + 4096 ? PC_GDN + (n - CPA) : n)); }

__device__ __forceinline__ void ph_pre(const Args& a, LAS unsigned char* lds) {
    const int tid = opaque_tid(), lane = tid & 63, wave = __builtin_amdgcn_readfirstlane(tid >> 6);
    const int G = gridDim.x;
    LAS float* ca = (LAS float*)lds;
    LAS float* red = (LAS float*)(lds + 2048 * 9 * 4);
    for (int i = tid; i < 9 * 2048; i += NTHR) { const int c = i / 2048, k = i - c * 2048; const float v = c == 0 ? a.in[I_CCTX][k] : a.in[I_C][(c - 1) * 2048 + k]; ca[k * 9 + c] = siluf_(v); }
    __syncthreads();
    float* MOD = (float*)(a.ws + WS_MOD);
    for (int task = blockIdx.x; task < 4 * 96; task += G) {
        const int l = task / 96, cb = task - l * 96;
        const float* wp = a.in[I_MODW] + ((size_t)l * 2048 + wave * 256) * 12288 + cb * 128 + lane * 2;
        float acc[9][2];
#pragma unroll
        for (int c = 0; c < 9; ++c) { acc[c][0] = 0.f; acc[c][1] = 0.f; }
        for (int k8 = 0; k8 < 256; k8 += 8) {
            f32x2 wv[8];
#pragma unroll
            for (int j = 0; j < 8; ++j) wv[j] = *(const f32x2*)(wp + (size_t)(k8 + j) * 12288);
#pragma unroll
            for (int j = 0; j < 8; ++j) { const LAS float* cp = ca + (wave * 256 + k8 + j) * 9;
#pragma unroll
                for (int c = 0; c < 9; ++c) { const float s = cp[c]; acc[c][0] += s * wv[j].x; acc[c][1] += s * wv[j].y; } }
        }
#pragma unroll
        for (int c = 0; c < 9; ++c) { red[(wave * 18 + c * 2) * 64 + lane] = acc[c][0]; red[(wave * 18 + c * 2 + 1) * 64 + lane] = acc[c][1]; }
        __syncthreads();
        for (int o = tid; o < 9 * 128; o += NTHR) { const int c = o >> 7, col = o & 127, ln = col >> 1, j = col & 1; float s = a.in[I_MODB][l * 12288 + cb * 128 + col];
#pragma unroll
            for (int w = 0; w < 8; ++w) s += red[(w * 18 + c * 2 + j) * 64 + ln];
            MOD[((size_t)l * 9 + c) * 12288 + cb * 128 + col] = s; }
        __syncthreads();
    }
    __syncthreads();
    LAS float* scr = (LAS float*)(lds + wave * 16384);
    const int gw = blockIdx.x * NWAVES + wave, NGW = G * NWAVES;
    bf16* WIN = (bf16*)(a.ws + WS_WIN); bf16* WOUT = (bf16*)(a.ws + WS_WOUT); bf16* WGU = (bf16*)(a.ws + WS_WGU); bf16* WDN = (bf16*)(a.ws + WS_WDN); bf16* WPOOL = (bf16*)(a.ws + WS_WPOOL);
    constexpr int IT_WIN = 32 * 238, IT_WOUT = 32 * 64, IT_GU = 32 * 176, IT_DN = 88 * 64, IT_POOL = 8 * 16;
    constexpr int NITEMS = 2 * IT_WIN + 2 * IT_WOUT + 8 * IT_GU + 4 * IT_DN + 8 * IT_POOL;
    for (int it = gw; it < NITEMS; it += NGW) {
        int r = it;
        if (r < 2 * IT_WIN) { const int i = r / IT_WIN; r -= i * IT_WIN; const int kb = r / 238, nb = r - kb * 238;
            conv_item(a.in[I_WIN] + (size_t)i * 2048 * 7616, 2048, 7616, WIN + (size_t)i * PW * 2048, win_row(32 * nb), scr, kb, nb, lane); continue; } r -= 2 * IT_WIN;
        if (r < 2 * IT_WOUT) { const int i = r / IT_WOUT; r -= i * IT_WOUT; const int kb = r / 64, nb = r - kb * 64;
            conv_item(a.in[I_WOUT] + (size_t)i * 2048 * 2048, 2048, 2048, WOUT + (size_t)i * 2048 * 2048, 32 * nb, scr, kb, nb, lane); continue; } r -= 2 * IT_WOUT;
        if (r < 8 * IT_GU) { const int li = r / IT_GU; r -= li * IT_GU; const int l = li >> 1, up = li & 1; const int kb = r / 176, nb = r - kb * 176; const int n0 = 32 * nb;
            conv_item(a.in[up ? I_WU : I_WG] + (size_t)l * 2048 * DFF, 2048, DFF, WGU + (size_t)l * 11264 * 2048, (n0 >> 7) * 256 + up * 128 + (n0 & 127), scr, kb, nb, lane); continue; } r -= 8 * IT_GU;
        if (r < 4 * IT_DN) { const int l = r / IT_DN; r -= l * IT_DN; const int kb = r / 64, nb = r - kb * 64;
            conv_item(a.in[I_WD] + (size_t)l * DFF * 2048, DFF, 2048, WDN + (size_t)l * 2048 * DFF, 32 * nb, scr, kb, nb, lane); continue; } r -= 4 * IT_DN;
        { const int ig = r / IT_POOL; r -= ig * IT_POOL; const int kb = r / 16, nb = r - kb * 16;
            conv_item(a.in[I_POOLW] + (size_t)ig * 512 * 512, 512, 512, WPOOL + (size_t)ig * 512 * 512, 32 * nb, scr, kb, nb, lane); }
    }
    { bf16* LW = (bf16*)(a.ws + WS_LORA); const int gt = blockIdx.x * NTHR + tid, NGT = G * NTHR;
        for (int idx = gt; idx < 8 * 65536; idx += NGT) { const int mat = idx >> 16, n = (idx >> 6) & 1023, k = idx & 63;
            const float v = (mat < 4 ? a.in[I_W2] : a.in[I_A2])[((size_t)(mat & 3) * 64 + k) * 1024 + n]; LW[idx] = (bf16)f2bf(v); }
        for (int idx = gt; idx < 2 * 1024 * 160; idx += NGT) { const int i2 = idx / (1024 * 160), r = idx - i2 * 1024 * 160, n = r / 160, k = r - n * 160;
            LW[8 * 65536 + idx] = (bf16)f2bf(a.in[I_G2][((size_t)i2 * 160 + k) * 1024 + n]); } }
    for (int r = gw; r < 128; r += NGW) { bf16* row = WIN + ((size_t)(r >> 6) * PW + 7616 + (r & 63)) * 2048; const v4u z = {0u, 0u, 0u, 0u};
#pragma unroll
        for (int j = 0; j < 4; ++j) *(v4u*)(row + (j * 64 + lane) * 8) = z; }
}

__device__ __forceinline__ void ph_norm(const Args& a, int l, int which) {
    const int tid = opaque_tid(), lane = tid & 63, wave = __builtin_amdgcn_readfirstlane(tid >> 6);
    const int gw = blockIdx.x * NWAVES + wave, NGW = gridDim.x * NWAVES;
    const float* nw = a.in[which ? I_NFFN : I_NMIX] + l * 2048;
    const float* MOD = (const float*)(a.ws + WS_MOD) + (size_t)l * 9 * 12288;
    bf16* H = (bf16*)(a.ws + WS_H);
    const bool from_in = (l == 0 && which == 0);
    for (int m = gw; m < NTOK; m += NGW) {
        const float* xr = from_in ? (m < NPROMPT ? a.in[I_XP] + (size_t)m * D : a.in[I_XS] + (size_t)(m - NPROMPT) * D) : a.out + (size_t)m * D;
        const int cond = m < NPROMPT ? 0 : 1 + ((m - NPROMPT) >> 10);
        const float* sh = MOD + (size_t)cond * 12288 + (which ? 3 : 0) * 2048; const float* sc = sh + 2048;
        f32x4 v[8]; float s = 0.f;
#pragma unroll
        for (int j = 0; j < 8; ++j) { v[j] = *(const f32x4*)(xr + 4 * lane + 256 * j); s += (v[j].x * v[j].x + v[j].y * v[j].y) + (v[j].z * v[j].z + v[j].w * v[j].w); }
        const float rstd = 1.0f / sqrtf(wave_sum(s) * (1.0f / D) + RMS_EPS);
#pragma unroll
        for (int j = 0; j < 8; ++j) { const int c = 4 * lane + 256 * j; const f32x4 w = *(const f32x4*)(nw + c), s1 = *(const f32x4*)(sc + c), s0 = *(const f32x4*)(sh + c);
            const f32x4 y = (v[j] * rstd) * w * (s1 + 1.0f) + s0;
            v2u o; o.x = pk2(y.x, y.y); o.y = pk2(y.z, y.w); *(v2u*)(H + (size_t)m * D + c) = o; }
    }
}
__device__ __forceinline__ void ph_final(const Args& a) {
    const int tid = opaque_tid(), lane = tid & 63, wave = __builtin_amdgcn_readfirstlane(tid >> 6);
    const int gw = blockIdx.x * NWAVES + wave, NGW = gridDim.x * NWAVES;
    const float* nw = a.in[I_NFIN];
    for (int m = gw; m < NTOK; m += NGW) {
        float* xr = a.out + (size_t)m * D;
        f32x4 v[8]; float s = 0.f;
#pragma unroll
        for (int j = 0; j < 8; ++j) { v[j] = *(const f32x4*)(xr + 4 * lane + 256 * j); s += (v[j].x * v[j].x + v[j].y * v[j].y) + (v[j].z * v[j].z + v[j].w * v[j].w); }
        const float rstd = 1.0f / sqrtf(wave_sum(s) * (1.0f / D) + RMS_EPS);
#pragma unroll
        for (int j = 0; j < 8; ++j) { const int c = 4 * lane + 256 * j; const f32x4 w = *(const f32x4*)(nw + c); *(f32x4*)(xr + c) = (v[j] * rstd) * w; }
    }
}
__device__ __forceinline__ void ph_pool(const Args& a) {
    const int tid = opaque_tid(), lane = tid & 63, wave = __builtin_amdgcn_readfirstlane(tid >> 6);
    const int gw = blockIdx.x * NWAVES + wave, NGW = gridDim.x * NWAVES;
    const bf16* H = (const bf16*)(a.ws + WS_H); bf16* O = (bf16*)(a.ws + WS_O);
    for (int m = gw; m < NTOK; m += NGW) {
        const bool samp = m >= NPROMPT; const int T = samp ? 1024 : 256; const int base = samp ? NPROMPT + (((m - NPROMPT) >> 10) << 10) : (m >> 8) << 8; const int t = m - base;
#pragma unroll
        for (int g = 0; g < 4; ++g) {
            const int win = 2 << g; int lo = t - win / 2, hi = lo + win; lo = lo < 0 ? 0 : lo; hi = hi > T ? T : hi;
            const int c = g * 512 + lane * 8;
            float s[8];
#pragma unroll
            for (int e = 0; e < 8; ++e) s[e] = 0.f;
            for (int r = lo; r < hi; ++r) { const v4u w = *(const v4u*)(H + (size_t)(base + r) * D + c);
                s[0] += bflo(w.x); s[1] += bfhi(w.x); s[2] += bflo(w.y); s[3] += bfhi(w.y); s[4] += bflo(w.z); s[5] += bfhi(w.z); s[6] += bflo(w.w); s[7] += bfhi(w.w); }
            const float inv = 1.0f / (float)(hi - lo);
            const v4u w = *(const v4u*)(H + (size_t)m * D + c);
            v4u o; o.x = pk2(s[0] * inv - bflo(w.x), s[1] * inv - bfhi(w.x)); o.y = pk2(s[2] * inv - bflo(w.y), s[3] * inv - bfhi(w.y));
            o.z = pk2(s[4] * inv - bflo(w.z), s[5] * inv - bfhi(w.z)); o.w = pk2(s[6] * inv - bflo(w.w), s[7] * inv - bfhi(w.w));
            *(v4u*)(O + (size_t)m * D + c) = o;
        }
    }
}

typedef short sfrag __attribute__((ext_vector_type(8)));
union Frag { sfrag v; unsigned u[4]; };
typedef __bf16 bf16x2_t __attribute__((ext_vector_type(2)));
__device__ __forceinline__ unsigned cvtpk(float lo, float hi) { const f32x2 v = {lo, hi}; return __builtin_bit_cast(unsigned, __builtin_convertvector(v, bf16x2_t)); }
__device__ __forceinline__ f32x4 mma(const Frag& A, const Frag& B, f32x4 C) { return __builtin_amdgcn_mfma_f32_16x16x32_bf16(A.v, B.v, C, 0, 0, 0); }
__device__ __forceinline__ Frag feed1(f32x4 d0) { Frag f; f.u[0] = cvtpk(d0.x, d0.y); f.u[1] = cvtpk(d0.z, d0.w); f.u[2] = 0u; f.u[3] = 0u; return f; }
__device__ __forceinline__ Frag feed2(f32x4 d0, f32x4 d1) { Frag f; f.u[0] = cvtpk(d0.x, d0.y); f.u[1] = cvtpk(d0.z, d0.w); f.u[2] = cvtpk(d1.x, d1.y); f.u[3] = cvtpk(d1.z, d1.w); return f; }
#define DPP_SHR(x, n, fill) __builtin_bit_cast(float, __builtin_amdgcn_update_dpp(__builtin_bit_cast(int, (float)(fill)), __builtin_bit_cast(int, (float)(x)), 0x110 + (n), 0xf, 0xf, false))
__device__ __forceinline__ float row_scan16(float x) { x += DPP_SHR(x, 1, 0.f); x += DPP_SHR(x, 2, 0.f); x += DPP_SHR(x, 4, 0.f); x += DPP_SHR(x, 8, 0.f); return x; }
#define DPP_ROR(x, n) __builtin_bit_cast(float, __builtin_amdgcn_update_dpp(0, __builtin_bit_cast(int, (float)(x)), 0x120 + (n), 0xf, 0xf, false))
__device__ __forceinline__ float row_sum16(float x) { x += DPP_ROR(x, 8); x += DPP_ROR(x, 4); x += DPP_ROR(x, 2); x += DPP_ROR(x, 1); return x; }
__device__ __forceinline__ float lane_get(float x, int src) { return __builtin_bit_cast(float, __builtin_amdgcn_ds_bpermute(src << 2, __builtin_bit_cast(int, x))); }
constexpr f32x4 F4Z = {0.f, 0.f, 0.f, 0.f};
__device__ __forceinline__ f32x4 tri_inv_T(f32x4 dL, f32x4 dLT, f32x4 eye) {
    const Frag fL = feed1(dL), fLT = feed1(dLT);
    const f32x4 L2 = mma(fLT, fL, F4Z), L2T = mma(fL, fLT, F4Z);
    const Frag f2 = feed1(L2), f2T = feed1(L2T);
    const f32x4 L4 = mma(f2T, f2, F4Z), L4T = mma(f2, f2T, F4Z);
    const f32x4 L8 = mma(feed1(L4T), feed1(L4), F4Z);
    const f32x4 R1 = mma(feed1(L2 + eye), feed1(dLT + eye), F4Z);
    const f32x4 R2 = mma(feed1(L4 + eye), feed1(R1), F4Z);
    return mma(feed1(L8 + eye), feed1(R2), F4Z);
}

__device__ __forceinline__ void rwkv_task(const Args& a, int i, int s, int h, int d, int lane, LAS float* wscr) {
    constexpr size_t S1 = (size_t)NTOK * 1024;
    const bf16* RW = (const bf16*)(a.ws + WS_SC);
    bf16* YS = (bf16*)(a.ws + WS_Y) + d * S1;
    const float* BON = (const float*)(a.ws + WS_SMALL);
    const float* lnw = a.in[I_LNW] + i * 1024 + h * 64; const float* lnb = a.in[I_LNB] + i * 1024 + h * 64;
    const int T = s < 16 ? 256 : 1024; const int row0 = s < 16 ? s * 256 : NPROMPT + (s - 16) * 1024;
    const int c = lane & 15, q = lane >> 4;
    f32x4 S[4][4];
    if (s >= 16) { const float* s0 = a.in[I_SRW] + ((((size_t)(s - 16) * 2 + i) * 2 + d) * 16 + h) * 4096;
#pragma unroll
        for (int kt = 0; kt < 4; ++kt)
#pragma unroll
            for (int vt = 0; vt < 4; ++vt) S[kt][vt] = *(const f32x4*)(s0 + (16 * vt + c) * 64 + 16 * kt + 4 * q); }
    else {
#pragma unroll
        for (int kt = 0; kt < 4; ++kt)
#pragma unroll
            for (int vt = 0; vt < 4; ++vt) S[kt][vt] = F4Z; }
    Frag sel[2];
#pragma unroll
    for (int p = 0; p < 2; ++p)
#pragma unroll
        for (int j = 0; j < 4; ++j) { const int e0 = 2 * j - 4 * p; const bool on = ((lane >> 2) & 3) == q && (e0 == (lane & 3) || e0 + 1 == (lane & 3)) && (j >> 1) == p;
            sel[p].u[j] = on ? (((lane & 1) == 0) ? 0x00003F80u : 0x3F800000u) : 0u; }
    bool mlt[4], mle[4]; f32x4 eye;
#pragma unroll
    for (int n = 0; n < 4; ++n) { mlt[n] = (4 * q + n) < c; mle[n] = (4 * q + n) <= c; eye[n] = (4 * q + n) == c ? 1.f : 0.f; }
    const int nch = T >> 4;
    const int kof = (3 + d) * 64, bof = (5 + d) * 64, lof = (7 + d) * 64;
    v2u nr[4], na[4], nk[4], nb[4], nlw[4], nv[4];
    for (int ch = 0; ch < nch; ++ch) {
        { const int tok = d ? T - 1 - (16 * ch + c) : 16 * ch + c; const bf16* rw = RW + ((size_t)(row0 + tok) * 16 + h) * 576 + 4 * q;
#pragma unroll
            for (int g = 0; g < 4; ++g) { nr[g] = *(const v2u*)(rw + 16 * g); na[g] = *(const v2u*)(rw + 64 + 16 * g); nk[g] = *(const v2u*)(rw + kof + 16 * g); nb[g] = *(const v2u*)(rw + bof + 16 * g); nlw[g] = *(const v2u*)(rw + lof + 16 * g); nv[g] = *(const v2u*)(rw + 128 + 16 * g); } }
        Frag f_at[2], f_rt[2], f_bt[2], f_kt[2], f_bh[2], f_kh[2], f_v[2];
#pragma unroll
        for (int g = 0; g < 4; ++g) {
            const int ks = g >> 1, hf = g & 1;
            float lw_[4] = {bflo(nlw[g].x), bfhi(nlw[g].x), bflo(nlw[g].y), bfhi(nlw[g].y)};
            float r_[4] = {bflo(nr[g].x), bfhi(nr[g].x), bflo(nr[g].y), bfhi(nr[g].y)}, a_[4] = {bflo(na[g].x), bfhi(na[g].x), bflo(na[g].y), bfhi(na[g].y)};
            float k_[4] = {bflo(nk[g].x), bfhi(nk[g].x), bflo(nk[g].y), bfhi(nk[g].y)}, b_[4] = {bflo(nb[g].x), bfhi(nb[g].x), bflo(nb[g].y), bfhi(nb[g].y)};
            float at[4], rt[4], bt[4], kt[4], bh[4], kh[4];
#pragma unroll
            for (int n = 0; n < 4; ++n) {
                const float G = row_scan16(lw_[n]); const float E1 = __builtin_amdgcn_exp2f(G), E2 = __builtin_amdgcn_rcpf(E1); const float E3 = DPP_SHR(E1, 1, 1.0f);
                const float ec = lane_get(E1, (lane & 48) | 15); wscr[(g * 4 + n) * 64 + lane] = ec;
                at[n] = a_[n] * E3; rt[n] = r_[n] * E1; bt[n] = b_[n] * E2; kt[n] = k_[n] * E2; bh[n] = bt[n] * ec; kh[n] = kt[n] * ec;
            }
            f_at[ks].u[2 * hf] = cvtpk(at[0], at[1]); f_at[ks].u[2 * hf + 1] = cvtpk(at[2], at[3]); f_rt[ks].u[2 * hf] = cvtpk(rt[0], rt[1]); f_rt[ks].u[2 * hf + 1] = cvtpk(rt[2], rt[3]);
            f_bt[ks].u[2 * hf] = cvtpk(bt[0], bt[1]); f_bt[ks].u[2 * hf + 1] = cvtpk(bt[2], bt[3]); f_kt[ks].u[2 * hf] = cvtpk(kt[0], kt[1]); f_kt[ks].u[2 * hf + 1] = cvtpk(kt[2], kt[3]);
            f_bh[ks].u[2 * hf] = cvtpk(bh[0], bh[1]); f_bh[ks].u[2 * hf + 1] = cvtpk(bh[2], bh[3]); f_kh[ks].u[2 * hf] = cvtpk(kh[0], kh[1]); f_kh[ks].u[2 * hf + 1] = cvtpk(kh[2], kh[3]);
            f_v[ks].u[2 * hf] = nv[g].x; f_v[ks].u[2 * hf + 1] = nv[g].y;
            __builtin_amdgcn_sched_barrier(0);
        }
        v2u pV[4]; LAS v4u* sBK = (LAS v4u*)(wscr + 1024);
#pragma unroll
        for (int g = 0; g < 4; ++g) { const f32x4 dv = mma(f_v[g >> 1], sel[g & 1], F4Z); pV[g].x = cvtpk(dv.x, dv.y); pV[g].y = cvtpk(dv.z, dv.w);
            const Frag fb = feed2(mma(f_bh[g >> 1], sel[g & 1], F4Z), mma(f_kh[g >> 1], sel[g & 1], F4Z)); sBK[g * 64 + lane] = (v4u){fb.u[0], fb.u[1], fb.u[2], fb.u[3]}; }
        __builtin_amdgcn_sched_barrier(0);
        f32x4 dLab = mma(f_at[1], f_bt[1], mma(f_at[0], f_bt[0], F4Z));
        f32x4 dLabT = mma(f_bt[1], f_at[1], mma(f_bt[0], f_at[0], F4Z));
        f32x4 dLakT = mma(f_kt[1], f_at[1], mma(f_kt[0], f_at[0], F4Z));
        f32x4 dArbT = mma(f_bt[1], f_rt[1], mma(f_bt[0], f_rt[0], F4Z));
        f32x4 dArkT = mma(f_kt[1], f_rt[1], mma(f_kt[0], f_rt[0], F4Z));
#pragma unroll
        for (int n = 0; n < 4; ++n) { dLab[n] = (c < 4 * q + n) ? dLab[n] : 0.f; dLabT[n] = mlt[n] ? dLabT[n] : 0.f; dLakT[n] = mlt[n] ? dLakT[n] : 0.f; dArbT[n] = mle[n] ? dArbT[n] : 0.f; dArkT[n] = mle[n] ? dArkT[n] : 0.f; }
        const Frag fTT = feed1(tri_inv_T(dLab, dLabT, eye)), fLakT = feed1(dLakT), fArbT = feed1(dArbT), fArkT = feed1(dArkT);
        __builtin_amdgcn_sched_barrier(0);
        v2u pSA[4];
        const int tokbase = 16 * ch + 4 * q;
#pragma unroll
        for (int vt = 0; vt < 4; ++vt) {
            const Frag fS0 = feed2(S[0][vt], S[1][vt]), fS1 = feed2(S[2][vt], S[3][vt]); Frag fV; fV.u[0] = pV[vt].x; fV.u[1] = pV[vt].y; fV.u[2] = 0u; fV.u[3] = 0u;
            f32x4 rhs = mma(f_at[1], fS1, mma(f_at[0], fS0, F4Z)); rhs = mma(fLakT, fV, rhs);
            const f32x4 sa = mma(fTT, feed1(rhs), F4Z); pSA[vt].x = cvtpk(sa.x, sa.y); pSA[vt].y = cvtpk(sa.z, sa.w);
            Frag fSA; fSA.u[0] = pSA[vt].x; fSA.u[1] = pSA[vt].y; fSA.u[2] = 0u; fSA.u[3] = 0u;
            f32x4 y = mma(f_rt[1], fS1, mma(f_rt[0], fS0, F4Z)); y = mma(fArbT, fSA, y); y = mma(fArkT, fV, y);
#pragma unroll
            for (int n = 0; n < 4; ++n) wscr[2048 + (vt * 4 + n) * 64 + lane] = y[n];
            __builtin_amdgcn_sched_barrier(0);
        }
#pragma unroll
        for (int vt = 0; vt < 4; ++vt) { Frag fB; fB.u[0] = pSA[vt].x; fB.u[1] = pSA[vt].y; fB.u[2] = pV[vt].x; fB.u[3] = pV[vt].y;
#pragma unroll
            for (int kt = 0; kt < 4; ++kt) { f32x4 cin;
#pragma unroll
                for (int n = 0; n < 4; ++n) cin[n] = S[kt][vt][n] * wscr[(kt * 4 + n) * 64 + lane];
                const v4u w = sBK[kt * 64 + lane]; Frag fbk; fbk.u[0] = w.x; fbk.u[1] = w.y; fbk.u[2] = w.z; fbk.u[3] = w.w;
                S[kt][vt] = mma(fbk, fB, cin); } }
        __builtin_amdgcn_sched_barrier(0);
        {
            float s1[4] = {0.f, 0.f, 0.f, 0.f}, s2[4] = {0.f, 0.f, 0.f, 0.f};
#pragma unroll
            for (int vt = 0; vt < 4; ++vt)
#pragma unroll
                for (int n = 0; n < 4; ++n) { const float yv = wscr[2048 + (vt * 4 + n) * 64 + lane]; s1[n] += yv; s2[n] += yv * yv; }
            float mean[4], rs[4], bon[4]; size_t orow[4];
#pragma unroll
            for (int n = 0; n < 4; ++n) { const float m1 = row_sum16(s1[n]) * (1.0f / 64.0f), m2 = row_sum16(s2[n]) * (1.0f / 64.0f); mean[n] = m1; rs[n] = 1.0f / sqrtf(fmaxf(m2 - m1 * m1, 0.f) + GN_EPS);
                const int t = tokbase + n; const int tok = d ? T - 1 - t : t; orow[n] = (size_t)(row0 + tok); bon[n] = BON[(orow[n] * 2 + d) * 16 + h]; }
#pragma unroll
            for (int vt = 0; vt < 4; ++vt) { const float lw_ = lnw[16 * vt + c], lb_ = lnb[16 * vt + c];
                const float vv[4] = {bflo(pV[vt].x), bfhi(pV[vt].x), bflo(pV[vt].y), bfhi(pV[vt].y)};
#pragma unroll
                for (int n = 0; n < 4; ++n) { const float yv = wscr[2048 + (vt * 4 + n) * 64 + lane];
                    YS[orow[n] * 1024 + h * 64 + 16 * vt + c] = (bf16)f2bf((yv - mean[n]) * rs[n] * lw_ + lb_ + bon[n] * vv[n]); } }
        }
    }
    if (s < 16) { float* so = a.out + OUT_SRW + ((((size_t)s * 2 + i) * 2 + d) * 16 + h) * 4096;
#pragma unroll
        for (int kt = 0; kt < 4; ++kt)
#pragma unroll
            for (int vt = 0; vt < 4; ++vt) *(f32x4*)(so + (16 * vt + c) * 64 + 16 * kt + 4 * q) = S[kt][vt]; }
}

__device__ __forceinline__ Frag scale_frag(const Frag& x, float sc) { Frag f;
#pragma unroll
    for (int j = 0; j < 4; ++j) f.u[j] = cvtpk(bflo(x.u[j]) * sc, bfhi(x.u[j]) * sc);
    return f; }
__device__ __forceinline__ void gdn_task(const Args& a, int i, int s, int h, int d, int vb, int lane, LAS float* wscr) {
    constexpr size_t S1 = (size_t)NTOK * 1024;
    const bf16* GD = (const bf16*)(a.ws + WS_SC) + 9 * S1;
    const float* BETA = (const float*)(a.ws + WS_SMALL) + (size_t)NTOK * 32; const float* GG = BETA + (size_t)NTOK * 16;
    bf16* O = (bf16*)(a.ws + WS_Y) + 2 * S1 + d * S1;
    const int T = s < 16 ? 256 : 1024; const int row0 = s < 16 ? s * 256 : NPROMPT + (s - 16) * 1024;
    const int c = lane & 15, q = lane >> 4;
    f32x4 S[8][2];
    if (s >= 16) { const float* s0 = a.in[I_SDL] + ((((size_t)(s - 16) * 2 + i) * 2 + d) * 8 + h) * 16384 + 32 * vb + c;
#pragma unroll
        for (int kt = 0; kt < 8; ++kt)
#pragma unroll
            for (int vt = 0; vt < 2; ++vt)
#pragma unroll
                for (int n = 0; n < 4; ++n) S[kt][vt][n] = s0[(16 * kt + 4 * q + n) * 128 + 16 * vt]; }
    else {
#pragma unroll
        for (int kt = 0; kt < 8; ++kt) { S[kt][0] = F4Z; S[kt][1] = F4Z; } }
    Frag sel[2];
#pragma unroll
    for (int p = 0; p < 2; ++p)
#pragma unroll
        for (int j = 0; j < 4; ++j) { const int e0 = 2 * j - 4 * p; const bool on = ((lane >> 2) & 3) == q && (e0 == (lane & 3) || e0 + 1 == (lane & 3)) && (j >> 1) == p;
            sel[p].u[j] = on ? (((lane & 1) == 0) ? 0x00003F80u : 0x3F800000u) : 0u; }
    f32x4 eye;
#pragma unroll
    for (int n = 0; n < 4; ++n) eye[n] = (4 * q + n) == c ? 1.f : 0.f;
    const int nch = T >> 4;
    Frag nk[4], nq[4], nv; float nbeta, ng;
    { const int tok = d ? T - 1 - c : c; const size_t row = row0 + tok; const bf16* gd = GD + (row * 8 + h) * 384 + 4 * q;
#pragma unroll
        for (int ks = 0; ks < 4; ++ks) { const v2u k0 = *(const v2u*)(gd + 128 + 32 * ks), k1 = *(const v2u*)(gd + 128 + 32 * ks + 16), q0 = *(const v2u*)(gd + 32 * ks), q1 = *(const v2u*)(gd + 32 * ks + 16);
            nk[ks].u[0] = k0.x; nk[ks].u[1] = k0.y; nk[ks].u[2] = k1.x; nk[ks].u[3] = k1.y; nq[ks].u[0] = q0.x; nq[ks].u[1] = q0.y; nq[ks].u[2] = q1.x; nq[ks].u[3] = q1.y; }
        { const v2u v0 = *(const v2u*)(gd + 256 + 32 * vb), v1 = *(const v2u*)(gd + 256 + 32 * vb + 16); nv.u[0] = v0.x; nv.u[1] = v0.y; nv.u[2] = v1.x; nv.u[3] = v1.y; }
        nbeta = BETA[row * 16 + d * 8 + h]; ng = GG[row * 16 + d * 8 + h]; }
    for (int ch = 0; ch < nch; ++ch) {
        const float beta = nbeta, gl = ng;
        const float G = row_scan16(gl); const float GC = lane_get(G, (lane & 48) | 15);
        float Grow[4], Brow[4];
#pragma unroll
        for (int n = 0; n < 4; ++n) { Grow[n] = lane_get(G, (lane & 48) | (4 * q + n)); Brow[n] = lane_get(beta, (lane & 48) | (4 * q + n)); }
        const float eG = __builtin_amdgcn_exp2f(G), eGCG = __builtin_amdgcn_exp2f(GC - G), eGC = __builtin_amdgcn_exp2f(GC);
        f32x4 dKK = F4Z, dKQ = F4Z;
#pragma unroll
        for (int ks = 0; ks < 4; ++ks) { dKK = mma(nk[ks], nk[ks], dKK); dKQ = mma(nk[ks], nq[ks], dKQ); }
        f32x4 dL, dLT, dAtT;
#pragma unroll
        for (int n = 0; n < 4; ++n) { const int r = 4 * q + n;
            const float eij = __builtin_amdgcn_exp2f(fminf(Grow[n] - G, 0.f)), eji = __builtin_amdgcn_exp2f(fminf(G - Grow[n], 0.f));
            dL[n] = (c < r) ? -Brow[n] * dKK[n] * eij : 0.f;
            dLT[n] = (r < c) ? -beta * dKK[n] * eji : 0.f;
            dAtT[n] = (r <= c) ? dKQ[n] * eji * 0.08838834764831845f : 0.f; }
        const Frag fTT = feed1(tri_inv_T(dL, dLT, eye)), fAtT = feed1(dAtT);
        f32x4 dV[2]; dV[0] = mma(nv, sel[0], F4Z); dV[1] = mma(nv, sel[1], F4Z);
        LAS v2u* sKd = (LAS v2u*)wscr;
#pragma unroll
        for (int ks = 0; ks < 4; ++ks) { const Frag kd = scale_frag(nk[ks], eGCG); const f32x4 t0 = mma(kd, sel[0], F4Z), t1 = mma(kd, sel[1], F4Z);
            sKd[(2 * ks) * 64 + lane] = (v2u){cvtpk(t0.x, t0.y), cvtpk(t0.z, t0.w)}; sKd[(2 * ks + 1) * 64 + lane] = (v2u){cvtpk(t1.x, t1.y), cvtpk(t1.z, t1.w)}; }
        Frag fX[4], fQg[4];
#pragma unroll
        for (int ks = 0; ks < 4; ++ks) { fX[ks] = scale_frag(nk[ks], beta * eG); fQg[ks] = scale_frag(nq[ks], eG * 0.08838834764831845f); }
        const int tokbase = 16 * ch + 4 * q;
#pragma unroll
        for (int vt = 0; vt < 2; ++vt) {
            f32x4 M = F4Z, o = F4Z;
#pragma unroll
            for (int ks = 0; ks < 4; ++ks) { const Frag fS = feed2(S[2 * ks][vt], S[2 * ks + 1][vt]); M = mma(fX[ks], fS, M); o = mma(fQg[ks], fS, o); }
            f32x4 rhs;
#pragma unroll
            for (int n = 0; n < 4; ++n) rhs[n] = Brow[n] * dV[vt][n] - M[n];
            const Frag fVn = feed1(mma(fTT, feed1(rhs), F4Z));
            o = mma(fAtT, fVn, o);
#pragma unroll
            for (int n = 0; n < 4; ++n) { const int t = tokbase + n; const int tok = d ? T - 1 - t : t; O[(size_t)(row0 + tok) * 1024 + h * 128 + 32 * vb + 16 * vt + c] = (bf16)f2bf(o[n]); }
#pragma unroll
            for (int kt = 0; kt < 8; ++kt) { const v2u w = sKd[kt * 64 + lane]; Frag fK; fK.u[0] = w.x; fK.u[1] = w.y; fK.u[2] = 0u; fK.u[3] = 0u; S[kt][vt] = mma(fK, fVn, S[kt][vt] * eGC); }
        }
        asm volatile("" ::: "memory");
        { const int chn = ch + 1 < nch ? ch + 1 : ch; const int tok = d ? T - 1 - (16 * chn + c) : 16 * chn + c; const size_t row = row0 + tok; const bf16* gd = GD + (row * 8 + h) * 384 + 4 * q;
#pragma unroll
            for (int ks = 0; ks < 4; ++ks) { const v2u k0 = *(const v2u*)(gd + 128 + 32 * ks), k1 = *(const v2u*)(gd + 128 + 32 * ks + 16), q0 = *(const v2u*)(gd + 32 * ks), q1 = *(const v2u*)(gd + 32 * ks + 16);
                nk[ks].u[0] = k0.x; nk[ks].u[1] = k0.y; nk[ks].u[2] = k1.x; nk[ks].u[3] = k1.y; nq[ks].u[0] = q0.x; nq[ks].u[1] = q0.y; nq[ks].u[2] = q1.x; nq[ks].u[3] = q1.y; }
            { const v2u v0 = *(const v2u*)(gd + 256 + 32 * vb), v1 = *(const v2u*)(gd + 256 + 32 * vb + 16); nv.u[0] = v0.x; nv.u[1] = v0.y; nv.u[2] = v1.x; nv.u[3] = v1.y; }
            nbeta = BETA[row * 16 + d * 8 + h]; ng = GG[row * 16 + d * 8 + h]; }
    }
    if (s < 16) { float* so = a.out + OUT_SDL + ((((size_t)s * 2 + i) * 2 + d) * 8 + h) * 16384 + 32 * vb + c;
#pragma unroll
        for (int kt = 0; kt < 8; ++kt)
#pragma unroll
            for (int vt = 0; vt < 2; ++vt)
#pragma unroll
                for (int n = 0; n < 4; ++n) so[(16 * kt + 4 * q + n) * 128 + 16 * vt] = S[kt][vt][n]; }
}
__device__ __forceinline__ void ph_scan(const Args& a, LAS unsigned char* lds, int i) {
    const int tid = opaque_tid(), lane = tid & 63, wave = __builtin_amdgcn_readfirstlane(tid >> 6);
    LAS float* wscr = (LAS float*)(lds + wave * 12288);
    const int G = gridDim.x;
    for (int task = wave * G + blockIdx.x; task < 2304; task += NWAVES * G) {
        if (task >= 256 && task < 512) { const int t = task - 256; rwkv_task(a, i, 16 + (t >> 5), (t & 31) >> 1, t & 1, lane, wscr); }
        else if (task >= 1024 && task < 1536) { const int t = task - 1024; rwkv_task(a, i, t >> 5, (t & 31) >> 1, t & 1, lane, wscr); }
    }
    asm volatile("" ::: "memory");
    for (int task = wave * G + blockIdx.x; task < 2304; task += NWAVES * G) {
        if (task < 256 || task >= 1536) { const int t = task < 256 ? task : task - 1536 + 256; const int s = t >> 6, r = t & 63; gdn_task(a, i, s, r >> 3, (r >> 2) & 1, r & 3, lane, wscr); }
        else if (task >= 512 && task < 1024) { const int t = task - 512; const int s = 16 + (t >> 6), r = t & 63; gdn_task(a, i, s, r >> 3, (r >> 2) & 1, r & 3, lane, wscr); }
    }
}
__device__ __forceinline__ void tok_info(int m, bool& samp, int& T, int& t) { samp = m >= NPROMPT; T = samp ? 1024 : 256; t = samp ? ((m - NPROMPT) & 1023) : (m & 255); }
__device__ __forceinline__ void shift_nb(bool samp, int T, int t, int n, int& dt, bool& valid) {
    if (!samp) { if (n & 1) { dt = 1; valid = t + 1 < T; } else { dt = -1; valid = t > 0; } }
    else { const int col = t & 63, row = t >> 6;
        if (n == 0) { dt = -1; valid = col > 0; } else if (n == 1) { dt = 1; valid = col < 63; } else if (n == 2) { dt = -64; valid = row > 0; } else { dt = 64; valid = row < 15; } }
}
constexpr int LA_LD = 424;
__device__ __forceinline__ void ph_prep(const Args& a, LAS unsigned char* lds, int i) {
    const int tid = opaque_tid(), lane = tid & 63, wave = __builtin_amdgcn_readfirstlane(tid >> 6);
    const int c = lane & 15, q = lane >> 4;
    const bf16* P = (const bf16*)(a.ws + WS_P);
    bf16* RW = (bf16*)(a.ws + WS_SC); constexpr size_t S1 = (size_t)NTOK * 1024;
    bf16* GD = RW + 9 * S1; float* GT = (float*)(RW + 12 * S1);
    float* BON = (float*)(a.ws + WS_SMALL); float* BETA = BON + (size_t)NTOK * 32; float* GG = BETA + (size_t)NTOK * 16;
    const float* MU = a.in[I_MU] + i * CPA;
    const bf16* W2T = (const bf16*)(a.ws + WS_LORA) + (size_t)i * 2 * 1024 * 64;
    const bf16* A2T = (const bf16*)(a.ws + WS_LORA) + (size_t)4 * 1024 * 64 + (size_t)i * 2 * 1024 * 64;
    const bf16* G2T = (const bf16*)(a.ws + WS_LORA) + (size_t)8 * 1024 * 64 + (size_t)i * 1024 * 160;
    LAS bf16* la = (LAS bf16*)lds;
    LAS float* lpar = (LAS float*)(lds + 40960);
    LAS float* lcw = (LAS float*)(lds + 40960 + 40960);
    for (int idx = tid; idx < 10 * 1024; idx += NTHR) { const int p = idx >> 10, ch = idx & 1023;
        const float v = p < 3 ? MU[p * 1024 + ch] : (p == 3 ? a.in[I_KK][i * 1024 + ch] : (p == 4 ? a.in[I_KA][i * 1024 + ch] : (p == 5 ? a.in[I_RK][i * 1024 + ch] : (p < 8 ? a.in[I_W0][(i * 2 + p - 6) * 1024 + ch] : a.in[I_A0][(i * 2 + p - 8) * 1024 + ch]))));
        lpar[idx] = v; }
    for (int idx = tid; idx < 3 * 3072; idx += NTHR) lcw[idx] = a.in[I_CONVW][(size_t)i * 3 * 3072 + idx];
    __syncthreads();
    for (int tile = blockIdx.x; tile < NTOK / 48; tile += gridDim.x) {
        const int m0 = tile * 48;
        for (int it = 0; it < 10; ++it) {
            float xv[4], xsv[4]; int jjv[4], ttv[4];
#pragma unroll
            for (int u = 0; u < 4; ++u) { const int idx = tid + NTHR * (4 * it + u); const bool ok = idx < 48 * 416; const int tt = ok ? idx / 416 : 0, jj = ok ? idx - tt * 416 : 0; jjv[u] = ok ? jj : -1; ttv[u] = tt;
                const int m = m0 + tt; bool samp; int T, t; tok_info(m, samp, T, t); int dt; bool valid; shift_nb(samp, T, t, jj & 3, dt, valid);
                xv[u] = bf2f(P[(size_t)m * PW + PC_LORA + jj]); xsv[u] = valid ? bf2f(P[(size_t)(m + dt) * PW + PC_LORA + jj]) : 0.f; }
#pragma unroll
            for (int u = 0; u < 4; ++u) { const int jj = jjv[u]; if (jj >= 0) { float v = xv[u] + (xsv[u] - xv[u]) * MU[3072 + jj];
                if (jj < 128) { const float e = __expf(2.0f * v); v = 1.0f - 2.0f / (e + 1.0f); } else if (jj >= 256) v = sigmoidf_(v);
                la[ttv[u] * LA_LD + jj] = (bf16)f2bf(v); } }
        }
        __syncthreads();
#pragma unroll 1
        for (int u = 0; u < 6; ++u) {
            const int hd = wave * 2 + u / 3, mt = u % 3; const int m = m0 + 16 * mt + c; bool samp; int T, t; tok_info(m, samp, T, t);
            int dtn[4]; bool vn[4];
#pragma unroll
            for (int n = 0; n < 4; ++n) shift_nb(samp, T, t, n, dtn[n], vn[n]);
            float r_[4][4], k_[4][4], v_[4][4]; float ss = 0.f;
#pragma unroll
            for (int nt = 0; nt < 4; ++nt) { const int ch = hd * 64 + 16 * nt + 4 * q; const bf16* pr = P + (size_t)m * PW + ch;
                const v2u wr = *(const v2u*)pr, wk = *(const v2u*)(pr + 1024), wv = *(const v2u*)(pr + 2048);
                const f32x4 mur = *(const LAS f32x4*)(lpar + ch), muk = *(const LAS f32x4*)(lpar + 1024 + ch), muv = *(const LAS f32x4*)(lpar + 2048 + ch), kkw = *(const LAS f32x4*)(lpar + 3072 + ch);
                const float xr[4] = {bflo(wr.x), bfhi(wr.x), bflo(wr.y), bfhi(wr.y)}, xk[4] = {bflo(wk.x), bfhi(wk.x), bflo(wk.y), bfhi(wk.y)}, xv[4] = {bflo(wv.x), bfhi(wv.x), bflo(wv.y), bfhi(wv.y)};
#pragma unroll
                for (int n = 0; n < 4; ++n) { const bf16* pn = pr + (long)dtn[n] * PW + n;
                    const float nr = vn[n] ? bf2f(pn[0]) : 0.f, nk = vn[n] ? bf2f(pn[1024]) : 0.f, nv = vn[n] ? bf2f(pn[2048]) : 0.f;
                    r_[nt][n] = xr[n] + (nr - xr[n]) * mur[n]; k_[nt][n] = xk[n] + (nk - xk[n]) * muk[n]; v_[nt][n] = xv[n] + (nv - xv[n]) * muv[n];
                    const float kkr = k_[nt][n] * kkw[n]; ss += kkr * kkr; } }
            ss += __shfl_xor(ss, 16); ss += __shfl_xor(ss, 32);
            const float kn = 1.0f / sqrtf(ss + 1e-12f);
            float bon0 = 0.f, bon1 = 0.f;
            const LAS bf16* lrow = la + (16 * mt + c) * LA_LD + 8 * q;
#pragma unroll
            for (int nt = 0; nt < 4; ++nt) {
                f32x4 wl0 = F4Z, wl1 = F4Z, al0 = F4Z, al1 = F4Z, gl = F4Z;
#pragma unroll
                for (int ks = 0; ks < 2; ++ks) {
                    const size_t wo = ((size_t)hd * 64 + 16 * nt + c) * 64 + 32 * ks + 8 * q;
                    Frag b, w; v4u x;
                    x = *(const LAS v4u*)(lrow + 32 * ks); b.u[0] = x.x; b.u[1] = x.y; b.u[2] = x.z; b.u[3] = x.w; x = *(const v4u*)(W2T + wo); w.u[0] = x.x; w.u[1] = x.y; w.u[2] = x.z; w.u[3] = x.w; wl0 = mma(w, b, wl0);
                    x = *(const LAS v4u*)(lrow + 64 + 32 * ks); b.u[0] = x.x; b.u[1] = x.y; b.u[2] = x.z; b.u[3] = x.w; x = *(const v4u*)(W2T + 65536 + wo); w.u[0] = x.x; w.u[1] = x.y; w.u[2] = x.z; w.u[3] = x.w; wl1 = mma(w, b, wl1);
                    x = *(const LAS v4u*)(lrow + 128 + 32 * ks); b.u[0] = x.x; b.u[1] = x.y; b.u[2] = x.z; b.u[3] = x.w; x = *(const v4u*)(A2T + wo); w.u[0] = x.x; w.u[1] = x.y; w.u[2] = x.z; w.u[3] = x.w; al0 = mma(w, b, al0);
                    x = *(const LAS v4u*)(lrow + 192 + 32 * ks); b.u[0] = x.x; b.u[1] = x.y; b.u[2] = x.z; b.u[3] = x.w; x = *(const v4u*)(A2T + 65536 + wo); w.u[0] = x.x; w.u[1] = x.y; w.u[2] = x.z; w.u[3] = x.w; al1 = mma(w, b, al1);
                }
#pragma unroll
                for (int ks = 0; ks < 5; ++ks) { Frag b, w; v4u x = *(const LAS v4u*)(lrow + 256 + 32 * ks); b.u[0] = x.x; b.u[1] = x.y; b.u[2] = x.z; b.u[3] = x.w;
                    x = *(const v4u*)(G2T + ((size_t)hd * 64 + 16 * nt + c) * 160 + 32 * ks + 8 * q); w.u[0] = x.x; w.u[1] = x.y; w.u[2] = x.z; w.u[3] = x.w; gl = mma(w, b, gl); }
                const int ch = hd * 64 + 16 * nt + 4 * q; const size_t o = (size_t)m * 1024 + ch;
                bf16* rw = RW + ((size_t)m * 16 + hd) * 576 + 16 * nt + 4 * q;
                const f32x4 kkw = *(const LAS f32x4*)(lpar + 3072 + ch), kaw = *(const LAS f32x4*)(lpar + 4096 + ch), rkw = *(const LAS f32x4*)(lpar + 5120 + ch);
                const f32x4 w00 = *(const LAS f32x4*)(lpar + 6144 + ch), w01 = *(const LAS f32x4*)(lpar + 7168 + ch), a00 = *(const LAS f32x4*)(lpar + 8192 + ch), a01 = *(const LAS f32x4*)(lpar + 9216 + ch);
                float kk[4], lw0[4], lw1[4], kd0[4], kd1[4], b0[4], b1[4];
#pragma unroll
                for (int n = 0; n < 4; ++n) { const float kx = k_[nt][n];
                    kk[n] = kx * kkw[n] * kn;
                    const float ic0 = sigmoidf_(a00[n] + al0[n]), ic1 = sigmoidf_(a01[n] + al1[n]);
                    lw0[n] = -0.6065306597f * 1.4426950409f * sigmoidf_(w00[n] + wl0[n]); lw1[n] = -0.6065306597f * 1.4426950409f * sigmoidf_(w01[n] + wl1[n]);
                    kd0[n] = kx * (1.0f + (ic0 - 1.0f) * kaw[n]); kd1[n] = kx * (1.0f + (ic1 - 1.0f) * kaw[n]); b0[n] = kk[n] * ic0; b1[n] = kk[n] * ic1;
                    bon0 += r_[nt][n] * kd0[n] * rkw[n]; bon1 += r_[nt][n] * kd1[n] * rkw[n]; }
                *(v2u*)(rw) = (v2u){cvtpk(r_[nt][0], r_[nt][1]), cvtpk(r_[nt][2], r_[nt][3])}; *(v2u*)(rw + 128) = (v2u){cvtpk(v_[nt][0], v_[nt][1]), cvtpk(v_[nt][2], v_[nt][3])};
                *(v2u*)(rw + 64) = (v2u){cvtpk(-kk[0], -kk[1]), cvtpk(-kk[2], -kk[3])};
                *(v2u*)(rw + 192) = (v2u){cvtpk(kd0[0], kd0[1]), cvtpk(kd0[2], kd0[3])}; *(v2u*)(rw + 256) = (v2u){cvtpk(kd1[0], kd1[1]), cvtpk(kd1[2], kd1[3])};
                *(v2u*)(rw + 320) = (v2u){cvtpk(b0[0], b0[1]), cvtpk(b0[2], b0[3])}; *(v2u*)(rw + 384) = (v2u){cvtpk(b1[0], b1[1]), cvtpk(b1[2], b1[3])};
                *(v2u*)(rw + 448) = (v2u){cvtpk(lw0[0], lw0[1]), cvtpk(lw0[2], lw0[3])}; *(v2u*)(rw + 512) = (v2u){cvtpk(lw1[0], lw1[1]), cvtpk(lw1[2], lw1[3])};
                *(f32x4*)(GT + o) = gl;
                __builtin_amdgcn_sched_barrier(0);
            }
            bon0 += __shfl_xor(bon0, 16); bon0 += __shfl_xor(bon0, 32); bon1 += __shfl_xor(bon1, 16); bon1 += __shfl_xor(bon1, 32);
            if (q == 0) { BON[((size_t)m * 2 + 0) * 16 + hd] = bon0; BON[((size_t)m * 2 + 1) * 16 + hd] = bon1; }
        }
#pragma unroll 1
        for (int r3 = 0; r3 < 3; ++r3) {
            const int unit = wave + 8 * r3; const int hd = unit / 3, mt = unit - hd * 3; const int m = m0 + 16 * mt + c; bool samp; int T, t; tok_info(m, samp, T, t);
            const bool hp = t > 0, hn = t + 1 < T;
            float sqk[2] = {0.f, 0.f};
#pragma unroll
            for (int pass = 0; pass < 2; ++pass) {
                float scl[2] = {1.f, 1.f};
                if (pass == 1) { sqk[0] += __shfl_xor(sqk[0], 16); sqk[0] += __shfl_xor(sqk[0], 32); sqk[1] += __shfl_xor(sqk[1], 16); sqk[1] += __shfl_xor(sqk[1], 32);
                    scl[0] = 1.0f / sqrtf(sqk[0] + 1e-6f); scl[1] = 1.0f / sqrtf(sqk[1] + 1e-6f); }
#pragma unroll
                for (int part = 0; part < 3; ++part) {
                    if (pass == 0 && part == 2) continue;
                    bf16* dst = GD + ((size_t)m * 8 + hd) * 384 + part * 128 + 4 * q; const float sc = part < 2 ? scl[part] : 1.f; float acc = 0.f;
#pragma unroll 4
                    for (int g = 0; g < 8; ++g) { const int ch = part * 1024 + hd * 128 + 16 * g + 4 * q; const bf16* pp = P + (size_t)m * PW + PC_GDN + ch;
                        const v2u x1 = *(const v2u*)pp; v2u x0 = {0u, 0u}, x2 = {0u, 0u}; if (hp) x0 = *(const v2u*)(pp - PW); if (hn) x2 = *(const v2u*)(pp + PW);
                        const f32x4 c0 = *(const LAS f32x4*)(lcw + ch), c1 = *(const LAS f32x4*)(lcw + 3072 + ch), c2 = *(const LAS f32x4*)(lcw + 2 * 3072 + ch);
                        float val[4];
                        val[0] = siluf_(bflo(x0.x) * c0[0] + bflo(x1.x) * c1[0] + bflo(x2.x) * c2[0]); val[1] = siluf_(bfhi(x0.x) * c0[1] + bfhi(x1.x) * c1[1] + bfhi(x2.x) * c2[1]);
                        val[2] = siluf_(bflo(x0.y) * c0[2] + bflo(x1.y) * c1[2] + bflo(x2.y) * c2[2]); val[3] = siluf_(bfhi(x0.y) * c0[3] + bfhi(x1.y) * c1[3] + bfhi(x2.y) * c2[3]);
                        if (pass == 0) acc += (val[0] * val[0] + val[1] * val[1]) + (val[2] * val[2] + val[3] * val[3]);
                        else *(v2u*)(dst + 16 * g) = (v2u){cvtpk(val[0] * sc, val[1] * sc), cvtpk(val[2] * sc, val[3] * sc)}; }
                    if (pass == 0) sqk[part] = acc;
                }
            }
        }
        for (int idx = tid; idx < 48 * 16; idx += NTHR) { const int tt = idx >> 4, dh = idx & 15; const int m = m0 + tt;
            BETA[(size_t)m * 16 + dh] = sigmoidf_(bf2f(P[(size_t)m * PW + PC_BETA + dh]));
            GG[(size_t)m * 16 + dh] = -1.4426950409f * __expf(a.in[I_ALOG][i * 16 + dh]) * softplusf_(bf2f(P[(size_t)m * PW + PC_ALPHA + dh]) + a.in[I_DTB][i * 16 + dh]); }
        __syncthreads();
    }
}
__device__ __forceinline__ void ph_post(const Args& a, int i) {
    const int tid = opaque_tid(), lane = tid & 63, wave = __builtin_amdgcn_readfirstlane(tid >> 6);
    const int gw = blockIdx.x * NWAVES + wave, NGW = gridDim.x * NWAVES;
    constexpr size_t S1 = (size_t)NTOK * 1024;
    const float* GT = (const float*)((const bf16*)(a.ws + WS_SC) + 12 * S1); const bf16* YS = (const bf16*)(a.ws + WS_Y); const bf16* OG = YS + 2 * S1;
    const bf16* P = (const bf16*)(a.ws + WS_P); bf16* O = (bf16*)(a.ws + WS_O);
    const float* gnw = a.in[I_GNW] + i * 128;
    for (int m = gw; m < NTOK; m += NGW) {
#pragma unroll
        for (int j = 0; j < 2; ++j) { const int ch = j * 512 + lane * 8; const size_t o = (size_t)m * 1024 + ch;
            const v4u y0 = *(const v4u*)(YS + o), y1 = *(const v4u*)(YS + S1 + o); const f32x4 g0 = *(const f32x4*)(GT + o), g1 = *(const f32x4*)(GT + o + 4);
            v4u w; w.x = pk2((bflo(y0.x) + bflo(y1.x)) * g0.x, (bfhi(y0.x) + bfhi(y1.x)) * g0.y); w.y = pk2((bflo(y0.y) + bflo(y1.y)) * g0.z, (bfhi(y0.y) + bfhi(y1.y)) * g0.w);
            w.z = pk2((bflo(y0.z) + bflo(y1.z)) * g1.x, (bfhi(y0.z) + bfhi(y1.z)) * g1.y); w.w = pk2((bflo(y0.w) + bflo(y1.w)) * g1.z, (bfhi(y0.w) + bfhi(y1.w)) * g1.w);
            *(v4u*)(O + (size_t)m * D + ch) = w; }
#pragma unroll
        for (int j = 0; j < 2; ++j) { const int ch = j * 512 + lane * 8; const size_t o = (size_t)m * 1024 + ch;
            const v4u o0 = *(const v4u*)(OG + o), o1 = *(const v4u*)(OG + S1 + o), zz = *(const v4u*)(P + (size_t)m * PW + PC_Z + ch);
            const f32x4 w0 = *(const f32x4*)(gnw + (ch & 127)), w1 = *(const f32x4*)(gnw + (ch & 127) + 4);
            float ov[8] = {bflo(o0.x) + bflo(o1.x), bfhi(o0.x) + bfhi(o1.x), bflo(o0.y) + bflo(o1.y), bfhi(o0.y) + bfhi(o1.y), bflo(o0.z) + bflo(o1.z), bfhi(o0.z) + bfhi(o1.z), bflo(o0.w) + bflo(o1.w), bfhi(o0.w) + bfhi(o1.w)};
            const float zv[8] = {bflo(zz.x), bfhi(zz.x), bflo(zz.y), bfhi(zz.y), bflo(zz.z), bfhi(zz.z), bflo(zz.w), bfhi(zz.w)};
            const float gw8[8] = {w0.x, w0.y, w0.z, w0.w, w1.x, w1.y, w1.z, w1.w};
            float ss = 0.f;
#pragma unroll
            for (int e = 0; e < 8; ++e) ss += ov[e] * ov[e];
            const float rs = 1.0f / sqrtf(row_sum16(ss) * (1.0f / 128.0f) + RMS_EPS);
#pragma unroll
            for (int e = 0; e < 8; ++e) ov[e] = ov[e] * rs * gw8[e] * siluf_(zv[e]);
            v4u w; w.x = pk2(ov[0], ov[1]); w.y = pk2(ov[2], ov[3]); w.z = pk2(ov[4], ov[5]); w.w = pk2(ov[6], ov[7]);
            *(v4u*)(O + (size_t)m * D + 1024 + ch) = w; }
    }
}

constexpr int PH_PER_LAYER = 9, N_PHASES = 2 + 4 * PH_PER_LAYER;
__host__ __device__ inline bool phase_exists(int ph) { if (ph == 0 || ph == N_PHASES - 1) return true; const int l = (ph - 1) / PH_PER_LAYER, k = (ph - 1) % PH_PER_LAYER; return (l & 1) ? !(k == 2 || k == 3 || k == 4) : true; }

#define RUN(ph) (a.ph_lo <= (ph) && (ph) < a.ph_hi)
#define SEAM(ph) do { if ((ph) + 1 < a.ph_hi) xcd_barrier(bar); } while (0)
#define SEAMX(ph) xcd_barrier(bar)
template <int L> __device__ __forceinline__ void run_layer(const Args& a, LAS unsigned char* lds, const XcdBarrier& bar) {
    constexpr int l = L, pb = 1 + PH_PER_LAYER * L, i = L >> 1;
    const int G = gridDim.x, bx = blockIdx.x;
    bf16* H = (bf16*)(a.ws + WS_H); bf16* O = (bf16*)(a.ws + WS_O); bf16* P = (bf16*)(a.ws + WS_P);
    const float* modl = (const float*)(a.ws + WS_MOD) + (size_t)l * 9 * 12288;
    if (RUN(pb + 0)) { ph_norm(a, l, 0); SEAM(pb + 0); }
#ifdef DUP_NORM
    if (RUN(pb + 0)) { ph_norm(a, l, 0); SEAMX(pb + 0); }
#endif
    if constexpr ((L & 1) == 0) {
        if (RUN(pb + 1)) { pg8::Gemm g{H, (const bf16*)(a.ws + WS_WIN) + (size_t)i * PW * 2048, NTOK, PW, 2048, 2048, 2048, 0, 0}; pg8::StaticOrder S; S.init(NTOK, PW, G, bx);
            pg8::EpiBf16 E{P, PW}; pg8::gemm_phase<pg8::EpiBf16, pg8::StaticOrder, true, true>(lds, g, S, E); SEAM(pb + 1); }
#ifdef DUP_GIN
        if (RUN(pb + 1)) { pg8::Gemm g{H, (const bf16*)(a.ws + WS_WIN) + (size_t)i * PW * 2048, NTOK, PW, 2048, 2048, 2048, 0, 0}; pg8::StaticOrder S; S.init(NTOK, PW, G, bx);
            pg8::EpiBf16 E{P, PW}; pg8::gemm_phase<pg8::EpiBf16, pg8::StaticOrder, true, true>(lds, g, S, E); SEAMX(pb + 1); }
#endif
        if (RUN(pb + 2)) { ph_prep(a, lds, i); SEAM(pb + 2); }
#ifdef DUP_PREP
        if (RUN(pb + 2)) { ph_prep(a, lds, i); SEAMX(pb + 2); }
#endif
        if (RUN(pb + 3)) { ph_scan(a, lds, i); SEAM(pb + 3); }
#ifdef DUP_SCAN
        if (RUN(pb + 3)) { ph_scan(a, lds, i); SEAMX(pb + 3); }
#endif
        if (RUN(pb + 4)) { ph_post(a, i); SEAM(pb + 4); }
#ifdef DUP_POST
        if (RUN(pb + 4)) { ph_post(a, i); SEAMX(pb + 4); }
#endif
        if (RUN(pb + 5)) { pg8::Gemm g{O, (const bf16*)(a.ws + WS_WOUT) + (size_t)i * 2048 * 2048, NTOK, 2048, 2048, 2048, 2048, 0, 0}; pg8::StaticOrder S; S.init(NTOK, 2048, G, bx);
            pg8::EpiResid E{l == 0 ? a.in[I_XP] : nullptr, a.in[I_XS], a.out, modl + 2 * 2048, nullptr};
            pg8::gemm_phase<pg8::EpiResid, pg8::StaticOrder, true, true>(lds, g, S, E); SEAM(pb + 5); }
    } else {
        if (RUN(pb + 1)) { ph_pool(a); SEAM(pb + 1); }
#ifdef DUP_POOL
        if (RUN(pb + 1)) { ph_pool(a); SEAMX(pb + 1); }
#endif
        if (RUN(pb + 5)) { pg8::Gemm g{O, (const bf16*)(a.ws + WS_WPOOL) + (size_t)i * 2048 * 512, NTOK, 2048, 512, 2048, 512, 1, 512}; pg8::StaticOrder S; S.init(NTOK, 2048, G, bx);
            pg8::EpiResid E{nullptr, nullptr, a.out, modl + 2 * 2048, a.in[I_POOLS] + i * 2048};
            pg8::gemm_phase<pg8::EpiResid, pg8::StaticOrder, true, true>(lds, g, S, E); SEAM(pb + 5); }
    }
    if (RUN(pb + 6)) { ph_norm(a, l, 1); SEAM(pb + 6); }
    if (RUN(pb + 7)) { pg8::Gemm g{H, (const bf16*)(a.ws + WS_WGU) + (size_t)l * 11264 * 2048, NTOK, 11264, 2048, 2048, 2048, 0, 0}; pg8::StaticOrder S; S.init(NTOK, 11264, G, bx);
        pg8::EpiSwiGLU E{P, DFF}; pg8::gemm_phase<pg8::EpiSwiGLU, pg8::StaticOrder, true, true>(lds, g, S, E); SEAM(pb + 7); }
#ifdef DUP_GGU
    if (RUN(pb + 7)) { pg8::Gemm g{H, (const bf16*)(a.ws + WS_WGU) + (size_t)l * 11264 * 2048, NTOK, 11264, 2048, 2048, 2048, 0, 0}; pg8::StaticOrder S; S.init(NTOK, 11264, G, bx);
        pg8::EpiSwiGLU E{P, DFF}; pg8::gemm_phase<pg8::EpiSwiGLU, pg8::StaticOrder, true, true>(lds, g, S, E); SEAMX(pb + 7); }
#endif
    if (RUN(pb + 8)) { pg8::Gemm g{P, (const bf16*)(a.ws + WS_WDN) + (size_t)l * 2048 * DFF, NTOK, 2048, DFF, DFF, DFF, 0, 0}; pg8::StaticOrder S; S.init(NTOK, 2048, G, bx);
        pg8::EpiResid E{nullptr, nullptr, a.out, modl + 5 * 2048, nullptr};
        pg8::gemm_phase<pg8::EpiResid, pg8::StaticOrder, true, true>(lds, g, S, E); SEAM(pb + 8); }
}

__global__ void __launch_bounds__(NTHR, 2) fwd(Args a) {
    extern __shared__ __attribute__((aligned(16))) unsigned char lds_raw[];
    LAS unsigned char* lds = (LAS unsigned char*)lds_raw;
    const int tid = threadIdx.x;
    volatile LAS unsigned* MISC = (volatile LAS unsigned*)(lds + LDS_MISC);
    for (int u = tid; u < (LDS_BYTES - LDS_STAGE) / 4; u += NTHR) ((LAS unsigned*)(lds + LDS_STAGE))[u] = 0u;
    __syncthreads();
    XcdBarrier bar; bar.bar = (unsigned*)(a.ws + WS_CTL) + CW_BAR; bar.x = 0; bar.st = nullptr;
    const bool multi = a.ph_hi - a.ph_lo > 1;
    if (multi) bar = xcd_barrier_post((unsigned*)(a.ws + WS_CTL) + CW_BAR, MISC + 8);
    if (RUN(0)) { ph_pre(a, lds); SEAM(0); }
#ifdef DUP_PRE
    if (RUN(0)) { ph_pre(a, lds); SEAMX(0); }
#endif
    run_layer<0>(a, lds, bar);
    run_layer<1>(a, lds, bar);
    run_layer<2>(a, lds, bar);
    run_layer<3>(a, lds, bar);
    if (RUN(N_PHASES - 1)) ph_final(a);
}
#undef RUN
#undef SEAM
#undef SEAMX

#ifndef MK_ONE_LAUNCH
#define MK_ONE_LAUNCH 1
#endif
extern "C" void kernel_launch(void* const* d_in, const int* in_sizes, int n_in, void* d_out, int out_size, void* d_ws, size_t ws_size, hipStream_t stream) {
    static int grid = 0;
    if (grid == 0) {
        if (n_in != N_IN || ws_size < WS_END) { fprintf(stderr, "kernel_launch: expected %d inputs and >= %zu bytes of workspace; got %d, %zu\n", (int)N_IN, (size_t)WS_END, n_in, ws_size); grid = -1; return; }
        int dev = 0, cus = 0, per_cu = 0;
        if (hipGetDevice(&dev) != hipSuccess || hipDeviceGetAttribute(&cus, hipDeviceAttributeMultiprocessorCount, dev) != hipSuccess) { grid = -1; return; }
        if (hipFuncSetAttribute((const void*)fwd, hipFuncAttributeMaxDynamicSharedMemorySize, LDS_BYTES) != hipSuccess) { fprintf(stderr, "kernel_launch: hipFuncSetAttribute failed\n"); grid = -1; return; }
        if (hipOccupancyMaxActiveBlocksPerMultiprocessor(&per_cu, (const void*)fwd, NTHR, LDS_BYTES) != hipSuccess || per_cu < 1) fprintf(stderr, "kernel_launch: occupancy query reports %d\n", per_cu);
        (void)hipGetLastError();
        grid = cus;
    }
    if (grid < 0) return;
    if (hipMemsetAsync((char*)d_ws + WS_CTL, 0, CTL_ZERO_BYTES, stream) != hipSuccess) return;
    Args a{};
    for (int i = 0; i < N_IN; ++i) a.in[i] = (const float*)d_in[i];
    a.out = (float*)d_out; a.ws = (unsigned char*)d_ws;
#if MK_ONE_LAUNCH
    a.ph_lo = 0; a.ph_hi = N_PHASES;
    hipLaunchKernelGGL(fwd, dim3(grid), dim3(NTHR), LDS_BYTES, stream, a);
#else
    for (int ph = 0; ph < N_PHASES; ++ph) { if (!phase_exists(ph)) continue; a.ph_lo = ph; a.ph_hi = ph + 1; hipLaunchKernelGGL(fwd, dim3(grid), dim3(NTHR), LDS_BYTES, stream, a); }
#endif
}
```

```cpp
#include <hip/hip_runtime.h>
#include <cstdio>
#include <cstdint>

namespace pg8 {
#define PG8_LAS __attribute__((address_space(3)))
typedef unsigned short bf16_t;
typedef short bf16x8 __attribute__((ext_vector_type(8)));
typedef float f32x4 __attribute__((ext_vector_type(4)));
typedef unsigned u32x4 __attribute__((ext_vector_type(4)));
constexpr int BM = 256, BK = 64, HALF = 128, HTB = HALF * BK * 2  , STAGE_BYTES = 8 * HTB, NXCD = 8, WGM = 8;

__host__ __device__ __forceinline__ int lds_byte(int r, int c) { const int st = (r >> 4) * 2 + (c >> 5), rr = r & 15, cc = c & 31, ob = rr * 64 + cc * 2; return st * 1024 + (ob ^ (((ob >> 9) & 1) << 5)); }
__host__ __device__ __forceinline__ void stage_rc(int b, int& R, int& C) { const int st = b / 1024, sb = b % 1024, swz = sb ^ (((sb >> 9) & 1) << 5); R = (st >> 1) * 16 + swz / 64; C = (st & 1) * 32 + (swz % 64) / 2; }
__host__ __device__ __forceinline__ int perm32(int rho) { const int n = rho >> 4, i = rho & 15; return 8 * (i >> 2) + 4 * n + (i & 3); }

struct Unit { int pm, pn; };
struct Gemm { const bf16_t* A; const bf16_t* Bt; int M, N, K, lda, ldb, gsh, gk; };

struct StaticOrder {
    int nM, nN, nwg, G, c;
    __host__ __device__ void init(int M, int N, int G_, int c_) { nM = M / BM; nN = N / BM; nwg = nM * nN; G = G_; c = c_; }
    __host__ __device__ bool next(int i, Unit& u) const {
        const long L = (long)i * G + c; if (L >= nwg) return false;
        int wgid = (int)L; { const int q = nwg / NXCD, r = nwg % NXCD, xcd = wgid % NXCD, off = wgid / NXCD; wgid = (xcd < r ? xcd * (q + 1) : r * (q + 1) + (xcd - r) * q) + off; }
        const int nig = WGM * nN, gid = wgid / nig, fm = gid * WGM, gsz = (nM - fm) < WGM ? (nM - fm) : WGM;
        u.pm = fm + ((wgid % nig) % gsz); u.pn = (wgid % nig) / gsz; return true;
    }
    __device__ __forceinline__ void a_ready(const Unit&) const {}
    __device__ __forceinline__ void done(const Unit&) const {}
};

__device__ __forceinline__ unsigned cvt_pk_bf16(float lo, float hi) { unsigned r; asm volatile("v_cvt_pk_bf16_f32 %0, %1, %2" : "=v"(r) : "v"(lo), "v"(hi)); return r; }

__device__ __forceinline__ int cond_of_panel(int pm) { return pm < 16 ? 0 : 1 + ((pm - 16) >> 2); }

struct EpiBf16 {
    static constexpr bool PERM = true, AFTER_DRAIN = false;
    bf16_t* O; int ldc;
    __device__ __forceinline__ void operator()(const f32x4 (&acc)[2][2][4][2], const Unit& u, int wr, int wc, int fr, int fq) const {
        const int row0 = u.pm * BM + wr * 64 + fr; const int col0 = u.pn * BM + wc * 32 + 8 * fq;
#pragma unroll
        for (int ai = 0; ai < 2; ++ai)
#pragma unroll
            for (int m = 0; m < 4; ++m) { bf16_t* rowp = O + (size_t)(row0 + ai * HALF + m * 16) * ldc + col0;
#pragma unroll
                for (int bj = 0; bj < 2; ++bj) { const f32x4 v0 = acc[ai][bj][m][0], v1 = acc[ai][bj][m][1];
                    u32x4 w; w.x = cvt_pk_bf16(v0[0], v0[1]); w.y = cvt_pk_bf16(v0[2], v0[3]); w.z = cvt_pk_bf16(v1[0], v1[1]); w.w = cvt_pk_bf16(v1[2], v1[3]);
                    *(u32x4*)(rowp + bj * HALF) = w; } }
    }
};
struct EpiSwiGLU {
    static constexpr bool PERM = true, AFTER_DRAIN = false;
    bf16_t* O; int ldc;
    __device__ __forceinline__ void operator()(const f32x4 (&acc)[2][2][4][2], const Unit& u, int wr, int wc, int fr, int fq) const {
        const int row0 = u.pm * BM + wr * 64 + fr; const int col0 = u.pn * HALF + wc * 32 + 8 * fq;
#pragma unroll
        for (int ai = 0; ai < 2; ++ai)
#pragma unroll
            for (int m = 0; m < 4; ++m) { bf16_t* rowp = O + (size_t)(row0 + ai * HALF + m * 16) * ldc + col0;
                float o[8];
#pragma unroll
                for (int n = 0; n < 2; ++n)
#pragma unroll
                    for (int e = 0; e < 4; ++e) { const float gte = acc[ai][0][m][n][e], up = acc[ai][1][m][n][e]; o[n * 4 + e] = gte * __builtin_amdgcn_rcpf(1.0f + __expf(-gte)) * up; }
                u32x4 w; w.x = cvt_pk_bf16(o[0], o[1]); w.y = cvt_pk_bf16(o[2], o[3]); w.z = cvt_pk_bf16(o[4], o[5]); w.w = cvt_pk_bf16(o[6], o[7]);
                *(u32x4*)rowp = w; }
    }
};
struct EpiResid {
    static constexpr bool PERM = false, AFTER_DRAIN = false;
    const float* xin_p; const float* xin_s; float* xout; const float* gate  ; const float* cscale;
    __device__ __forceinline__ void operator()(const f32x4 (&acc)[2][2][4][2], const Unit& u, int wr, int wc, int fr, int fq) const {
        const int row0 = u.pm * BM + wr * 64 + fr, col0 = u.pn * BM + wc * 32 + 4 * fq;
        const float* gp = gate + (size_t)cond_of_panel(u.pm) * 12288 + col0;
        f32x4 gv[2][2];
#pragma unroll
        for (int bj = 0; bj < 2; ++bj)
#pragma unroll
            for (int n = 0; n < 2; ++n) { gv[bj][n] = *(const f32x4*)(gp + bj * HALF + n * 16); if (cscale) gv[bj][n] = gv[bj][n] * *(const f32x4*)(cscale + col0 + bj * HALF + n * 16); }
#pragma unroll
        for (int ai = 0; ai < 2; ++ai)
#pragma unroll
            for (int m = 0; m < 4; ++m) { const int row = row0 + ai * HALF + m * 16;
                const float* xi = xin_p ? (row < 4096 ? xin_p + (size_t)row * 2048 : xin_s + (size_t)(row - 4096) * 2048) : xout + (size_t)row * 2048;
                float* xo = xout + (size_t)row * 2048;
#pragma unroll
                for (int bj = 0; bj < 2; ++bj)
#pragma unroll
                    for (int n = 0; n < 2; ++n) { const f32x4 xv = *(const f32x4*)(xi + col0 + bj * HALF + n * 16); *(f32x4*)(xo + col0 + bj * HALF + n * 16) = xv + gv[bj][n] * acc[ai][bj][m][n]; } }
    }
};

template <class Epi, class Sched, bool ALIGN_EPI = false, bool SP2 = false>
__device__ __forceinline__ void gemm_phase(PG8_LAS unsigned char* lds, const Gemm g, const Sched& S, const Epi& E) {
    const int tid = threadIdx.x, wid = __builtin_amdgcn_readfirstlane(tid >> 6), lane = tid & 63, wr = wid >> 2, wc = wid & 3, fr = lane & 15, fq = lane >> 4;
    const int K = g.K, nt = K / BK;
    unsigned voffA[2], voffB[2];
#pragma unroll
    for (int i = 0; i < 2; ++i) { int R, C; stage_rc(tid * 16 + i * 8192, R, C); const int Rb = Epi::PERM ? ((R & ~31) + perm32(R & 31)) : R;
        voffA[i] = (unsigned)(R * g.lda + C) * 2u; voffB[i] = (unsigned)(Rb * g.ldb + C) * 2u; }
    const size_t kstep = (size_t)(BK * 2);
    const size_t hstepA = (size_t)HALF * g.lda * 2, hstepB = (size_t)HALF * g.ldb * 2;
    const size_t tstepA = 2 * hstepA, tstepB = 2 * hstepB;
    const unsigned ldsw = (unsigned)wid * 1024u;
    const int aoff = lds_byte(wr * 64 + fr, fq * 8), boff = lds_byte(wc * 32 + fr, fq * 8);
#define PG8_SA(b, h) (((b) * 2 + (h)) * HTB)
#define PG8_SB(b, h) ((4 + (b) * 2 + (h)) * HTB)
#define PG8_STAGE(bufoff, gbase, voff) do { _Pragma("unroll") for (int _i = 0; _i < 2; ++_i) \
        __builtin_amdgcn_global_load_lds((const unsigned*)((const char*)(gbase) + (voff)[_i]), (PG8_LAS unsigned*)(lds + (bufoff) + ldsw + _i * 8192), 16, 0, 0); } while (0)
#define PG8_LDA(dst, b, h) do { _Pragma("unroll") for (int m = 0; m < 4; ++m) _Pragma("unroll") for (int k = 0; k < 2; ++k) dst[m][k] = *(const PG8_LAS bf16x8*)(lds + PG8_SA(b, h) + aoff + m * 2048 + k * 1024); } while (0)
#define PG8_LDB(dst, b, h) do { _Pragma("unroll") for (int n = 0; n < 2; ++n) _Pragma("unroll") for (int k = 0; k < 2; ++k) dst[n][k] = *(const PG8_LAS bf16x8*)(lds + PG8_SB(b, h) + boff + n * 2048 + k * 1024); } while (0)
#define PG8_MMA(ai, bj, At, Bt) do { __builtin_amdgcn_s_setprio(1); _Pragma("unroll") for (int m = 0; m < 4; ++m) _Pragma("unroll") for (int n = 0; n < 2; ++n) _Pragma("unroll") for (int k = 0; k < 2; ++k) \
        acc[ai][bj][m][n] = __builtin_amdgcn_mfma_f32_16x16x32_bf16(Bt[n][k], At[m][k], acc[ai][bj][m][n], 0, 0, 0); __builtin_amdgcn_s_setprio(0); } while (0)
#define PG8_WAIT_V(n) asm volatile("s_waitcnt vmcnt(" #n ")" ::: "memory")
#define PG8_WAIT_L(n) asm volatile("s_waitcnt lgkmcnt(" #n ")" ::: "memory")
#define PG8_BAR __builtin_amdgcn_s_barrier()
#define PG8_SCHED __builtin_amdgcn_sched_barrier(0)
    Unit cur, nxt; int ui = 0;
    if (!S.next(0, cur)) return;
    f32x4 acc[2][2][4][2];
#pragma unroll
    for (int a = 0; a < 2; ++a)
#pragma unroll
        for (int b = 0; b < 2; ++b)
#pragma unroll
            for (int m = 0; m < 4; ++m)
#pragma unroll
                for (int n = 0; n < 2; ++n) acc[a][b][m][n] = (f32x4){0.f, 0.f, 0.f, 0.f};
    bf16x8 At[4][2], B0[2][2], B1[2][2];
    const char* cA = (const char*)g.A + (size_t)cur.pm * tstepA + (size_t)((cur.pn >> g.gsh) * g.gk) * 2; const char* cB = (const char*)g.Bt + (size_t)cur.pn * tstepB;
    S.a_ready(cur);
    if constexpr (SP2) {
        PG8_STAGE(PG8_SB(0, 0), cB, voffB); PG8_STAGE(PG8_SB(0, 1), cB + hstepB, voffB); PG8_STAGE(PG8_SA(0, 0), cA, voffA); PG8_STAGE(PG8_SA(0, 1), cA + hstepA, voffA);
        if (wr == 1) PG8_BAR;
        PG8_WAIT_V(2); PG8_BAR;
        PG8_STAGE(PG8_SB(1, 0), cB + kstep, voffB); PG8_STAGE(PG8_SA(1, 0), cA + kstep, voffA); PG8_STAGE(PG8_SB(1, 1), cB + hstepB + kstep, voffB);
        PG8_WAIT_V(6); PG8_BAR;
    } else {
        PG8_STAGE(PG8_SB(0, 0), cB, voffB); PG8_STAGE(PG8_SA(0, 0), cA, voffA); PG8_STAGE(PG8_SB(0, 1), cB + hstepB, voffB); PG8_STAGE(PG8_SA(0, 1), cA + hstepA, voffA);
        if (wr == 1) PG8_BAR;
        PG8_WAIT_V(4); PG8_BAR;
        PG8_STAGE(PG8_SB(1, 0), cB + kstep, voffB); PG8_STAGE(PG8_SA(1, 0), cA + kstep, voffA); PG8_STAGE(PG8_SB(1, 1), cB + hstepB + kstep, voffB);
        PG8_WAIT_V(6); PG8_BAR;
    }
    for (;;) {
        const bool has_next = S.next(ui + 1, nxt);
        const char* nA = has_next ? (const char*)g.A + (size_t)nxt.pm * tstepA + (size_t)((nxt.pn >> g.gsh) * g.gk) * 2 : cA; const char* nB = has_next ? (const char*)g.Bt + (size_t)nxt.pn * tstepB : cB;
        for (int t = 0; t < nt; t += 2) {
            const bool last = (t == nt - 2);
            const char* a1 = cA + (size_t)(t + 1) * kstep;
            const char* a2 = last ? nA : cA + (size_t)(t + 2) * kstep; const char* b2 = last ? nB : cB + (size_t)(t + 2) * kstep;
            const char* a3 = a2 + kstep; const char* b3 = b2 + kstep;
            if (last && has_next) S.a_ready(nxt);
            if constexpr (SP2) {
            PG8_LDB(B0, 0, 0); PG8_LDB(B1, 0, 1); PG8_SCHED; PG8_LDA(At, 0, 0); PG8_STAGE(PG8_SA(1, 1), a1 + hstepA, voffA);
            PG8_WAIT_V(8); PG8_WAIT_L(0); PG8_BAR; PG8_MMA(0, 0, At, B0); PG8_MMA(0, 1, At, B1); PG8_BAR; PG8_SCHED;
            PG8_LDA(At, 0, 1); PG8_STAGE(PG8_SB(0, 0), b2, voffB); PG8_STAGE(PG8_SB(0, 1), b2 + hstepB, voffB); PG8_STAGE(PG8_SA(0, 0), a2, voffA);
            PG8_WAIT_V(8); PG8_WAIT_L(0); PG8_BAR; PG8_MMA(1, 0, At, B0); PG8_MMA(1, 1, At, B1); PG8_BAR; PG8_SCHED;
            PG8_LDB(B0, 1, 0); PG8_LDB(B1, 1, 1); PG8_SCHED; PG8_LDA(At, 1, 0); PG8_STAGE(PG8_SA(0, 1), a2 + hstepA, voffA);
            PG8_WAIT_V(8); PG8_WAIT_L(0); PG8_BAR; PG8_MMA(0, 0, At, B0); PG8_MMA(0, 1, At, B1); PG8_BAR; PG8_SCHED;
            PG8_LDA(At, 1, 1); PG8_STAGE(PG8_SB(1, 0), b3, voffB); PG8_STAGE(PG8_SB(1, 1), b3 + hstepB, voffB); PG8_STAGE(PG8_SA(1, 0), a3, voffA);
            PG8_WAIT_V(8); PG8_WAIT_L(0); PG8_BAR; PG8_MMA(1, 0, At, B0); PG8_MMA(1, 1, At, B1); PG8_BAR; PG8_SCHED;
            } else {
            PG8_LDB(B0, 0, 0); PG8_SCHED; PG8_LDA(At, 0, 0); PG8_STAGE(PG8_SA(1, 1), a1 + hstepA, voffA);
            PG8_WAIT_L(8); PG8_BAR; PG8_WAIT_L(0); PG8_MMA(0, 0, At, B0); PG8_BAR; PG8_SCHED;
            PG8_LDB(B1, 0, 1); PG8_STAGE(PG8_SB(0, 0), b2, voffB);
            PG8_BAR; PG8_WAIT_L(0); PG8_MMA(0, 1, At, B1); PG8_BAR;
            PG8_LDA(At, 0, 1); PG8_STAGE(PG8_SA(0, 0), a2, voffA);
            PG8_BAR; PG8_WAIT_L(0); PG8_MMA(1, 0, At, B0); PG8_BAR; PG8_SCHED;
            PG8_STAGE(PG8_SB(0, 1), b2 + hstepB, voffB);
            PG8_WAIT_V(6); PG8_BAR; PG8_MMA(1, 1, At, B1); PG8_BAR;
            PG8_LDB(B0, 1, 0); PG8_SCHED; PG8_LDA(At, 1, 0); PG8_STAGE(PG8_SA(0, 1), a2 + hstepA, voffA);
            PG8_WAIT_L(8); PG8_BAR; PG8_WAIT_L(0); PG8_MMA(0, 0, At, B0); PG8_BAR; PG8_SCHED;
            PG8_LDB(B1, 1, 1); PG8_STAGE(PG8_SB(1, 0), b3, voffB);
            PG8_BAR; PG8_WAIT_L(0); PG8_MMA(0, 1, At, B1); PG8_BAR;
            PG8_LDA(At, 1, 1); PG8_STAGE(PG8_SA(1, 0), a3, voffA);
            PG8_BAR; PG8_WAIT_L(0); PG8_MMA(1, 0, At, B0); PG8_BAR; PG8_SCHED;
            PG8_STAGE(PG8_SB(1, 1), b3 + hstepB, voffB);
            PG8_WAIT_V(6); PG8_BAR; PG8_MMA(1, 1, At, B1); PG8_BAR;
            }
        }
        if constexpr (ALIGN_EPI) { if (wr == 0) PG8_BAR; }
        if constexpr (!Epi::AFTER_DRAIN) { E(acc, cur, wr, wc, fr, fq); S.done(cur); }
        if (!has_next) break;
#pragma unroll
        for (int a = 0; a < 2; ++a)
#pragma unroll
            for (int b = 0; b < 2; ++b)
#pragma unroll
                for (int m = 0; m < 4; ++m)
#pragma unroll
                    for (int n = 0; n < 2; ++n) acc[a][b][m][n] = (f32x4){0.f, 0.f, 0.f, 0.f};
        cur = nxt; cA = nA; cB = nB; ++ui;
        if constexpr (ALIGN_EPI) { if (wr == 1) PG8_BAR; }
    }
    PG8_WAIT_V(0);
    if constexpr (!ALIGN_EPI) { if (wr == 0) PG8_BAR; }
    PG8_BAR;
    if constexpr (Epi::AFTER_DRAIN) { E.fused(acc, cur, wr, wc, fr, fq, lds, wid, lane); S.done(cur); }
#undef PG8_SA
#undef PG8_SB
#undef PG8_STAGE
#undef PG8_LDA
#undef PG8_LDB
#undef PG8_MMA
#undef PG8_WAIT_V
#undef PG8_WAIT_L
#undef PG8_BAR
#undef PG8_SCHED
}
}

constexpr int D = 2048, NTOK = 12288, NPROMPT = 4096, DFF = 5632, PW = 7680  , CPA = 3488;
constexpr int NWAVES = 8, NTHR = 512;
constexpr int PC_GDN = 3072, PC_Z = 6144, PC_LORA = 7168, PC_BETA = 7584, PC_ALPHA = 7600;
constexpr float RMS_EPS = 1e-6f, GN_EPS = 64e-5f;

constexpr size_t MiB = 1u << 20;
constexpr size_t WS_CTL = 0, CTL_ZERO_BYTES = 1 * MiB;
constexpr size_t WS_MOD = 1 * MiB;
constexpr size_t WS_WIN = 3 * MiB;
constexpr size_t WS_WOUT = 63 * MiB;
constexpr size_t WS_WGU = 79 * MiB;
constexpr size_t WS_WDN = 255 * MiB;
constexpr size_t WS_WPOOL = 343 * MiB;
constexpr size_t WS_H = 347 * MiB;
constexpr size_t WS_O = 395 * MiB;
constexpr size_t WS_P = 443 * MiB;
constexpr size_t WS_SC = 623 * MiB;
constexpr size_t SC_ONE = 48 * MiB;
constexpr size_t WS_Y = 1247 * MiB;
constexpr size_t WS_SMALL = 1439 * MiB;
constexpr size_t WS_LORA = 1443 * MiB;
constexpr size_t WS_END = 1445 * MiB;
constexpr int CW_BAR = 4096;

constexpr int LDS_STAGE = 131072, LDS_MISC = LDS_STAGE + 320, LDS_BYTES = 147456;

#define GAS __attribute__((address_space(1)))
#define LAS __attribute__((address_space(3)))
typedef unsigned short bf16;
typedef unsigned v4u __attribute__((ext_vector_type(4)));
typedef unsigned v2u __attribute__((ext_vector_type(2)));
typedef float f32x4 __attribute__((ext_vector_type(4)));
typedef float f32x2 __attribute__((ext_vector_type(2)));
#define LDS_WAIT() asm volatile("s_waitcnt lgkmcnt(0)" ::: "memory")

__device__ __forceinline__ unsigned f2bf(float f) { unsigned u = __builtin_bit_cast(unsigned, f); return (u + 0x7fffu + ((u >> 16) & 1u)) >> 16; }
__device__ __forceinline__ unsigned pk2(float lo, float hi) { return f2bf(lo) | (f2bf(hi) << 16); }
__device__ __forceinline__ float bf2f(bf16 b) { return __builtin_bit_cast(float, (unsigned)b << 16); }
__device__ __forceinline__ float bflo(unsigned w) { return __builtin_bit_cast(float, w << 16); }
__device__ __forceinline__ float bfhi(unsigned w) { return __builtin_bit_cast(float, w & 0xffff0000u); }
__device__ __forceinline__ float sigmoidf_(float x) { return __builtin_amdgcn_rcpf(1.0f + __builtin_amdgcn_exp2f(-1.4426950409f * x)); }
__device__ __forceinline__ float siluf_(float x) { return x * __builtin_amdgcn_rcpf(1.0f + __builtin_amdgcn_exp2f(-1.4426950409f * x)); }
__device__ __forceinline__ float softplusf_(float x) { return x > 20.f ? x : log1pf(__expf(x)); }
__device__ __forceinline__ float wave_sum(float v) {
#pragma unroll
    for (int o = 1; o < 64; o <<= 1) v += __shfl_xor(v, o);
    return v;
}
__device__ __forceinline__ int opaque_tid() { int t = threadIdx.x; asm volatile("" : "+v"(t)); return t; }
__device__ __forceinline__ float rdl(float v, int k) { return __builtin_bit_cast(float, __builtin_amdgcn_readlane(__builtin_bit_cast(int, v), k)); }

#define XB_TMO      128
#define XB_XCNT(j)  (256  + 64 * (j))
#define XB_XSUB(j)  (1280 + 64 * (j))
#define XB_XGEN(j)  (2304 + 64 * (j))
#define XB_TOP      3328
#define XB_TOPGEN   3392
#define XCD_BAR_WORDS 3456
#define XB_SPIN_CAP (1u << 18)
__device__ __forceinline__ unsigned xb_ld(unsigned* p)              { return __hip_atomic_load(p, __ATOMIC_RELAXED, __HIP_MEMORY_SCOPE_AGENT); }
__device__ __forceinline__ unsigned xb_add(unsigned* p, unsigned v) { return __hip_atomic_fetch_add(p, v, __ATOMIC_RELAXED, __HIP_MEMORY_SCOPE_AGENT); }
__device__ __forceinline__ unsigned xb_xcc_id() { return (unsigned)__builtin_amdgcn_s_getreg((3 << 11) | 20) & 0xFu; }
#define XB_SPIN(cond, bar) do { unsigned _sp = 0; while (cond) { __builtin_amdgcn_s_sleep(1); \
    if ((++_sp & 255u) == 0u) { if (xb_ld(&(bar)[XB_TMO])) break; if (_sp > XB_SPIN_CAP) { atomicAdd(&(bar)[XB_TMO], 1u); break; } } } } while (0)
struct XcdBarrier { unsigned* bar; unsigned x; volatile LAS unsigned* st; };
__device__ __forceinline__ XcdBarrier xcd_barrier_post(unsigned* bar, volatile LAS unsigned* st) {
    XcdBarrier b; b.bar = bar; b.x = xb_xcc_id(); b.st = st;
    if (threadIdx.x == 0) (void)xb_add(&bar[XB_XCNT(b.x)], 1u);
    return b;
}
__device__ __forceinline__ void xcd_barrier_complete(unsigned* bar, unsigned x, unsigned& nloc, unsigned& nx) {
    const unsigned G = gridDim.x * gridDim.y * gridDim.z;
    unsigned sum, cnt, mine, sp = 0u;
    for (;;) {
        sum = 0u; cnt = 0u; mine = 0u;
#pragma unroll
        for (unsigned j = 0; j < 16; ++j) { const unsigned c = xb_ld(&bar[XB_XCNT(j)]); sum += c; cnt += (c > 0u) ? 1u : 0u; mine = (j == x) ? c : mine; }
        if (sum == G) break;
        __builtin_amdgcn_s_sleep(1);
        if ((++sp & 255u) == 0u) { if (xb_ld(&bar[XB_TMO])) break; if (sp > XB_SPIN_CAP) { atomicAdd(&bar[XB_TMO], 1u); break; } }
    }
    nloc = mine > 0u ? mine : 1u; nx = cnt > 0u ? cnt : 1u;
}
__device__ __forceinline__ void xcd_barrier(const XcdBarrier& b) {
    asm volatile("s_waitcnt vmcnt(0)" ::: "memory");
    __syncthreads();
    if (threadIdx.x == 0) {
        unsigned* bar = b.bar;
        __builtin_amdgcn_s_waitcnt(0);
        unsigned nloc = b.st[0], nx = b.st[1];
        if (nloc == 0u) { xcd_barrier_complete(bar, b.x, nloc, nx); b.st[0] = nloc; b.st[1] = nx; }
        const unsigned old = xb_add(&bar[XB_XSUB(b.x)], 1u);
        const unsigned gen = old / nloc;
        if (old + 1u == (gen + 1u) * nloc) {
            __builtin_amdgcn_fence(__ATOMIC_RELEASE, "agent");
            asm volatile("s_waitcnt vmcnt(0)" ::: "memory");
            const unsigned og = xb_add(&bar[XB_TOP], 1u);
            const unsigned tg = og / nx;
            if (og + 1u == (tg + 1u) * nx) xb_add(&bar[XB_TOPGEN], 1u);
            else XB_SPIN(xb_ld(&bar[XB_TOPGEN]) == tg, bar);
            __builtin_amdgcn_fence(__ATOMIC_ACQUIRE, "agent");
            xb_add(&bar[XB_XGEN(b.x)], 1u);
            asm volatile("s_waitcnt vmcnt(0)" ::: "memory");
        } else {
            XB_SPIN(xb_ld(&bar[XB_XGEN(b.x)]) == gen, bar);
            __builtin_amdgcn_fence(__ATOMIC_ACQUIRE, "agent");
            asm volatile("s_waitcnt vmcnt(0)" ::: "memory");
        }
    }
    __syncthreads();
}

enum { I_XP = 0, I_XS, I_SRW, I_SDL, I_C, I_CCTX, I_MODW, I_MODB, I_NMIX, I_NFFN, I_NFIN, I_WIN, I_WOUT, I_MU, I_W0, I_W2, I_A0, I_A2, I_G2, I_KK, I_KA, I_RK, I_LNW, I_LNB,
       I_CONVW, I_ALOG, I_DTB, I_GNW, I_POOLW, I_POOLS, I_WG, I_WU, I_WD, N_IN };
struct Args { const float* in[N_IN]; float* out; unsigned char* ws; int ph_lo, ph_hi; };
constexpr size_t OUT_SRW = (size_t)NTOK * D, OUT_SDL = OUT_SRW + (size_t)16 * 2 * 2 * 16 * 64 * 64;

__device__ __forceinline__ void conv_item(const float* W, int K, int N, bf16* WT, int drow0, LAS float* scr, int kb, int nb, int lane) {
    const int k0 = 64 * kb, n0 = 32 * nb;
#pragma unroll 8
    for (int i = 0; i < 32; ++i) { const int kk = 2 * i + (lane >> 5); scr[kk * 33 + (lane & 31)] = W[(size_t)(k0 + kk) * N + n0 + (lane & 31)]; }
    LDS_WAIT(); asm volatile("" ::: "memory");
    const int c = lane & 7;
#pragma unroll
    for (int j = 0; j < 4; ++j) { const int n = (lane >> 3) + 8 * j; const LAS float* s = scr + (8 * c) * 33 + n;
        v4u o; o.x = pk2(s[0 * 33], s[1 * 33]); o.y = pk2(s[2 * 33], s[3 * 33]); o.z = pk2(s[4 * 33], s[5 * 33]); o.w = pk2(s[6 * 33], s[7 * 33]);
        *(v4u*)(WT + (size_t)(drow0 + n) * K + k0 + 8 * c) = o; }
    LDS_WAIT(); asm volatile("" ::: "memory");
}
__device__ __forceinline__ int win_row(int n) { return n < 3072 ? n : (n < CPA ? PC_LORA + (n - 3072) : (n < CPA + 4096 ? PC_GDN + (n - CPA) : n)); }

__device__ __forceinline__ void ph_pre(const Args& a, LAS unsigned char* lds) {
    const int tid = opaque_tid(), lane = tid & 63, wave = __builtin_amdgcn_readfirstlane(tid >> 6);
    const int G = gridDim.x;
    LAS float* ca = (LAS float*)lds;
    LAS float* red = (LAS float*)(lds + 2048 * 9 * 4);
    for (int i = tid; i < 9 * 2048; i += NTHR) { const int c = i / 2048, k = i - c * 2048; const float v = c == 0 ? a.in[I_CCTX][k] : a.in[I_C][(c - 1) * 2048 + k]; ca[k * 9 + c] = siluf_(v); }
    __syncthreads();
    float* MOD = (float*)(a.ws + WS_MOD);
    for (int task = blockIdx.x; task < 4 * 96; task += G) {
        const int l = task / 96, cb = task - l * 96;
        const float* wp = a.in[I_MODW] + ((size_t)l * 2048 + wave * 256) * 12288 + cb * 128 + lane * 2;
        float acc[9][2];
#pragma unroll
        for (int c = 0; c < 9; ++c) { acc[c][0] = 0.f; acc[c][1] = 0.f; }
        for (int k8 = 0; k8 < 256; k8 += 8) {
            f32x2 wv[8];
#pragma unroll
            for (int j = 0; j < 8; ++j) wv[j] = *(const f32x2*)(wp + (size_t)(k8 + j) * 12288);
#pragma unroll
            for (int j = 0; j < 8; ++j) { const LAS float* cp = ca + (wave * 256 + k8 + j) * 9;
#pragma unroll
                for (int c = 0; c < 9; ++c) { const float s = cp[c]; acc[c][0] += s * wv[j].x; acc[c][1] += s * wv[j].y; } }
        }
#pragma unroll
        for (int c = 0; c < 9; ++c) { red[(wave * 18 + c * 2) * 64 + lane] = acc[c][0]; red[(wave * 18 + c * 2 + 1) * 64 + lane] = acc[c][1]; }
        __syncthreads();
        for (int o = tid; o < 9 * 128; o += NTHR) { const int c = o >> 7, col = o & 127, ln = col >> 1, j = col & 1; float s = a.in[I_MODB][l * 12288 + cb * 128 + col];
#pragma unroll
            for (int w = 0; w < 8; ++w) s += red[(w * 18 + c * 2 + j) * 64 + ln];
            MOD[((size_t)l * 9 + c) * 12288 + cb * 128 + col] = s; }
        __syncthreads();
    }
    __syncthreads();
    LAS float* scr = (LAS float*)(lds + wave * 16384);
    const int gw = blockIdx.x * NWAVES + wave, NGW = G * NWAVES;
    bf16* WIN = (bf16*)(a.ws + WS_WIN); bf16* WOUT = (bf16*)(a.ws + WS_WOUT); bf16* WGU = (bf16*)(a.ws + WS_WGU); bf16* WDN = (bf16*)(a.ws + WS_WDN); bf16* WPOOL = (bf16*)(a.ws + WS_WPOOL);
    constexpr int IT_WIN = 32 * 238, IT_WOUT = 32 * 64, IT_GU = 32 * 176, IT_DN = 88 * 64, IT_POOL = 8 * 16;
    constexpr int NITEMS = 2 * IT_WIN + 2 * IT_WOUT + 8 * IT_GU + 4 * IT_DN + 8 * IT_POOL;
    for (int it = gw; it < NITEMS; it += NGW) {
        int r = it;
        if (r < 2 * IT_WIN) { const int i = r / IT_WIN; r -= i * IT_WIN; const int kb = r / 238, nb = r - kb * 238;
            conv_item(a.in[I_WIN] + (size_t)i * 2048 * 7616, 2048, 7616, WIN + (size_t)i * PW * 2048, win_row(32 * nb), scr, kb, nb, lane); continue; } r -= 2 * IT_WIN;
        if (r < 2 * IT_WOUT) { const int i = r / IT_WOUT; r -= i * IT_WOUT; const int kb = r / 64, nb = r - kb * 64;
            conv_item(a.in[I_WOUT] + (size_t)i * 2048 * 2048, 2048, 2048, WOUT + (size_t)i * 2048 * 2048, 32 * nb, scr, kb, nb, lane); continue; } r -= 2 * IT_WOUT;
        if (r < 8 * IT_GU) { const int li = r / IT_GU; r -= li * IT_GU; const int l = li >> 1, up = li & 1; const int kb = r / 176, nb = r - kb * 176; const int n0 = 32 * nb;
            conv_item(a.in[up ? I_WU : I_WG] + (size_t)l * 2048 * DFF, 2048, DFF, WGU + (size_t)l * 11264 * 2048, (n0 >> 7) * 256 + up * 128 + (n0 & 127), scr, kb, nb, lane); continue; } r -= 8 * IT_GU;
        if (r < 4 * IT_DN) { const int l = r / IT_DN; r -= l * IT_DN; const int kb = r / 64, nb = r - kb * 64;
            conv_item(a.in[I_WD] + (size_t)l * DFF * 2048, DFF, 2048, WDN + (size_t)l * 2048 * DFF, 32 * nb, scr, kb, nb, lane); continue; } r -= 4 * IT_DN;
        { const int ig = r / IT_POOL; r -= ig * IT_POOL; const int kb = r / 16, nb = r - kb * 16;
            conv_item(a.in[I_POOLW] + (size_t)ig * 512 * 512, 512, 512, WPOOL + (size_t)ig * 512 * 512, 32 * nb, scr, kb, nb, lane); }
    }
    { bf16* LW = (bf16*)(a.ws + WS_LORA); const int gt = blockIdx.x * NTHR + tid, NGT = G * NTHR;
        for (int idx = gt; idx < 8 * 65536; idx += NGT) { const int mat = idx >> 16, n = (idx >> 6) & 1023, k = idx & 63;
            const float v = (mat < 4 ? a.in[I_W2] : a.in[I_A2])[((size_t)(mat & 3) * 64 + k) * 1024 + n]; LW[idx] = (bf16)f2bf(v); }
        for (int idx = gt; idx < 2 * 1024 * 160; idx += NGT) { const int i2 = idx / (1024 * 160), r = idx - i2 * 1024 * 160, n = r / 160, k = r - n * 160;
            LW[8 * 65536 + idx] = (bf16)f2bf(a.in[I_G2][((size_t)i2 * 160 + k) * 1024 + n]); } }
    for (int r = gw; r < 128; r += NGW) { bf16* row = WIN + ((size_t)(r >> 6) * PW + 7616 + (r & 63)) * 2048; const v4u z = {0u, 0u, 0u, 0u};
#pragma unroll
        for (int j = 0; j < 4; ++j) *(v4u*)(row + (j * 64 + lane) * 8) = z; }
}

__device__ __forceinline__ void ph_norm(const Args& a, int l, int which) {
    const int tid = opaque_tid(), lane = tid & 63, wave = __builtin_amdgcn_readfirstlane(tid >> 6);
    const int gw = blockIdx.x * NWAVES + wave, NGW = gridDim.x * NWAVES;
    const float* nw = a.in[which ? I_NFFN : I_NMIX] + l * 2048;
    const float* MOD = (const float*)(a.ws + WS_MOD) + (size_t)l * 9 * 12288;
    bf16* H = (bf16*)(a.ws + WS_H);
    const bool from_in = (l == 0 && which == 0);
    for (int m = gw; m < NTOK; m += NGW) {
        const float* xr = from_in ? (m < NPROMPT ? a.in[I_XP] + (size_t)m * D : a.in[I_XS] + (size_t)(m - NPROMPT) * D) : a.out + (size_t)m * D;
        const int cond = m < NPROMPT ? 0 : 1 + ((m - NPROMPT) >> 10);
        const float* sh = MOD + (size_t)cond * 12288 + (which ? 3 : 0) * 2048; const float* sc = sh + 2048;
        f32x4 v[8]; float s = 0.f;
#pragma unroll
        for (int j = 0; j < 8; ++j) { v[j] = *(const f32x4*)(xr + 4 * lane + 256 * j); s += (v[j].x * v[j].x + v[j].y * v[j].y) + (v[j].z * v[j].z + v[j].w * v[j].w); }
        const float rstd = 1.0f / sqrtf(wave_sum(s) * (1.0f / D) + RMS_EPS);
#pragma unroll
        for (int j = 0; j < 8; ++j) { const int c = 4 * lane + 256 * j; const f32x4 w = *(const f32x4*)(nw + c), s1 = *(const f32x4*)(sc + c), s0 = *(const f32x4*)(sh + c);
            const f32x4 y = (v[j] * rstd) * w * (s1 + 1.0f) + s0;
            v2u o; o.x = pk2(y.x, y.y); o.y = pk2(y.z, y.w); *(v2u*)(H + (size_t)m * D + c) = o; }
    }
}
__device__ __forceinline__ void ph_final(const Args& a) {
    const int tid = opaque_tid(), lane = tid & 63, wave = __builtin_amdgcn_readfirstlane(tid >> 6);
    const int gw = blockIdx.x * NWAVES + wave, NGW = gridDim.x * NWAVES;
    const float* nw = a.in[I_NFIN];
    for (int m = gw; m < NTOK; m += NGW) {
        float* xr = a.out + (size_t)m * D;
        f32x4 v[8]; float s = 0.f;
#pragma unroll
        for (int j = 0; j < 8; ++j) { v[j] = *(const f32x4*)(xr + 4 * lane + 256 * j); s += (v[j].x * v[j].x + v[j].y * v[j].y) + (v[j].z * v[j].z + v[j].w * v[j].w); }
        const float rstd = 1.0f / sqrtf(wave_sum(s) * (1.0f / D) + RMS_EPS);
#pragma unroll
        for (int j = 0; j < 8; ++j) { const int c = 4 * lane + 256 * j; const f32x4 w = *(const f32x4*)(nw + c); *(f32x4*)(xr + c) = (v[j] * rstd) * w; }
    }
}
__device__ __forceinline__ void ph_pool(const Args& a) {
    const int tid = opaque_tid(), lane = tid & 63, wave = __builtin_amdgcn_readfirstlane(tid >> 6);
    const int gw = blockIdx.x * NWAVES + wave, NGW = gridDim.x * NWAVES;
    const bf16* H = (const bf16*)(a.ws + WS_H); bf16* O = (bf16*)(a.ws + WS_O);
    for (int m = gw; m < NTOK; m += NGW) {
        const bool samp = m >= NPROMPT; const int T = samp ? 1024 : 256; const int base = samp ? NPROMPT + (((m - NPROMPT) >> 10) << 10) : (m >> 8) << 8; const int t = m - base;
#pragma unroll
        for (int g = 0; g < 4; ++g) {
            const int win = 2 << g; int lo = t - win / 2, hi = lo + win; lo = lo < 0 ? 0 : lo; hi = hi > T ? T : hi;
            const int c = g * 512 + lane * 8;
            float s[8];
#pragma unroll
            for (int e = 0; e < 8; ++e) s[e] = 0.f;
            for (int r = lo; r < hi; ++r) { const v4u w = *(const v4u*)(H + (size_t)(base + r) * D + c);
                s[0] += bflo(w.x); s[1] += bfhi(w.x); s[2] += bflo(w.y); s[3] += bfhi(w.y); s[4] += bflo(w.z); s[5] += bfhi(w.z); s[6] += bflo(w.w); s[7] += bfhi(w.w); }
            const float inv = 1.0f / (float)(hi - lo);
            const v4u w = *(const v4u*)(H + (size_t)m * D + c);
            v4u o; o.x = pk2(s[0] * inv - bflo(w.x), s[1] * inv - bfhi(w.x)); o.y = pk2(s[2] * inv - bflo(w.y), s[3] * inv - bfhi(w.y));
            o.z = pk2(s[4] * inv - bflo(w.z), s[5] * inv - bfhi(w.z)); o.w = pk2(s[6] * inv - bflo(w.w), s[7] * inv - bfhi(w.w));
            *(v4u*)(O + (size_t)m * D + c) = o;
        }
    }
}

typedef short sfrag __attribute__((ext_vector_type(8)));
union Frag { sfrag v; unsigned u[4]; };
typedef __bf16 bf16x2_t __attribute__((ext_vector_type(2)));
__device__ __forceinline__ unsigned cvtpk(float lo, float hi) { const f32x2 v = {lo, hi}; return __builtin_bit_cast(unsigned, __builtin_convertvector(v, bf16x2_t)); }
__device__ __forceinline__ f32x4 mma(const Frag& A, const Frag& B, f32x4 C) { return __builtin_amdgcn_mfma_f32_16x16x32_bf16(A.v, B.v, C, 0, 0, 0); }
__device__ __forceinline__ Frag feed1(f32x4 d0) { Frag f; f.u[0] = cvtpk(d0.x, d0.y); f.u[1] = cvtpk(d0.z, d0.w); f.u[2] = 0u; f.u[3] = 0u; return f; }
__device__ __forceinline__ Frag feed2(f32x4 d0, f32x4 d1) { Frag f; f.u[0] = cvtpk(d0.x, d0.y); f.u[1] = cvtpk(d0.z, d0.w); f.u[2] = cvtpk(d1.x, d1.y); f.u[3] = cvtpk(d1.z, d1.w); return f; }
#define DPP_SHR(x, n, fill) __builtin_bit_cast(float, __builtin_amdgcn_update_dpp(__builtin_bit_cast(int, (float)(fill)), __builtin_bit_cast(int, (float)(x)), 0x110 + (n), 0xf, 0xf, false))
__device__ __forceinline__ float row_scan16(float x) { x += DPP_SHR(x, 1, 0.f); x += DPP_SHR(x, 2, 0.f); x += DPP_SHR(x, 4, 0.f); x += DPP_SHR(x, 8, 0.f); return x; }
#define DPP_ROR(x, n) __builtin_bit_cast(float, __builtin_amdgcn_update_dpp(0, __builtin_bit_cast(int, (float)(x)), 0x120 + (n), 0xf, 0xf, false))
__device__ __forceinline__ float row_sum16(float x) { x += DPP_ROR(x, 8); x += DPP_ROR(x, 4); x += DPP_ROR(x, 2); x += DPP_ROR(x, 1); return x; }
__device__ __forceinline__ float lane_get(float x, int src) { return __builtin_bit_cast(float, __builtin_amdgcn_ds_bpermute(src << 2, __builtin_bit_cast(int, x))); }
constexpr f32x4 F4Z = {0.f, 0.f, 0.f, 0.f};
__device__ __forceinline__ f32x4 tri_inv_T(f32x4 dL, f32x4 dLT, f32x4 eye) {
    const Frag fL = feed1(dL), fLT = feed1(dLT);
    const f32x4 L2 = mma(fLT, fL, F4Z), L2T = mma(fL, fLT, F4Z);
    const Frag f2 = feed1(L2), f2T = feed1(L2T);
    const f32x4 L4 = mma(f2T, f2, F4Z), L4T = mma(f2, f2T, F4Z);
    const f32x4 L8 = mma(feed1(L4T), feed1(L4), F4Z);
    const f32x4 R1 = mma(feed1(L2 + eye), feed1(dLT + eye), F4Z);
    const f32x4 R2 = mma(feed1(L4 + eye), feed1(R1), F4Z);
    return mma(feed1(L8 + eye), feed1(R2), F4Z);
}

__device__ __forceinline__ void rwkv_task(const Args& a, int i, int s, int h, int d, int lane, LAS float* wscr) {
    constexpr size_t S1 = (size_t)NTOK * 1024;
    const bf16* RW = (const bf16*)(a.ws + WS_SC);
    bf16* YS = (bf16*)(a.ws + WS_Y) + d * S1;
    const float* BON = (const float*)(a.ws + WS_SMALL);
    const float* lnw = a.in[I_LNW] + i * 1024 + h * 64; const float* lnb = a.in[I_LNB] + i * 1024 + h * 64;
    const int T = s < 16 ? 256 : 1024; const int row0 = s < 16 ? s * 256 : NPROMPT + (s - 16) * 1024;
    const int c = lane & 15, q = lane >> 4;
    f32x4 S[4][4];
    if (s >= 16) { const float* s0 = a.in[I_SRW] + ((((size_t)(s - 16) * 2 + i) * 2 + d) * 16 + h) * 4096;
#pragma unroll
        for (int kt = 0; kt < 4; ++kt)
#pragma unroll
            for (int vt = 0; vt < 4; ++vt) S[kt][vt] = *(const f32x4*)(s0 + (16 * vt + c) * 64 + 16 * kt + 4 * q); }
    else {
#pragma unroll
        for (int kt = 0; kt < 4; ++kt)
#pragma unroll
            for (int vt = 0; vt < 4; ++vt) S[kt][vt] = F4Z; }
    Frag sel[2];
#pragma unroll
    for (int p = 0; p < 2; ++p)
#pragma unroll
        for (int j = 0; j < 4; ++j) { const int e0 = 2 * j - 4 * p; const bool on = ((lane >> 2) & 3) == q && (e0 == (lane & 3) || e0 + 1 == (lane & 3)) && (j >> 1) == p;
            sel[p].u[j] = on ? (((lane & 1) == 0) ? 0x00003F80u : 0x3F800000u) : 0u; }
    bool mlt[4], mle[4]; f32x4 eye;
#pragma unroll
    for (int n = 0; n < 4; ++n) { mlt[n] = (4 * q + n) < c; mle[n] = (4 * q + n) <= c; eye[n] = (4 * q + n) == c ? 1.f : 0.f; }
    const int nch = T >> 4;
    const int kof = (3 + d) * 1024, bof = (5 + d) * 1024, lof = (7 + d) * 1024;
    v2u nr[4], na[4], nk[4], nb[4], nlw[4], nv[4];
    { const int tok = d ? T - 1 - c : c; const int mrow = row0 + tok; const bf16* rw = RW + (((size_t)(mrow >> 4) * 16 + h) * 9) * 1024 + (mrow & 15) * 16 + 4 * q;
#pragma unroll
        for (int g = 0; g < 4; ++g) { nr[g] = *(const v2u*)(rw + 256 * g); na[g] = *(const v2u*)(rw + 1024 + 256 * g); nk[g] = *(const v2u*)(rw + kof + 256 * g); nb[g] = *(const v2u*)(rw + bof + 256 * g); nlw[g] = *(const v2u*)(rw + lof + 256 * g); nv[g] = *(const v2u*)(rw + 2048 + 256 * g); } }
    for (int ch = 0; ch < nch; ++ch) {
        Frag f_at[2], f_rt[2], f_bt[2], f_kt[2], f_bh[2], f_kh[2], f_v[2];
#pragma unroll
        for (int g = 0; g < 4; ++g) {
            const int ks = g >> 1, hf = g & 1;
            float lw_[4] = {bflo(nlw[g].x), bfhi(nlw[g].x), bflo(nlw[g].y), bfhi(nlw[g].y)};
            float r_[4] = {bflo(nr[g].x), bfhi(nr[g].x), bflo(nr[g].y), bfhi(nr[g].y)}, a_[4] = {bflo(na[g].x), bfhi(na[g].x), bflo(na[g].y), bfhi(na[g].y)};
            float k_[4] = {bflo(nk[g].x), bfhi(nk[g].x), bflo(nk[g].y), bfhi(nk[g].y)}, b_[4] = {bflo(nb[g].x), bfhi(nb[g].x), bflo(nb[g].y), bfhi(nb[g].y)};
            float at[4], rt[4], bt[4], kt[4], bh[4], kh[4];
#pragma unroll
            for (int n = 0; n < 4; ++n) {
                const float G = row_scan16(lw_[n]); const float E1 = __builtin_amdgcn_exp2f(G), E2 = __builtin_amdgcn_rcpf(E1); const float E3 = DPP_SHR(E1, 1, 1.0f);
                const float ec = lane_get(E1, (lane & 48) | 15); wscr[(g * 4 + n) * 64 + lane] = ec;
                at[n] = a_[n] * E3; rt[n] = r_[n] * E1; bt[n] = b_[n] * E2; kt[n] = k_[n] * E2; bh[n] = bt[n] * ec; kh[n] = kt[n] * ec;
            }
            f_at[ks].u[2 * hf] = cvtpk(at[0], at[1]); f_at[ks].u[2 * hf + 1] = cvtpk(at[2], at[3]); f_rt[ks].u[2 * hf] = cvtpk(rt[0], rt[1]); f_rt[ks].u[2 * hf + 1] = cvtpk(rt[2], rt[3]);
            f_bt[ks].u[2 * hf] = cvtpk(bt[0], bt[1]); f_bt[ks].u[2 * hf + 1] = cvtpk(bt[2], bt[3]); f_kt[ks].u[2 * hf] = cvtpk(kt[0], kt[1]); f_kt[ks].u[2 * hf + 1] = cvtpk(kt[2], kt[3]);
            f_bh[ks].u[2 * hf] = cvtpk(bh[0], bh[1]); f_bh[ks].u[2 * hf + 1] = cvtpk(bh[2], bh[3]); f_kh[ks].u[2 * hf] = cvtpk(kh[0], kh[1]); f_kh[ks].u[2 * hf + 1] = cvtpk(kh[2], kh[3]);
            f_v[ks].u[2 * hf] = nv[g].x; f_v[ks].u[2 * hf + 1] = nv[g].y;
            __builtin_amdgcn_sched_barrier(0);
        }
        LAS v2u* sV = (LAS v2u*)(wscr + 3072); LAS v4u* sBK = (LAS v4u*)(wscr + 1024);
#pragma unroll
        for (int g = 0; g < 4; ++g) { const f32x4 dv = mma(f_v[g >> 1], sel[g & 1], F4Z); sV[g * 64 + lane] = (v2u){cvtpk(dv.x, dv.y), cvtpk(dv.z, dv.w)};
            const Frag fb = feed2(mma(f_bh[g >> 1], sel[g & 1], F4Z), mma(f_kh[g >> 1], sel[g & 1], F4Z)); sBK[g * 64 + lane] = (v4u){fb.u[0], fb.u[1], fb.u[2], fb.u[3]}; }
        __builtin_amdgcn_sched_barrier(0);
        f32x4 dLab = mma(f_at[1], f_bt[1], mma(f_at[0], f_bt[0], F4Z));
        f32x4 dLabT = mma(f_bt[1], f_at[1], mma(f_bt[0], f_at[0], F4Z));
        f32x4 dLakT = mma(f_kt[1], f_at[1], mma(f_kt[0], f_at[0], F4Z));
        f32x4 dArbT = mma(f_bt[1], f_rt[1], mma(f_bt[0], f_rt[0], F4Z));
        f32x4 dArkT = mma(f_kt[1], f_rt[1], mma(f_kt[0], f_rt[0], F4Z));
#pragma unroll
        for (int n = 0; n < 4; ++n) { dLab[n] = (c < 4 * q + n) ? dLab[n] : 0.f; dLabT[n] = mlt[n] ? dLabT[n] : 0.f; dLakT[n] = mlt[n] ? dLakT[n] : 0.f; dArbT[n] = mle[n] ? dArbT[n] : 0.f; dArkT[n] = mle[n] ? dArkT[n] : 0.f; }
        const Frag fTT = feed1(tri_inv_T(dLab, dLabT, eye)), fLakT = feed1(dLakT), fArbT = feed1(dArbT), fArkT = feed1(dArkT);
        __builtin_amdgcn_sched_barrier(0);
        { const int chn = ch + 1 < nch ? ch + 1 : ch; const int tok = d ? T - 1 - (16 * chn + c) : 16 * chn + c; const int mrow = row0 + tok; const bf16* rw = RW + (((size_t)(mrow >> 4) * 16 + h) * 9) * 1024 + (mrow & 15) * 16 + 4 * q;
#pragma unroll
            for (int g = 0; g < 4; ++g) { nr[g] = *(const v2u*)(rw + 256 * g); na[g] = *(const v2u*)(rw + 1024 + 256 * g); nk[g] = *(const v2u*)(rw + kof + 256 * g); nb[g] = *(const v2u*)(rw + bof + 256 * g); nlw[g] = *(const v2u*)(rw + lof + 256 * g); nv[g] = *(const v2u*)(rw + 2048 + 256 * g); } }
        __builtin_amdgcn_sched_barrier(0);
        v2u pSA[4];
        const int tokbase = 16 * ch + 4 * q;
#pragma unroll
        for (int vt = 0; vt < 4; ++vt) {
            const Frag fS0 = feed2(S[0][vt], S[1][vt]), fS1 = feed2(S[2][vt], S[3][vt]); const v2u pv = sV[vt * 64 + lane]; Frag fV; fV.u[0] = pv.x; fV.u[1] = pv.y; fV.u[2] = 0u; fV.u[3] = 0u;
            f32x4 rhs = mma(f_at[1], fS1, mma(f_at[0], fS0, F4Z)); rhs = mma(fLakT, fV, rhs);
            const f32x4 sa = mma(fTT, feed1(rhs), F4Z); pSA[vt].x = cvtpk(sa.x, sa.y); pSA[vt].y = cvtpk(sa.z, sa.w);
            Frag fSA; fSA.u[0] = pSA[vt].x; fSA.u[1] = pSA[vt].y; fSA.u[2] = 0u; fSA.u[3] = 0u;
            f32x4 y = mma(f_rt[1], fS1, mma(f_rt[0], fS0, F4Z)); y = mma(fArbT, fSA, y); y = mma(fArkT, fV, y);
#pragma unroll
            for (int n = 0; n < 4; ++n) wscr[2048 + (vt * 4 + n) * 64 + lane] = y[n];
            __builtin_amdgcn_sched_barrier(0);
        }
#pragma unroll
        for (int vt = 0; vt < 4; ++vt) { const v2u pv = sV[vt * 64 + lane]; Frag fB; fB.u[0] = pSA[vt].x; fB.u[1] = pSA[vt].y; fB.u[2] = pv.x; fB.u[3] = pv.y;
#pragma unroll
            for (int kt = 0; kt < 4; ++kt) { f32x4 cin;
#pragma unroll
                for (int n = 0; n < 4; ++n) cin[n] = S[kt][vt][n] * wscr[(kt * 4 + n) * 64 + lane];
                const v4u w = sBK[kt * 64 + lane]; Frag fbk; fbk.u[0] = w.x; fbk.u[1] = w.y; fbk.u[2] = w.z; fbk.u[3] = w.w;
                S[kt][vt] = mma(fbk, fB, cin); } }
        __builtin_amdgcn_sched_barrier(0);
        {
            float s1[4] = {0.f, 0.f, 0.f, 0.f}, s2[4] = {0.f, 0.f, 0.f, 0.f};
#pragma unroll
            for (int vt = 0; vt < 4; ++vt)
#pragma unroll
                for (int n = 0; n < 4; ++n) { const float yv = wscr[2048 + (vt * 4 + n) * 64 + lane]; s1[n] += yv; s2[n] += yv * yv; }
            float mean[4], rs[4], bon[4]; size_t orow[4];
#pragma unroll
            for (int n = 0; n < 4; ++n) { const float m1 = row_sum16(s1[n]) * (1.0f / 64.0f), m2 = row_sum16(s2[n]) * (1.0f / 64.0f); mean[n] = m1; rs[n] = 1.0f / sqrtf(fmaxf(m2 - m1 * m1, 0.f) + GN_EPS);
                const int t = tokbase + n; const int tok = d ? T - 1 - t : t; const int mrow = row0 + tok; bon[n] = BON[((size_t)mrow * 2 + d) * 16 + h]; orow[n] = (((size_t)(mrow >> 4) * 16 + h) * 4) * 256 + (mrow & 15) * 16 + c; }
#pragma unroll
            for (int vt = 0; vt < 4; ++vt) { const float lw_ = lnw[16 * vt + c], lb_ = lnb[16 * vt + c];
                const v2u pv = sV[vt * 64 + lane]; const float vv[4] = {bflo(pv.x), bfhi(pv.x), bflo(pv.y), bfhi(pv.y)};
#pragma unroll
                for (int n = 0; n < 4; ++n) { const float yv = wscr[2048 + (vt * 4 + n) * 64 + lane];
                    YS[orow[n] + vt * 256] = (bf16)f2bf((yv - mean[n]) * rs[n] * lw_ + lb_ + bon[n] * vv[n]); } }
        }
    }
    if (s < 16) { float* so = a.out + OUT_SRW + ((((size_t)s * 2 + i) * 2 + d) * 16 + h) * 4096;
#pragma unroll
        for (int kt = 0; kt < 4; ++kt)
#pragma unroll
            for (int vt = 0; vt < 4; ++vt) *(f32x4*)(so + (16 * vt + c) * 64 + 16 * kt + 4 * q) = S[kt][vt]; }
}

__device__ __forceinline__ Frag scale_frag(const Frag& x, float sc) { Frag f;
#pragma unroll
    for (int j = 0; j < 4; ++j) f.u[j] = cvtpk(bflo(x.u[j]) * sc, bfhi(x.u[j]) * sc);
    return f; }
__device__ __forceinline__ void gdn_task(const Args& a, int i, int s, int h, int d, int vb, int lane, LAS float* wscr) {
    constexpr size_t S1 = (size_t)NTOK * 1024;
    const bf16* GD = (const bf16*)(a.ws + WS_SC) + 9 * S1;
    const float* BETA = (const float*)(a.ws + WS_SMALL) + (size_t)NTOK * 32; const float* GG = BETA + (size_t)NTOK * 16;
    bf16* O = (bf16*)(a.ws + WS_Y) + 2 * S1 + d * S1;
    const int T = s < 16 ? 256 : 1024; const int row0 = s < 16 ? s * 256 : NPROMPT + (s - 16) * 1024;
    const int c = lane & 15, q = lane >> 4;
    f32x4 S[8][2];
    if (s >= 16) { const float* s0 = a.in[I_SDL] + ((((size_t)(s - 16) * 2 + i) * 2 + d) * 8 + h) * 16384 + 32 * vb + c;
#pragma unroll
        for (int kt = 0; kt < 8; ++kt)
#pragma unroll
            for (int vt = 0; vt < 2; ++vt)
#pragma unroll
                for (int n = 0; n < 4; ++n) S[kt][vt][n] = s0[(16 * kt + 4 * q + n) * 128 + 16 * vt]; }
    else {
#pragma unroll
        for (int kt = 0; kt < 8; ++kt) { S[kt][0] = F4Z; S[kt][1] = F4Z; } }
    Frag sel[2];
#pragma unroll
    for (int p = 0; p < 2; ++p)
#pragma unroll
        for (int j = 0; j < 4; ++j) { const int e0 = 2 * j - 4 * p; const bool on = ((lane >> 2) & 3) == q && (e0 == (lane & 3) || e0 + 1 == (lane & 3)) && (j >> 1) == p;
            sel[p].u[j] = on ? (((lane & 1) == 0) ? 0x00003F80u : 0x3F800000u) : 0u; }
    f32x4 eye;
#pragma unroll
    for (int n = 0; n < 4; ++n) eye[n] = (4 * q + n) == c ? 1.f : 0.f;
    const int nch = T >> 4;
    Frag nk[4], nq[4], nv; float nbeta, ng;
    { const int tok = d ? T - 1 - c : c; const size_t row = row0 + tok; const bf16* gd = GD + ((((row >> 4) * 8 + h) * 3) * 8) * 256 + (row & 15) * 16 + 4 * q;
#pragma unroll
        for (int ks = 0; ks < 4; ++ks) { const v2u k0 = *(const v2u*)(gd + 2048 + 512 * ks), k1 = *(const v2u*)(gd + 2048 + 512 * ks + 256), q0 = *(const v2u*)(gd + 512 * ks), q1 = *(const v2u*)(gd + 512 * ks + 256);
            nk[ks].u[0] = k0.x; nk[ks].u[1] = k0.y; nk[ks].u[2] = k1.x; nk[ks].u[3] = k1.y; nq[ks].u[0] = q0.x; nq[ks].u[1] = q0.y; nq[ks].u[2] = q1.x; nq[ks].u[3] = q1.y; }
        { const v2u v0 = *(const v2u*)(gd + 4096 + 512 * vb), v1 = *(const v2u*)(gd + 4096 + 512 * vb + 256); nv.u[0] = v0.x; nv.u[1] = v0.y; nv.u[2] = v1.x; nv.u[3] = v1.y; }
        nbeta = BETA[row * 16 + d * 8 + h]; ng = GG[row * 16 + d * 8 + h]; }
    for (int ch = 0; ch < nch; ++ch) {
        const float beta = nbeta, gl = ng;
        const float G = row_scan16(gl); const float GC = lane_get(G, (lane & 48) | 15);
        float Grow[4], Brow[4];
#pragma unroll
        for (int n = 0; n < 4; ++n) { Grow[n] = lane_get(G, (lane & 48) | (4 * q + n)); Brow[n] = lane_get(beta, (lane & 48) | (4 * q + n)); }
        const float eG = __builtin_amdgcn_exp2f(G), eGCG = __builtin_amdgcn_exp2f(GC - G), eGC = __builtin_amdgcn_exp2f(GC);
        f32x4 dKK = F4Z, dKQ = F4Z;
#pragma unroll
        for (int ks = 0; ks < 4; ++ks) { dKK = mma(nk[ks], nk[ks], dKK); dKQ = mma(nk[ks], nq[ks], dKQ); }
        f32x4 dL, dLT, dAtT;
#pragma unroll
        for (int n = 0; n < 4; ++n) { const int r = 4 * q + n;
            const float eij = __builtin_amdgcn_exp2f(fminf(Grow[n] - G, 0.f)), eji = __builtin_amdgcn_exp2f(fminf(G - Grow[n], 0.f));
            dL[n] = (c < r) ? -Brow[n] * dKK[n] * eij : 0.f;
            dLT[n] = (r < c) ? -beta * dKK[n] * eji : 0.f;
            dAtT[n] = (r <= c) ? dKQ[n] * eji * 0.08838834764831845f : 0.f; }
        const Frag fTT = feed1(tri_inv_T(dL, dLT, eye)), fAtT = feed1(dAtT);
        f32x4 dV[2]; dV[0] = mma(nv, sel[0], F4Z); dV[1] = mma(nv, sel[1], F4Z);
        LAS v2u* sKd = (LAS v2u*)wscr;
#pragma unroll
        for (int ks = 0; ks < 4; ++ks) { const Frag kd = scale_frag(nk[ks], eGCG); const f32x4 t0 = mma(kd, sel[0], F4Z), t1 = mma(kd, sel[1], F4Z);
            sKd[(2 * ks) * 64 + lane] = (v2u){cvtpk(t0.x, t0.y), cvtpk(t0.z, t0.w)}; sKd[(2 * ks + 1) * 64 + lane] = (v2u){cvtpk(t1.x, t1.y), cvtpk(t1.z, t1.w)}; }
        Frag fX[4], fQg[4];
#pragma unroll
        for (int ks = 0; ks < 4; ++ks) { fX[ks] = scale_frag(nk[ks], beta * eG); fQg[ks] = scale_frag(nq[ks], eG * 0.08838834764831845f); }
        const int tokbase = 16 * ch + 4 * q;
#pragma unroll
        for (int vt = 0; vt < 2; ++vt) {
            f32x4 M = F4Z, o = F4Z;
#pragma unroll
            for (int ks = 0; ks < 4; ++ks) { const Frag fS = feed2(S[2 * ks][vt], S[2 * ks + 1][vt]); M = mma(fX[ks], fS, M); o = mma(fQg[ks], fS, o); }
            f32x4 rhs;
#pragma unroll
            for (int n = 0; n < 4; ++n) rhs[n] = Brow[n] * dV[vt][n] - M[n];
            const Frag fVn = feed1(mma(fTT, feed1(rhs), F4Z));
            o = mma(fAtT, fVn, o);
#pragma unroll
            for (int n = 0; n < 4; ++n) { const int t = tokbase + n; const int tok = d ? T - 1 - t : t; const int mrow = row0 + tok; O[(((size_t)(mrow >> 4) * 8 + h) * 8 + 2 * vb + vt) * 256 + (mrow & 15) * 16 + c] = (bf16)f2bf(o[n]); }
#pragma unroll
            for (int kt = 0; kt < 8; ++kt) { const v2u w = sKd[kt * 64 + lane]; Frag fK; fK.u[0] = w.x; fK.u[1] = w.y; fK.u[2] = 0u; fK.u[3] = 0u; S[kt][vt] = mma(fK, fVn, S[kt][vt] * eGC); }
        }
        asm volatile("" ::: "memory");
        { const int chn = ch + 1 < nch ? ch + 1 : ch; const int tok = d ? T - 1 - (16 * chn + c) : 16 * chn + c; const size_t row = row0 + tok; const bf16* gd = GD + ((((row >> 4) * 8 + h) * 3) * 8) * 256 + (row & 15) * 16 + 4 * q;
#pragma unroll
            for (int ks = 0; ks < 4; ++ks) { const v2u k0 = *(const v2u*)(gd + 2048 + 512 * ks), k1 = *(const v2u*)(gd + 2048 + 512 * ks + 256), q0 = *(const v2u*)(gd + 512 * ks), q1 = *(const v2u*)(gd + 512 * ks + 256);
                nk[ks].u[0] = k0.x; nk[ks].u[1] = k0.y; nk[ks].u[2] = k1.x; nk[ks].u[3] = k1.y; nq[ks].u[0] = q0.x; nq[ks].u[1] = q0.y; nq[ks].u[2] = q1.x; nq[ks].u[3] = q1.y; }
            { const v2u v0 = *(const v2u*)(gd + 4096 + 512 * vb), v1 = *(const v2u*)(gd + 4096 + 512 * vb + 256); nv.u[0] = v0.x; nv.u[1] = v0.y; nv.u[2] = v1.x; nv.u[3] = v1.y; }
            nbeta = BETA[row * 16 + d * 8 + h]; ng = GG[row * 16 + d * 8 + h]; }
    }
    if (s < 16) { float* so = a.out + OUT_SDL + ((((size_t)s * 2 + i) * 2 + d) * 8 + h) * 16384 + 32 * vb + c;
#pragma unroll
        for (int kt = 0; kt < 8; ++kt)
#pragma unroll
            for (int vt = 0; vt < 2; ++vt)
#pragma unroll
                for (int n = 0; n < 4; ++n) so[(16 * kt + 4 * q + n) * 128 + 16 * vt] = S[kt][vt][n]; }
}
__device__ __forceinline__ void ph_scan(const Args& a, LAS unsigned char* lds, int i) {
    const int tid = opaque_tid(), lane = tid & 63, wave = __builtin_amdgcn_readfirstlane(tid >> 6);
    LAS float* wscr = (LAS float*)(lds + wave * 14336);
    const int G = gridDim.x;
    for (int task = wave * G + blockIdx.x; task < 2304; task += NWAVES * G) {
        if (task >= 256 && task < 512) { const int t = task - 256; rwkv_task(a, i, 16 + (t >> 5), (t & 31) >> 1, t & 1, lane, wscr); }
        else if (task >= 1024 && task < 1536) { const int t = task - 1024; rwkv_task(a, i, t >> 5, (t & 31) >> 1, t & 1, lane, wscr); }
    }
    asm volatile("" ::: "memory");
    for (int task = wave * G + blockIdx.x; task < 2304; task += NWAVES * G) {
        if (task < 256 || task >= 1536) { const int t = task < 256 ? task : task - 1536 + 256; const int s = t >> 6, r = t & 63; gdn_task(a, i, s, r >> 3, (r >> 2) & 1, r & 3, lane, wscr); }
        else if (task >= 512 && task < 1024) { const int t = task - 512; const int s = 16 + (t >> 6), r = t & 63; gdn_task(a, i, s, r >> 3, (r >> 2) & 1, r & 3, lane, wscr); }
    }
}
__device__ __forceinline__ void tok_info(int m, bool& samp, int& T, int& t) { samp = m >= NPROMPT; T = samp ? 1024 : 256; t = samp ? ((m - NPROMPT) & 1023) : (m & 255); }
__device__ __forceinline__ void shift_nb(bool samp, int T, int t, int n, int& dt, bool& valid) {
    if (!samp) { if (n & 1) { dt = 1; valid = t + 1 < T; } else { dt = -1; valid = t > 0; } }
    else { const int col = t & 63, row = t >> 6;
        if (n == 0) { dt = -1; valid = col > 0; } else if (n == 1) { dt = 1; valid = col < 63; } else if (n == 2) { dt = -64; valid = row > 0; } else { dt = 64; valid = row < 15; } }
}
constexpr int LA_LD = 424;
__device__ __forceinline__ void ph_prep(const Args& a, LAS unsigned char* lds, int i) {
    const int tid = opaque_tid(), lane = tid & 63, wave = __builtin_amdgcn_readfirstlane(tid >> 6);
    const int c = lane & 15, q = lane >> 4;
    const bf16* P = (const bf16*)(a.ws + WS_P);
    bf16* RW = (bf16*)(a.ws + WS_SC); constexpr size_t S1 = (size_t)NTOK * 1024;
    bf16* GD = RW + 9 * S1; float* GT = (float*)(RW + 12 * S1);
    float* BON = (float*)(a.ws + WS_SMALL); float* BETA = BON + (size_t)NTOK * 32; float* GG = BETA + (size_t)NTOK * 16;
    const float* MU = a.in[I_MU] + i * CPA;
    const bf16* W2T = (const bf16*)(a.ws + WS_LORA) + (size_t)i * 2 * 1024 * 64;
    const bf16* A2T = (const bf16*)(a.ws + WS_LORA) + (size_t)4 * 1024 * 64 + (size_t)i * 2 * 1024 * 64;
    const bf16* G2T = (const bf16*)(a.ws + WS_LORA) + (size_t)8 * 1024 * 64 + (size_t)i * 1024 * 160;
    LAS bf16* la = (LAS bf16*)lds;
    LAS float* lpar = (LAS float*)(lds + 40960);
    LAS float* lcw = (LAS float*)(lds + 40960 + 40960);
    for (int idx = tid; idx < 10 * 1024; idx += NTHR) { const int p = idx >> 10, ch = idx & 1023;
        const float v = p < 3 ? MU[p * 1024 + ch] : (p == 3 ? a.in[I_KK][i * 1024 + ch] : (p == 4 ? a.in[I_KA][i * 1024 + ch] : (p == 5 ? a.in[I_RK][i * 1024 + ch] : (p < 8 ? a.in[I_W0][(i * 2 + p - 6) * 1024 + ch] : a.in[I_A0][(i * 2 + p - 8) * 1024 + ch]))));
        lpar[idx] = v; }
    for (int idx = tid; idx < 3 * 3072; idx += NTHR) lcw[idx] = a.in[I_CONVW][(size_t)i * 3 * 3072 + idx];
    __syncthreads();
    for (int tile = blockIdx.x; tile < NTOK / 48; tile += gridDim.x) {
        const int m0 = tile * 48;
#ifdef PREP_DUP_A
        for (int rep = 0; rep < 2; ++rep)
#endif
        for (int it = 0; it < 10; ++it) {
            float xv[4], xsv[4]; int jjv[4], ttv[4];
#pragma unroll
            for (int u = 0; u < 4; ++u) { const int idx = tid + NTHR * (4 * it + u); const bool ok = idx < 48 * 416; const int tt = ok ? idx / 416 : 0, jj = ok ? idx - tt * 416 : 0; jjv[u] = ok ? jj : -1; ttv[u] = tt;
                const int m = m0 + tt; bool samp; int T, t; tok_info(m, samp, T, t); int dt; bool valid; shift_nb(samp, T, t, jj & 3, dt, valid);
                xv[u] = bf2f(P[(size_t)m * PW + PC_LORA + jj]); const float ls = bf2f(P[(size_t)(m + (valid ? dt : 0)) * PW + PC_LORA + jj]); xsv[u] = valid ? ls : 0.f; }
#pragma unroll
            for (int u = 0; u < 4; ++u) { const int jj = jjv[u]; if (jj >= 0) { float v = xv[u] + (xsv[u] - xv[u]) * MU[3072 + jj];
                if (jj < 128) { const float e = __builtin_amdgcn_exp2f(2.8853900818f * v); v = 1.0f - 2.0f * __builtin_amdgcn_rcpf(e + 1.0f); } else if (jj >= 256) v = sigmoidf_(v);
                la[ttv[u] * LA_LD + jj] = (bf16)f2bf(v); } }
        }
        __syncthreads();
#ifdef PREP_DUP_RW
#pragma unroll 1
        for (int rep = 0; rep < 2; ++rep)
#endif
#pragma unroll 1
        for (int u = 0; u < 6; ++u) {
            const int hd = wave * 2 + u / 3, mt = u % 3; const int m = m0 + 16 * mt + c; bool samp; int T, t; tok_info(m, samp, T, t);
            int dtn[4]; bool vn[4];
#pragma unroll
            for (int n = 0; n < 4; ++n) { shift_nb(samp, T, t, n, dtn[n], vn[n]); dtn[n] = vn[n] ? dtn[n] : 0; }
            float r_[4][4], k_[4][4], v_[4][4]; float ss = 0.f;
#pragma unroll
            for (int nt = 0; nt < 4; ++nt) { const int ch = hd * 64 + 16 * nt + 4 * q; const bf16* pr = P + (size_t)m * PW + ch;
                const v2u wr = *(const v2u*)pr, wk = *(const v2u*)(pr + 1024), wv = *(const v2u*)(pr + 2048);
                const f32x4 mur = *(const LAS f32x4*)(lpar + ch), muk = *(const LAS f32x4*)(lpar + 1024 + ch), muv = *(const LAS f32x4*)(lpar + 2048 + ch), kkw = *(const LAS f32x4*)(lpar + 3072 + ch);
                const float xr[4] = {bflo(wr.x), bfhi(wr.x), bflo(wr.y), bfhi(wr.y)}, xk[4] = {bflo(wk.x), bfhi(wk.x), bflo(wk.y), bfhi(wk.y)}, xv[4] = {bflo(wv.x), bfhi(wv.x), bflo(wv.y), bfhi(wv.y)};
#pragma unroll
                for (int n = 0; n < 4; ++n) { const bf16* pn = pr + (long)dtn[n] * PW + n;
                    const float lr = bf2f(pn[0]), lk = bf2f(pn[1024]), lv = bf2f(pn[2048]); const float nr = vn[n] ? lr : 0.f, nk = vn[n] ? lk : 0.f, nv = vn[n] ? lv : 0.f;
                    r_[nt][n] = xr[n] + (nr - xr[n]) * mur[n]; k_[nt][n] = xk[n] + (nk - xk[n]) * muk[n]; v_[nt][n] = xv[n] + (nv - xv[n]) * muv[n];
                    const float kkr = k_[nt][n] * kkw[n]; ss += kkr * kkr; } }
            ss += __shfl_xor(ss, 16); ss += __shfl_xor(ss, 32);
            const float kn = __builtin_amdgcn_rsqf(ss + 1e-12f);
            float bon0 = 0.f, bon1 = 0.f;
            const LAS bf16* lrow = la + (16 * mt + c) * LA_LD + 8 * q;
#pragma unroll
            for (int nt = 0; nt < 4; ++nt) {
                f32x4 wl0 = F4Z, wl1 = F4Z, al0 = F4Z, al1 = F4Z, gl = F4Z;
#pragma unroll
                for (int ks = 0; ks < 2; ++ks) {
                    const size_t wo = ((size_t)hd * 64 + 16 * nt + c) * 64 + 32 * ks + 8 * q;
                    Frag b, w; v4u x;
                    x = *(const LAS v4u*)(lrow + 32 * ks); b.u[0] = x.x; b.u[1] = x.y; b.u[2] = x.z; b.u[3] = x.w; x = *(const v4u*)(W2T + wo); w.u[0] = x.x; w.u[1] = x.y; w.u[2] = x.z; w.u[3] = x.w; wl0 = mma(w, b, wl0);
                    x = *(const LAS v4u*)(lrow + 64 + 32 * ks); b.u[0] = x.x; b.u[1] = x.y; b.u[2] = x.z; b.u[3] = x.w; x = *(const v4u*)(W2T + 65536 + wo); w.u[0] = x.x; w.u[1] = x.y; w.u[2] = x.z; w.u[3] = x.w; wl1 = mma(w, b, wl1);
                    x = *(const LAS v4u*)(lrow + 128 + 32 * ks); b.u[0] = x.x; b.u[1] = x.y; b.u[2] = x.z; b.u[3] = x.w; x = *(const v4u*)(A2T + wo); w.u[0] = x.x; w.u[1] = x.y; w.u[2] = x.z; w.u[3] = x.w; al0 = mma(w, b, al0);
                    x = *(const LAS v4u*)(lrow + 192 + 32 * ks); b.u[0] = x.x; b.u[1] = x.y; b.u[2] = x.z; b.u[3] = x.w; x = *(const v4u*)(A2T + 65536 + wo); w.u[0] = x.x; w.u[1] = x.y; w.u[2] = x.z; w.u[3] = x.w; al1 = mma(w, b, al1);
                }
#pragma unroll
                for (int ks = 0; ks < 5; ++ks) { Frag b, w; v4u x = *(const LAS v4u*)(lrow + 256 + 32 * ks); b.u[0] = x.x; b.u[1] = x.y; b.u[2] = x.z; b.u[3] = x.w;
                    x = *(const v4u*)(G2T + ((size_t)hd * 64 + 16 * nt + c) * 160 + 32 * ks + 8 * q); w.u[0] = x.x; w.u[1] = x.y; w.u[2] = x.z; w.u[3] = x.w; gl = mma(w, b, gl); }
                const int ch = hd * 64 + 16 * nt + 4 * q; const size_t o = (size_t)m * 1024 + ch;
                bf16* rw = RW + ((((size_t)(m >> 4) * 16 + hd) * 9) * 4 + nt) * 256 + c * 16 + 4 * q;
                const f32x4 kkw = *(const LAS f32x4*)(lpar + 3072 + ch), kaw = *(const LAS f32x4*)(lpar + 4096 + ch), rkw = *(const LAS f32x4*)(lpar + 5120 + ch);
                const f32x4 w00 = *(const LAS f32x4*)(lpar + 6144 + ch), w01 = *(const LAS f32x4*)(lpar + 7168 + ch), a00 = *(const LAS f32x4*)(lpar + 8192 + ch), a01 = *(const LAS f32x4*)(lpar + 9216 + ch);
                float kk[4], lw0[4], lw1[4], kd0[4], kd1[4], b0[4], b1[4];
#pragma unroll
                for (int n = 0; n < 4; ++n) { const float kx = k_[nt][n];
                    kk[n] = kx * kkw[n] * kn;
                    const float ic0 = sigmoidf_(a00[n] + al0[n]), ic1 = sigmoidf_(a01[n] + al1[n]);
                    lw0[n] = -0.6065306597f * 1.4426950409f * sigmoidf_(w00[n] + wl0[n]); lw1[n] = -0.6065306597f * 1.4426950409f * sigmoidf_(w01[n] + wl1[n]);
                    kd0[n] = kx * (1.0f + (ic0 - 1.0f) * kaw[n]); kd1[n] = kx * (1.0f + (ic1 - 1.0f) * kaw[n]); b0[n] = kk[n] * ic0; b1[n] = kk[n] * ic1;
                    bon0 += r_[nt][n] * kd0[n] * rkw[n]; bon1 += r_[nt][n] * kd1[n] * rkw[n]; }
                *(v2u*)(rw) = (v2u){cvtpk(r_[nt][0], r_[nt][1]), cvtpk(r_[nt][2], r_[nt][3])}; *(v2u*)(rw + 2 * 1024) = (v2u){cvtpk(v_[nt][0], v_[nt][1]), cvtpk(v_[nt][2], v_[nt][3])};
                *(v2u*)(rw + 1 * 1024) = (v2u){cvtpk(-kk[0], -kk[1]), cvtpk(-kk[2], -kk[3])};
                *(v2u*)(rw + 3 * 1024) = (v2u){cvtpk(kd0[0], kd0[1]), cvtpk(kd0[2], kd0[3])}; *(v2u*)(rw + 4 * 1024) = (v2u){cvtpk(kd1[0], kd1[1]), cvtpk(kd1[2], kd1[3])};
                *(v2u*)(rw + 5 * 1024) = (v2u){cvtpk(b0[0], b0[1]), cvtpk(b0[2], b0[3])}; *(v2u*)(rw + 6 * 1024) = (v2u){cvtpk(b1[0], b1[1]), cvtpk(b1[2], b1[3])};
                *(v2u*)(rw + 7 * 1024) = (v2u){cvtpk(lw0[0], lw0[1]), cvtpk(lw0[2], lw0[3])}; *(v2u*)(rw + 8 * 1024) = (v2u){cvtpk(lw1[0], lw1[1]), cvtpk(lw1[2], lw1[3])};
                *(f32x4*)(GT + (((size_t)(m >> 4) * 16 + hd) * 4 + nt) * 256 + c * 16 + 4 * q) = gl;
                __builtin_amdgcn_sched_barrier(0);
            }
            bon0 += __shfl_xor(bon0, 16); bon0 += __shfl_xor(bon0, 32); bon1 += __shfl_xor(bon1, 16); bon1 += __shfl_xor(bon1, 32);
            if (q == 0) { BON[((size_t)m * 2 + 0) * 16 + hd] = bon0; BON[((size_t)m * 2 + 1) * 16 + hd] = bon1; }
        }
#ifdef PREP_DUP_GD
#pragma unroll 1
        for (int rep = 0; rep < 2; ++rep)
#endif
#pragma unroll 1
        for (int r3 = 0; r3 < 3; ++r3) {
            const int unit = wave + 8 * r3; const int hd = unit / 3, mt = unit - hd * 3; const int m = m0 + 16 * mt + c; bool samp; int T, t; tok_info(m, samp, T, t);
            const bool hp = t > 0, hn = t + 1 < T;
            float sqk[2] = {0.f, 0.f};
#pragma unroll
            for (int pass = 0; pass < 2; ++pass) {
                float scl[2] = {1.f, 1.f};
                if (pass == 1) { sqk[0] += __shfl_xor(sqk[0], 16); sqk[0] += __shfl_xor(sqk[0], 32); sqk[1] += __shfl_xor(sqk[1], 16); sqk[1] += __shfl_xor(sqk[1], 32);
                    scl[0] = __builtin_amdgcn_rsqf(sqk[0] + 1e-6f); scl[1] = __builtin_amdgcn_rsqf(sqk[1] + 1e-6f); }
#pragma unroll
                for (int part = 0; part < 3; ++part) {
                    if (pass == 0 && part == 2) continue;
                    bf16* dst = GD + ((((size_t)(m >> 4) * 8 + hd) * 3 + part) * 8) * 256 + c * 16 + 4 * q;
                    const float sc = part < 2 ? scl[part] : 1.f; float acc = 0.f;
#pragma unroll 4
                    for (int g = 0; g < 8; ++g) { const int ch = part * 1024 + hd * 128 + 16 * g + 4 * q; const bf16* pp = P + (size_t)m * PW + PC_GDN + ch;
                        const v2u x1 = *(const v2u*)pp; v2u x0 = *(const v2u*)(pp - (hp ? PW : 0)), x2 = *(const v2u*)(pp + (hn ? PW : 0)); x0.x = hp ? x0.x : 0u; x0.y = hp ? x0.y : 0u; x2.x = hn ? x2.x : 0u; x2.y = hn ? x2.y : 0u;
                        const f32x4 c0 = *(const LAS f32x4*)(lcw + ch), c1 = *(const LAS f32x4*)(lcw + 3072 + ch), c2 = *(const LAS f32x4*)(lcw + 2 * 3072 + ch);
                        float val[4];
                        val[0] = siluf_(bflo(x0.x) * c0[0] + bflo(x1.x) * c1[0] + bflo(x2.x) * c2[0]); val[1] = siluf_(bfhi(x0.x) * c0[1] + bfhi(x1.x) * c1[1] + bfhi(x2.x) * c2[1]);
                        val[2] = siluf_(bflo(x0.y) * c0[2] + bflo(x1.y) * c1[2] + bflo(x2.y) * c2[2]); val[3] = siluf_(bfhi(x0.y) * c0[3] + bfhi(x1.y) * c1[3] + bfhi(x2.y) * c2[3]);
                        if (pass == 0) acc += (val[0] * val[0] + val[1] * val[1]) + (val[2] * val[2] + val[3] * val[3]);
                        else *(v2u*)(dst + 256 * g) = (v2u){cvtpk(val[0] * sc, val[1] * sc), cvtpk(val[2] * sc, val[3] * sc)}; }
                    if (pass == 0) sqk[part] = acc;
                }
            }
        }
        for (int idx = tid; idx < 48 * 16; idx += NTHR) { const int tt = idx >> 4, dh = idx & 15; const int m = m0 + tt;
            BETA[(size_t)m * 16 + dh] = sigmoidf_(bf2f(P[(size_t)m * PW + PC_BETA + dh]));
            GG[(size_t)m * 16 + dh] = -1.4426950409f * __expf(a.in[I_ALOG][i * 16 + dh]) * softplusf_(bf2f(P[(size_t)m * PW + PC_ALPHA + dh]) + a.in[I_DTB][i * 16 + dh]); }
        __syncthreads();
    }
}
__device__ __forceinline__ void ph_post(const Args& a, int i) {
    const int tid = opaque_tid(), lane = tid & 63, wave = __builtin_amdgcn_readfirstlane(tid >> 6);
    const int gw = blockIdx.x * NWAVES + wave, NGW = gridDim.x * NWAVES; const int c = lane & 15, q = lane >> 4;
    constexpr size_t S1 = (size_t)NTOK * 1024;
    const float* GT = (const float*)((const bf16*)(a.ws + WS_SC) + 12 * S1); const bf16* YS = (const bf16*)(a.ws + WS_Y); const bf16* OG = YS + 2 * S1;
    const bf16* P = (const bf16*)(a.ws + WS_P); bf16* O = (bf16*)(a.ws + WS_O);
    const float* gnw = a.in[I_GNW] + i * 128;
    for (int u = gw; u < (NTOK / 16) * 24; u += NGW) {
        const int tb = u / 24, hh = u - tb * 24; const int m = tb * 16 + c;
        if (hh < 16) { const size_t blk = (((size_t)tb * 16 + hh) * 4) * 256 + c * 16 + 4 * q;
#pragma unroll
            for (int g = 0; g < 4; ++g) { const v2u y0 = *(const v2u*)(YS + blk + 256 * g), y1 = *(const v2u*)(YS + S1 + blk + 256 * g); const f32x4 gt = *(const f32x4*)(GT + blk + 256 * g);
                v2u w; w.x = pk2((bflo(y0.x) + bflo(y1.x)) * gt.x, (bfhi(y0.x) + bfhi(y1.x)) * gt.y); w.y = pk2((bflo(y0.y) + bflo(y1.y)) * gt.z, (bfhi(y0.y) + bfhi(y1.y)) * gt.w);
                *(v2u*)(O + (size_t)m * D + hh * 64 + 16 * g + 4 * q) = w; } }
        else { const int h = hh - 16; const size_t blk = (((size_t)tb * 8 + h) * 8) * 256 + c * 16 + 4 * q;
            float ov[8][4]; float ss = 0.f;
#pragma unroll
            for (int g = 0; g < 8; ++g) { const v2u o0 = *(const v2u*)(OG + blk + 256 * g), o1 = *(const v2u*)(OG + S1 + blk + 256 * g);
                ov[g][0] = bflo(o0.x) + bflo(o1.x); ov[g][1] = bfhi(o0.x) + bfhi(o1.x); ov[g][2] = bflo(o0.y) + bflo(o1.y); ov[g][3] = bfhi(o0.y) + bfhi(o1.y);
                ss += (ov[g][0] * ov[g][0] + ov[g][1] * ov[g][1]) + (ov[g][2] * ov[g][2] + ov[g][3] * ov[g][3]); }
            ss += __shfl_xor(ss, 16); ss += __shfl_xor(ss, 32);
            const float rs = __builtin_amdgcn_rsqf(ss * (1.0f / 128.0f) + RMS_EPS);
#pragma unroll
            for (int g = 0; g < 8; ++g) { const int ch = 16 * g + 4 * q; const v2u zz = *(const v2u*)(P + (size_t)m * PW + PC_Z + h * 128 + ch); const f32x4 gwv = *(const f32x4*)(gnw + ch);
                v2u w; w.x = pk2(ov[g][0] * rs * gwv.x * siluf_(bflo(zz.x)), ov[g][1] * rs * gwv.y * siluf_(bfhi(zz.x))); w.y = pk2(ov[g][2] * rs * gwv.z * siluf_(bflo(zz.y)), ov[g][3] * rs * gwv.w * siluf_(bfhi(zz.y)));
                *(v2u*)(O + (size_t)m * D + 1024 + h * 128 + ch) = w; } }
    }
}

constexpr int PH_PER_LAYER = 9, N_PHASES = 2 + 4 * PH_PER_LAYER;
__host__ __device__ inline bool phase_exists(int ph) { if (ph == 0 || ph == N_PHASES - 1) return true; const int l = (ph - 1) / PH_PER_LAYER, k = (ph - 1) % PH_PER_LAYER; return (l & 1) ? !(k == 2 || k == 3 || k == 4) : true; }

#define RUN(ph) (a.ph_lo <= (ph) && (ph) < a.ph_hi)
#define SEAM(ph) do { if ((ph) + 1 < a.ph_hi) xcd_barrier(bar); } while (0)
#define SEAMX(ph) xcd_barrier(bar)
template <int L> __device__ __forceinline__ void run_layer(const Args& a, LAS unsigned char* lds, const XcdBarrier& bar) {
    constexpr int l = L, pb = 1 + PH_PER_LAYER * L, i = L >> 1;
    const int G = gridDim.x, bx = blockIdx.x;
    bf16* H = (bf16*)(a.ws + WS_H); bf16* O = (bf16*)(a.ws + WS_O); bf16* P = (bf16*)(a.ws + WS_P);
    const float* modl = (const float*)(a.ws + WS_MOD) + (size_t)l * 9 * 12288;
    if (RUN(pb + 0)) { ph_norm(a, l, 0); SEAM(pb + 0); }
#ifdef DUP_NORM
    if (RUN(pb + 0)) { ph_norm(a, l, 0); SEAMX(pb + 0); }
#endif
    if constexpr ((L & 1) == 0) {
        if (RUN(pb + 1)) { pg8::Gemm g{H, (const bf16*)(a.ws + WS_WIN) + (size_t)i * PW * 2048, NTOK, PW, 2048, 2048, 2048, 0, 0}; pg8::StaticOrder S; S.init(NTOK, PW, G, bx);
            pg8::EpiBf16 E{P, PW}; pg8::gemm_phase<pg8::EpiBf16, pg8::StaticOrder, true, true>(lds, g, S, E); SEAM(pb + 1); }
#ifdef DUP_GIN
        if (RUN(pb + 1)) { pg8::Gemm g{H, (const bf16*)(a.ws + WS_WIN) + (size_t)i * PW * 2048, NTOK, PW, 2048, 2048, 2048, 0, 0}; pg8::StaticOrder S; S.init(NTOK, PW, G, bx);
            pg8::EpiBf16 E{P, PW}; pg8::gemm_phase<pg8::EpiBf16, pg8::StaticOrder, true, true>(lds, g, S, E); SEAMX(pb + 1); }
#endif
        if (RUN(pb + 2)) { ph_prep(a, lds, i); SEAM(pb + 2); }
#ifdef DUP_PREP
        if (RUN(pb + 2)) { ph_prep(a, lds, i); SEAMX(pb + 2); }
#endif
        if (RUN(pb + 3)) { ph_scan(a, lds, i); SEAM(pb + 3); }
#ifdef DUP_SCAN
        if (RUN(pb + 3)) { ph_scan(a, lds, i); SEAMX(pb + 3); }
#endif
        if (RUN(pb + 4)) { ph_post(a, i); SEAM(pb + 4); }
#ifdef DUP_POST
        if (RUN(pb + 4)) { ph_post(a, i); SEAMX(pb + 4); }
#endif
        if (RUN(pb + 5)) { pg8::Gemm g{O, (const bf16*)(a.ws + WS_WOUT) + (size_t)i * 2048 * 2048, NTOK, 2048, 2048, 2048, 2048, 0, 0}; pg8::StaticOrder S; S.init(NTOK, 2048, G, bx);
            pg8::EpiResid E{l == 0 ? a.in[I_XP] : nullptr, a.in[I_XS], a.out, modl + 2 * 2048, nullptr};
            pg8::gemm_phase<pg8::EpiResid, pg8::StaticOrder, true, true>(lds, g, S, E); SEAM(pb + 5); }
    } else {
        if (RUN(pb + 1)) { ph_pool(a); SEAM(pb + 1); }
#ifdef DUP_POOL
        if (RUN(pb + 1)) { ph_pool(a); SEAMX(pb + 1); }
#endif
        if (RUN(pb + 5)) { pg8::Gemm g{O, (const bf16*)(a.ws + WS_WPOOL) + (size_t)i * 2048 * 512, NTOK, 2048, 512, 2048, 512, 1, 512}; pg8::StaticOrder S; S.init(NTOK, 2048, G, bx);
            pg8::EpiResid E{nullptr, nullptr, a.out, modl + 2 * 2048, a.in[I_POOLS] + i * 2048};
            pg8::gemm_phase<pg8::EpiResid, pg8::StaticOrder, true, true>(lds, g, S, E); SEAM(pb + 5); }
    }
    if (RUN(pb + 6)) { ph_norm(a, l, 1); SEAM(pb + 6); }
    if (RUN(pb + 7)) { pg8::Gemm g{H, (const bf16*)(a.ws + WS_WGU) + (size_t)l * 11264 * 2048, NTOK, 11264, 2048, 2048, 2048, 0, 0}; pg8::StaticOrder S; S.init(NTOK, 11264, G, bx);
        pg8::EpiSwiGLU E{P, DFF}; pg8::gemm_phase<pg8::EpiSwiGLU, pg8::StaticOrder, true, true>(lds, g, S, E); SEAM(pb + 7); }
#ifdef DUP_GGU
    if (RUN(pb + 7)) { pg8::Gemm g{H, (const bf16*)(a.ws + WS_WGU) + (size_t)l * 11264 * 2048, NTOK, 11264, 2048, 2048, 2048, 0, 0}; pg8::StaticOrder S; S.init(NTOK, 11264, G, bx);
        pg8::EpiSwiGLU E{P, DFF}; pg8::gemm_phase<pg8::EpiSwiGLU, pg8::StaticOrder, true, true>(lds, g, S, E); SEAMX(pb + 7); }
#endif
    if (RUN(pb + 8)) { pg8::Gemm g{P, (const bf16*)(a.ws + WS_WDN) + (size_t)l * 2048 * DFF, NTOK, 2048, DFF, DFF, DFF, 0, 0}; pg8::StaticOrder S; S.init(NTOK, 2048, G, bx);
        pg8::EpiResid E{nullptr, nullptr, a.out, modl + 5 * 2048, nullptr};
        pg8::gemm_phase<pg8::EpiResid, pg8::StaticOrder, true, true>(lds, g, S, E); SEAM(pb + 8); }
}

__global__ void __launch_bounds__(NTHR, 2) fwd(Args a) {
    extern __shared__ __attribute__((aligned(16))) unsigned char lds_raw[];
    LAS unsigned char* lds = (LAS unsigned char*)lds_raw;
    const int tid = threadIdx.x;
    volatile LAS unsigned* MISC = (volatile LAS unsigned*)(lds + LDS_MISC);
    for (int u = tid; u < (LDS_BYTES - LDS_STAGE) / 4; u += NTHR) ((LAS unsigned*)(lds + LDS_STAGE))[u] = 0u;
    __syncthreads();
    XcdBarrier bar; bar.bar = (unsigned*)(a.ws + WS_CTL) + CW_BAR; bar.x = 0; bar.st = nullptr;
    const bool multi = a.ph_hi - a.ph_lo > 1;
    if (multi) bar = xcd_barrier_post((unsigned*)(a.ws + WS_CTL) + CW_BAR, MISC + 8);
    if (RUN(0)) { ph_pre(a, lds); SEAM(0); }
#ifdef DUP_PRE
    if (RUN(0)) { ph_pre(a, lds); SEAMX(0); }
#endif
    run_layer<0>(a, lds, bar);
    run_layer<1>(a, lds, bar);
    run_layer<2>(a, lds, bar);
    run_layer<3>(a, lds, bar);
    if (RUN(N_PHASES - 1)) ph_final(a);
}
#undef RUN
#undef SEAM
#undef SEAMX

#ifndef MK_ONE_LAUNCH
#define MK_ONE_LAUNCH 1
#endif
extern "C" void kernel_launch(void* const* d_in, const int* in_sizes, int n_in, void* d_out, int out_size, void* d_ws, size_t ws_size, hipStream_t stream) {
    static int grid = 0;
    if (grid == 0) {
        if (n_in != N_IN || ws_size < WS_END) { fprintf(stderr, "kernel_launch: expected %d inputs and >= %zu bytes of workspace; got %d, %zu\n", (int)N_IN, (size_t)WS_END, n_in, ws_size); grid = -1; return; }
        int dev = 0, cus = 0, per_cu = 0;
        if (hipGetDevice(&dev) != hipSuccess || hipDeviceGetAttribute(&cus, hipDeviceAttributeMultiprocessorCount, dev) != hipSuccess) { grid = -1; return; }
        if (hipFuncSetAttribute((const void*)fwd, hipFuncAttributeMaxDynamicSharedMemorySize, LDS_BYTES) != hipSuccess) { fprintf(stderr, "kernel_launch: hipFuncSetAttribute failed\n"); grid = -1; return; }
        if (hipOccupancyMaxActiveBlocksPerMultiprocessor(&per_cu, (const void*)fwd, NTHR, LDS_BYTES) != hipSuccess || per_cu < 1) fprintf(stderr, "kernel_launch: occupancy query reports %d\n", per_cu);
        (void)hipGetLastError();
        grid = cus;
    }
    if (grid < 0) return;
    if (hipMemsetAsync((char*)d_ws + WS_CTL, 0, CTL_ZERO_BYTES, stream) != hipSuccess) return;
    Args a{};
    for (int i = 0; i < N_IN; ++i) a.in[i] = (const float*)d_in[i];
    a.out = (float*)d_out; a.ws = (unsigned char*)d_ws;
#if MK_ONE_LAUNCH
    a.ph_lo = 0; a.ph_hi = N_PHASES;
    hipLaunchKernelGGL(fwd, dim3(grid), dim3(NTHR), LDS_BYTES, stream, a);
#else
    for (int ph = 0; ph < N_PHASES; ++ph) { if (!phase_exists(ph)) continue; a.ph_lo = ph; a.ph_hi = ph + 1; hipLaunchKernelGGL(fwd, dim3(grid), dim3(NTHR), LDS_BYTES, stream, a); }
#endif
}
```

```cpp
#include <hip/hip_runtime.h>
#include <cstdio>
#include <cstdint>

namespace pg8 {
#define PG8_LAS __attribute__((address_space(3)))
typedef unsigned short bf16_t;
typedef short bf16x8 __attribute__((ext_vector_type(8)));
typedef float f32x4 __attribute__((ext_vector_type(4)));
typedef unsigned u32x4 __attribute__((ext_vector_type(4)));
constexpr int BM = 256, BK = 64, HALF = 128, HTB = HALF * BK * 2  , STAGE_BYTES = 8 * HTB, NXCD = 8, WGM = 8;

__host__ __device__ __forceinline__ int lds_byte(int r, int c) { const int st = (r >> 4) * 2 + (c >> 5), rr = r & 15, cc = c & 31, ob = rr * 64 + cc * 2; return st * 1024 + (ob ^ (((ob >> 9) & 1) << 5)); }
__host__ __device__ __forceinline__ void stage_rc(int b, int& R, int& C) { const int st = b / 1024, sb = b % 1024, swz = sb ^ (((sb >> 9) & 1) << 5); R = (st >> 1) * 16 + swz / 64; C = (st & 1) * 32 + (swz % 64) / 2; }
__host__ __device__ __forceinline__ int perm32(int rho) { const int n = rho >> 4, i = rho & 15; return 8 * (i >> 2) + 4 * n + (i & 3); }

struct Unit { int pm, pn; };
struct Gemm { const bf16_t* A; const bf16_t* Bt; int M, N, K, lda, ldb, gsh, gk; };

struct StaticOrder {
    int nM, nN, nwg, G, c;
    __host__ __device__ void init(int M, int N, int G_, int c_) { nM = M / BM; nN = N / BM; nwg = nM * nN; G = G_; c = c_; }
    __host__ __device__ bool next(int i, Unit& u) const {
        const long L = (long)i * G + c; if (L >= nwg) return false;
        int wgid = (int)L; { const int q = nwg / NXCD, r = nwg % NXCD, xcd = wgid % NXCD, off = wgid / NXCD; wgid = (xcd < r ? xcd * (q + 1) : r * (q + 1) + (xcd - r) * q) + off; }
        const int nig = WGM * nN, gid = wgid / nig, fm = gid * WGM, gsz = (nM - fm) < WGM ? (nM - fm) : WGM;
        u.pm = fm + ((wgid % nig) % gsz); u.pn = (wgid % nig) / gsz; return true;
    }
    __device__ __forceinline__ void a_ready(const Unit&) const {}
    __device__ __forceinline__ void done(const Unit&) const {}
};

__device__ __forceinline__ unsigned cvt_pk_bf16(float lo, float hi) { unsigned r; asm volatile("v_cvt_pk_bf16_f32 %0, %1, %2" : "=v"(r) : "v"(lo), "v"(hi)); return r; }

__device__ __forceinline__ int cond_of_panel(int pm) { return pm < 16 ? 0 : 1 + ((pm - 16) >> 2); }

struct EpiBf16 {
    static constexpr bool PERM = true, AFTER_DRAIN = false;
    bf16_t* O; int ldc;
    __device__ __forceinline__ void operator()(const f32x4 (&acc)[2][2][4][2], const Unit& u, int wr, int wc, int fr, int fq) const {
        const int row0 = u.pm * BM + wr * 64 + fr; const int col0 = u.pn * BM + wc * 32 + 8 * fq;
#pragma unroll
        for (int ai = 0; ai < 2; ++ai)
#pragma unroll
            for (int m = 0; m < 4; ++m) { bf16_t* rowp = O + (size_t)(row0 + ai * HALF + m * 16) * ldc + col0;
#pragma unroll
                for (int bj = 0; bj < 2; ++bj) { const f32x4 v0 = acc[ai][bj][m][0], v1 = acc[ai][bj][m][1];
                    u32x4 w; w.x = cvt_pk_bf16(v0[0], v0[1]); w.y = cvt_pk_bf16(v0[2], v0[3]); w.z = cvt_pk_bf16(v1[0], v1[1]); w.w = cvt_pk_bf16(v1[2], v1[3]);
                    *(u32x4*)(rowp + bj * HALF) = w; } }
    }
};
struct EpiSwiGLU {
    static constexpr bool PERM = true, AFTER_DRAIN = false;
    bf16_t* O; int ldc;
    __device__ __forceinline__ void operator()(const f32x4 (&acc)[2][2][4][2], const Unit& u, int wr, int wc, int fr, int fq) const {
        const int row0 = u.pm * BM + wr * 64 + fr; const int col0 = u.pn * HALF + wc * 32 + 8 * fq;
#pragma unroll
        for (int ai = 0; ai < 2; ++ai)
#pragma unroll
            for (int m = 0; m < 4; ++m) { bf16_t* rowp = O + (size_t)(row0 + ai * HALF + m * 16) * ldc + col0;
                float o[8];
#pragma unroll
                for (int n = 0; n < 2; ++n)
#pragma unroll
                    for (int e = 0; e < 4; ++e) { const float gte = acc[ai][0][m][n][e], up = acc[ai][1][m][n][e]; o[n * 4 + e] = gte * __builtin_amdgcn_rcpf(1.0f + __expf(-gte)) * up; }
                u32x4 w; w.x = cvt_pk_bf16(o[0], o[1]); w.y = cvt_pk_bf16(o[2], o[3]); w.z = cvt_pk_bf16(o[4], o[5]); w.w = cvt_pk_bf16(o[6], o[7]);
                *(u32x4*)rowp = w; }
    }
};
struct EpiResid {
    static constexpr bool PERM = false, AFTER_DRAIN = false;
    const float* xin_p; const float* xin_s; float* xout; const float* gate  ; const float* cscale;
    __device__ __forceinline__ void operator()(const f32x4 (&acc)[2][2][4][2], const Unit& u, int wr, int wc, int fr, int fq) const {
        const int row0 = u.pm * BM + wr * 64 + fr, col0 = u.pn * BM + wc * 32 + 4 * fq;
        const float* gp = gate + (size_t)cond_of_panel(u.pm) * 12288 + col0;
        f32x4 gv[2][2];
#pragma unroll
        for (int bj = 0; bj < 2; ++bj)
#pragma unroll
            for (int n = 0; n < 2; ++n) { gv[bj][n] = *(const f32x4*)(gp + bj * HALF + n * 16); if (cscale) gv[bj][n] = gv[bj][n] * *(const f32x4*)(cscale + col0 + bj * HALF + n * 16); }
#pragma unroll
        for (int ai = 0; ai < 2; ++ai)
#pragma unroll
            for (int m = 0; m < 4; ++m) { const int row = row0 + ai * HALF + m * 16;
                const float* xi = xin_p ? (row < 4096 ? xin_p + (size_t)row * 2048 : xin_s + (size_t)(row - 4096) * 2048) : xout + (size_t)row * 2048;
                float* xo = xout + (size_t)row * 2048;
#pragma unroll
                for (int bj = 0; bj < 2; ++bj)
#pragma unroll
                    for (int n = 0; n < 2; ++n) { const f32x4 xv = *(const f32x4*)(xi + col0 + bj * HALF + n * 16); *(f32x4*)(xo + col0 + bj * HALF + n * 16) = xv + gv[bj][n] * acc[ai][bj][m][n]; } }
    }
};

template <class Epi, class Sched, bool ALIGN_EPI = false, bool SP2 = false>
__device__ __forceinline__ void gemm_phase(PG8_LAS unsigned char* lds, const Gemm g, const Sched& S, const Epi& E) {
    const int tid = threadIdx.x, wid = __builtin_amdgcn_readfirstlane(tid >> 6), lane = tid & 63, wr = wid >> 2, wc = wid & 3, fr = lane & 15, fq = lane >> 4;
    const int K = g.K, nt = K / BK;
    unsigned voffA[2], voffB[2];
#pragma unroll
    for (int i = 0; i < 2; ++i) { int R, C; stage_rc(tid * 16 + i * 8192, R, C); const int Rb = Epi::PERM ? ((R & ~31) + perm32(R & 31)) : R;
        voffA[i] = (unsigned)(R * g.lda + C) * 2u; voffB[i] = (unsigned)(Rb * g.ldb + C) * 2u; }
    const size_t kstep = (size_t)(BK * 2);
    const size_t hstepA = (size_t)HALF * g.lda * 2, hstepB = (size_t)HALF * g.ldb * 2;
    const size_t tstepA = 2 * hstepA, tstepB = 2 * hstepB;
    const unsigned ldsw = (unsigned)wid * 1024u;
    const int aoff = lds_byte(wr * 64 + fr, fq * 8), boff = lds_byte(wc * 32 + fr, fq * 8);
#define PG8_SA(b, h) (((b) * 2 + (h)) * HTB)
#define PG8_SB(b, h) ((4 + (b) * 2 + (h)) * HTB)
#define PG8_STAGE(bufoff, gbase, voff) do { _Pragma("unroll") for (int _i = 0; _i < 2; ++_i) \
        __builtin_amdgcn_global_load_lds((const unsigned*)((const char*)(gbase) + (voff)[_i]), (PG8_LAS unsigned*)(lds + (bufoff) + ldsw + _i * 8192), 16, 0, 0); } while (0)
#define PG8_LDA(dst, b, h) do { _Pragma("unroll") for (int m = 0; m < 4; ++m) _Pragma("unroll") for (int k = 0; k < 2; ++k) dst[m][k] = *(const PG8_LAS bf16x8*)(lds + PG8_SA(b, h) + aoff + m * 2048 + k * 1024); } while (0)
#define PG8_LDB(dst, b, h) do { _Pragma("unroll") for (int n = 0; n < 2; ++n) _Pragma("unroll") for (int k = 0; k < 2; ++k) dst[n][k] = *(const PG8_LAS bf16x8*)(lds + PG8_SB(b, h) + boff + n * 2048 + k * 1024); } while (0)
#define PG8_MMA(ai, bj, At, Bt) do { __builtin_amdgcn_s_setprio(1); _Pragma("unroll") for (int m = 0; m < 4; ++m) _Pragma("unroll") for (int n = 0; n < 2; ++n) _Pragma("unroll") for (int k = 0; k < 2; ++k) \
        acc[ai][bj][m][n] = __builtin_amdgcn_mfma_f32_16x16x32_bf16(Bt[n][k], At[m][k], acc[ai][bj][m][n], 0, 0, 0); __builtin_amdgcn_s_setprio(0); } while (0)
#define PG8_WAIT_V(n) asm volatile("s_waitcnt vmcnt(" #n ")" ::: "memory")
#define PG8_WAIT_L(n) asm volatile("s_waitcnt lgkmcnt(" #n ")" ::: "memory")
#define PG8_BAR __builtin_amdgcn_s_barrier()
#define PG8_SCHED __builtin_amdgcn_sched_barrier(0)
    Unit cur, nxt; int ui = 0;
    if (!S.next(0, cur)) return;
    f32x4 acc[2][2][4][2];
#pragma unroll
    for (int a = 0; a < 2; ++a)
#pragma unroll
        for (int b = 0; b < 2; ++b)
#pragma unroll
            for (int m = 0; m < 4; ++m)
#pragma unroll
                for (int n = 0; n < 2; ++n) acc[a][b][m][n] = (f32x4){0.f, 0.f, 0.f, 0.f};
    bf16x8 At[4][2], B0[2][2], B1[2][2];
    const char* cA = (const char*)g.A + (size_t)cur.pm * tstepA + (size_t)((cur.pn >> g.gsh) * g.gk) * 2; const char* cB = (const char*)g.Bt + (size_t)cur.pn * tstepB;
    S.a_ready(cur);
    if constexpr (SP2) {
        PG8_STAGE(PG8_SB(0, 0), cB, voffB); PG8_STAGE(PG8_SB(0, 1), cB + hstepB, voffB); PG8_STAGE(PG8_SA(0, 0), cA, voffA); PG8_STAGE(PG8_SA(0, 1), cA + hstepA, voffA);
        if (wr == 1) PG8_BAR;
        PG8_WAIT_V(2); PG8_BAR;
        PG8_STAGE(PG8_SB(1, 0), cB + kstep, voffB); PG8_STAGE(PG8_SA(1, 0), cA + kstep, voffA); PG8_STAGE(PG8_SB(1, 1), cB + hstepB + kstep, voffB);
        PG8_WAIT_V(6); PG8_BAR;
    } else {
        PG8_STAGE(PG8_SB(0, 0), cB, voffB); PG8_STAGE(PG8_SA(0, 0), cA, voffA); PG8_STAGE(PG8_SB(0, 1), cB + hstepB, voffB); PG8_STAGE(PG8_SA(0, 1), cA + hstepA, voffA);
        if (wr == 1) PG8_BAR;
        PG8_WAIT_V(4); PG8_BAR;
        PG8_STAGE(PG8_SB(1, 0), cB + kstep, voffB); PG8_STAGE(PG8_SA(1, 0), cA + kstep, voffA); PG8_STAGE(PG8_SB(1, 1), cB + hstepB + kstep, voffB);
        PG8_WAIT_V(6); PG8_BAR;
    }
    for (;;) {
        const bool has_next = S.next(ui + 1, nxt);
        const char* nA = has_next ? (const char*)g.A + (size_t)nxt.pm * tstepA + (size_t)((nxt.pn >> g.gsh) * g.gk) * 2 : cA; const char* nB = has_next ? (const char*)g.Bt + (size_t)nxt.pn * tstepB : cB;
        for (int t = 0; t < nt; t += 2) {
            const bool last = (t == nt - 2);
            const char* a1 = cA + (size_t)(t + 1) * kstep;
            const char* a2 = last ? nA : cA + (size_t)(t + 2) * kstep; const char* b2 = last ? nB : cB + (size_t)(t + 2) * kstep;
            const char* a3 = a2 + kstep; const char* b3 = b2 + kstep;
            if (last && has_next) S.a_ready(nxt);
            if constexpr (SP2) {
            PG8_LDB(B0, 0, 0); PG8_LDB(B1, 0, 1); PG8_SCHED; PG8_LDA(At, 0, 0); PG8_STAGE(PG8_SA(1, 1), a1 + hstepA, voffA);
            PG8_WAIT_V(8); PG8_WAIT_L(0); PG8_BAR; PG8_MMA(0, 0, At, B0); PG8_MMA(0, 1, At, B1); PG8_BAR; PG8_SCHED;
            PG8_LDA(At, 0, 1); PG8_STAGE(PG8_SB(0, 0), b2, voffB); PG8_STAGE(PG8_SB(0, 1), b2 + hstepB, voffB); PG8_STAGE(PG8_SA(0, 0), a2, voffA);
            PG8_WAIT_V(8); PG8_WAIT_L(0); PG8_BAR; PG8_MMA(1, 0, At, B0); PG8_MMA(1, 1, At, B1); PG8_BAR; PG8_SCHED;
            PG8_LDB(B0, 1, 0); PG8_LDB(B1, 1, 1); PG8_SCHED; PG8_LDA(At, 1, 0); PG8_STAGE(PG8_SA(0, 1), a2 + hstepA, voffA);
            PG8_WAIT_V(8); PG8_WAIT_L(0); PG8_BAR; PG8_MMA(0, 0, At, B0); PG8_MMA(0, 1, At, B1); PG8_BAR; PG8_SCHED;
            PG8_LDA(At, 1, 1); PG8_STAGE(PG8_SB(1, 0), b3, voffB); PG8_STAGE(PG8_SB(1, 1), b3 + hstepB, voffB); PG8_STAGE(PG8_SA(1, 0), a3, voffA);
            PG8_WAIT_V(8); PG8_WAIT_L(0); PG8_BAR; PG8_MMA(1, 0, At, B0); PG8_MMA(1, 1, At, B1); PG8_BAR; PG8_SCHED;
            } else {
            PG8_LDB(B0, 0, 0); PG8_SCHED; PG8_LDA(At, 0, 0); PG8_STAGE(PG8_SA(1, 1), a1 + hstepA, voffA);
            PG8_WAIT_L(8); PG8_BAR; PG8_WAIT_L(0); PG8_MMA(0, 0, At, B0); PG8_BAR; PG8_SCHED;
            PG8_LDB(B1, 0, 1); PG8_STAGE(PG8_SB(0, 0), b2, voffB);
            PG8_BAR; PG8_WAIT_L(0); PG8_MMA(0, 1, At, B1); PG8_BAR;
            PG8_LDA(At, 0, 1); PG8_STAGE(PG8_SA(0, 0), a2, voffA);
            PG8_BAR; PG8_WAIT_L(0); PG8_MMA(1, 0, At, B0); PG8_BAR; PG8_SCHED;
            PG8_STAGE(PG8_SB(0, 1), b2 + hstepB, voffB);
            PG8_WAIT_V(6); PG8_BAR; PG8_MMA(1, 1, At, B1); PG8_BAR;
            PG8_LDB(B0, 1, 0); PG8_SCHED; PG8_LDA(At, 1, 0); PG8_STAGE(PG8_SA(0, 1), a2 + hstepA, voffA);
            PG8_WAIT_L(8); PG8_BAR; PG8_WAIT_L(0); PG8_MMA(0, 0, At, B0); PG8_BAR; PG8_SCHED;
            PG8_LDB(B1, 1, 1); PG8_STAGE(PG8_SB(1, 0), b3, voffB);
            PG8_BAR; PG8_WAIT_L(0); PG8_MMA(0, 1, At, B1); PG8_BAR;
            PG8_LDA(At, 1, 1); PG8_STAGE(PG8_SA(1, 0), a3, voffA);
            PG8_BAR; PG8_WAIT_L(0); PG8_MMA(1, 0, At, B0); PG8_BAR; PG8_SCHED;
            PG8_STAGE(PG8_SB(1, 1), b3 + hstepB, voffB);
            PG8_WAIT_V(6); PG8_BAR; PG8_MMA(1, 1, At, B1); PG8_BAR;
            }
        }
        if constexpr (ALIGN_EPI) { if (wr == 0) PG8_BAR; }
        if constexpr (!Epi::AFTER_DRAIN) { E(acc, cur, wr, wc, fr, fq); S.done(cur); }
        if (!has_next) break;
#pragma unroll
        for (int a = 0; a < 2; ++a)
#pragma unroll
            for (int b = 0; b < 2; ++b)
#pragma unroll
                for (int m = 0; m < 4; ++m)
#pragma unroll
                    for (int n = 0; n < 2; ++n) acc[a][b][m][n] = (f32x4){0.f, 0.f, 0.f, 0.f};
        cur = nxt; cA = nA; cB = nB; ++ui;
        if constexpr (ALIGN_EPI) { if (wr == 1) PG8_BAR; }
    }
    PG8_WAIT_V(0);
    if constexpr (!ALIGN_EPI) { if (wr == 0) PG8_BAR; }
    PG8_BAR;
    if constexpr (Epi::AFTER_DRAIN) { E.fused(acc, cur, wr, wc, fr, fq, lds, wid, lane); S.done(cur); }
#undef PG8_SA
#undef PG8_SB
#undef PG8_STAGE
#undef PG8_LDA
#undef PG8_LDB
#undef PG8_MMA
#undef PG8_WAIT_V
#undef PG8_WAIT_L
#undef PG8_BAR
#undef PG8_SCHED
}
}

constexpr int D = 2048, NTOK = 12288, NPROMPT = 4096, DFF = 5632, PW = 7680  , CPA = 3488;
constexpr int NWAVES = 8, NTHR = 512;
constexpr int PC_GDN = 3072, PC_Z = 6144, PC_LORA = 7168, PC_BETA = 7584, PC_ALPHA = 7600;
constexpr float RMS_EPS = 1e-6f, GN_EPS = 64e-5f;

constexpr size_t MiB = 1u << 20;
constexpr size_t WS_CTL = 0, CTL_ZERO_BYTES = 1 * MiB;
constexpr size_t WS_MOD = 1 * MiB;
constexpr size_t WS_WIN = 3 * MiB;
constexpr size_t WS_WOUT = 63 * MiB;
constexpr size_t WS_WGU = 79 * MiB;
constexpr size_t WS_WDN = 255 * MiB;
constexpr size_t WS_WPOOL = 343 * MiB;
constexpr size_t WS_H = 347 * MiB;
constexpr size_t WS_O = 395 * MiB;
constexpr size_t WS_P = 443 * MiB;
constexpr size_t WS_SC = 623 * MiB;
constexpr size_t SC_ONE = 48 * MiB;
constexpr size_t WS_Y = 1247 * MiB;
constexpr size_t WS_SMALL = 1439 * MiB;
constexpr size_t WS_LORA = 1443 * MiB;
constexpr size_t WS_END = 1445 * MiB;
constexpr int CW_BAR = 4096;

constexpr int LDS_STAGE = 131072, LDS_MISC = LDS_STAGE + 320, LDS_BYTES = 147456;

#define GAS __attribute__((address_space(1)))
#define LAS __attribute__((address_space(3)))
typedef unsigned short bf16;
typedef unsigned v4u __attribute__((ext_vector_type(4)));
typedef unsigned v2u __attribute__((ext_vector_type(2)));
typedef float f32x4 __attribute__((ext_vector_type(4)));
typedef float f32x2 __attribute__((ext_vector_type(2)));
#define LDS_WAIT() asm volatile("s_waitcnt lgkmcnt(0)" ::: "memory")

__device__ __forceinline__ unsigned f2bf(float f) { unsigned u = __builtin_bit_cast(unsigned, f); return (u + 0x7fffu + ((u >> 16) & 1u)) >> 16; }
__device__ __forceinline__ unsigned pk2(float lo, float hi) { return f2bf(lo) | (f2bf(hi) << 16); }
__device__ __forceinline__ float bf2f(bf16 b) { return __builtin_bit_cast(float, (unsigned)b << 16); }
__device__ __forceinline__ float bflo(unsigned w) { return __builtin_bit_cast(float, w << 16); }
__device__ __forceinline__ float bfhi(unsigned w) { return __builtin_bit_cast(float, w & 0xffff0000u); }
__device__ __forceinline__ float sigmoidf_(float x) { return __builtin_amdgcn_rcpf(1.0f + __builtin_amdgcn_exp2f(-1.4426950409f * x)); }
__device__ __forceinline__ float siluf_(float x) { return x * __builtin_amdgcn_rcpf(1.0f + __builtin_amdgcn_exp2f(-1.4426950409f * x)); }
__device__ __forceinline__ float softplusf_(float x) { return x > 20.f ? x : log1pf(__expf(x)); }
__device__ __forceinline__ float wave_sum(float v) {
#pragma unroll
    for (int o = 1; o < 64; o <<= 1) v += __shfl_xor(v, o);
    return v;
}
__device__ __forceinline__ int opaque_tid() { int t = threadIdx.x; asm volatile("" : "+v"(t)); return t; }
__device__ __forceinline__ float rdl(float v, int k) { return __builtin_bit_cast(float, __builtin_amdgcn_readlane(__builtin_bit_cast(int, v), k)); }

#define XB_TMO      128
#define XB_XCNT(j)  (256  + 64 * (j))
#define XB_XSUB(j)  (1280 + 64 * (j))
#define XB_XGEN(j)  (2304 + 64 * (j))
#define XB_TOP      3328
#define XB_TOPGEN   3392
#define XCD_BAR_WORDS 3456
#define XB_SPIN_CAP (1u << 18)
__device__ __forceinline__ unsigned xb_ld(unsigned* p)              { return __hip_atomic_load(p, __ATOMIC_RELAXED, __HIP_MEMORY_SCOPE_AGENT); }
__device__ __forceinline__ unsigned xb_add(unsigned* p, unsigned v) { return __hip_atomic_fetch_add(p, v, __ATOMIC_RELAXED, __HIP_MEMORY_SCOPE_AGENT); }
__device__ __forceinline__ unsigned xb_xcc_id() { return (unsigned)__builtin_amdgcn_s_getreg((3 << 11) | 20) & 0xFu; }
#define XB_SPIN(cond, bar) do { unsigned _sp = 0; while (cond) { __builtin_amdgcn_s_sleep(1); \
    if ((++_sp & 255u) == 0u) { if (xb_ld(&(bar)[XB_TMO])) break; if (_sp > XB_SPIN_CAP) { atomicAdd(&(bar)[XB_TMO], 1u); break; } } } } while (0)
struct XcdBarrier { unsigned* bar; unsigned x; volatile LAS unsigned* st; };
__device__ __forceinline__ XcdBarrier xcd_barrier_post(unsigned* bar, volatile LAS unsigned* st) {
    XcdBarrier b; b.bar = bar; b.x = xb_xcc_id(); b.st = st;
    if (threadIdx.x == 0) (void)xb_add(&bar[XB_XCNT(b.x)], 1u);
    return b;
}
__device__ __forceinline__ void xcd_barrier_complete(unsigned* bar, unsigned x, unsigned& nloc, unsigned& nx) {
    const unsigned G = gridDim.x * gridDim.y * gridDim.z;
    unsigned sum, cnt, mine, sp = 0u;
    for (;;) {
        sum = 0u; cnt = 0u; mine = 0u;
#pragma unroll
        for (unsigned j = 0; j < 16; ++j) { const unsigned c = xb_ld(&bar[XB_XCNT(j)]); sum += c; cnt += (c > 0u) ? 1u : 0u; mine = (j == x) ? c : mine; }
        if (sum == G) break;
        __builtin_amdgcn_s_sleep(1);
        if ((++sp & 255u) == 0u) { if (xb_ld(&bar[XB_TMO])) break; if (sp > XB_SPIN_CAP) { atomicAdd(&bar[XB_TMO], 1u); break; } }
    }
    nloc = mine > 0u ? mine : 1u; nx = cnt > 0u ? cnt : 1u;
}
__device__ __forceinline__ void xcd_barrier(const XcdBarrier& b) {
    asm volatile("s_waitcnt vmcnt(0)" ::: "memory");
    __syncthreads();
    if (threadIdx.x == 0) {
        unsigned* bar = b.bar;
        __builtin_amdgcn_s_waitcnt(0);
        unsigned nloc = b.st[0], nx = b.st[1];
        if (nloc == 0u) { xcd_barrier_complete(bar, b.x, nloc, nx); b.st[0] = nloc; b.st[1] = nx; }
        const unsigned old = xb_add(&bar[XB_XSUB(b.x)], 1u);
        const unsigned gen = old / nloc;
        if (old + 1u == (gen + 1u) * nloc) {
            __builtin_amdgcn_fence(__ATOMIC_RELEASE, "agent");
            asm volatile("s_waitcnt vmcnt(0)" ::: "memory");
            const unsigned og = xb_add(&bar[XB_TOP], 1u);
            const unsigned tg = og / nx;
            if (og + 1u == (tg + 1u) * nx) xb_add(&bar[XB_TOPGEN], 1u);
            else XB_SPIN(xb_ld(&bar[XB_TOPGEN]) == tg, bar);
            __builtin_amdgcn_fence(__ATOMIC_ACQUIRE, "agent");
            xb_add(&bar[XB_XGEN(b.x)], 1u);
            asm volatile("s_waitcnt vmcnt(0)" ::: "memory");
        } else {
            XB_SPIN(xb_ld(&bar[XB_XGEN(b.x)]) == gen, bar);
            __builtin_amdgcn_fence(__ATOMIC_ACQUIRE, "agent");
            asm volatile("s_waitcnt vmcnt(0)" ::: "memory");
        }
    }
    __syncthreads();
}

enum { I_XP = 0, I_XS, I_SRW, I_SDL, I_C, I_CCTX, I_MODW, I_MODB, I_NMIX, I_NFFN, I_NFIN, I_WIN, I_WOUT, I_MU, I_W0, I_W2, I_A0, I_A2, I_G2, I_KK, I_KA, I_RK, I_LNW, I_LNB,
       I_CONVW, I_ALOG, I_DTB, I_GNW, I_POOLW, I_POOLS, I_WG, I_WU, I_WD, N_IN };
struct Args { const float* in[N_IN]; float* out; unsigned char* ws; int ph_lo, ph_hi; };
constexpr size_t OUT_SRW = (size_t)NTOK * D, OUT_SDL = OUT_SRW + (size_t)16 * 2 * 2 * 16 * 64 * 64;

__device__ __forceinline__ void conv_item(const float* W, int K, int N, bf16* WT, int drow0, LAS float* scr, int kb, int nb, int lane) {
    const int k0 = 64 * kb, n0 = 32 * nb;
#pragma unroll 8
    for (int i = 0; i < 32; ++i) { const int kk = 2 * i + (lane >> 5); scr[kk * 33 + (lane & 31)] = W[(size_t)(k0 + kk) * N + n0 + (lane & 31)]; }
    LDS_WAIT(); asm volatile("" ::: "memory");
    const int c = lane & 7;
#pragma unroll
    for (int j = 0; j < 4; ++j) { const int n = (lane >> 3) + 8 * j; const LAS float* s = scr + (8 * c) * 33 + n;
        v4u o; o.x = pk2(s[0 * 33], s[1 * 33]); o.y = pk2(s[2 * 33], s[3 * 33]); o.z = pk2(s[4 * 33], s[5 * 33]); o.w = pk2(s[6 * 33], s[7 * 33]);
        *(v4u*)(WT + (size_t)(drow0 + n) * K + k0 + 8 * c) = o; }
    LDS_WAIT(); asm volatile("" ::: "memory");
}
__device__ __forceinline__ int win_row(int n) { return n < 3072 ? n : (n < CPA ? PC_LORA + (n - 3072) : (n < CPA + 4096 ? PC_GDN + (n - CPA) : n)); }

__device__ __forceinline__ void ph_pre(const Args& a, LAS unsigned char* lds) {
    const int tid = opaque_tid(), lane = tid & 63, wave = __builtin_amdgcn_readfirstlane(tid >> 6);
    const int G = gridDim.x;
    LAS float* ca = (LAS float*)lds;
    LAS float* red = (LAS float*)(lds + 2048 * 9 * 4);
    for (int i = tid; i < 9 * 2048; i += NTHR) { const int c = i / 2048, k = i - c * 2048; const float v = c == 0 ? a.in[I_CCTX][k] : a.in[I_C][(c - 1) * 2048 + k]; ca[k * 9 + c] = siluf_(v); }
    __syncthreads();
    float* MOD = (float*)(a.ws + WS_MOD);
    for (int task = blockIdx.x; task < 4 * 96; task += G) {
        const int l = task / 96, cb = task - l * 96;
        const float* wp = a.in[I_MODW] + ((size_t)l * 2048 + wave * 256) * 12288 + cb * 128 + lane * 2;
        float acc[9][2];
#pragma unroll
        for (int c = 0; c < 9; ++c) { acc[c][0] = 0.f; acc[c][1] = 0.f; }
        for (int k8 = 0; k8 < 256; k8 += 8) {
            f32x2 wv[8];
#pragma unroll
            for (int j = 0; j < 8; ++j) wv[j] = *(const f32x2*)(wp + (size_t)(k8 + j) * 12288);
#pragma unroll
            for (int j = 0; j < 8; ++j) { const LAS float* cp = ca + (wave * 256 + k8 + j) * 9;
#pragma unroll
                for (int c = 0; c < 9; ++c) { const float s = cp[c]; acc[c][0] += s * wv[j].x; acc[c][1] += s * wv[j].y; } }
        }
#pragma unroll
        for (int c = 0; c < 9; ++c) { red[(wave * 18 + c * 2) * 64 + lane] = acc[c][0]; red[(wave * 18 + c * 2 + 1) * 64 + lane] = acc[c][1]; }
        __syncthreads();
        for (int o = tid; o < 9 * 128; o += NTHR) { const int c = o >> 7, col = o & 127, ln = col >> 1, j = col & 1; float s = a.in[I_MODB][l * 12288 + cb * 128 + col];
#pragma unroll
            for (int w = 0; w < 8; ++w) s += red[(w * 18 + c * 2 + j) * 64 + ln];
            MOD[((size_t)l * 9 + c) * 12288 + cb * 128 + col] = s; }
        __syncthreads();
    }
    __syncthreads();
    LAS float* scr = (LAS float*)(lds + wave * 16384);
    const int gw = blockIdx.x * NWAVES + wave, NGW = G * NWAVES;
    bf16* WIN = (bf16*)(a.ws + WS_WIN); bf16* WOUT = (bf16*)(a.ws + WS_WOUT); bf16* WGU = (bf16*)(a.ws + WS_WGU); bf16* WDN = (bf16*)(a.ws + WS_WDN); bf16* WPOOL = (bf16*)(a.ws + WS_WPOOL);
    constexpr int IT_WIN = 32 * 238, IT_WOUT = 32 * 64, IT_GU = 32 * 176, IT_DN = 88 * 64, IT_POOL = 8 * 16;
    constexpr int NITEMS = 2 * IT_WIN + 2 * IT_WOUT + 8 * IT_GU + 4 * IT_DN + 8 * IT_POOL;
    for (int it = gw; it < NITEMS; it += NGW) {
        int r = it;
        if (r < 2 * IT_WIN) { const int i = r / IT_WIN; r -= i * IT_WIN; const int kb = r / 238, nb = r - kb * 238;
            conv_item(a.in[I_WIN] + (size_t)i * 2048 * 7616, 2048, 7616, WIN + (size_t)i * PW * 2048, win_row(32 * nb), scr, kb, nb, lane); continue; } r -= 2 * IT_WIN;
        if (r < 2 * IT_WOUT) { const int i = r / IT_WOUT; r -= i * IT_WOUT; const int kb = r / 64, nb = r - kb * 64;
            conv_item(a.in[I_WOUT] + (size_t)i * 2048 * 2048, 2048, 2048, WOUT + (size_t)i * 2048 * 2048, 32 * nb, scr, kb, nb, lane); continue; } r -= 2 * IT_WOUT;
        if (r < 8 * IT_GU) { const int li = r / IT_GU; r -= li * IT_GU; const int l = li >> 1, up = li & 1; const int kb = r / 176, nb = r - kb * 176; const int n0 = 32 * nb;
            conv_item(a.in[up ? I_WU : I_WG] + (size_t)l * 2048 * DFF, 2048, DFF, WGU + (size_t)l * 11264 * 2048, (n0 >> 7) * 256 + up * 128 + (n0 & 127), scr, kb, nb, lane); continue; } r -= 8 * IT_GU;
        if (r < 4 * IT_DN) { const int l = r / IT_DN; r -= l * IT_DN; const int kb = r / 64, nb = r - kb * 64;
            conv_item(a.in[I_WD] + (size_t)l * DFF * 2048, DFF, 2048, WDN + (size_t)l * 2048 * DFF, 32 * nb, scr, kb, nb, lane); continue; } r -= 4 * IT_DN;
        { const int ig = r / IT_POOL; r -= ig * IT_POOL; const int kb = r / 16, nb = r - kb * 16;
            conv_item(a.in[I_POOLW] + (size_t)ig * 512 * 512, 512, 512, WPOOL + (size_t)ig * 512 * 512, 32 * nb, scr, kb, nb, lane); }
    }
    { bf16* LW = (bf16*)(a.ws + WS_LORA); const int gt = blockIdx.x * NTHR + tid, NGT = G * NTHR;
        for (int idx = gt; idx < 8 * 65536; idx += NGT) { const int mat = idx >> 16, n = (idx >> 6) & 1023, k = idx & 63;
            const float v = (mat < 4 ? a.in[I_W2] : a.in[I_A2])[((size_t)(mat & 3) * 64 + k) * 1024 + n]; LW[idx] = (bf16)f2bf(v); }
        for (int idx = gt; idx < 2 * 1024 * 160; idx += NGT) { const int i2 = idx / (1024 * 160), r = idx - i2 * 1024 * 160, n = r / 160, k = r - n * 160;
            LW[8 * 65536 + idx] = (bf16)f2bf(a.in[I_G2][((size_t)i2 * 160 + k) * 1024 + n]); } }
    for (int r = gw; r < 128; r += NGW) { bf16* row = WIN + ((size_t)(r >> 6) * PW + 7616 + (r & 63)) * 2048; const v4u z = {0u, 0u, 0u, 0u};
#pragma unroll
        for (int j = 0; j < 4; ++j) *(v4u*)(row + (j * 64 + lane) * 8) = z; }
}

__device__ __forceinline__ void ph_norm(const Args& a, int l, int which) {
    const int tid = opaque_tid(), lane = tid & 63, wave = __builtin_amdgcn_readfirstlane(tid >> 6);
    const int gw = blockIdx.x * NWAVES + wave, NGW = gridDim.x * NWAVES;
    const float* nw = a.in[which ? I_NFFN : I_NMIX] + l * 2048;
    const float* MOD = (const float*)(a.ws + WS_MOD) + (size_t)l * 9 * 12288;
    bf16* H = (bf16*)(a.ws + WS_H);
    const bool from_in = (l == 0 && which == 0);
    for (int m = gw; m < NTOK; m += NGW) {
        const float* xr = from_in ? (m < NPROMPT ? a.in[I_XP] + (size_t)m * D : a.in[I_XS] + (size_t)(m - NPROMPT) * D) : a.out + (size_t)m * D;
        const int cond = m < NPROMPT ? 0 : 1 + ((m - NPROMPT) >> 10);
        const float* sh = MOD + (size_t)cond * 12288 + (which ? 3 : 0) * 2048; const float* sc = sh + 2048;
        f32x4 v[8]; float s = 0.f;
#pragma unroll
        for (int j = 0; j < 8; ++j) { v[j] = *(const f32x4*)(xr + 4 * lane + 256 * j); s += (v[j].x * v[j].x + v[j].y * v[j].y) + (v[j].z * v[j].z + v[j].w * v[j].w); }
        const float rstd = 1.0f / sqrtf(wave_sum(s) * (1.0f / D) + RMS_EPS);
#pragma unroll
        for (int j = 0; j < 8; ++j) { const int c = 4 * lane + 256 * j; const f32x4 w = *(const f32x4*)(nw + c), s1 = *(const f32x4*)(sc + c), s0 = *(const f32x4*)(sh + c);
            const f32x4 y = (v[j] * rstd) * w * (s1 + 1.0f) + s0;
            v2u o; o.x = pk2(y.x, y.y); o.y = pk2(y.z, y.w); *(v2u*)(H + (size_t)m * D + c) = o; }
    }
}
__device__ __forceinline__ void ph_final(const Args& a) {
    const int tid = opaque_tid(), lane = tid & 63, wave = __builtin_amdgcn_readfirstlane(tid >> 6);
    const int gw = blockIdx.x * NWAVES + wave, NGW = gridDim.x * NWAVES;
    const float* nw = a.in[I_NFIN];
    for (int m = gw; m < NTOK; m += NGW) {
        float* xr = a.out + (size_t)m * D;
        f32x4 v[8]; float s = 0.f;
#pragma unroll
        for (int j = 0; j < 8; ++j) { v[j] = *(const f32x4*)(xr + 4 * lane + 256 * j); s += (v[j].x * v[j].x + v[j].y * v[j].y) + (v[j].z * v[j].z + v[j].w * v[j].w); }
        const float rstd = 1.0f / sqrtf(wave_sum(s) * (1.0f / D) + RMS_EPS);
#pragma unroll
        for (int j = 0; j < 8; ++j) { const int c = 4 * lane + 256 * j; const f32x4 w = *(const f32x4*)(nw + c); *(f32x4*)(xr + c) = (v[j] * rstd) * w; }
    }
}
template <int G_> __device__ __forceinline__ void pool_group(const bf16* H, bf16* O, int m, int base, int t, int T, int lane) {
    constexpr int win = 2 << G_; const int c = G_ * 512 + lane * 8;
    int lo = t - win / 2, hi = lo + win; const int lo_c = lo < 0 ? 0 : lo, hi_c = hi > T ? T : hi;
    float s[8];
#pragma unroll
    for (int e = 0; e < 8; ++e) s[e] = 0.f;
#pragma unroll
    for (int j = 0; j < win; ++j) { const int r = lo + j; const bool ok = r >= 0 && r < T; const int rc = ok ? r : t;
        v4u w = *(const v4u*)(H + (size_t)(base + rc) * D + c); if (!ok) w = (v4u){0u, 0u, 0u, 0u};
        s[0] += bflo(w.x); s[1] += bfhi(w.x); s[2] += bflo(w.y); s[3] += bfhi(w.y); s[4] += bflo(w.z); s[5] += bfhi(w.z); s[6] += bflo(w.w); s[7] += bfhi(w.w); }
    const float inv = 1.0f / (float)(hi_c - lo_c);
    const v4u w = *(const v4u*)(H + (size_t)m * D + c);
    v4u o; o.x = pk2(s[0] * inv - bflo(w.x), s[1] * inv - bfhi(w.x)); o.y = pk2(s[2] * inv - bflo(w.y), s[3] * inv - bfhi(w.y));
    o.z = pk2(s[4] * inv - bflo(w.z), s[5] * inv - bfhi(w.z)); o.w = pk2(s[6] * inv - bflo(w.w), s[7] * inv - bfhi(w.w));
    *(v4u*)(O + (size_t)m * D + c) = o;
}
__device__ __forceinline__ void ph_pool(const Args& a) {
    const int tid = opaque_tid(), lane = tid & 63, wave = __builtin_amdgcn_readfirstlane(tid >> 6);
    const int gw = blockIdx.x * NWAVES + wave, NGW = gridDim.x * NWAVES;
    const bf16* H = (const bf16*)(a.ws + WS_H); bf16* O = (bf16*)(a.ws + WS_O);
    for (int m = gw; m < NTOK; m += NGW) {
        const bool samp = m >= NPROMPT; const int T = samp ? 1024 : 256; const int base = samp ? NPROMPT + (((m - NPROMPT) >> 10) << 10) : (m >> 8) << 8; const int t = m - base;
        pool_group<0>(H, O, m, base, t, T, lane); pool_group<1>(H, O, m, base, t, T, lane); pool_group<2>(H, O, m, base, t, T, lane); pool_group<3>(H, O, m, base, t, T, lane);
    }
}

typedef short sfrag __attribute__((ext_vector_type(8)));
union Frag { sfrag v; unsigned u[4]; };
typedef __bf16 bf16x2_t __attribute__((ext_vector_type(2)));
__device__ __forceinline__ unsigned cvtpk(float lo, float hi) { const f32x2 v = {lo, hi}; return __builtin_bit_cast(unsigned, __builtin_convertvector(v, bf16x2_t)); }
__device__ __forceinline__ f32x4 mma(const Frag& A, const Frag& B, f32x4 C) { return __builtin_amdgcn_mfma_f32_16x16x32_bf16(A.v, B.v, C, 0, 0, 0); }
__device__ __forceinline__ Frag feed1(f32x4 d0) { Frag f; f.u[0] = cvtpk(d0.x, d0.y); f.u[1] = cvtpk(d0.z, d0.w); f.u[2] = 0u; f.u[3] = 0u; return f; }
__device__ __forceinline__ Frag feed2(f32x4 d0, f32x4 d1) { Frag f; f.u[0] = cvtpk(d0.x, d0.y); f.u[1] = cvtpk(d0.z, d0.w); f.u[2] = cvtpk(d1.x, d1.y); f.u[3] = cvtpk(d1.z, d1.w); return f; }
#define DPP_SHR(x, n, fill) __builtin_bit_cast(float, __builtin_amdgcn_update_dpp(__builtin_bit_cast(int, (float)(fill)), __builtin_bit_cast(int, (float)(x)), 0x110 + (n), 0xf, 0xf, false))
__device__ __forceinline__ float row_scan16(float x) { x += DPP_SHR(x, 1, 0.f); x += DPP_SHR(x, 2, 0.f); x += DPP_SHR(x, 4, 0.f); x += DPP_SHR(x, 8, 0.f); return x; }
#define DPP_ROR(x, n) __builtin_bit_cast(float, __builtin_amdgcn_update_dpp(0, __builtin_bit_cast(int, (float)(x)), 0x120 + (n), 0xf, 0xf, false))
__device__ __forceinline__ float row_sum16(float x) { x += DPP_ROR(x, 8); x += DPP_ROR(x, 4); x += DPP_ROR(x, 2); x += DPP_ROR(x, 1); return x; }
__device__ __forceinline__ float lane_get(float x, int src) { return __builtin_bit_cast(float, __builtin_amdgcn_ds_bpermute(src << 2, __builtin_bit_cast(int, x))); }
constexpr f32x4 F4Z = {0.f, 0.f, 0.f, 0.f};
__device__ __forceinline__ f32x4 tri_inv_T(f32x4 dL, f32x4 dLT, f32x4 eye) {
    const Frag fL = feed1(dL), fLT = feed1(dLT);
    const f32x4 L2 = mma(fLT, fL, F4Z), L2T = mma(fL, fLT, F4Z);
    const Frag f2 = feed1(L2), f2T = feed1(L2T);
    const f32x4 L4 = mma(f2T, f2, F4Z), L4T = mma(f2, f2T, F4Z);
    const f32x4 L8 = mma(feed1(L4T), feed1(L4), F4Z);
    const f32x4 R1 = mma(feed1(L2 + eye), feed1(dLT + eye), F4Z);
    const f32x4 R2 = mma(feed1(L4 + eye), feed1(R1), F4Z);
    return mma(feed1(L8 + eye), feed1(R2), F4Z);
}

__device__ __forceinline__ void rwkv_task(const Args& a, int i, int s, int h, int d, int lane, LAS float* wscr) {
    constexpr size_t S1 = (size_t)NTOK * 1024;
    const bf16* RW = (const bf16*)(a.ws + WS_SC);
    bf16* YS = (bf16*)(a.ws + WS_Y) + d * S1;
    const float* BON = (const float*)(a.ws + WS_SMALL);
    const float* lnw = a.in[I_LNW] + i * 1024 + h * 64; const float* lnb = a.in[I_LNB] + i * 1024 + h * 64;
    const int T = s < 16 ? 256 : 1024; const int row0 = s < 16 ? s * 256 : NPROMPT + (s - 16) * 1024;
    const int c = lane & 15, q = lane >> 4;
    f32x4 S[4][4];
    if (s >= 16) { const float* s0 = a.in[I_SRW] + ((((size_t)(s - 16) * 2 + i) * 2 + d) * 16 + h) * 4096;
#pragma unroll
        for (int kt = 0; kt < 4; ++kt)
#pragma unroll
            for (int vt = 0; vt < 4; ++vt) S[kt][vt] = *(const f32x4*)(s0 + (16 * vt + c) * 64 + 16 * kt + 4 * q); }
    else {
#pragma unroll
        for (int kt = 0; kt < 4; ++kt)
#pragma unroll
            for (int vt = 0; vt < 4; ++vt) S[kt][vt] = F4Z; }
    Frag sel[2];
#pragma unroll
    for (int p = 0; p < 2; ++p)
#pragma unroll
        for (int j = 0; j < 4; ++j) { const int e0 = 2 * j - 4 * p; const bool on = ((lane >> 2) & 3) == q && (e0 == (lane & 3) || e0 + 1 == (lane & 3)) && (j >> 1) == p;
            sel[p].u[j] = on ? (((lane & 1) == 0) ? 0x00003F80u : 0x3F800000u) : 0u; }
    bool mlt[4], mle[4]; f32x4 eye;
#pragma unroll
    for (int n = 0; n < 4; ++n) { mlt[n] = (4 * q + n) < c; mle[n] = (4 * q + n) <= c; eye[n] = (4 * q + n) == c ? 1.f : 0.f; }
    const int nch = T >> 4;
    const int kof = (3 + d) * 1024, bof = (5 + d) * 1024, lof = (7 + d) * 1024;
    v2u nr[4], na[4], nk[4], nb[4], nlw[4], nv[4];
    { const int tok = d ? T - 1 - c : c; const int mrow = row0 + tok; const bf16* rw = RW + (((size_t)(mrow >> 4) * 16 + h) * 9) * 1024 + (mrow & 15) * 16 + 4 * q;
#pragma unroll
        for (int g = 0; g < 4; ++g) { nr[g] = *(const v2u*)(rw + 256 * g); na[g] = *(const v2u*)(rw + 1024 + 256 * g); nk[g] = *(const v2u*)(rw + kof + 256 * g); nb[g] = *(const v2u*)(rw + bof + 256 * g); nlw[g] = *(const v2u*)(rw + lof + 256 * g); nv[g] = *(const v2u*)(rw + 2048 + 256 * g); } }
    for (int ch = 0; ch < nch; ++ch) {
        Frag f_at[2], f_rt[2], f_bt[2], f_kt[2], f_bh[2], f_kh[2], f_v[2];
#pragma unroll
        for (int g = 0; g < 4; ++g) {
            const int ks = g >> 1, hf = g & 1;
            float lw_[4] = {bflo(nlw[g].x), bfhi(nlw[g].x), bflo(nlw[g].y), bfhi(nlw[g].y)};
            float r_[4] = {bflo(nr[g].x), bfhi(nr[g].x), bflo(nr[g].y), bfhi(nr[g].y)}, a_[4] = {bflo(na[g].x), bfhi(na[g].x), bflo(na[g].y), bfhi(na[g].y)};
            float k_[4] = {bflo(nk[g].x), bfhi(nk[g].x), bflo(nk[g].y), bfhi(nk[g].y)}, b_[4] = {bflo(nb[g].x), bfhi(nb[g].x), bflo(nb[g].y), bfhi(nb[g].y)};
            float at[4], rt[4], bt[4], kt[4], bh[4], kh[4];
#pragma unroll
            for (int n = 0; n < 4; ++n) {
                const float G = row_scan16(lw_[n]); const float E1 = __builtin_amdgcn_exp2f(G), E2 = __builtin_amdgcn_rcpf(E1); const float E3 = DPP_SHR(E1, 1, 1.0f);
                const float ec = lane_get(E1, (lane & 48) | 15); wscr[(g * 4 + n) * 64 + lane] = ec;
                at[n] = a_[n] * E3; rt[n] = r_[n] * E1; bt[n] = b_[n] * E2; kt[n] = k_[n] * E2; bh[n] = bt[n] * ec; kh[n] = kt[n] * ec;
            }
            f_at[ks].u[2 * hf] = cvtpk(at[0], at[1]); f_at[ks].u[2 * hf + 1] = cvtpk(at[2], at[3]); f_rt[ks].u[2 * hf] = cvtpk(rt[0], rt[1]); f_rt[ks].u[2 * hf + 1] = cvtpk(rt[2], rt[3]);
            f_bt[ks].u[2 * hf] = cvtpk(bt[0], bt[1]); f_bt[ks].u[2 * hf + 1] = cvtpk(bt[2], bt[3]); f_kt[ks].u[2 * hf] = cvtpk(kt[0], kt[1]); f_kt[ks].u[2 * hf + 1] = cvtpk(kt[2], kt[3]);
            f_bh[ks].u[2 * hf] = cvtpk(bh[0], bh[1]); f_bh[ks].u[2 * hf + 1] = cvtpk(bh[2], bh[3]); f_kh[ks].u[2 * hf] = cvtpk(kh[0], kh[1]); f_kh[ks].u[2 * hf + 1] = cvtpk(kh[2], kh[3]);
            f_v[ks].u[2 * hf] = nv[g].x; f_v[ks].u[2 * hf + 1] = nv[g].y;
            __builtin_amdgcn_sched_barrier(0);
        }
        LAS v2u* sV = (LAS v2u*)(wscr + 3072); LAS v4u* sBK = (LAS v4u*)(wscr + 1024);
#pragma unroll
        for (int g = 0; g < 4; ++g) { const f32x4 dv = mma(f_v[g >> 1], sel[g & 1], F4Z); sV[g * 64 + lane] = (v2u){cvtpk(dv.x, dv.y), cvtpk(dv.z, dv.w)};
            const Frag fb = feed2(mma(f_bh[g >> 1], sel[g & 1], F4Z), mma(f_kh[g >> 1], sel[g & 1], F4Z)); sBK[g * 64 + lane] = (v4u){fb.u[0], fb.u[1], fb.u[2], fb.u[3]}; }
        __builtin_amdgcn_sched_barrier(0);
        f32x4 dLab = mma(f_at[1], f_bt[1], mma(f_at[0], f_bt[0], F4Z));
        f32x4 dLabT = mma(f_bt[1], f_at[1], mma(f_bt[0], f_at[0], F4Z));
        f32x4 dLakT = mma(f_kt[1], f_at[1], mma(f_kt[0], f_at[0], F4Z));
        f32x4 dArbT = mma(f_bt[1], f_rt[1], mma(f_bt[0], f_rt[0], F4Z));
        f32x4 dArkT = mma(f_kt[1], f_rt[1], mma(f_kt[0], f_rt[0], F4Z));
#pragma unroll
        for (int n = 0; n < 4; ++n) { dLab[n] = (c < 4 * q + n) ? dLab[n] : 0.f; dLabT[n] = mlt[n] ? dLabT[n] : 0.f; dLakT[n] = mlt[n] ? dLakT[n] : 0.f; dArbT[n] = mle[n] ? dArbT[n] : 0.f; dArkT[n] = mle[n] ? dArkT[n] : 0.f; }
        const Frag fTT = feed1(tri_inv_T(dLab, dLabT, eye)), fLakT = feed1(dLakT), fArbT = feed1(dArbT), fArkT = feed1(dArkT);
        __builtin_amdgcn_sched_barrier(0);
        { const int chn = ch + 1 < nch ? ch + 1 : ch; const int tok = d ? T - 1 - (16 * chn + c) : 16 * chn + c; const int mrow = row0 + tok; const bf16* rw = RW + (((size_t)(mrow >> 4) * 16 + h) * 9) * 1024 + (mrow & 15) * 16 + 4 * q;
#pragma unroll
            for (int g = 0; g < 4; ++g) { nr[g] = *(const v2u*)(rw + 256 * g); na[g] = *(const v2u*)(rw + 1024 + 256 * g); nk[g] = *(const v2u*)(rw + kof + 256 * g); nb[g] = *(const v2u*)(rw + bof + 256 * g); nlw[g] = *(const v2u*)(rw + lof + 256 * g); nv[g] = *(const v2u*)(rw + 2048 + 256 * g); } }
        __builtin_amdgcn_sched_barrier(0);
        v2u pSA[4];
        const int tokbase = 16 * ch + 4 * q;
#pragma unroll
        for (int vt = 0; vt < 4; ++vt) {
            const Frag fS0 = feed2(S[0][vt], S[1][vt]), fS1 = feed2(S[2][vt], S[3][vt]); const v2u pv = sV[vt * 64 + lane]; Frag fV; fV.u[0] = pv.x; fV.u[1] = pv.y; fV.u[2] = 0u; fV.u[3] = 0u;
            f32x4 rhs = mma(f_at[1], fS1, mma(f_at[0], fS0, F4Z)); rhs = mma(fLakT, fV, rhs);
            const f32x4 sa = mma(fTT, feed1(rhs), F4Z); pSA[vt].x = cvtpk(sa.x, sa.y); pSA[vt].y = cvtpk(sa.z, sa.w);
            Frag fSA; fSA.u[0] = pSA[vt].x; fSA.u[1] = pSA[vt].y; fSA.u[2] = 0u; fSA.u[3] = 0u;
            f32x4 y = mma(f_rt[1], fS1, mma(f_rt[0], fS0, F4Z)); y = mma(fArbT, fSA, y); y = mma(fArkT, fV, y);
#pragma unroll
            for (int n = 0; n < 4; ++n) wscr[2048 + (vt * 4 + n) * 64 + lane] = y[n];
            __builtin_amdgcn_sched_barrier(0);
        }
#pragma unroll
        for (int vt = 0; vt < 4; ++vt) { const v2u pv = sV[vt * 64 + lane]; Frag fB; fB.u[0] = pSA[vt].x; fB.u[1] = pSA[vt].y; fB.u[2] = pv.x; fB.u[3] = pv.y;
#pragma unroll
            for (int kt = 0; kt < 4; ++kt) { f32x4 cin;
#pragma unroll
                for (int n = 0; n < 4; ++n) cin[n] = S[kt][vt][n] * wscr[(kt * 4 + n) * 64 + lane];
                const v4u w = sBK[kt * 64 + lane]; Frag fbk; fbk.u[0] = w.x; fbk.u[1] = w.y; fbk.u[2] = w.z; fbk.u[3] = w.w;
                S[kt][vt] = mma(fbk, fB, cin); } }
        __builtin_amdgcn_sched_barrier(0);
        {
            float s1[4] = {0.f, 0.f, 0.f, 0.f}, s2[4] = {0.f, 0.f, 0.f, 0.f};
#pragma unroll
            for (int vt = 0; vt < 4; ++vt)
#pragma unroll
                for (int n = 0; n < 4; ++n) { const float yv = wscr[2048 + (vt * 4 + n) * 64 + lane]; s1[n] += yv; s2[n] += yv * yv; }
            float mean[4], rs[4], bon[4]; size_t orow[4];
#pragma unroll
            for (int n = 0; n < 4; ++n) { const float m1 = row_sum16(s1[n]) * (1.0f / 64.0f), m2 = row_sum16(s2[n]) * (1.0f / 64.0f); mean[n] = m1; rs[n] = 1.0f / sqrtf(fmaxf(m2 - m1 * m1, 0.f) + GN_EPS);
                const int t = tokbase + n; const int tok = d ? T - 1 - t : t; const int mrow = row0 + tok; bon[n] = BON[((size_t)mrow * 2 + d) * 16 + h]; orow[n] = (((size_t)(mrow >> 4) * 16 + h) * 4) * 256 + (mrow & 15) * 16 + c; }
#pragma unroll
            for (int vt = 0; vt < 4; ++vt) { const float lw_ = lnw[16 * vt + c], lb_ = lnb[16 * vt + c];
                const v2u pv = sV[vt * 64 + lane]; const float vv[4] = {bflo(pv.x), bfhi(pv.x), bflo(pv.y), bfhi(pv.y)};
#pragma unroll
                for (int n = 0; n < 4; ++n) { const float yv = wscr[2048 + (vt * 4 + n) * 64 + lane];
                    YS[orow[n] + vt * 256] = (bf16)f2bf((yv - mean[n]) * rs[n] * lw_ + lb_ + bon[n] * vv[n]); } }
        }
    }
    if (s < 16) { float* so = a.out + OUT_SRW + ((((size_t)s * 2 + i) * 2 + d) * 16 + h) * 4096;
#pragma unroll
        for (int kt = 0; kt < 4; ++kt)
#pragma unroll
            for (int vt = 0; vt < 4; ++vt) *(f32x4*)(so + (16 * vt + c) * 64 + 16 * kt + 4 * q) = S[kt][vt]; }
}

__device__ __forceinline__ Frag scale_frag(const Frag& x, float sc) { Frag f;
#pragma unroll
    for (int j = 0; j < 4; ++j) f.u[j] = cvtpk(bflo(x.u[j]) * sc, bfhi(x.u[j]) * sc);
    return f; }
__device__ __forceinline__ void gdn_task(const Args& a, int i, int s, int h, int d, int vb, int lane, LAS float* wscr) {
    constexpr size_t S1 = (size_t)NTOK * 1024;
    const bf16* GD = (const bf16*)(a.ws + WS_SC) + 9 * S1;
    const float* BETA = (const float*)(a.ws + WS_SMALL) + (size_t)NTOK * 32; const float* GG = BETA + (size_t)NTOK * 16;
    bf16* O = (bf16*)(a.ws + WS_Y) + 2 * S1 + d * S1;
    const int T = s < 16 ? 256 : 1024; const int row0 = s < 16 ? s * 256 : NPROMPT + (s - 16) * 1024;
    const int c = lane & 15, q = lane >> 4;
    f32x4 S[8][2];
    if (s >= 16) { const float* s0 = a.in[I_SDL] + ((((size_t)(s - 16) * 2 + i) * 2 + d) * 8 + h) * 16384 + 32 * vb + c;
#pragma unroll
        for (int kt = 0; kt < 8; ++kt)
#pragma unroll
            for (int vt = 0; vt < 2; ++vt)
#pragma unroll
                for (int n = 0; n < 4; ++n) S[kt][vt][n] = s0[(16 * kt + 4 * q + n) * 128 + 16 * vt]; }
    else {
#pragma unroll
        for (int kt = 0; kt < 8; ++kt) { S[kt][0] = F4Z; S[kt][1] = F4Z; } }
    Frag sel[2];
#pragma unroll
    for (int p = 0; p < 2; ++p)
#pragma unroll
        for (int j = 0; j < 4; ++j) { const int e0 = 2 * j - 4 * p; const bool on = ((lane >> 2) & 3) == q && (e0 == (lane & 3) || e0 + 1 == (lane & 3)) && (j >> 1) == p;
            sel[p].u[j] = on ? (((lane & 1) == 0) ? 0x00003F80u : 0x3F800000u) : 0u; }
    f32x4 eye;
#pragma unroll
    for (int n = 0; n < 4; ++n) eye[n] = (4 * q + n) == c ? 1.f : 0.f;
    const int nch = T >> 4;
    Frag nk[4], nq[4], nv; float nbeta, ng;
    { const int tok = d ? T - 1 - c : c; const size_t row = row0 + tok; const bf16* gd = GD + ((((row >> 4) * 8 + h) * 3) * 8) * 256 + (row & 15) * 16 + 4 * q;
#pragma unroll
        for (int ks = 0; ks < 4; ++ks) { const v2u k0 = *(const v2u*)(gd + 2048 + 512 * ks), k1 = *(const v2u*)(gd + 2048 + 512 * ks + 256), q0 = *(const v2u*)(gd + 512 * ks), q1 = *(const v2u*)(gd + 512 * ks + 256);
            nk[ks].u[0] = k0.x; nk[ks].u[1] = k0.y; nk[ks].u[2] = k1.x; nk[ks].u[3] = k1.y; nq[ks].u[0] = q0.x; nq[ks].u[1] = q0.y; nq[ks].u[2] = q1.x; nq[ks].u[3] = q1.y; }
        { const v2u v0 = *(const v2u*)(gd + 4096 + 512 * vb), v1 = *(const v2u*)(gd + 4096 + 512 * vb + 256); nv.u[0] = v0.x; nv.u[1] = v0.y; nv.u[2] = v1.x; nv.u[3] = v1.y; }
        nbeta = BETA[row * 16 + d * 8 + h]; ng = GG[row * 16 + d * 8 + h]; }
    for (int ch = 0; ch < nch; ++ch) {
        const float beta = nbeta, gl = ng;
        const float G = row_scan16(gl); const float GC = lane_get(G, (lane & 48) | 15);
        float Grow[4], Brow[4];
#pragma unroll
        for (int n = 0; n < 4; ++n) { Grow[n] = lane_get(G, (lane & 48) | (4 * q + n)); Brow[n] = lane_get(beta, (lane & 48) | (4 * q + n)); }
        const float eG = __builtin_amdgcn_exp2f(G), eGCG = __builtin_amdgcn_exp2f(GC - G), eGC = __builtin_amdgcn_exp2f(GC);
        f32x4 dKK = F4Z, dKQ = F4Z;
#pragma unroll
        for (int ks = 0; ks < 4; ++ks) { dKK = mma(nk[ks], nk[ks], dKK); dKQ = mma(nk[ks], nq[ks], dKQ); }
        f32x4 dL, dLT, dAtT;
#pragma unroll
        for (int n = 0; n < 4; ++n) { const int r = 4 * q + n;
            const float eij = __builtin_amdgcn_exp2f(fminf(Grow[n] - G, 0.f)), eji = __builtin_amdgcn_exp2f(fminf(G - Grow[n], 0.f));
            dL[n] = (c < r) ? -Brow[n] * dKK[n] * eij : 0.f;
            dLT[n] = (r < c) ? -beta * dKK[n] * eji : 0.f;
            dAtT[n] = (r <= c) ? dKQ[n] * eji * 0.08838834764831845f : 0.f; }
        const Frag fTT = feed1(tri_inv_T(dL, dLT, eye)), fAtT = feed1(dAtT);
        f32x4 dV[2]; dV[0] = mma(nv, sel[0], F4Z); dV[1] = mma(nv, sel[1], F4Z);
        LAS v2u* sKd = (LAS v2u*)wscr;
#pragma unroll
        for (int ks = 0; ks < 4; ++ks) { const Frag kd = scale_frag(nk[ks], eGCG); const f32x4 t0 = mma(kd, sel[0], F4Z), t1 = mma(kd, sel[1], F4Z);
            sKd[(2 * ks) * 64 + lane] = (v2u){cvtpk(t0.x, t0.y), cvtpk(t0.z, t0.w)}; sKd[(2 * ks + 1) * 64 + lane] = (v2u){cvtpk(t1.x, t1.y), cvtpk(t1.z, t1.w)}; }
        Frag fX[4], fQg[4];
#pragma unroll
        for (int ks = 0; ks < 4; ++ks) { fX[ks] = scale_frag(nk[ks], beta * eG); fQg[ks] = scale_frag(nq[ks], eG * 0.08838834764831845f); }
        const int tokbase = 16 * ch + 4 * q;
#pragma unroll
        for (int vt = 0; vt < 2; ++vt) {
            f32x4 M = F4Z, o = F4Z;
#pragma unroll
            for (int ks = 0; ks < 4; ++ks) { const Frag fS = feed2(S[2 * ks][vt], S[2 * ks + 1][vt]); M = mma(fX[ks], fS, M); o = mma(fQg[ks], fS, o); }
            f32x4 rhs;
#pragma unroll
            for (int n = 0; n < 4; ++n) rhs[n] = Brow[n] * dV[vt][n] - M[n];
            const Frag fVn = feed1(mma(fTT, feed1(rhs), F4Z));
            o = mma(fAtT, fVn, o);
#pragma unroll
            for (int n = 0; n < 4; ++n) { const int t = tokbase + n; const int tok = d ? T - 1 - t : t; const int mrow = row0 + tok; O[(((size_t)(mrow >> 4) * 8 + h) * 8 + 2 * vb + vt) * 256 + (mrow & 15) * 16 + c] = (bf16)f2bf(o[n]); }
#pragma unroll
            for (int kt = 0; kt < 8; ++kt) { const v2u w = sKd[kt * 64 + lane]; Frag fK; fK.u[0] = w.x; fK.u[1] = w.y; fK.u[2] = 0u; fK.u[3] = 0u; S[kt][vt] = mma(fK, fVn, S[kt][vt] * eGC); }
        }
        asm volatile("" ::: "memory");
        { const int chn = ch + 1 < nch ? ch + 1 : ch; const int tok = d ? T - 1 - (16 * chn + c) : 16 * chn + c; const size_t row = row0 + tok; const bf16* gd = GD + ((((row >> 4) * 8 + h) * 3) * 8) * 256 + (row & 15) * 16 + 4 * q;
#pragma unroll
            for (int ks = 0; ks < 4; ++ks) { const v2u k0 = *(const v2u*)(gd + 2048 + 512 * ks), k1 = *(const v2u*)(gd + 2048 + 512 * ks + 256), q0 = *(const v2u*)(gd + 512 * ks), q1 = *(const v2u*)(gd + 512 * ks + 256);
                nk[ks].u[0] = k0.x; nk[ks].u[1] = k0.y; nk[ks].u[2] = k1.x; nk[ks].u[3] = k1.y; nq[ks].u[0] = q0.x; nq[ks].u[1] = q0.y; nq[ks].u[2] = q1.x; nq[ks].u[3] = q1.y; }
            { const v2u v0 = *(const v2u*)(gd + 4096 + 512 * vb), v1 = *(const v2u*)(gd + 4096 + 512 * vb + 256); nv.u[0] = v0.x; nv.u[1] = v0.y; nv.u[2] = v1.x; nv.u[3] = v1.y; }
            nbeta = BETA[row * 16 + d * 8 + h]; ng = GG[row * 16 + d * 8 + h]; }
    }
    if (s < 16) { float* so = a.out + OUT_SDL + ((((size_t)s * 2 + i) * 2 + d) * 8 + h) * 16384 + 32 * vb + c;
#pragma unroll
        for (int kt = 0; kt < 8; ++kt)
#pragma unroll
            for (int vt = 0; vt < 2; ++vt)
#pragma unroll
                for (int n = 0; n < 4; ++n) so[(16 * kt + 4 * q + n) * 128 + 16 * vt] = S[kt][vt][n]; }
}
__device__ __forceinline__ void ph_scan(const Args& a, LAS unsigned char* lds, int i) {
    const int tid = opaque_tid(), lane = tid & 63, wave = __builtin_amdgcn_readfirstlane(tid >> 6);
    LAS float* wscr = (LAS float*)(lds + wave * 14336);
    const int G = gridDim.x;
    for (int task = wave * G + blockIdx.x; task < 2304; task += NWAVES * G) {
        if (task >= 256 && task < 512) { const int t = task - 256; rwkv_task(a, i, 16 + (t >> 5), (t & 31) >> 1, t & 1, lane, wscr); }
        else if (task >= 1024 && task < 1536) { const int t = task - 1024; rwkv_task(a, i, t >> 5, (t & 31) >> 1, t & 1, lane, wscr); }
    }
    asm volatile("" ::: "memory");
    for (int task = wave * G + blockIdx.x; task < 2304; task += NWAVES * G) {
        if (task < 256 || task >= 1536) { const int t = task < 256 ? task : task - 1536 + 256; const int s = t >> 6, r = t & 63; gdn_task(a, i, s, r >> 3, (r >> 2) & 1, r & 3, lane, wscr); }
        else if (task >= 512 && task < 1024) { const int t = task - 512; const int s = 16 + (t >> 6), r = t & 63; gdn_task(a, i, s, r >> 3, (r >> 2) & 1, r & 3, lane, wscr); }
    }
}
__device__ __forceinline__ void tok_info(int m, bool& samp, int& T, int& t) { samp = m >= NPROMPT; T = samp ? 1024 : 256; t = samp ? ((m - NPROMPT) & 1023) : (m & 255); }
__device__ __forceinline__ void shift_nb(bool samp, int T, int t, int n, int& dt, bool& valid) {
    if (!samp) { if (n & 1) { dt = 1; valid = t + 1 < T; } else { dt = -1; valid = t > 0; } }
    else { const int col = t & 63, row = t >> 6;
        if (n == 0) { dt = -1; valid = col > 0; } else if (n == 1) { dt = 1; valid = col < 63; } else if (n == 2) { dt = -64; valid = row > 0; } else { dt = 64; valid = row < 15; } }
}
constexpr int LA_LD = 424;
__device__ __forceinline__ void ph_prep(const Args& a, LAS unsigned char* lds, int i) {
    const int tid = opaque_tid(), lane = tid & 63, wave = __builtin_amdgcn_readfirstlane(tid >> 6);
    const int c = lane & 15, q = lane >> 4;
    const bf16* P = (const bf16*)(a.ws + WS_P);
    bf16* RW = (bf16*)(a.ws + WS_SC); constexpr size_t S1 = (size_t)NTOK * 1024;
    bf16* GD = RW + 9 * S1; float* GT = (float*)(RW + 12 * S1);
    float* BON = (float*)(a.ws + WS_SMALL); float* BETA = BON + (size_t)NTOK * 32; float* GG = BETA + (size_t)NTOK * 16;
    const float* MU = a.in[I_MU] + i * CPA;
    const bf16* W2T = (const bf16*)(a.ws + WS_LORA) + (size_t)i * 2 * 1024 * 64;
    const bf16* A2T = (const bf16*)(a.ws + WS_LORA) + (size_t)4 * 1024 * 64 + (size_t)i * 2 * 1024 * 64;
    const bf16* G2T = (const bf16*)(a.ws + WS_LORA) + (size_t)8 * 1024 * 64 + (size_t)i * 1024 * 160;
    LAS bf16* la = (LAS bf16*)lds;
    LAS float* lpar = (LAS float*)(lds + 40960);
    LAS float* lcw = (LAS float*)(lds + 40960 + 40960);
    for (int idx = tid; idx < 10 * 1024; idx += NTHR) { const int p = idx >> 10, ch = idx & 1023;
        const float v = p < 3 ? MU[p * 1024 + ch] : (p == 3 ? a.in[I_KK][i * 1024 + ch] : (p == 4 ? a.in[I_KA][i * 1024 + ch] : (p == 5 ? a.in[I_RK][i * 1024 + ch] : (p < 8 ? a.in[I_W0][(i * 2 + p - 6) * 1024 + ch] : a.in[I_A0][(i * 2 + p - 8) * 1024 + ch]))));
        lpar[idx] = v; }
    for (int idx = tid; idx < 3 * 3072; idx += NTHR) lcw[idx] = a.in[I_CONVW][(size_t)i * 3 * 3072 + idx];
    __syncthreads();
    for (int tile = blockIdx.x; tile < NTOK / 48; tile += gridDim.x) {
        const int m0 = tile * 48;
#ifdef PREP_DUP_A
        for (int rep = 0; rep < 2; ++rep)
#endif
        for (int it = 0; it < 10; ++it) {
            float xv[4], xsv[4]; int jjv[4], ttv[4];
#pragma unroll
            for (int u = 0; u < 4; ++u) { const int idx = tid + NTHR * (4 * it + u); const bool ok = idx < 48 * 416; const int tt = ok ? idx / 416 : 0, jj = ok ? idx - tt * 416 : 0; jjv[u] = ok ? jj : -1; ttv[u] = tt;
                const int m = m0 + tt; bool samp; int T, t; tok_info(m, samp, T, t); int dt; bool valid; shift_nb(samp, T, t, jj & 3, dt, valid);
                xv[u] = bf2f(P[(size_t)m * PW + PC_LORA + jj]); const float ls = bf2f(P[(size_t)(m + (valid ? dt : 0)) * PW + PC_LORA + jj]); xsv[u] = valid ? ls : 0.f; }
#pragma unroll
            for (int u = 0; u < 4; ++u) { const int jj = jjv[u]; if (jj >= 0) { float v = xv[u] + (xsv[u] - xv[u]) * MU[3072 + jj];
                if (jj < 128) { const float e = __builtin_amdgcn_exp2f(2.8853900818f * v); v = 1.0f - 2.0f * __builtin_amdgcn_rcpf(e + 1.0f); } else if (jj >= 256) v = sigmoidf_(v);
                la[ttv[u] * LA_LD + jj] = (bf16)f2bf(v); } }
        }
        __syncthreads();
#ifdef PREP_DUP_RW
#pragma unroll 1
        for (int rep = 0; rep < 2; ++rep)
#endif
#pragma unroll 1
        for (int u = 0; u < 6; ++u) {
            const int hd = wave * 2 + u / 3, mt = u % 3; const int m = m0 + 16 * mt + c; bool samp; int T, t; tok_info(m, samp, T, t);
            int dtn[4]; bool vn[4];
#pragma unroll
            for (int n = 0; n < 4; ++n) { shift_nb(samp, T, t, n, dtn[n], vn[n]); dtn[n] = vn[n] ? dtn[n] : 0; }
            float r_[4][4], k_[4][4], v_[4][4]; float ss = 0.f;
#pragma unroll
            for (int nt = 0; nt < 4; ++nt) { const int ch = hd * 64 + 16 * nt + 4 * q; const bf16* pr = P + (size_t)m * PW + ch;
                const v2u wr = *(const v2u*)pr, wk = *(const v2u*)(pr + 1024), wv = *(const v2u*)(pr + 2048);
                const f32x4 mur = *(const LAS f32x4*)(lpar + ch), muk = *(const LAS f32x4*)(lpar + 1024 + ch), muv = *(const LAS f32x4*)(lpar + 2048 + ch), kkw = *(const LAS f32x4*)(lpar + 3072 + ch);
                const float xr[4] = {bflo(wr.x), bfhi(wr.x), bflo(wr.y), bfhi(wr.y)}, xk[4] = {bflo(wk.x), bfhi(wk.x), bflo(wk.y), bfhi(wk.y)}, xv[4] = {bflo(wv.x), bfhi(wv.x), bflo(wv.y), bfhi(wv.y)};
#pragma unroll
                for (int n = 0; n < 4; ++n) { const bf16* pn = pr + (long)dtn[n] * PW + n;
                    const float lr = bf2f(pn[0]), lk = bf2f(pn[1024]), lv = bf2f(pn[2048]); const float nr = vn[n] ? lr : 0.f, nk = vn[n] ? lk : 0.f, nv = vn[n] ? lv : 0.f;
                    r_[nt][n] = xr[n] + (nr - xr[n]) * mur[n]; k_[nt][n] = xk[n] + (nk - xk[n]) * muk[n]; v_[nt][n] = xv[n] + (nv - xv[n]) * muv[n];
                    const float kkr = k_[nt][n] * kkw[n]; ss += kkr * kkr; } }
            ss += __shfl_xor(ss, 16); ss += __shfl_xor(ss, 32);
            const float kn = __builtin_amdgcn_rsqf(ss + 1e-12f);
            float bon0 = 0.f, bon1 = 0.f;
            const LAS bf16* lrow = la + (16 * mt + c) * LA_LD + 8 * q;
#pragma unroll
            for (int nt = 0; nt < 4; ++nt) {
                f32x4 wl0 = F4Z, wl1 = F4Z, al0 = F4Z, al1 = F4Z, gl = F4Z;
#pragma unroll
                for (int ks = 0; ks < 2; ++ks) {
                    const size_t wo = ((size_t)hd * 64 + 16 * nt + c) * 64 + 32 * ks + 8 * q;
                    Frag b, w; v4u x;
                    x = *(const LAS v4u*)(lrow + 32 * ks); b.u[0] = x.x; b.u[1] = x.y; b.u[2] = x.z; b.u[3] = x.w; x = *(const v4u*)(W2T + wo); w.u[0] = x.x; w.u[1] = x.y; w.u[2] = x.z; w.u[3] = x.w; wl0 = mma(w, b, wl0);
                    x = *(const LAS v4u*)(lrow + 64 + 32 * ks); b.u[0] = x.x; b.u[1] = x.y; b.u[2] = x.z; b.u[3] = x.w; x = *(const v4u*)(W2T + 65536 + wo); w.u[0] = x.x; w.u[1] = x.y; w.u[2] = x.z; w.u[3] = x.w; wl1 = mma(w, b, wl1);
                    x = *(const LAS v4u*)(lrow + 128 + 32 * ks); b.u[0] = x.x; b.u[1] = x.y; b.u[2] = x.z; b.u[3] = x.w; x = *(const v4u*)(A2T + wo); w.u[0] = x.x; w.u[1] = x.y; w.u[2] = x.z; w.u[3] = x.w; al0 = mma(w, b, al0);
                    x = *(const LAS v4u*)(lrow + 192 + 32 * ks); b.u[0] = x.x; b.u[1] = x.y; b.u[2] = x.z; b.u[3] = x.w; x = *(const v4u*)(A2T + 65536 + wo); w.u[0] = x.x; w.u[1] = x.y; w.u[2] = x.z; w.u[3] = x.w; al1 = mma(w, b, al1);
                }
#pragma unroll
                for (int ks = 0; ks < 5; ++ks) { Frag b, w; v4u x = *(const LAS v4u*)(lrow + 256 + 32 * ks); b.u[0] = x.x; b.u[1] = x.y; b.u[2] = x.z; b.u[3] = x.w;
                    x = *(const v4u*)(G2T + ((size_t)hd * 64 + 16 * nt + c) * 160 + 32 * ks + 8 * q); w.u[0] = x.x; w.u[1] = x.y; w.u[2] = x.z; w.u[3] = x.w; gl = mma(w, b, gl); }
                const int ch = hd * 64 + 16 * nt + 4 * q; const size_t o = (size_t)m * 1024 + ch;
                bf16* rw = RW + ((((size_t)(m >> 4) * 16 + hd) * 9) * 4 + nt) * 256 + c * 16 + 4 * q;
                const f32x4 kkw = *(const LAS f32x4*)(lpar + 3072 + ch), kaw = *(const LAS f32x4*)(lpar + 4096 + ch), rkw = *(const LAS f32x4*)(lpar + 5120 + ch);
                const f32x4 w00 = *(const LAS f32x4*)(lpar + 6144 + ch), w01 = *(const LAS f32x4*)(lpar + 7168 + ch), a00 = *(const LAS f32x4*)(lpar + 8192 + ch), a01 = *(const LAS f32x4*)(lpar + 9216 + ch);
                float kk[4], lw0[4], lw1[4], kd0[4], kd1[4], b0[4], b1[4];
#pragma unroll
                for (int n = 0; n < 4; ++n) { const float kx = k_[nt][n];
                    kk[n] = kx * kkw[n] * kn;
                    const float ic0 = sigmoidf_(a00[n] + al0[n]), ic1 = sigmoidf_(a01[n] + al1[n]);
                    lw0[n] = -0.6065306597f * 1.4426950409f * sigmoidf_(w00[n] + wl0[n]); lw1[n] = -0.6065306597f * 1.4426950409f * sigmoidf_(w01[n] + wl1[n]);
                    kd0[n] = kx * (1.0f + (ic0 - 1.0f) * kaw[n]); kd1[n] = kx * (1.0f + (ic1 - 1.0f) * kaw[n]); b0[n] = kk[n] * ic0; b1[n] = kk[n] * ic1;
                    bon0 += r_[nt][n] * kd0[n] * rkw[n]; bon1 += r_[nt][n] * kd1[n] * rkw[n]; }
                *(v2u*)(rw) = (v2u){cvtpk(r_[nt][0], r_[nt][1]), cvtpk(r_[nt][2], r_[nt][3])}; *(v2u*)(rw + 2 * 1024) = (v2u){cvtpk(v_[nt][0], v_[nt][1]), cvtpk(v_[nt][2], v_[nt][3])};
                *(v2u*)(rw + 1 * 1024) = (v2u){cvtpk(-kk[0], -kk[1]), cvtpk(-kk[2], -kk[3])};
                *(v2u*)(rw + 3 * 1024) = (v2u){cvtpk(kd0[0], kd0[1]), cvtpk(kd0[2], kd0[3])}; *(v2u*)(rw + 4 * 1024) = (v2u){cvtpk(kd1[0], kd1[1]), cvtpk(kd1[2], kd1[3])};
                *(v2u*)(rw + 5 * 1024) = (v2u){cvtpk(b0[0], b0[1]), cvtpk(b0[2], b0[3])}; *(v2u*)(rw + 6 * 1024) = (v2u){cvtpk(b1[0], b1[1]), cvtpk(b1[2], b1[3])};
                *(v2u*)(rw + 7 * 1024) = (v2u){cvtpk(lw0[0], lw0[1]), cvtpk(lw0[2], lw0[3])}; *(v2u*)(rw + 8 * 1024) = (v2u){cvtpk(lw1[0], lw1[1]), cvtpk(lw1[2], lw1[3])};
                *(f32x4*)(GT + (((size_t)(m >> 4) * 16 + hd) * 4 + nt) * 256 + c * 16 + 4 * q) = gl;
                __builtin_amdgcn_sched_barrier(0);
            }
            bon0 += __shfl_xor(bon0, 16); bon0 += __shfl_xor(bon0, 32); bon1 += __shfl_xor(bon1, 16); bon1 += __shfl_xor(bon1, 32);
            if (q == 0) { BON[((size_t)m * 2 + 0) * 16 + hd] = bon0; BON[((size_t)m * 2 + 1) * 16 + hd] = bon1; }
        }
#ifdef PREP_DUP_GD
#pragma unroll 1
        for (int rep = 0; rep < 2; ++rep)
#endif
#pragma unroll 1
        for (int r3 = 0; r3 < 3; ++r3) {
            const int unit = wave + 8 * r3; const int hd = unit / 3, mt = unit - hd * 3; const int m = m0 + 16 * mt + c; bool samp; int T, t; tok_info(m, samp, T, t);
            const bool hp = t > 0, hn = t + 1 < T;
            float sqk[2] = {0.f, 0.f};
#pragma unroll
            for (int pass = 0; pass < 2; ++pass) {
                float scl[2] = {1.f, 1.f};
                if (pass == 1) { sqk[0] += __shfl_xor(sqk[0], 16); sqk[0] += __shfl_xor(sqk[0], 32); sqk[1] += __shfl_xor(sqk[1], 16); sqk[1] += __shfl_xor(sqk[1], 32);
                    scl[0] = __builtin_amdgcn_rsqf(sqk[0] + 1e-6f); scl[1] = __builtin_amdgcn_rsqf(sqk[1] + 1e-6f); }
#pragma unroll
                for (int part = 0; part < 3; ++part) {
                    if (pass == 0 && part == 2) continue;
                    bf16* dst = GD + ((((size_t)(m >> 4) * 8 + hd) * 3 + part) * 8) * 256 + c * 16 + 4 * q;
                    const float sc = part < 2 ? scl[part] : 1.f; float acc = 0.f;
#pragma unroll 4
                    for (int g = 0; g < 8; ++g) { const int ch = part * 1024 + hd * 128 + 16 * g + 4 * q; const bf16* pp = P + (size_t)m * PW + PC_GDN + ch;
                        const v2u x1 = *(const v2u*)pp; v2u x0 = *(const v2u*)(pp - (hp ? PW : 0)), x2 = *(const v2u*)(pp + (hn ? PW : 0)); x0.x = hp ? x0.x : 0u; x0.y = hp ? x0.y : 0u; x2.x = hn ? x2.x : 0u; x2.y = hn ? x2.y : 0u;
                        const f32x4 c0 = *(const LAS f32x4*)(lcw + ch), c1 = *(const LAS f32x4*)(lcw + 3072 + ch), c2 = *(const LAS f32x4*)(lcw + 2 * 3072 + ch);
                        float val[4];
                        val[0] = siluf_(bflo(x0.x) * c0[0] + bflo(x1.x) * c1[0] + bflo(x2.x) * c2[0]); val[1] = siluf_(bfhi(x0.x) * c0[1] + bfhi(x1.x) * c1[1] + bfhi(x2.x) * c2[1]);
                        val[2] = siluf_(bflo(x0.y) * c0[2] + bflo(x1.y) * c1[2] + bflo(x2.y) * c2[2]); val[3] = siluf_(bfhi(x0.y) * c0[3] + bfhi(x1.y) * c1[3] + bfhi(x2.y) * c2[3]);
                        if (pass == 0) acc += (val[0] * val[0] + val[1] * val[1]) + (val[2] * val[2] + val[3] * val[3]);
                        else *(v2u*)(dst + 256 * g) = (v2u){cvtpk(val[0] * sc, val[1] * sc), cvtpk(val[2] * sc, val[3] * sc)}; }
                    if (pass == 0) sqk[part] = acc;
                }
            }
        }
        for (int idx = tid; idx < 48 * 16; idx += NTHR) { const int tt = idx >> 4, dh = idx & 15; const int m = m0 + tt;
            BETA[(size_t)m * 16 + dh] = sigmoidf_(bf2f(P[(size_t)m * PW + PC_BETA + dh]));
            GG[(size_t)m * 16 + dh] = -1.4426950409f * __expf(a.in[I_ALOG][i * 16 + dh]) * softplusf_(bf2f(P[(size_t)m * PW + PC_ALPHA + dh]) + a.in[I_DTB][i * 16 + dh]); }
        __syncthreads();
    }
}
__device__ __forceinline__ void ph_post(const Args& a, int i) {
    const int tid = opaque_tid(), lane = tid & 63, wave = __builtin_amdgcn_readfirstlane(tid >> 6);
    const int gw = blockIdx.x * NWAVES + wave, NGW = gridDim.x * NWAVES; const int c = lane & 15, q = lane >> 4;
    constexpr size_t S1 = (size_t)NTOK * 1024;
    const float* GT = (const float*)((const bf16*)(a.ws + WS_SC) + 12 * S1); const bf16* YS = (const bf16*)(a.ws + WS_Y); const bf16* OG = YS + 2 * S1;
    const bf16* P = (const bf16*)(a.ws + WS_P); bf16* O = (bf16*)(a.ws + WS_O);
    const float* gnw = a.in[I_GNW] + i * 128;
    for (int u = gw; u < (NTOK / 16) * 24; u += NGW) {
        const int tb = u / 24, hh = u - tb * 24; const int m = tb * 16 + c;
        if (hh < 16) { const size_t blk = (((size_t)tb * 16 + hh) * 4) * 256 + c * 16 + 4 * q;
#pragma unroll
            for (int g = 0; g < 4; ++g) { const v2u y0 = *(const v2u*)(YS + blk + 256 * g), y1 = *(const v2u*)(YS + S1 + blk + 256 * g); const f32x4 gt = *(const f32x4*)(GT + blk + 256 * g);
                v2u w; w.x = pk2((bflo(y0.x) + bflo(y1.x)) * gt.x, (bfhi(y0.x) + bfhi(y1.x)) * gt.y); w.y = pk2((bflo(y0.y) + bflo(y1.y)) * gt.z, (bfhi(y0.y) + bfhi(y1.y)) * gt.w);
                *(v2u*)(O + (size_t)m * D + hh * 64 + 16 * g + 4 * q) = w; } }
        else { const int h = hh - 16; const size_t blk = (((size_t)tb * 8 + h) * 8) * 256 + c * 16 + 4 * q;
            float ov[8][4]; float ss = 0.f;
#pragma unroll
            for (int g = 0; g < 8; ++g) { const v2u o0 = *(const v2u*)(OG + blk + 256 * g), o1 = *(const v2u*)(OG + S1 + blk + 256 * g);
                ov[g][0] = bflo(o0.x) + bflo(o1.x); ov[g][1] = bfhi(o0.x) + bfhi(o1.x); ov[g][2] = bflo(o0.y) + bflo(o1.y); ov[g][3] = bfhi(o0.y) + bfhi(o1.y);
                ss += (ov[g][0] * ov[g][0] + ov[g][1] * ov[g][1]) + (ov[g][2] * ov[g][2] + ov[g][3] * ov[g][3]); }
            ss += __shfl_xor(ss, 16); ss += __shfl_xor(ss, 32);
            const float rs = __builtin_amdgcn_rsqf(ss * (1.0f / 128.0f) + RMS_EPS);
#pragma unroll
            for (int g = 0; g < 8; ++g) { const int ch = 16 * g + 4 * q; const v2u zz = *(const v2u*)(P + (size_t)m * PW + PC_Z + h * 128 + ch); const f32x4 gwv = *(const f32x4*)(gnw + ch);
                v2u w; w.x = pk2(ov[g][0] * rs * gwv.x * siluf_(bflo(zz.x)), ov[g][1] * rs * gwv.y * siluf_(bfhi(zz.x))); w.y = pk2(ov[g][2] * rs * gwv.z * siluf_(bflo(zz.y)), ov[g][3] * rs * gwv.w * siluf_(bfhi(zz.y)));
                *(v2u*)(O + (size_t)m * D + 1024 + h * 128 + ch) = w; } }
    }
}

constexpr int PH_PER_LAYER = 9, N_PHASES = 2 + 4 * PH_PER_LAYER;
__host__ __device__ inline bool phase_exists(int ph) { if (ph == 0 || ph == N_PHASES - 1) return true; const int l = (ph - 1) / PH_PER_LAYER, k = (ph - 1) % PH_PER_LAYER; return (l & 1) ? !(k == 2 || k == 3 || k == 4) : true; }

#define RUN(ph) (a.ph_lo <= (ph) && (ph) < a.ph_hi)
#define SEAM(ph) do { if ((ph) + 1 < a.ph_hi) xcd_barrier(bar); } while (0)
#define SEAMX(ph) xcd_barrier(bar)
template <int L> __device__ __forceinline__ void run_layer(const Args& a, LAS unsigned char* lds, const XcdBarrier& bar) {
    constexpr int l = L, pb = 1 + PH_PER_LAYER * L, i = L >> 1;
    const int G = gridDim.x, bx = blockIdx.x;
    bf16* H = (bf16*)(a.ws + WS_H); bf16* O = (bf16*)(a.ws + WS_O); bf16* P = (bf16*)(a.ws + WS_P);
    const float* modl = (const float*)(a.ws + WS_MOD) + (size_t)l * 9 * 12288;
    if (RUN(pb + 0)) { ph_norm(a, l, 0); SEAM(pb + 0); }
#ifdef DUP_NORM
    if (RUN(pb + 0)) { ph_norm(a, l, 0); SEAMX(pb + 0); }
#endif
    if constexpr ((L & 1) == 0) {
        if (RUN(pb + 1)) { pg8::Gemm g{H, (const bf16*)(a.ws + WS_WIN) + (size_t)i * PW * 2048, NTOK, PW, 2048, 2048, 2048, 0, 0}; pg8::StaticOrder S; S.init(NTOK, PW, G, bx);
            pg8::EpiBf16 E{P, PW}; pg8::gemm_phase<pg8::EpiBf16, pg8::StaticOrder, true, true>(lds, g, S, E); SEAM(pb + 1); }
#ifdef DUP_GIN
        if (RUN(pb + 1)) { pg8::Gemm g{H, (const bf16*)(a.ws + WS_WIN) + (size_t)i * PW * 2048, NTOK, PW, 2048, 2048, 2048, 0, 0}; pg8::StaticOrder S; S.init(NTOK, PW, G, bx);
            pg8::EpiBf16 E{P, PW}; pg8::gemm_phase<pg8::EpiBf16, pg8::StaticOrder, true, true>(lds, g, S, E); SEAMX(pb + 1); }
#endif
        if (RUN(pb + 2)) { ph_prep(a, lds, i); SEAM(pb + 2); }
#ifdef DUP_PREP
        if (RUN(pb + 2)) { ph_prep(a, lds, i); SEAMX(pb + 2); }
#endif
        if (RUN(pb + 3)) { ph_scan(a, lds, i); SEAM(pb + 3); }
#ifdef DUP_SCAN
        if (RUN(pb + 3)) { ph_scan(a, lds, i); SEAMX(pb + 3); }
#endif
        if (RUN(pb + 4)) { ph_post(a, i); SEAM(pb + 4); }
#ifdef DUP_POST
        if (RUN(pb + 4)) { ph_post(a, i); SEAMX(pb + 4); }
#endif
        if (RUN(pb + 5)) { pg8::Gemm g{O, (const bf16*)(a.ws + WS_WOUT) + (size_t)i * 2048 * 2048, NTOK, 2048, 2048, 2048, 2048, 0, 0}; pg8::StaticOrder S; S.init(NTOK, 2048, G, bx);
            pg8::EpiResid E{l == 0 ? a.in[I_XP] : nullptr, a.in[I_XS], a.out, modl + 2 * 2048, nullptr};
            pg8::gemm_phase<pg8::EpiResid, pg8::StaticOrder, true, true>(lds, g, S, E); SEAM(pb + 5); }
    } else {
        if (RUN(pb + 1)) { ph_pool(a); SEAM(pb + 1); }
#ifdef DUP_POOL
        if (RUN(pb + 1)) { ph_pool(a); SEAMX(pb + 1); }
#endif
        if (RUN(pb + 5)) { pg8::Gemm g{O, (const bf16*)(a.ws + WS_WPOOL) + (size_t)i * 2048 * 512, NTOK, 2048, 512, 2048, 512, 1, 512}; pg8::StaticOrder S; S.init(NTOK, 2048, G, bx);
            pg8::EpiResid E{nullptr, nullptr, a.out, modl + 2 * 2048, a.in[I_POOLS] + i * 2048};
            pg8::gemm_phase<pg8::EpiResid, pg8::StaticOrder, true, true>(lds, g, S, E); SEAM(pb + 5); }
    }
    if (RUN(pb + 6)) { ph_norm(a, l, 1); SEAM(pb + 6); }
    if (RUN(pb + 7)) { pg8::Gemm g{H, (const bf16*)(a.ws + WS_WGU) + (size_t)l * 11264 * 2048, NTOK, 11264, 2048, 2048, 2048, 0, 0}; pg8::StaticOrder S; S.init(NTOK, 11264, G, bx);
        pg8::EpiSwiGLU E{P, DFF}; pg8::gemm_phase<pg8::EpiSwiGLU, pg8::StaticOrder, true, true>(lds, g, S, E); SEAM(pb + 7); }
#ifdef DUP_GGU
    if (RUN(pb + 7)) { pg8::Gemm g{H, (const bf16*)(a.ws + WS_WGU) + (size_t)l * 11264 * 2048, NTOK, 11264, 2048, 2048, 2048, 0, 0}; pg8::StaticOrder S; S.init(NTOK, 11264, G, bx);
        pg8::EpiSwiGLU E{P, DFF}; pg8::gemm_phase<pg8::EpiSwiGLU, pg8::StaticOrder, true, true>(lds, g, S, E); SEAMX(pb + 7); }
#endif
    if (RUN(pb + 8)) { pg8::Gemm g{P, (const bf16*)(a.ws + WS_WDN) + (size_t)l * 2048 * DFF, NTOK, 2048, DFF, DFF, DFF, 0, 0}; pg8::StaticOrder S; S.init(NTOK, 2048, G, bx);
        pg8::EpiResid E{nullptr, nullptr, a.out, modl + 5 * 2048, nullptr};
        pg8::gemm_phase<pg8::EpiResid, pg8::StaticOrder, true, true>(lds, g, S, E); SEAM(pb + 8); }
}

__global__ void __launch_bounds__(NTHR, 2) fwd(Args a) {
    extern __shared__ __attribute__((aligned(16))) unsigned char lds_raw[];
    LAS unsigned char* lds = (LAS unsigned char*)lds_raw;
    const int tid = threadIdx.x;
    volatile LAS unsigned* MISC = (volatile LAS unsigned*)(lds + LDS_MISC);
    for (int u = tid; u < (LDS_BYTES - LDS_STAGE) / 4; u += NTHR) ((LAS unsigned*)(lds + LDS_STAGE))[u] = 0u;
    __syncthreads();
    XcdBarrier bar; bar.bar = (unsigned*)(a.ws + WS_CTL) + CW_BAR; bar.x = 0; bar.st = nullptr;
    const bool multi = a.ph_hi - a.ph_lo > 1;
    if (multi) bar = xcd_barrier_post((unsigned*)(a.ws + WS_CTL) + CW_BAR, MISC + 8);
    if (RUN(0)) { ph_pre(a, lds); SEAM(0); }
#ifdef DUP_PRE
    if (RUN(0)) { ph_pre(a, lds); SEAMX(0); }
#endif
    run_layer<0>(a, lds, bar);
    run_layer<1>(a, lds, bar);
    run_layer<2>(a, lds, bar);
    run_layer<3>(a, lds, bar);
    if (RUN(N_PHASES - 1)) ph_final(a);
}
#undef RUN
#undef SEAM
#undef SEAMX

#ifndef MK_ONE_LAUNCH
#define MK_ONE_LAUNCH 1
#endif
extern "C" void kernel_launch(void* const* d_in, const int* in_sizes, int n_in, void* d_out, int out_size, void* d_ws, size_t ws_size, hipStream_t stream) {
    static int grid = 0;
    if (grid == 0) {
        if (n_in != N_IN || ws_size < WS_END) { fprintf(stderr, "kernel_launch: expected %d inputs and >= %zu bytes of workspace; got %d, %zu\n", (int)N_IN, (size_t)WS_END, n_in, ws_size); grid = -1; return; }
        int dev = 0, cus = 0, per_cu = 0;
        if (hipGetDevice(&dev) != hipSuccess || hipDeviceGetAttribute(&cus, hipDeviceAttributeMultiprocessorCount, dev) != hipSuccess) { grid = -1; return; }
        if (hipFuncSetAttribute((const void*)fwd, hipFuncAttributeMaxDynamicSharedMemorySize, LDS_BYTES) != hipSuccess) { fprintf(stderr, "kernel_launch: hipFuncSetAttribute failed\n"); grid = -1; return; }
        if (hipOccupancyMaxActiveBlocksPerMultiprocessor(&per_cu, (const void*)fwd, NTHR, LDS_BYTES) != hipSuccess || per_cu < 1) fprintf(stderr, "kernel_launch: occupancy query reports %d\n", per_cu);
        (void)hipGetLastError();
        grid = cus;
    }
    if (grid < 0) return;
    if (hipMemsetAsync((char*)d_ws + WS_CTL, 0, CTL_ZERO_BYTES, stream) != hipSuccess) return;
    Args a{};
    for (int i = 0; i < N_IN; ++i) a.in[i] = (const float*)d_in[i];
    a.out = (float*)d_out; a.ws = (unsigned char*)d_ws;
#if MK_ONE_LAUNCH
    a.ph_lo = 0; a.ph_hi = N_PHASES;
    hipLaunchKernelGGL(fwd, dim3(grid), dim3(NTHR), LDS_BYTES, stream, a);
#else
    for (int ph = 0; ph < N_PHASES; ++ph) { if (!phase_exists(ph)) continue; a.ph_lo = ph; a.ph_hi = ph + 1; hipLaunchKernelGGL(fwd, dim3(grid), dim3(NTHR), LDS_BYTES, stream, a); }
#endif
}
```

```cpp
#include <hip/hip_runtime.h>
#include <cstdio>
#include <cstdint>

namespace pg8 {
#define PG8_LAS __attribute__((address_space(3)))
typedef unsigned short bf16_t;
typedef short bf16x8 __attribute__((ext_vector_type(8)));
typedef float f32x4 __attribute__((ext_vector_type(4)));
typedef unsigned u32x4 __attribute__((ext_vector_type(4)));
constexpr int BM = 256, BK = 64, HALF = 128, HTB = HALF * BK * 2  , STAGE_BYTES = 8 * HTB, NXCD = 8, WGM = 8;

__host__ __device__ __forceinline__ int lds_byte(int r, int c) { const int st = (r >> 4) * 2 + (c >> 5), rr = r & 15, cc = c & 31, ob = rr * 64 + cc * 2; return st * 1024 + (ob ^ (((ob >> 9) & 1) << 5)); }
__host__ __device__ __forceinline__ void stage_rc(int b, int& R, int& C) { const int st = b / 1024, sb = b % 1024, swz = sb ^ (((sb >> 9) & 1) << 5); R = (st >> 1) * 16 + swz / 64; C = (st & 1) * 32 + (swz % 64) / 2; }
__host__ __device__ __forceinline__ int perm32(int rho) { const int n = rho >> 4, i = rho & 15; return 8 * (i >> 2) + 4 * n + (i & 3); }

struct Unit { int pm, pn; };
struct Gemm { const bf16_t* A; const bf16_t* Bt; int M, N, K, lda, ldb, gsh, gk; };

struct StaticOrder {
    int nM, nN, nwg, G, c;
    __host__ __device__ void init(int M, int N, int G_, int c_) { nM = M / BM; nN = N / BM; nwg = nM * nN; G = G_; c = c_; }
    __host__ __device__ bool next(int i, Unit& u) const {
        const long L = (long)i * G + c; if (L >= nwg) return false;
        int wgid = (int)L; { const int q = nwg / NXCD, r = nwg % NXCD, xcd = wgid % NXCD, off = wgid / NXCD; wgid = (xcd < r ? xcd * (q + 1) : r * (q + 1) + (xcd - r) * q) + off; }
        const int nig = WGM * nN, gid = wgid / nig, fm = gid * WGM, gsz = (nM - fm) < WGM ? (nM - fm) : WGM;
        u.pm = fm + ((wgid % nig) % gsz); u.pn = (wgid % nig) / gsz; return true;
    }
    __device__ __forceinline__ void a_ready(const Unit&) const {}
    __device__ __forceinline__ void done(const Unit&) const {}
};

__device__ __forceinline__ unsigned cvt_pk_bf16(float lo, float hi) { unsigned r; asm volatile("v_cvt_pk_bf16_f32 %0, %1, %2" : "=v"(r) : "v"(lo), "v"(hi)); return r; }

__device__ __forceinline__ int cond_of_panel(int pm) { return pm < 16 ? 0 : 1 + ((pm - 16) >> 2); }

struct EpiBf16 {
    static constexpr bool PERM = true, AFTER_DRAIN = false;
    bf16_t* O; int ldc;
    __device__ __forceinline__ void operator()(const f32x4 (&acc)[2][2][4][2], const Unit& u, int wr, int wc, int fr, int fq) const {
        const int row0 = u.pm * BM + wr * 64 + fr; const int col0 = u.pn * BM + wc * 32 + 8 * fq;
#pragma unroll
        for (int ai = 0; ai < 2; ++ai)
#pragma unroll
            for (int m = 0; m < 4; ++m) { bf16_t* rowp = O + (size_t)(row0 + ai * HALF + m * 16) * ldc + col0;
#pragma unroll
                for (int bj = 0; bj < 2; ++bj) { const f32x4 v0 = acc[ai][bj][m][0], v1 = acc[ai][bj][m][1];
                    u32x4 w; w.x = cvt_pk_bf16(v0[0], v0[1]); w.y = cvt_pk_bf16(v0[2], v0[3]); w.z = cvt_pk_bf16(v1[0], v1[1]); w.w = cvt_pk_bf16(v1[2], v1[3]);
                    *(u32x4*)(rowp + bj * HALF) = w; } }
    }
};
struct EpiSwiGLU {
    static constexpr bool PERM = true, AFTER_DRAIN = false;
    bf16_t* O; int ldc;
    __device__ __forceinline__ void operator()(const f32x4 (&acc)[2][2][4][2], const Unit& u, int wr, int wc, int fr, int fq) const {
        const int row0 = u.pm * BM + wr * 64 + fr; const int col0 = u.pn * HALF + wc * 32 + 8 * fq;
#pragma unroll
        for (int ai = 0; ai < 2; ++ai)
#pragma unroll
            for (int m = 0; m < 4; ++m) { bf16_t* rowp = O + (size_t)(row0 + ai * HALF + m * 16) * ldc + col0;
                float o[8];
#pragma unroll
                for (int n = 0; n < 2; ++n)
#pragma unroll
                    for (int e = 0; e < 4; ++e) { const float gte = acc[ai][0][m][n][e], up = acc[ai][1][m][n][e]; o[n * 4 + e] = gte * __builtin_amdgcn_rcpf(1.0f + __expf(-gte)) * up; }
                u32x4 w; w.x = cvt_pk_bf16(o[0], o[1]); w.y = cvt_pk_bf16(o[2], o[3]); w.z = cvt_pk_bf16(o[4], o[5]); w.w = cvt_pk_bf16(o[6], o[7]);
                *(u32x4*)rowp = w; }
    }
};
struct EpiResid {
    static constexpr bool PERM = false, AFTER_DRAIN = false;
    const float* xin_p; const float* xin_s; float* xout; const float* gate  ; const float* cscale;
    __device__ __forceinline__ void operator()(const f32x4 (&acc)[2][2][4][2], const Unit& u, int wr, int wc, int fr, int fq) const {
        const int row0 = u.pm * BM + wr * 64 + fr, col0 = u.pn * BM + wc * 32 + 4 * fq;
        const float* gp = gate + (size_t)cond_of_panel(u.pm) * 12288 + col0;
        f32x4 gv[2][2];
#pragma unroll
        for (int bj = 0; bj < 2; ++bj)
#pragma unroll
            for (int n = 0; n < 2; ++n) { gv[bj][n] = *(const f32x4*)(gp + bj * HALF + n * 16); if (cscale) gv[bj][n] = gv[bj][n] * *(const f32x4*)(cscale + col0 + bj * HALF + n * 16); }
#pragma unroll
        for (int ai = 0; ai < 2; ++ai)
#pragma unroll
            for (int m = 0; m < 4; ++m) { const int row = row0 + ai * HALF + m * 16;
                const float* xi = xin_p ? (row < 4096 ? xin_p + (size_t)row * 2048 : xin_s + (size_t)(row - 4096) * 2048) : xout + (size_t)row * 2048;
                float* xo = xout + (size_t)row * 2048;
#pragma unroll
                for (int bj = 0; bj < 2; ++bj)
#pragma unroll
                    for (int n = 0; n < 2; ++n) { const f32x4 xv = *(const f32x4*)(xi + col0 + bj * HALF + n * 16); *(f32x4*)(xo + col0 + bj * HALF + n * 16) = xv + gv[bj][n] * acc[ai][bj][m][n]; } }
    }
};

template <class Epi, class Sched, bool ALIGN_EPI = false, bool SP2 = false>
__device__ __forceinline__ void gemm_phase(PG8_LAS unsigned char* lds, const Gemm g, const Sched& S, const Epi& E) {
    const int tid = threadIdx.x, wid = __builtin_amdgcn_readfirstlane(tid >> 6), lane = tid & 63, wr = wid >> 2, wc = wid & 3, fr = lane & 15, fq = lane >> 4;
    const int K = g.K, nt = K / BK;
    unsigned voffA[2], voffB[2];
#pragma unroll
    for (int i = 0; i < 2; ++i) { int R, C; stage_rc(tid * 16 + i * 8192, R, C); const int Rb = Epi::PERM ? ((R & ~31) + perm32(R & 31)) : R;
        voffA[i] = (unsigned)(R * g.lda + C) * 2u; voffB[i] = (unsigned)(Rb * g.ldb + C) * 2u; }
    const size_t kstep = (size_t)(BK * 2);
    const size_t hstepA = (size_t)HALF * g.lda * 2, hstepB = (size_t)HALF * g.ldb * 2;
    const size_t tstepA = 2 * hstepA, tstepB = 2 * hstepB;
    const unsigned ldsw = (unsigned)wid * 1024u;
    const int aoff = lds_byte(wr * 64 + fr, fq * 8), boff = lds_byte(wc * 32 + fr, fq * 8);
#define PG8_SA(b, h) (((b) * 2 + (h)) * HTB)
#define PG8_SB(b, h) ((4 + (b) * 2 + (h)) * HTB)
#define PG8_STAGE(bufoff, gbase, voff) do { _Pragma("unroll") for (int _i = 0; _i < 2; ++_i) \
        __builtin_amdgcn_global_load_lds((const unsigned*)((const char*)(gbase) + (voff)[_i]), (PG8_LAS unsigned*)(lds + (bufoff) + ldsw + _i * 8192), 16, 0, 0); } while (0)
#define PG8_LDA(dst, b, h) do { _Pragma("unroll") for (int m = 0; m < 4; ++m) _Pragma("unroll") for (int k = 0; k < 2; ++k) dst[m][k] = *(const PG8_LAS bf16x8*)(lds + PG8_SA(b, h) + aoff + m * 2048 + k * 1024); } while (0)
#define PG8_LDB(dst, b, h) do { _Pragma("unroll") for (int n = 0; n < 2; ++n) _Pragma("unroll") for (int k = 0; k < 2; ++k) dst[n][k] = *(const PG8_LAS bf16x8*)(lds + PG8_SB(b, h) + boff + n * 2048 + k * 1024); } while (0)
#define PG8_MMA(ai, bj, At, Bt) do { __builtin_amdgcn_s_setprio(1); _Pragma("unroll") for (int m = 0; m < 4; ++m) _Pragma("unroll") for (int n = 0; n < 2; ++n) _Pragma("unroll") for (int k = 0; k < 2; ++k) \
        acc[ai][bj][m][n] = __builtin_amdgcn_mfma_f32_16x16x32_bf16(Bt[n][k], At[m][k], acc[ai][bj][m][n], 0, 0, 0); __builtin_amdgcn_s_setprio(0); } while (0)
#define PG8_WAIT_V(n) asm volatile("s_waitcnt vmcnt(" #n ")" ::: "memory")
#define PG8_WAIT_L(n) asm volatile("s_waitcnt lgkmcnt(" #n ")" ::: "memory")
#define PG8_BAR __builtin_amdgcn_s_barrier()
#define PG8_SCHED __builtin_amdgcn_sched_barrier(0)
    Unit cur, nxt; int ui = 0;
    if (!S.next(0, cur)) return;
    f32x4 acc[2][2][4][2];
#pragma unroll
    for (int a = 0; a < 2; ++a)
#pragma unroll
        for (int b = 0; b < 2; ++b)
#pragma unroll
            for (int m = 0; m < 4; ++m)
#pragma unroll
                for (int n = 0; n < 2; ++n) acc[a][b][m][n] = (f32x4){0.f, 0.f, 0.f, 0.f};
    bf16x8 At[4][2], B0[2][2], B1[2][2];
    const char* cA = (const char*)g.A + (size_t)cur.pm * tstepA + (size_t)((cur.pn >> g.gsh) * g.gk) * 2; const char* cB = (const char*)g.Bt + (size_t)cur.pn * tstepB;
    S.a_ready(cur);
    if constexpr (SP2) {
        PG8_STAGE(PG8_SB(0, 0), cB, voffB); PG8_STAGE(PG8_SB(0, 1), cB + hstepB, voffB); PG8_STAGE(PG8_SA(0, 0), cA, voffA); PG8_STAGE(PG8_SA(0, 1), cA + hstepA, voffA);
        if (wr == 1) PG8_BAR;
        PG8_WAIT_V(2); PG8_BAR;
        PG8_STAGE(PG8_SB(1, 0), cB + kstep, voffB); PG8_STAGE(PG8_SA(1, 0), cA + kstep, voffA); PG8_STAGE(PG8_SB(1, 1), cB + hstepB + kstep, voffB);
        PG8_WAIT_V(6); PG8_BAR;
    } else {
        PG8_STAGE(PG8_SB(0, 0), cB, voffB); PG8_STAGE(PG8_SA(0, 0), cA, voffA); PG8_STAGE(PG8_SB(0, 1), cB + hstepB, voffB); PG8_STAGE(PG8_SA(0, 1), cA + hstepA, voffA);
        if (wr == 1) PG8_BAR;
        PG8_WAIT_V(4); PG8_BAR;
        PG8_STAGE(PG8_SB(1, 0), cB + kstep, voffB); PG8_STAGE(PG8_SA(1, 0), cA + kstep, voffA); PG8_STAGE(PG8_SB(1, 1), cB + hstepB + kstep, voffB);
        PG8_WAIT_V(6); PG8_BAR;
    }
    for (;;) {
        const bool has_next = S.next(ui + 1, nxt);
        const char* nA = has_next ? (const char*)g.A + (size_t)nxt.pm * tstepA + (size_t)((nxt.pn >> g.gsh) * g.gk) * 2 : cA; const char* nB = has_next ? (const char*)g.Bt + (size_t)nxt.pn * tstepB : cB;
        for (int t = 0; t < nt; t += 2) {
            const bool last = (t == nt - 2);
            const char* a1 = cA + (size_t)(t + 1) * kstep;
            const char* a2 = last ? nA : cA + (size_t)(t + 2) * kstep; const char* b2 = last ? nB : cB + (size_t)(t + 2) * kstep;
            const char* a3 = a2 + kstep; const char* b3 = b2 + kstep;
            if (last && has_next) S.a_ready(nxt);
            if constexpr (SP2) {
            PG8_LDB(B0, 0, 0); PG8_LDB(B1, 0, 1); PG8_SCHED; PG8_LDA(At, 0, 0); PG8_STAGE(PG8_SA(1, 1), a1 + hstepA, voffA);
            PG8_WAIT_V(8); PG8_WAIT_L(0); PG8_BAR; PG8_MMA(0, 0, At, B0); PG8_MMA(0, 1, At, B1); PG8_BAR; PG8_SCHED;
            PG8_LDA(At, 0, 1); PG8_STAGE(PG8_SB(0, 0), b2, voffB); PG8_STAGE(PG8_SB(0, 1), b2 + hstepB, voffB); PG8_STAGE(PG8_SA(0, 0), a2, voffA);
            PG8_WAIT_V(8); PG8_WAIT_L(0); PG8_BAR; PG8_MMA(1, 0, At, B0); PG8_MMA(1, 1, At, B1); PG8_BAR; PG8_SCHED;
            PG8_LDB(B0, 1, 0); PG8_LDB(B1, 1, 1); PG8_SCHED; PG8_LDA(At, 1, 0); PG8_STAGE(PG8_SA(0, 1), a2 + hstepA, voffA);
            PG8_WAIT_V(8); PG8_WAIT_L(0); PG8_BAR; PG8_MMA(0, 0, At, B0); PG8_MMA(0, 1, At, B1); PG8_BAR; PG8_SCHED;
            PG8_LDA(At, 1, 1); PG8_STAGE(PG8_SB(1, 0), b3, voffB); PG8_STAGE(PG8_SB(1, 1), b3 + hstepB, voffB); PG8_STAGE(PG8_SA(1, 0), a3, voffA);
            PG8_WAIT_V(8); PG8_WAIT_L(0); PG8_BAR; PG8_MMA(1, 0, At, B0); PG8_MMA(1, 1, At, B1); PG8_BAR; PG8_SCHED;
            } else {
            PG8_LDB(B0, 0, 0); PG8_SCHED; PG8_LDA(At, 0, 0); PG8_STAGE(PG8_SA(1, 1), a1 + hstepA, voffA);
            PG8_WAIT_L(8); PG8_BAR; PG8_WAIT_L(0); PG8_MMA(0, 0, At, B0); PG8_BAR; PG8_SCHED;
            PG8_LDB(B1, 0, 1); PG8_STAGE(PG8_SB(0, 0), b2, voffB);
            PG8_BAR; PG8_WAIT_L(0); PG8_MMA(0, 1, At, B1); PG8_BAR;
            PG8_LDA(At, 0, 1); PG8_STAGE(PG8_SA(0, 0), a2, voffA);
            PG8_BAR; PG8_WAIT_L(0); PG8_MMA(1, 0, At, B0); PG8_BAR; PG8_SCHED;
            PG8_STAGE(PG8_SB(0, 1), b2 + hstepB, voffB);
            PG8_WAIT_V(6); PG8_BAR; PG8_MMA(1, 1, At, B1); PG8_BAR;
            PG8_LDB(B0, 1, 0); PG8_SCHED; PG8_LDA(At, 1, 0); PG8_STAGE(PG8_SA(0, 1), a2 + hstepA, voffA);
            PG8_WAIT_L(8); PG8_BAR; PG8_WAIT_L(0); PG8_MMA(0, 0, At, B0); PG8_BAR; PG8_SCHED;
            PG8_LDB(B1, 1, 1); PG8_STAGE(PG8_SB(1, 0), b3, voffB);
            PG8_BAR; PG8_WAIT_L(0); PG8_MMA(0, 1, At, B1); PG8_BAR;
            PG8_LDA(At, 1, 1); PG8_STAGE(PG8_SA(1, 0), a3, voffA);
            PG8_BAR; PG8_WAIT_L(0); PG8_MMA(1, 0, At, B0); PG8_BAR; PG8_SCHED;
            PG8_STAGE(PG8_SB(1, 1), b3 + hstepB, voffB);
            PG8_WAIT_V(6); PG8_BAR; PG8_MMA(1, 1, At, B1); PG8_BAR;
            }
        }
        if constexpr (ALIGN_EPI) { if (wr == 0) PG8_BAR; }
        if constexpr (!Epi::AFTER_DRAIN) { E(acc, cur, wr, wc, fr, fq); S.done(cur); }
        if (!has_next) break;
#pragma unroll
        for (int a = 0; a < 2; ++a)
#pragma unroll
            for (int b = 0; b < 2; ++b)
#pragma unroll
                for (int m = 0; m < 4; ++m)
#pragma unroll
                    for (int n = 0; n < 2; ++n) acc[a][b][m][n] = (f32x4){0.f, 0.f, 0.f, 0.f};
        cur = nxt; cA = nA; cB = nB; ++ui;
        if constexpr (ALIGN_EPI) { if (wr == 1) PG8_BAR; }
    }
    PG8_WAIT_V(0);
    if constexpr (!ALIGN_EPI) { if (wr == 0) PG8_BAR; }
    PG8_BAR;
    if constexpr (Epi::AFTER_DRAIN) { E.fused(acc, cur, wr, wc, fr, fq, lds, wid, lane); S.done(cur); }
#undef PG8_SA
#undef PG8_SB
#undef PG8_STAGE
#undef PG8_LDA
#undef PG8_LDB
#undef PG8_MMA
#undef PG8_WAIT_V
#undef PG8_WAIT_L
#undef PG8_BAR
#undef PG8_SCHED
}
}

constexpr int D = 2048, NTOK = 12288, NPROMPT = 4096, DFF = 5632, PW = 7680  , CPA = 3488;
constexpr int NWAVES = 8, NTHR = 512;
constexpr int PC_GDN = 3072, PC_Z = 6144, PC_LORA = 7168, PC_BETA = 7584, PC_ALPHA = 7600;
constexpr float RMS_EPS = 1e-6f, GN_EPS = 64e-5f;

constexpr size_t MiB = 1u << 20;
constexpr size_t WS_CTL = 0, CTL_ZERO_BYTES = 1 * MiB;
constexpr size_t WS_MOD = 1 * MiB;
constexpr size_t WS_WIN = 3 * MiB;
constexpr size_t WS_WOUT = 63 * MiB;
constexpr size_t WS_WGU = 79 * MiB;
constexpr size_t WS_WDN = 255 * MiB;
constexpr size_t WS_WPOOL = 343 * MiB;
constexpr size_t WS_H = 347 * MiB;
constexpr size_t WS_O = 395 * MiB;
constexpr size_t WS_P = 443 * MiB;
constexpr size_t WS_SC = 623 * MiB;
constexpr size_t SC_ONE = 48 * MiB;
constexpr size_t WS_Y = 1247 * MiB;
constexpr size_t WS_SMALL = 1439 * MiB;
constexpr size_t WS_LORA = 1443 * MiB;
constexpr size_t WS_END = 1445 * MiB;
constexpr int CW_BAR = 4096;

constexpr int LDS_STAGE = 131072, LDS_MISC = LDS_STAGE + 320, LDS_BYTES = 147456;

#define GAS __attribute__((address_space(1)))
#define LAS __attribute__((address_space(3)))
typedef unsigned short bf16;
typedef unsigned v4u __attribute__((ext_vector_type(4)));
typedef unsigned v2u __attribute__((ext_vector_type(2)));
typedef float f32x4 __attribute__((ext_vector_type(4)));
typedef float f32x2 __attribute__((ext_vector_type(2)));
#define LDS_WAIT() asm volatile("s_waitcnt lgkmcnt(0)" ::: "memory")

__device__ __forceinline__ unsigned f2bf(float f) { unsigned u = __builtin_bit_cast(unsigned, f); return (u + 0x7fffu + ((u >> 16) & 1u)) >> 16; }
__device__ __forceinline__ unsigned pk2(float lo, float hi) { return f2bf(lo) | (f2bf(hi) << 16); }
__device__ __forceinline__ float bf2f(bf16 b) { return __builtin_bit_cast(float, (unsigned)b << 16); }
__device__ __forceinline__ float bflo(unsigned w) { return __builtin_bit_cast(float, w << 16); }
__device__ __forceinline__ float bfhi(unsigned w) { return __builtin_bit_cast(float, w & 0xffff0000u); }
__device__ __forceinline__ float sigmoidf_(float x) { return __builtin_amdgcn_rcpf(1.0f + __builtin_amdgcn_exp2f(-1.4426950409f * x)); }
__device__ __forceinline__ float siluf_(float x) { return x * __builtin_amdgcn_rcpf(1.0f + __builtin_amdgcn_exp2f(-1.4426950409f * x)); }
__device__ __forceinline__ float softplusf_(float x) { return x > 20.f ? x : log1pf(__expf(x)); }
__device__ __forceinline__ float wave_sum(float v) {
#pragma unroll
    for (int o = 1; o < 64; o <<= 1) v += __shfl_xor(v, o);
    return v;
}
__device__ __forceinline__ int opaque_tid() { int t = threadIdx.x; asm volatile("" : "+v"(t)); return t; }
__device__ __forceinline__ float rdl(float v, int k) { return __builtin_bit_cast(float, __builtin_amdgcn_readlane(__builtin_bit_cast(int, v), k)); }

#define XB_TMO      128
#define XB_XCNT(j)  (256  + 64 * (j))
#define XB_XSUB(j)  (1280 + 64 * (j))
#define XB_XGEN(j)  (2304 + 64 * (j))
#define XB_TOP      3328
#define XB_TOPGEN   3392
#define XCD_BAR_WORDS 3456
#define XB_SPIN_CAP (1u << 18)
__device__ __forceinline__ unsigned xb_ld(unsigned* p)              { return __hip_atomic_load(p, __ATOMIC_RELAXED, __HIP_MEMORY_SCOPE_AGENT); }
__device__ __forceinline__ unsigned xb_add(unsigned* p, unsigned v) { return __hip_atomic_fetch_add(p, v, __ATOMIC_RELAXED, __HIP_MEMORY_SCOPE_AGENT); }
__device__ __forceinline__ unsigned xb_xcc_id() { return (unsigned)__builtin_amdgcn_s_getreg((3 << 11) | 20) & 0xFu; }
#define XB_SPIN(cond, bar) do { unsigned _sp = 0; while (cond) { __builtin_amdgcn_s_sleep(1); \
    if ((++_sp & 255u) == 0u) { if (xb_ld(&(bar)[XB_TMO])) break; if (_sp > XB_SPIN_CAP) { atomicAdd(&(bar)[XB_TMO], 1u); break; } } } } while (0)
struct XcdBarrier { unsigned* bar; unsigned x; volatile LAS unsigned* st; };
__device__ __forceinline__ XcdBarrier xcd_barrier_post(unsigned* bar, volatile LAS unsigned* st) {
    XcdBarrier b; b.bar = bar; b.x = xb_xcc_id(); b.st = st;
    if (threadIdx.x == 0) (void)xb_add(&bar[XB_XCNT(b.x)], 1u);
    return b;
}
__device__ __forceinline__ void xcd_barrier_complete(unsigned* bar, unsigned x, unsigned& nloc, unsigned& nx) {
    const unsigned G = gridDim.x * gridDim.y * gridDim.z;
    unsigned sum, cnt, mine, sp = 0u;
    for (;;) {
        sum = 0u; cnt = 0u; mine = 0u;
#pragma unroll
        for (unsigned j = 0; j < 16; ++j) { const unsigned c = xb_ld(&bar[XB_XCNT(j)]); sum += c; cnt += (c > 0u) ? 1u : 0u; mine = (j == x) ? c : mine; }
        if (sum == G) break;
        __builtin_amdgcn_s_sleep(1);
        if ((++sp & 255u) == 0u) { if (xb_ld(&bar[XB_TMO])) break; if (sp > XB_SPIN_CAP) { atomicAdd(&bar[XB_TMO], 1u); break; } }
    }
    nloc = mine > 0u ? mine : 1u; nx = cnt > 0u ? cnt : 1u;
}
__device__ __forceinline__ void xcd_barrier(const XcdBarrier& b) {
    asm volatile("s_waitcnt vmcnt(0)" ::: "memory");
    __syncthreads();
    if (threadIdx.x == 0) {
        unsigned* bar = b.bar;
        __builtin_amdgcn_s_waitcnt(0);
        unsigned nloc = b.st[0], nx = b.st[1];
        if (nloc == 0u) { xcd_barrier_complete(bar, b.x, nloc, nx); b.st[0] = nloc; b.st[1] = nx; }
        const unsigned old = xb_add(&bar[XB_XSUB(b.x)], 1u);
        const unsigned gen = old / nloc;
        if (old + 1u == (gen + 1u) * nloc) {
            __builtin_amdgcn_fence(__ATOMIC_RELEASE, "agent");
            asm volatile("s_waitcnt vmcnt(0)" ::: "memory");
            const unsigned og = xb_add(&bar[XB_TOP], 1u);
            const unsigned tg = og / nx;
            if (og + 1u == (tg + 1u) * nx) xb_add(&bar[XB_TOPGEN], 1u);
            else XB_SPIN(xb_ld(&bar[XB_TOPGEN]) == tg, bar);
            __builtin_amdgcn_fence(__ATOMIC_ACQUIRE, "agent");
            xb_add(&bar[XB_XGEN(b.x)], 1u);
            asm volatile("s_waitcnt vmcnt(0)" ::: "memory");
        } else {
            XB_SPIN(xb_ld(&bar[XB_XGEN(b.x)]) == gen, bar);
            __builtin_amdgcn_fence(__ATOMIC_ACQUIRE, "agent");
            asm volatile("s_waitcnt vmcnt(0)" ::: "memory");
        }
    }
    __syncthreads();
}

enum { I_XP = 0, I_XS, I_SRW, I_SDL, I_C, I_CCTX, I_MODW, I_MODB, I_NMIX, I_NFFN, I_NFIN, I_WIN, I_WOUT, I_MU, I_W0, I_W2, I_A0, I_A2, I_G2, I_KK, I_KA, I_RK, I_LNW, I_LNB,
       I_CONVW, I_ALOG, I_DTB, I_GNW, I_POOLW, I_POOLS, I_WG, I_WU, I_WD, N_IN };
struct Args { const float* in[N_IN]; float* out; unsigned char* ws; int ph_lo, ph_hi; };
constexpr size_t OUT_SRW = (size_t)NTOK * D, OUT_SDL = OUT_SRW + (size_t)16 * 2 * 2 * 16 * 64 * 64;

__device__ __forceinline__ void conv_item(const float* W, int K, int N, bf16* WT, int drow0, LAS float* scr, int kb, int nb, int lane) {
    const int k0 = 64 * kb, n0 = 32 * nb;
#pragma unroll 8
    for (int i = 0; i < 32; ++i) { const int kk = 2 * i + (lane >> 5); scr[kk * 33 + (lane & 31)] = W[(size_t)(k0 + kk) * N + n0 + (lane & 31)]; }
    LDS_WAIT(); asm volatile("" ::: "memory");
    const int c = lane & 7;
#pragma unroll
    for (int j = 0; j < 4; ++j) { const int n = (lane >> 3) + 8 * j; const LAS float* s = scr + (8 * c) * 33 + n;
        v4u o; o.x = pk2(s[0 * 33], s[1 * 33]); o.y = pk2(s[2 * 33], s[3 * 33]); o.z = pk2(s[4 * 33], s[5 * 33]); o.w = pk2(s[6 * 33], s[7 * 33]);
        *(v4u*)(WT + (size_t)(drow0 + n) * K + k0 + 8 * c) = o; }
    LDS_WAIT(); asm volatile("" ::: "memory");
}
__device__ __forceinline__ int win_row(int n) { return n < 3072 ? n : (n < CPA ? PC_LORA + (n - 3072) : (n < CPA + 4096 ? PC_GDN + (n - CPA) : n)); }

constexpr int IT_WIN = 32 * 238, IT_WOUT = 32 * 64, IT_GU = 32 * 176, IT_DN = 88 * 64, IT_POOL = 8 * 16;
constexpr int CONV_SET_ITEMS = IT_WIN + IT_WOUT + 4 * IT_GU + 2 * IT_DN + 4 * IT_POOL;
__device__ __forceinline__ void conv_set(const Args& a, int s, int r, LAS float* scr, int lane) {
    bf16* WIN = (bf16*)(a.ws + WS_WIN); bf16* WOUT = (bf16*)(a.ws + WS_WOUT); bf16* WGU = (bf16*)(a.ws + WS_WGU); bf16* WDN = (bf16*)(a.ws + WS_WDN); bf16* WPOOL = (bf16*)(a.ws + WS_WPOOL);
    if (r < IT_WIN) { const int kb = r / 238, nb = r - kb * 238;
        conv_item(a.in[I_WIN] + (size_t)s * 2048 * 7616, 2048, 7616, WIN + (size_t)s * PW * 2048, win_row(32 * nb), scr, kb, nb, lane); return; } r -= IT_WIN;
    if (r < IT_WOUT) { const int kb = r / 64, nb = r - kb * 64;
        conv_item(a.in[I_WOUT] + (size_t)s * 2048 * 2048, 2048, 2048, WOUT + (size_t)s * 2048 * 2048, 32 * nb, scr, kb, nb, lane); return; } r -= IT_WOUT;
    if (r < 4 * IT_GU) { const int li = r / IT_GU; r -= li * IT_GU; const int l = 2 * s + (li >> 1), up = li & 1; const int kb = r / 176, nb = r - kb * 176; const int n0 = 32 * nb;
        conv_item(a.in[up ? I_WU : I_WG] + (size_t)l * 2048 * DFF, 2048, DFF, WGU + (size_t)l * 11264 * 2048, (n0 >> 7) * 256 + up * 128 + (n0 & 127), scr, kb, nb, lane); return; } r -= 4 * IT_GU;
    if (r < 2 * IT_DN) { const int li = r / IT_DN; r -= li * IT_DN; const int l = 2 * s + li; const int kb = r / 64, nb = r - kb * 64;
        conv_item(a.in[I_WD] + (size_t)l * DFF * 2048, DFF, 2048, WDN + (size_t)l * 2048 * DFF, 32 * nb, scr, kb, nb, lane); return; } r -= 2 * IT_DN;
    { const int g = r / IT_POOL; r -= g * IT_POOL; const int ig = s * 4 + g; const int kb = r / 16, nb = r - kb * 16;
        conv_item(a.in[I_POOLW] + (size_t)ig * 512 * 512, 512, 512, WPOOL + (size_t)ig * 512 * 512, 32 * nb, scr, kb, nb, lane); }
}
__device__ __forceinline__ void ph_pre(const Args& a, LAS unsigned char* lds) {
    const int tid = opaque_tid(), lane = tid & 63, wave = __builtin_amdgcn_readfirstlane(tid >> 6);
    const int G = gridDim.x;
    LAS float* ca = (LAS float*)lds;
    LAS float* red = (LAS float*)(lds + 2048 * 9 * 4);
    for (int i = tid; i < 9 * 2048; i += NTHR) { const int c = i / 2048, k = i - c * 2048; const float v = c == 0 ? a.in[I_CCTX][k] : a.in[I_C][(c - 1) * 2048 + k]; ca[k * 9 + c] = siluf_(v); }
    __syncthreads();
    float* MOD = (float*)(a.ws + WS_MOD);
    for (int task = blockIdx.x; task < 4 * 96; task += G) {
        const int l = task / 96, cb = task - l * 96;
        const float* wp = a.in[I_MODW] + ((size_t)l * 2048 + wave * 256) * 12288 + cb * 128 + lane * 2;
        float acc[9][2];
#pragma unroll
        for (int c = 0; c < 9; ++c) { acc[c][0] = 0.f; acc[c][1] = 0.f; }
        for (int k8 = 0; k8 < 256; k8 += 8) {
            f32x2 wv[8];
#pragma unroll
            for (int j = 0; j < 8; ++j) wv[j] = *(const f32x2*)(wp + (size_t)(k8 + j) * 12288);
#pragma unroll
            for (int j = 0; j < 8; ++j) { const LAS float* cp = ca + (wave * 256 + k8 + j) * 9;
#pragma unroll
                for (int c = 0; c < 9; ++c) { const float s = cp[c]; acc[c][0] += s * wv[j].x; acc[c][1] += s * wv[j].y; } }
        }
#pragma unroll
        for (int c = 0; c < 9; ++c) { red[(wave * 18 + c * 2) * 64 + lane] = acc[c][0]; red[(wave * 18 + c * 2 + 1) * 64 + lane] = acc[c][1]; }
        __syncthreads();
        for (int o = tid; o < 9 * 128; o += NTHR) { const int c = o >> 7, col = o & 127, ln = col >> 1, j = col & 1; float s = a.in[I_MODB][l * 12288 + cb * 128 + col];
#pragma unroll
            for (int w = 0; w < 8; ++w) s += red[(w * 18 + c * 2 + j) * 64 + ln];
            MOD[((size_t)l * 9 + c) * 12288 + cb * 128 + col] = s; }
        __syncthreads();
    }
    __syncthreads();
    LAS float* scr = (LAS float*)(lds + wave * 16384);
    const int gw = blockIdx.x * NWAVES + wave, NGW = G * NWAVES;
    bf16* WIN = (bf16*)(a.ws + WS_WIN);
    for (int it = gw; it < CONV_SET_ITEMS; it += NGW) conv_set(a, 0, it, scr, lane);
    { bf16* LW = (bf16*)(a.ws + WS_LORA); const int gt = blockIdx.x * NTHR + tid, NGT = G * NTHR;
        for (int idx = gt; idx < 8 * 65536; idx += NGT) { const int mat = idx >> 16, n = (idx >> 6) & 1023, k = idx & 63;
            const float v = (mat < 4 ? a.in[I_W2] : a.in[I_A2])[((size_t)(mat & 3) * 64 + k) * 1024 + n]; LW[idx] = (bf16)f2bf(v); }
        for (int idx = gt; idx < 2 * 1024 * 160; idx += NGT) { const int i2 = idx / (1024 * 160), r = idx - i2 * 1024 * 160, n = r / 160, k = r - n * 160;
            LW[8 * 65536 + idx] = (bf16)f2bf(a.in[I_G2][((size_t)i2 * 160 + k) * 1024 + n]); } }
    for (int r = gw; r < 128; r += NGW) { bf16* row = WIN + ((size_t)(r >> 6) * PW + 7616 + (r & 63)) * 2048; const v4u z = {0u, 0u, 0u, 0u};
#pragma unroll
        for (int j = 0; j < 4; ++j) *(v4u*)(row + (j * 64 + lane) * 8) = z; }
}

__device__ __forceinline__ void ph_norm(const Args& a, int l, int which) {
    const int tid = opaque_tid(), lane = tid & 63, wave = __builtin_amdgcn_readfirstlane(tid >> 6);
    const int gw = blockIdx.x * NWAVES + wave, NGW = gridDim.x * NWAVES;
    const float* nw = a.in[which ? I_NFFN : I_NMIX] + l * 2048;
    const float* MOD = (const float*)(a.ws + WS_MOD) + (size_t)l * 9 * 12288;
    bf16* H = (bf16*)(a.ws + WS_H);
    const bool from_in = (l == 0 && which == 0);
    for (int m = gw; m < NTOK; m += NGW) {
        const float* xr = from_in ? (m < NPROMPT ? a.in[I_XP] + (size_t)m * D : a.in[I_XS] + (size_t)(m - NPROMPT) * D) : a.out + (size_t)m * D;
        const int cond = m < NPROMPT ? 0 : 1 + ((m - NPROMPT) >> 10);
        const float* sh = MOD + (size_t)cond * 12288 + (which ? 3 : 0) * 2048; const float* sc = sh + 2048;
        f32x4 v[8]; float s = 0.f;
#pragma unroll
        for (int j = 0; j < 8; ++j) { v[j] = *(const f32x4*)(xr + 4 * lane + 256 * j); s += (v[j].x * v[j].x + v[j].y * v[j].y) + (v[j].z * v[j].z + v[j].w * v[j].w); }
        const float rstd = 1.0f / sqrtf(wave_sum(s) * (1.0f / D) + RMS_EPS);
#pragma unroll
        for (int j = 0; j < 8; ++j) { const int c = 4 * lane + 256 * j; const f32x4 w = *(const f32x4*)(nw + c), s1 = *(const f32x4*)(sc + c), s0 = *(const f32x4*)(sh + c);
            const f32x4 y = (v[j] * rstd) * w * (s1 + 1.0f) + s0;
            v2u o; o.x = pk2(y.x, y.y); o.y = pk2(y.z, y.w); *(v2u*)(H + (size_t)m * D + c) = o; }
    }
}
__device__ __forceinline__ void ph_final(const Args& a) {
    const int tid = opaque_tid(), lane = tid & 63, wave = __builtin_amdgcn_readfirstlane(tid >> 6);
    const int gw = blockIdx.x * NWAVES + wave, NGW = gridDim.x * NWAVES;
    const float* nw = a.in[I_NFIN];
    for (int m = gw; m < NTOK; m += NGW) {
        float* xr = a.out + (size_t)m * D;
        f32x4 v[8]; float s = 0.f;
#pragma unroll
        for (int j = 0; j < 8; ++j) { v[j] = *(const f32x4*)(xr + 4 * lane + 256 * j); s += (v[j].x * v[j].x + v[j].y * v[j].y) + (v[j].z * v[j].z + v[j].w * v[j].w); }
        const float rstd = 1.0f / sqrtf(wave_sum(s) * (1.0f / D) + RMS_EPS);
#pragma unroll
        for (int j = 0; j < 8; ++j) { const int c = 4 * lane + 256 * j; const f32x4 w = *(const f32x4*)(nw + c); *(f32x4*)(xr + c) = (v[j] * rstd) * w; }
    }
}
template <int G_> __device__ __forceinline__ void pool_group(const bf16* H, bf16* O, int m, int base, int t, int T, int lane) {
    constexpr int win = 2 << G_; const int c = G_ * 512 + lane * 8;
    int lo = t - win / 2, hi = lo + win; const int lo_c = lo < 0 ? 0 : lo, hi_c = hi > T ? T : hi;
    float s[8];
#pragma unroll
    for (int e = 0; e < 8; ++e) s[e] = 0.f;
#pragma unroll
    for (int j = 0; j < win; ++j) { const int r = lo + j; const bool ok = r >= 0 && r < T; const int rc = ok ? r : t;
        v4u w = *(const v4u*)(H + (size_t)(base + rc) * D + c); if (!ok) w = (v4u){0u, 0u, 0u, 0u};
        s[0] += bflo(w.x); s[1] += bfhi(w.x); s[2] += bflo(w.y); s[3] += bfhi(w.y); s[4] += bflo(w.z); s[5] += bfhi(w.z); s[6] += bflo(w.w); s[7] += bfhi(w.w); }
    const float inv = 1.0f / (float)(hi_c - lo_c);
    const v4u w = *(const v4u*)(H + (size_t)m * D + c);
    v4u o; o.x = pk2(s[0] * inv - bflo(w.x), s[1] * inv - bfhi(w.x)); o.y = pk2(s[2] * inv - bflo(w.y), s[3] * inv - bfhi(w.y));
    o.z = pk2(s[4] * inv - bflo(w.z), s[5] * inv - bfhi(w.z)); o.w = pk2(s[6] * inv - bflo(w.w), s[7] * inv - bfhi(w.w));
    *(v4u*)(O + (size_t)m * D + c) = o;
}
__device__ __forceinline__ void ph_pool(const Args& a) {
    const int tid = opaque_tid(), lane = tid & 63, wave = __builtin_amdgcn_readfirstlane(tid >> 6);
    const int gw = blockIdx.x * NWAVES + wave, NGW = gridDim.x * NWAVES;
    const bf16* H = (const bf16*)(a.ws + WS_H); bf16* O = (bf16*)(a.ws + WS_O);
    for (int m = gw; m < NTOK; m += NGW) {
        const bool samp = m >= NPROMPT; const int T = samp ? 1024 : 256; const int base = samp ? NPROMPT + (((m - NPROMPT) >> 10) << 10) : (m >> 8) << 8; const int t = m - base;
        pool_group<0>(H, O, m, base, t, T, lane); pool_group<1>(H, O, m, base, t, T, lane); pool_group<2>(H, O, m, base, t, T, lane); pool_group<3>(H, O, m, base, t, T, lane);
    }
}

typedef short sfrag __attribute__((ext_vector_type(8)));
union Frag { sfrag v; unsigned u[4]; };
typedef __bf16 bf16x2_t __attribute__((ext_vector_type(2)));
__device__ __forceinline__ unsigned cvtpk(float lo, float hi) { const f32x2 v = {lo, hi}; return __builtin_bit_cast(unsigned, __builtin_convertvector(v, bf16x2_t)); }
__device__ __forceinline__ f32x4 mma(const Frag& A, const Frag& B, f32x4 C) { return __builtin_amdgcn_mfma_f32_16x16x32_bf16(A.v, B.v, C, 0, 0, 0); }
__device__ __forceinline__ Frag feed1(f32x4 d0) { Frag f; f.u[0] = cvtpk(d0.x, d0.y); f.u[1] = cvtpk(d0.z, d0.w); f.u[2] = 0u; f.u[3] = 0u; return f; }
__device__ __forceinline__ Frag feed2(f32x4 d0, f32x4 d1) { Frag f; f.u[0] = cvtpk(d0.x, d0.y); f.u[1] = cvtpk(d0.z, d0.w); f.u[2] = cvtpk(d1.x, d1.y); f.u[3] = cvtpk(d1.z, d1.w); return f; }
#define DPP_SHR(x, n, fill) __builtin_bit_cast(float, __builtin_amdgcn_update_dpp(__builtin_bit_cast(int, (float)(fill)), __builtin_bit_cast(int, (float)(x)), 0x110 + (n), 0xf, 0xf, false))
__device__ __forceinline__ float row_scan16(float x) { x += DPP_SHR(x, 1, 0.f); x += DPP_SHR(x, 2, 0.f); x += DPP_SHR(x, 4, 0.f); x += DPP_SHR(x, 8, 0.f); return x; }
#define DPP_ROR(x, n) __builtin_bit_cast(float, __builtin_amdgcn_update_dpp(0, __builtin_bit_cast(int, (float)(x)), 0x120 + (n), 0xf, 0xf, false))
__device__ __forceinline__ float row_sum16(float x) { x += DPP_ROR(x, 8); x += DPP_ROR(x, 4); x += DPP_ROR(x, 2); x += DPP_ROR(x, 1); return x; }
__device__ __forceinline__ float lane_get(float x, int src) { return __builtin_bit_cast(float, __builtin_amdgcn_ds_bpermute(src << 2, __builtin_bit_cast(int, x))); }
constexpr f32x4 F4Z = {0.f, 0.f, 0.f, 0.f};
__device__ __forceinline__ f32x4 tri_inv_T(f32x4 dL, f32x4 dLT, f32x4 eye) {
    const Frag fL = feed1(dL), fLT = feed1(dLT);
    const f32x4 L2 = mma(fLT, fL, F4Z), L2T = mma(fL, fLT, F4Z);
    const Frag f2 = feed1(L2), f2T = feed1(L2T);
    const f32x4 L4 = mma(f2T, f2, F4Z), L4T = mma(f2, f2T, F4Z);
    const f32x4 L8 = mma(feed1(L4T), feed1(L4), F4Z);
    const f32x4 R1 = mma(feed1(L2 + eye), feed1(dLT + eye), F4Z);
    const f32x4 R2 = mma(feed1(L4 + eye), feed1(R1), F4Z);
    return mma(feed1(L8 + eye), feed1(R2), F4Z);
}

__device__ __forceinline__ void rwkv_task(const Args& a, int i, int s, int h, int d, int lane, LAS float* wscr) {
    constexpr size_t S1 = (size_t)NTOK * 1024;
    const bf16* RW = (const bf16*)(a.ws + WS_SC);
    bf16* YS = (bf16*)(a.ws + WS_Y) + d * S1;
    const float* BON = (const float*)(a.ws + WS_SMALL);
    const float* lnw = a.in[I_LNW] + i * 1024 + h * 64; const float* lnb = a.in[I_LNB] + i * 1024 + h * 64;
    const int T = s < 16 ? 256 : 1024; const int row0 = s < 16 ? s * 256 : NPROMPT + (s - 16) * 1024;
    const int c = lane & 15, q = lane >> 4;
    f32x4 S[4][4];
    if (s >= 16) { const float* s0 = a.in[I_SRW] + ((((size_t)(s - 16) * 2 + i) * 2 + d) * 16 + h) * 4096;
#pragma unroll
        for (int kt = 0; kt < 4; ++kt)
#pragma unroll
            for (int vt = 0; vt < 4; ++vt) S[kt][vt] = *(const f32x4*)(s0 + (16 * vt + c) * 64 + 16 * kt + 4 * q); }
    else {
#pragma unroll
        for (int kt = 0; kt < 4; ++kt)
#pragma unroll
            for (int vt = 0; vt < 4; ++vt) S[kt][vt] = F4Z; }
    Frag sel[2];
#pragma unroll
    for (int p = 0; p < 2; ++p)
#pragma unroll
        for (int j = 0; j < 4; ++j) { const int e0 = 2 * j - 4 * p; const bool on = ((lane >> 2) & 3) == q && (e0 == (lane & 3) || e0 + 1 == (lane & 3)) && (j >> 1) == p;
            sel[p].u[j] = on ? (((lane & 1) == 0) ? 0x00003F80u : 0x3F800000u) : 0u; }
    bool mlt[4], mle[4]; f32x4 eye;
#pragma unroll
    for (int n = 0; n < 4; ++n) { mlt[n] = (4 * q + n) < c; mle[n] = (4 * q + n) <= c; eye[n] = (4 * q + n) == c ? 1.f : 0.f; }
    const int nch = T >> 4;
    const int kof = (3 + d) * 1024, bof = (5 + d) * 1024, lof = (7 + d) * 1024;
    v2u nr[4], na[4], nk[4], nb[4], nlw[4], nv[4];
    { const int tok = d ? T - 1 - c : c; const int mrow = row0 + tok; const bf16* rw = RW + (((size_t)(mrow >> 4) * 16 + h) * 9) * 1024 + (mrow & 15) * 16 + 4 * q;
#pragma unroll
        for (int g = 0; g < 4; ++g) { nr[g] = *(const v2u*)(rw + 256 * g); na[g] = *(const v2u*)(rw + 1024 + 256 * g); nk[g] = *(const v2u*)(rw + kof + 256 * g); nb[g] = *(const v2u*)(rw + bof + 256 * g); nlw[g] = *(const v2u*)(rw + lof + 256 * g); nv[g] = *(const v2u*)(rw + 2048 + 256 * g); } }
    for (int ch = 0; ch < nch; ++ch) {
        Frag f_at[2], f_rt[2], f_bt[2], f_kt[2], f_bh[2], f_kh[2], f_v[2];
#pragma unroll
        for (int g = 0; g < 4; ++g) {
            const int ks = g >> 1, hf = g & 1;
            float lw_[4] = {bflo(nlw[g].x), bfhi(nlw[g].x), bflo(nlw[g].y), bfhi(nlw[g].y)};
            float r_[4] = {bflo(nr[g].x), bfhi(nr[g].x), bflo(nr[g].y), bfhi(nr[g].y)}, a_[4] = {bflo(na[g].x), bfhi(na[g].x), bflo(na[g].y), bfhi(na[g].y)};
            float k_[4] = {bflo(nk[g].x), bfhi(nk[g].x), bflo(nk[g].y), bfhi(nk[g].y)}, b_[4] = {bflo(nb[g].x), bfhi(nb[g].x), bflo(nb[g].y), bfhi(nb[g].y)};
            float at[4], rt[4], bt[4], kt[4], bh[4], kh[4];
#pragma unroll
            for (int n = 0; n < 4; ++n) {
                const float G = row_scan16(lw_[n]); const float E1 = __builtin_amdgcn_exp2f(G), E2 = __builtin_amdgcn_rcpf(E1); const float E3 = DPP_SHR(E1, 1, 1.0f);
                const float ec = lane_get(E1, (lane & 48) | 15); wscr[(g * 4 + n) * 64 + lane] = ec;
                at[n] = a_[n] * E3; rt[n] = r_[n] * E1; bt[n] = b_[n] * E2; kt[n] = k_[n] * E2; bh[n] = bt[n] * ec; kh[n] = kt[n] * ec;
            }
            f_at[ks].u[2 * hf] = cvtpk(at[0], at[1]); f_at[ks].u[2 * hf + 1] = cvtpk(at[2], at[3]); f_rt[ks].u[2 * hf] = cvtpk(rt[0], rt[1]); f_rt[ks].u[2 * hf + 1] = cvtpk(rt[2], rt[3]);
            f_bt[ks].u[2 * hf] = cvtpk(bt[0], bt[1]); f_bt[ks].u[2 * hf + 1] = cvtpk(bt[2], bt[3]); f_kt[ks].u[2 * hf] = cvtpk(kt[0], kt[1]); f_kt[ks].u[2 * hf + 1] = cvtpk(kt[2], kt[3]);
            f_bh[ks].u[2 * hf] = cvtpk(bh[0], bh[1]); f_bh[ks].u[2 * hf + 1] = cvtpk(bh[2], bh[3]); f_kh[ks].u[2 * hf] = cvtpk(kh[0], kh[1]); f_kh[ks].u[2 * hf + 1] = cvtpk(kh[2], kh[3]);
            f_v[ks].u[2 * hf] = nv[g].x; f_v[ks].u[2 * hf + 1] = nv[g].y;
            if (g == 1) __builtin_amdgcn_sched_barrier(0);
        }
        LAS v2u* sV = (LAS v2u*)(wscr + 3072); LAS v4u* sBK = (LAS v4u*)(wscr + 1024);
#pragma unroll
        for (int g = 0; g < 4; ++g) { const f32x4 dv = mma(f_v[g >> 1], sel[g & 1], F4Z); sV[g * 64 + lane] = (v2u){cvtpk(dv.x, dv.y), cvtpk(dv.z, dv.w)};
            const Frag fb = feed2(mma(f_bh[g >> 1], sel[g & 1], F4Z), mma(f_kh[g >> 1], sel[g & 1], F4Z)); sBK[g * 64 + lane] = (v4u){fb.u[0], fb.u[1], fb.u[2], fb.u[3]}; }
        __builtin_amdgcn_sched_barrier(0);
        f32x4 dLab = mma(f_at[1], f_bt[1], mma(f_at[0], f_bt[0], F4Z));
        f32x4 dLabT = mma(f_bt[1], f_at[1], mma(f_bt[0], f_at[0], F4Z));
        f32x4 dLakT = mma(f_kt[1], f_at[1], mma(f_kt[0], f_at[0], F4Z));
        f32x4 dArbT = mma(f_bt[1], f_rt[1], mma(f_bt[0], f_rt[0], F4Z));
        f32x4 dArkT = mma(f_kt[1], f_rt[1], mma(f_kt[0], f_rt[0], F4Z));
#pragma unroll
        for (int n = 0; n < 4; ++n) { dLab[n] = (c < 4 * q + n) ? dLab[n] : 0.f; dLabT[n] = mlt[n] ? dLabT[n] : 0.f; dLakT[n] = mlt[n] ? dLakT[n] : 0.f; dArbT[n] = mle[n] ? dArbT[n] : 0.f; dArkT[n] = mle[n] ? dArkT[n] : 0.f; }
        const Frag fTT = feed1(tri_inv_T(dLab, dLabT, eye)), fLakT = feed1(dLakT), fArbT = feed1(dArbT), fArkT = feed1(dArkT);
        __builtin_amdgcn_sched_barrier(0);
        { const int chn = ch + 1 < nch ? ch + 1 : ch; const int tok = d ? T - 1 - (16 * chn + c) : 16 * chn + c; const int mrow = row0 + tok; const bf16* rw = RW + (((size_t)(mrow >> 4) * 16 + h) * 9) * 1024 + (mrow & 15) * 16 + 4 * q;
#pragma unroll
            for (int g = 0; g < 4; ++g) { nr[g] = *(const v2u*)(rw + 256 * g); na[g] = *(const v2u*)(rw + 1024 + 256 * g); nk[g] = *(const v2u*)(rw + kof + 256 * g); nb[g] = *(const v2u*)(rw + bof + 256 * g); nlw[g] = *(const v2u*)(rw + lof + 256 * g); nv[g] = *(const v2u*)(rw + 2048 + 256 * g); } }
        __builtin_amdgcn_sched_barrier(0);
        v2u pSA[4];
        const int tokbase = 16 * ch + 4 * q;
#pragma unroll
        for (int vt = 0; vt < 4; ++vt) {
            const Frag fS0 = feed2(S[0][vt], S[1][vt]), fS1 = feed2(S[2][vt], S[3][vt]); const v2u pv = sV[vt * 64 + lane]; Frag fV; fV.u[0] = pv.x; fV.u[1] = pv.y; fV.u[2] = 0u; fV.u[3] = 0u;
            f32x4 rhs = mma(f_at[1], fS1, mma(f_at[0], fS0, F4Z)); rhs = mma(fLakT, fV, rhs);
            const f32x4 sa = mma(fTT, feed1(rhs), F4Z); pSA[vt].x = cvtpk(sa.x, sa.y); pSA[vt].y = cvtpk(sa.z, sa.w);
            Frag fSA; fSA.u[0] = pSA[vt].x; fSA.u[1] = pSA[vt].y; fSA.u[2] = 0u; fSA.u[3] = 0u;
            f32x4 y = mma(f_rt[1], fS1, mma(f_rt[0], fS0, F4Z)); y = mma(fArbT, fSA, y); y = mma(fArkT, fV, y);
#pragma unroll
            for (int n = 0; n < 4; ++n) wscr[2048 + (vt * 4 + n) * 64 + lane] = y[n];
            __builtin_amdgcn_sched_barrier(0);
        }
#pragma unroll
        for (int vt = 0; vt < 4; ++vt) { const v2u pv = sV[vt * 64 + lane]; Frag fB; fB.u[0] = pSA[vt].x; fB.u[1] = pSA[vt].y; fB.u[2] = pv.x; fB.u[3] = pv.y;
#pragma unroll
            for (int kt = 0; kt < 4; ++kt) { f32x4 cin;
#pragma unroll
                for (int n = 0; n < 4; ++n) cin[n] = S[kt][vt][n] * wscr[(kt * 4 + n) * 64 + lane];
                const v4u w = sBK[kt * 64 + lane]; Frag fbk; fbk.u[0] = w.x; fbk.u[1] = w.y; fbk.u[2] = w.z; fbk.u[3] = w.w;
                S[kt][vt] = mma(fbk, fB, cin); } }
        __builtin_amdgcn_sched_barrier(0);
        {
            float s1[4] = {0.f, 0.f, 0.f, 0.f}, s2[4] = {0.f, 0.f, 0.f, 0.f};
#pragma unroll
            for (int vt = 0; vt < 4; ++vt)
#pragma unroll
                for (int n = 0; n < 4; ++n) { const float yv = wscr[2048 + (vt * 4 + n) * 64 + lane]; s1[n] += yv; s2[n] += yv * yv; }
            float mean[4], rs[4], bon[4]; size_t orow[4];
#pragma unroll
            for (int n = 0; n < 4; ++n) { const float m1 = row_sum16(s1[n]) * (1.0f / 64.0f), m2 = row_sum16(s2[n]) * (1.0f / 64.0f); mean[n] = m1; rs[n] = 1.0f / sqrtf(fmaxf(m2 - m1 * m1, 0.f) + GN_EPS);
                const int t = tokbase + n; const int tok = d ? T - 1 - t : t; const int mrow = row0 + tok; bon[n] = BON[((size_t)mrow * 2 + d) * 16 + h]; orow[n] = (((size_t)(mrow >> 4) * 16 + h) * 4) * 256 + (mrow & 15) * 16 + c; }
#pragma unroll
            for (int vt = 0; vt < 4; ++vt) { const float lw_ = lnw[16 * vt + c], lb_ = lnb[16 * vt + c];
                const v2u pv = sV[vt * 64 + lane]; const float vv[4] = {bflo(pv.x), bfhi(pv.x), bflo(pv.y), bfhi(pv.y)};
#pragma unroll
                for (int n = 0; n < 4; ++n) { const float yv = wscr[2048 + (vt * 4 + n) * 64 + lane];
                    YS[orow[n] + vt * 256] = (bf16)f2bf((yv - mean[n]) * rs[n] * lw_ + lb_ + bon[n] * vv[n]); } }
        }
    }
    if (s < 16) { float* so = a.out + OUT_SRW + ((((size_t)s * 2 + i) * 2 + d) * 16 + h) * 4096;
#pragma unroll
        for (int kt = 0; kt < 4; ++kt)
#pragma unroll
            for (int vt = 0; vt < 4; ++vt) *(f32x4*)(so + (16 * vt + c) * 64 + 16 * kt + 4 * q) = S[kt][vt]; }
}

__device__ __forceinline__ Frag scale_frag(const Frag& x, float sc) { Frag f;
#pragma unroll
    for (int j = 0; j < 4; ++j) f.u[j] = cvtpk(bflo(x.u[j]) * sc, bfhi(x.u[j]) * sc);
    return f; }
__device__ __forceinline__ void gdn_task(const Args& a, int i, int s, int h, int d, int vb, int lane, LAS float* wscr) {
    constexpr size_t S1 = (size_t)NTOK * 1024;
    const bf16* GD = (const bf16*)(a.ws + WS_SC) + 9 * S1;
    const float* BETA = (const float*)(a.ws + WS_SMALL) + (size_t)NTOK * 32; const float* GG = BETA + (size_t)NTOK * 16;
    bf16* O = (bf16*)(a.ws + WS_Y) + 2 * S1 + d * S1;
    const int T = s < 16 ? 256 : 1024; const int row0 = s < 16 ? s * 256 : NPROMPT + (s - 16) * 1024;
    const int c = lane & 15, q = lane >> 4;
    f32x4 S[8][2];
    if (s >= 16) { const float* s0 = a.in[I_SDL] + ((((size_t)(s - 16) * 2 + i) * 2 + d) * 8 + h) * 16384 + 32 * vb + c;
#pragma unroll
        for (int kt = 0; kt < 8; ++kt)
#pragma unroll
            for (int vt = 0; vt < 2; ++vt)
#pragma unroll
                for (int n = 0; n < 4; ++n) S[kt][vt][n] = s0[(16 * kt + 4 * q + n) * 128 + 16 * vt]; }
    else {
#pragma unroll
        for (int kt = 0; kt < 8; ++kt) { S[kt][0] = F4Z; S[kt][1] = F4Z; } }
    Frag sel[2];
#pragma unroll
    for (int p = 0; p < 2; ++p)
#pragma unroll
        for (int j = 0; j < 4; ++j) { const int e0 = 2 * j - 4 * p; const bool on = ((lane >> 2) & 3) == q && (e0 == (lane & 3) || e0 + 1 == (lane & 3)) && (j >> 1) == p;
            sel[p].u[j] = on ? (((lane & 1) == 0) ? 0x00003F80u : 0x3F800000u) : 0u; }
    f32x4 eye;
#pragma unroll
    for (int n = 0; n < 4; ++n) eye[n] = (4 * q + n) == c ? 1.f : 0.f;
    const int nch = T >> 4;
    Frag nk[4], nq[4], nv; float nbeta, ng;
    { const int tok = d ? T - 1 - c : c; const size_t row = row0 + tok; const bf16* gd = GD + ((((row >> 4) * 8 + h) * 3) * 8) * 256 + (row & 15) * 16 + 4 * q;
#pragma unroll
        for (int ks = 0; ks < 4; ++ks) { const v2u k0 = *(const v2u*)(gd + 2048 + 512 * ks), k1 = *(const v2u*)(gd + 2048 + 512 * ks + 256), q0 = *(const v2u*)(gd + 512 * ks), q1 = *(const v2u*)(gd + 512 * ks + 256);
            nk[ks].u[0] = k0.x; nk[ks].u[1] = k0.y; nk[ks].u[2] = k1.x; nk[ks].u[3] = k1.y; nq[ks].u[0] = q0.x; nq[ks].u[1] = q0.y; nq[ks].u[2] = q1.x; nq[ks].u[3] = q1.y; }
        { const v2u v0 = *(const v2u*)(gd + 4096 + 512 * vb), v1 = *(const v2u*)(gd + 4096 + 512 * vb + 256); nv.u[0] = v0.x; nv.u[1] = v0.y; nv.u[2] = v1.x; nv.u[3] = v1.y; }
        nbeta = BETA[row * 16 + d * 8 + h]; ng = GG[row * 16 + d * 8 + h]; }
    for (int ch = 0; ch < nch; ++ch) {
        const float beta = nbeta, gl = ng;
        const float G = row_scan16(gl); const float GC = lane_get(G, (lane & 48) | 15);
        float Grow[4], Brow[4];
#pragma unroll
        for (int n = 0; n < 4; ++n) { Grow[n] = lane_get(G, (lane & 48) | (4 * q + n)); Brow[n] = lane_get(beta, (lane & 48) | (4 * q + n)); }
        const float eG = __builtin_amdgcn_exp2f(G), eGCG = __builtin_amdgcn_exp2f(GC - G), eGC = __builtin_amdgcn_exp2f(GC);
        f32x4 dKK = F4Z, dKQ = F4Z;
#pragma unroll
        for (int ks = 0; ks < 4; ++ks) { dKK = mma(nk[ks], nk[ks], dKK); dKQ = mma(nk[ks], nq[ks], dKQ); }
        f32x4 dL, dLT, dAtT;
#pragma unroll
        for (int n = 0; n < 4; ++n) { const int r = 4 * q + n;
            const float eij = __builtin_amdgcn_exp2f(fminf(Grow[n] - G, 0.f)), eji = __builtin_amdgcn_exp2f(fminf(G - Grow[n], 0.f));
            dL[n] = (c < r) ? -Brow[n] * dKK[n] * eij : 0.f;
            dLT[n] = (r < c) ? -beta * dKK[n] * eji : 0.f;
            dAtT[n] = (r <= c) ? dKQ[n] * eji * 0.08838834764831845f : 0.f; }
        const Frag fTT = feed1(tri_inv_T(dL, dLT, eye)), fAtT = feed1(dAtT);
        f32x4 dV[2]; dV[0] = mma(nv, sel[0], F4Z); dV[1] = mma(nv, sel[1], F4Z);
        LAS v2u* sKd = (LAS v2u*)wscr;
#pragma unroll
        for (int ks = 0; ks < 4; ++ks) { const Frag kd = scale_frag(nk[ks], eGCG); const f32x4 t0 = mma(kd, sel[0], F4Z), t1 = mma(kd, sel[1], F4Z);
            sKd[(2 * ks) * 64 + lane] = (v2u){cvtpk(t0.x, t0.y), cvtpk(t0.z, t0.w)}; sKd[(2 * ks + 1) * 64 + lane] = (v2u){cvtpk(t1.x, t1.y), cvtpk(t1.z, t1.w)}; }
        Frag fX[4], fQg[4];
#pragma unroll
        for (int ks = 0; ks < 4; ++ks) { fX[ks] = scale_frag(nk[ks], beta * eG); fQg[ks] = scale_frag(nq[ks], eG * 0.08838834764831845f); }
        const int tokbase = 16 * ch + 4 * q;
#pragma unroll
        for (int vt = 0; vt < 2; ++vt) {
            f32x4 M = F4Z, o = F4Z;
#pragma unroll
            for (int ks = 0; ks < 4; ++ks) { const Frag fS = feed2(S[2 * ks][vt], S[2 * ks + 1][vt]); M = mma(fX[ks], fS, M); o = mma(fQg[ks], fS, o); }
            f32x4 rhs;
#pragma unroll
            for (int n = 0; n < 4; ++n) rhs[n] = Brow[n] * dV[vt][n] - M[n];
            const Frag fVn = feed1(mma(fTT, feed1(rhs), F4Z));
            o = mma(fAtT, fVn, o);
#pragma unroll
            for (int n = 0; n < 4; ++n) { const int t = tokbase + n; const int tok = d ? T - 1 - t : t; const int mrow = row0 + tok; O[(((size_t)(mrow >> 4) * 8 + h) * 8 + 2 * vb + vt) * 256 + (mrow & 15) * 16 + c] = (bf16)f2bf(o[n]); }
#pragma unroll
            for (int kt = 0; kt < 8; ++kt) { const v2u w = sKd[kt * 64 + lane]; Frag fK; fK.u[0] = w.x; fK.u[1] = w.y; fK.u[2] = 0u; fK.u[3] = 0u; S[kt][vt] = mma(fK, fVn, S[kt][vt] * eGC); }
        }
        asm volatile("" ::: "memory");
        { const int chn = ch + 1 < nch ? ch + 1 : ch; const int tok = d ? T - 1 - (16 * chn + c) : 16 * chn + c; const size_t row = row0 + tok; const bf16* gd = GD + ((((row >> 4) * 8 + h) * 3) * 8) * 256 + (row & 15) * 16 + 4 * q;
#pragma unroll
            for (int ks = 0; ks < 4; ++ks) { const v2u k0 = *(const v2u*)(gd + 2048 + 512 * ks), k1 = *(const v2u*)(gd + 2048 + 512 * ks + 256), q0 = *(const v2u*)(gd + 512 * ks), q1 = *(const v2u*)(gd + 512 * ks + 256);
                nk[ks].u[0] = k0.x; nk[ks].u[1] = k0.y; nk[ks].u[2] = k1.x; nk[ks].u[3] = k1.y; nq[ks].u[0] = q0.x; nq[ks].u[1] = q0.y; nq[ks].u[2] = q1.x; nq[ks].u[3] = q1.y; }
            { const v2u v0 = *(const v2u*)(gd + 4096 + 512 * vb), v1 = *(const v2u*)(gd + 4096 + 512 * vb + 256); nv.u[0] = v0.x; nv.u[1] = v0.y; nv.u[2] = v1.x; nv.u[3] = v1.y; }
            nbeta = BETA[row * 16 + d * 8 + h]; ng = GG[row * 16 + d * 8 + h]; }
    }
    if (s < 16) { float* so = a.out + OUT_SDL + ((((size_t)s * 2 + i) * 2 + d) * 8 + h) * 16384 + 32 * vb + c;
#pragma unroll
        for (int kt = 0; kt < 8; ++kt)
#pragma unroll
            for (int vt = 0; vt < 2; ++vt)
#pragma unroll
                for (int n = 0; n < 4; ++n) so[(16 * kt + 4 * q + n) * 128 + 16 * vt] = S[kt][vt][n]; }
}
__device__ __forceinline__ void ph_scan(const Args& a, LAS unsigned char* lds, int i, bool convert_late) {
    const int tid = opaque_tid(), lane = tid & 63, wave = __builtin_amdgcn_readfirstlane(tid >> 6);
    LAS float* wscr = (LAS float*)(lds + wave * 14336);
    const int G = gridDim.x;
#ifdef SCAN_DUP_RW
    for (int rep = 0; rep < 2; ++rep)
#endif
    for (int task = wave * G + blockIdx.x; task < 2304; task += NWAVES * G) {
        if (task >= 256 && task < 512) { const int t = task - 256; rwkv_task(a, i, 16 + (t >> 5), (t & 31) >> 1, t & 1, lane, wscr); }
        else if (task >= 1024 && task < 1536) { const int t = task - 1024; rwkv_task(a, i, t >> 5, (t & 31) >> 1, t & 1, lane, wscr); }
    }
    asm volatile("" ::: "memory");
#ifdef SCAN_DUP_GD
    for (int rep = 0; rep < 2; ++rep)
#endif
    for (int task = wave * G + blockIdx.x; task < 2304; task += NWAVES * G) {
        if (task < 256 || task >= 1536) { const int t = task < 256 ? task : task - 1536 + 256; const int s = t >> 6, r = t & 63; gdn_task(a, i, s, r >> 3, (r >> 2) & 1, r & 3, lane, wscr); }
        else if (task >= 512 && task < 1024) { const int t = task - 512; const int s = 16 + (t >> 6), r = t & 63; gdn_task(a, i, s, r >> 3, (r >> 2) & 1, r & 3, lane, wscr); }
    }
    if (convert_late && (wave == 0 || wave >= 4)) { const int rank = blockIdx.x * 5 + (wave == 0 ? 0 : wave - 3);
        asm volatile("s_waitcnt lgkmcnt(0)" ::: "memory");
        for (int it = rank; it < CONV_SET_ITEMS; it += 5 * G) conv_set(a, 1, it, (LAS float*)wscr, lane); }
}
__device__ __forceinline__ void tok_info(int m, bool& samp, int& T, int& t) { samp = m >= NPROMPT; T = samp ? 1024 : 256; t = samp ? ((m - NPROMPT) & 1023) : (m & 255); }
__device__ __forceinline__ void shift_nb(bool samp, int T, int t, int n, int& dt, bool& valid) {
    if (!samp) { if (n & 1) { dt = 1; valid = t + 1 < T; } else { dt = -1; valid = t > 0; } }
    else { const int col = t & 63, row = t >> 6;
        if (n == 0) { dt = -1; valid = col > 0; } else if (n == 1) { dt = 1; valid = col < 63; } else if (n == 2) { dt = -64; valid = row > 0; } else { dt = 64; valid = row < 15; } }
}
constexpr int LA_LD = 424;
__device__ __forceinline__ void ph_prep(const Args& a, LAS unsigned char* lds, int i) {
    const int tid = opaque_tid(), lane = tid & 63, wave = __builtin_amdgcn_readfirstlane(tid >> 6);
    const int c = lane & 15, q = lane >> 4;
    const bf16* P = (const bf16*)(a.ws + WS_P);
    bf16* RW = (bf16*)(a.ws + WS_SC); constexpr size_t S1 = (size_t)NTOK * 1024;
    bf16* GD = RW + 9 * S1; float* GT = (float*)(RW + 12 * S1);
    float* BON = (float*)(a.ws + WS_SMALL); float* BETA = BON + (size_t)NTOK * 32; float* GG = BETA + (size_t)NTOK * 16;
    const float* MU = a.in[I_MU] + i * CPA;
    const bf16* W2T = (const bf16*)(a.ws + WS_LORA) + (size_t)i * 2 * 1024 * 64;
    const bf16* A2T = (const bf16*)(a.ws + WS_LORA) + (size_t)4 * 1024 * 64 + (size_t)i * 2 * 1024 * 64;
    const bf16* G2T = (const bf16*)(a.ws + WS_LORA) + (size_t)8 * 1024 * 64 + (size_t)i * 1024 * 160;
    LAS bf16* la = (LAS bf16*)lds;
    LAS float* lpar = (LAS float*)(lds + 40960);
    LAS float* lcw = (LAS float*)(lds + 40960 + 40960);
    for (int idx = tid; idx < 10 * 1024; idx += NTHR) { const int p = idx >> 10, ch = idx & 1023;
        const float v = p < 3 ? MU[p * 1024 + ch] : (p == 3 ? a.in[I_KK][i * 1024 + ch] : (p == 4 ? a.in[I_KA][i * 1024 + ch] : (p == 5 ? a.in[I_RK][i * 1024 + ch] : (p < 8 ? a.in[I_W0][(i * 2 + p - 6) * 1024 + ch] : a.in[I_A0][(i * 2 + p - 8) * 1024 + ch]))));
        lpar[idx] = v; }
    for (int idx = tid; idx < 3 * 3072; idx += NTHR) lcw[idx] = a.in[I_CONVW][(size_t)i * 3 * 3072 + idx];
    __syncthreads();
    for (int tile = blockIdx.x; tile < NTOK / 48; tile += gridDim.x) {
        const int m0 = tile * 48;
#ifdef PREP_DUP_A
        for (int rep = 0; rep < 2; ++rep)
#endif
        for (int it = 0; it < 10; ++it) {
            float xv[4], xsv[4]; int jjv[4], ttv[4];
#pragma unroll
            for (int u = 0; u < 4; ++u) { const int idx = tid + NTHR * (4 * it + u); const bool ok = idx < 48 * 416; const int tt = ok ? idx / 416 : 0, jj = ok ? idx - tt * 416 : 0; jjv[u] = ok ? jj : -1; ttv[u] = tt;
                const int m = m0 + tt; bool samp; int T, t; tok_info(m, samp, T, t); int dt; bool valid; shift_nb(samp, T, t, jj & 3, dt, valid);
                xv[u] = bf2f(P[(size_t)m * PW + PC_LORA + jj]); const float ls = bf2f(P[(size_t)(m + (valid ? dt : 0)) * PW + PC_LORA + jj]); xsv[u] = valid ? ls : 0.f; }
#pragma unroll
            for (int u = 0; u < 4; ++u) { const int jj = jjv[u]; if (jj >= 0) { float v = xv[u] + (xsv[u] - xv[u]) * MU[3072 + jj];
                if (jj < 128) { const float e = __builtin_amdgcn_exp2f(2.8853900818f * v); v = 1.0f - 2.0f * __builtin_amdgcn_rcpf(e + 1.0f); } else if (jj >= 256) v = sigmoidf_(v);
                la[ttv[u] * LA_LD + jj] = (bf16)f2bf(v); } }
        }
        __syncthreads();
#ifdef PREP_DUP_RW
#pragma unroll 1
        for (int rep = 0; rep < 2; ++rep)
#endif
#pragma unroll 1
        for (int u = 0; u < 6; ++u) {
            const int hd = wave * 2 + u / 3, mt = u % 3; const int m = m0 + 16 * mt + c; bool samp; int T, t; tok_info(m, samp, T, t);
            int dtn[4]; bool vn[4];
#pragma unroll
            for (int n = 0; n < 4; ++n) { shift_nb(samp, T, t, n, dtn[n], vn[n]); dtn[n] = vn[n] ? dtn[n] : 0; }
            float r_[4][4], k_[4][4], v_[4][4]; float ss = 0.f;
#pragma unroll
            for (int nt = 0; nt < 4; ++nt) { const int ch = hd * 64 + 16 * nt + 4 * q; const bf16* pr = P + (size_t)m * PW + ch;
                const v2u wr = *(const v2u*)pr, wk = *(const v2u*)(pr + 1024), wv = *(const v2u*)(pr + 2048);
                const f32x4 mur = *(const LAS f32x4*)(lpar + ch), muk = *(const LAS f32x4*)(lpar + 1024 + ch), muv = *(const LAS f32x4*)(lpar + 2048 + ch), kkw = *(const LAS f32x4*)(lpar + 3072 + ch);
                const float xr[4] = {bflo(wr.x), bfhi(wr.x), bflo(wr.y), bfhi(wr.y)}, xk[4] = {bflo(wk.x), bfhi(wk.x), bflo(wk.y), bfhi(wk.y)}, xv[4] = {bflo(wv.x), bfhi(wv.x), bflo(wv.y), bfhi(wv.y)};
#pragma unroll
                for (int n = 0; n < 4; ++n) { const bf16* pn = pr + (long)dtn[n] * PW + n;
                    const float lr = bf2f(pn[0]), lk = bf2f(pn[1024]), lv = bf2f(pn[2048]); const float nr = vn[n] ? lr : 0.f, nk = vn[n] ? lk : 0.f, nv = vn[n] ? lv : 0.f;
                    r_[nt][n] = xr[n] + (nr - xr[n]) * mur[n]; k_[nt][n] = xk[n] + (nk - xk[n]) * muk[n]; v_[nt][n] = xv[n] + (nv - xv[n]) * muv[n];
                    const float kkr = k_[nt][n] * kkw[n]; ss += kkr * kkr; } }
            ss += __shfl_xor(ss, 16); ss += __shfl_xor(ss, 32);
            const float kn = __builtin_amdgcn_rsqf(ss + 1e-12f);
            float bon0 = 0.f, bon1 = 0.f;
            const LAS bf16* lrow = la + (16 * mt + c) * LA_LD + 8 * q;
#pragma unroll
            for (int nt = 0; nt < 4; ++nt) {
                f32x4 wl0 = F4Z, wl1 = F4Z, al0 = F4Z, al1 = F4Z, gl = F4Z;
#pragma unroll
                for (int ks = 0; ks < 2; ++ks) {
                    const size_t wo = ((size_t)hd * 64 + 16 * nt + c) * 64 + 32 * ks + 8 * q;
                    Frag b, w; v4u x;
                    x = *(const LAS v4u*)(lrow + 32 * ks); b.u[0] = x.x; b.u[1] = x.y; b.u[2] = x.z; b.u[3] = x.w; x = *(const v4u*)(W2T + wo); w.u[0] = x.x; w.u[1] = x.y; w.u[2] = x.z; w.u[3] = x.w; wl0 = mma(w, b, wl0);
                    x = *(const LAS v4u*)(lrow + 64 + 32 * ks); b.u[0] = x.x; b.u[1] = x.y; b.u[2] = x.z; b.u[3] = x.w; x = *(const v4u*)(W2T + 65536 + wo); w.u[0] = x.x; w.u[1] = x.y; w.u[2] = x.z; w.u[3] = x.w; wl1 = mma(w, b, wl1);
                    x = *(const LAS v4u*)(lrow + 128 + 32 * ks); b.u[0] = x.x; b.u[1] = x.y; b.u[2] = x.z; b.u[3] = x.w; x = *(const v4u*)(A2T + wo); w.u[0] = x.x; w.u[1] = x.y; w.u[2] = x.z; w.u[3] = x.w; al0 = mma(w, b, al0);
                    x = *(const LAS v4u*)(lrow + 192 + 32 * ks); b.u[0] = x.x; b.u[1] = x.y; b.u[2] = x.z; b.u[3] = x.w; x = *(const v4u*)(A2T + 65536 + wo); w.u[0] = x.x; w.u[1] = x.y; w.u[2] = x.z; w.u[3] = x.w; al1 = mma(w, b, al1);
                }
#pragma unroll
                for (int ks = 0; ks < 5; ++ks) { Frag b, w; v4u x = *(const LAS v4u*)(lrow + 256 + 32 * ks); b.u[0] = x.x; b.u[1] = x.y; b.u[2] = x.z; b.u[3] = x.w;
                    x = *(const v4u*)(G2T + ((size_t)hd * 64 + 16 * nt + c) * 160 + 32 * ks + 8 * q); w.u[0] = x.x; w.u[1] = x.y; w.u[2] = x.z; w.u[3] = x.w; gl = mma(w, b, gl); }
                const int ch = hd * 64 + 16 * nt + 4 * q; const size_t o = (size_t)m * 1024 + ch;
                bf16* rw = RW + ((((size_t)(m >> 4) * 16 + hd) * 9) * 4 + nt) * 256 + c * 16 + 4 * q;
                const f32x4 kkw = *(const LAS f32x4*)(lpar + 3072 + ch), kaw = *(const LAS f32x4*)(lpar + 4096 + ch), rkw = *(const LAS f32x4*)(lpar + 5120 + ch);
                const f32x4 w00 = *(const LAS f32x4*)(lpar + 6144 + ch), w01 = *(const LAS f32x4*)(lpar + 7168 + ch), a00 = *(const LAS f32x4*)(lpar + 8192 + ch), a01 = *(const LAS f32x4*)(lpar + 9216 + ch);
                float kk[4], lw0[4], lw1[4], kd0[4], kd1[4], b0[4], b1[4];
#pragma unroll
                for (int n = 0; n < 4; ++n) { const float kx = k_[nt][n];
                    kk[n] = kx * kkw[n] * kn;
                    const float ic0 = sigmoidf_(a00[n] + al0[n]), ic1 = sigmoidf_(a01[n] + al1[n]);
                    lw0[n] = -0.6065306597f * 1.4426950409f * sigmoidf_(w00[n] + wl0[n]); lw1[n] = -0.6065306597f * 1.4426950409f * sigmoidf_(w01[n] + wl1[n]);
                    kd0[n] = kx * (1.0f + (ic0 - 1.0f) * kaw[n]); kd1[n] = kx * (1.0f + (ic1 - 1.0f) * kaw[n]); b0[n] = kk[n] * ic0; b1[n] = kk[n] * ic1;
                    bon0 += r_[nt][n] * kd0[n] * rkw[n]; bon1 += r_[nt][n] * kd1[n] * rkw[n]; }
                *(v2u*)(rw) = (v2u){cvtpk(r_[nt][0], r_[nt][1]), cvtpk(r_[nt][2], r_[nt][3])}; *(v2u*)(rw + 2 * 1024) = (v2u){cvtpk(v_[nt][0], v_[nt][1]), cvtpk(v_[nt][2], v_[nt][3])};
                *(v2u*)(rw + 1 * 1024) = (v2u){cvtpk(-kk[0], -kk[1]), cvtpk(-kk[2], -kk[3])};
                *(v2u*)(rw + 3 * 1024) = (v2u){cvtpk(kd0[0], kd0[1]), cvtpk(kd0[2], kd0[3])}; *(v2u*)(rw + 4 * 1024) = (v2u){cvtpk(kd1[0], kd1[1]), cvtpk(kd1[2], kd1[3])};
                *(v2u*)(rw + 5 * 1024) = (v2u){cvtpk(b0[0], b0[1]), cvtpk(b0[2], b0[3])}; *(v2u*)(rw + 6 * 1024) = (v2u){cvtpk(b1[0], b1[1]), cvtpk(b1[2], b1[3])};
                *(v2u*)(rw + 7 * 1024) = (v2u){cvtpk(lw0[0], lw0[1]), cvtpk(lw0[2], lw0[3])}; *(v2u*)(rw + 8 * 1024) = (v2u){cvtpk(lw1[0], lw1[1]), cvtpk(lw1[2], lw1[3])};
                *(f32x4*)(GT + (((size_t)(m >> 4) * 16 + hd) * 4 + nt) * 256 + c * 16 + 4 * q) = gl;
                __builtin_amdgcn_sched_barrier(0);
            }
            bon0 += __shfl_xor(bon0, 16); bon0 += __shfl_xor(bon0, 32); bon1 += __shfl_xor(bon1, 16); bon1 += __shfl_xor(bon1, 32);
            if (q == 0) { BON[((size_t)m * 2 + 0) * 16 + hd] = bon0; BON[((size_t)m * 2 + 1) * 16 + hd] = bon1; }
        }
#ifdef PREP_DUP_GD
#pragma unroll 1
        for (int rep = 0; rep < 2; ++rep)
#endif
#pragma unroll 1
        for (int r3 = 0; r3 < 3; ++r3) {
            const int unit = wave + 8 * r3; const int hd = unit / 3, mt = unit - hd * 3; const int m = m0 + 16 * mt + c; bool samp; int T, t; tok_info(m, samp, T, t);
            const bool hp = t > 0, hn = t + 1 < T;
            float sqk[2] = {0.f, 0.f};
#pragma unroll
            for (int pass = 0; pass < 2; ++pass) {
                float scl[2] = {1.f, 1.f};
                if (pass == 1) { sqk[0] += __shfl_xor(sqk[0], 16); sqk[0] += __shfl_xor(sqk[0], 32); sqk[1] += __shfl_xor(sqk[1], 16); sqk[1] += __shfl_xor(sqk[1], 32);
                    scl[0] = __builtin_amdgcn_rsqf(sqk[0] + 1e-6f); scl[1] = __builtin_amdgcn_rsqf(sqk[1] + 1e-6f); }
#pragma unroll
                for (int part = 0; part < 3; ++part) {
                    if (pass == 0 && part == 2) continue;
                    bf16* dst = GD + ((((size_t)(m >> 4) * 8 + hd) * 3 + part) * 8) * 256 + c * 16 + 4 * q;
                    const float sc = part < 2 ? scl[part] : 1.f; float acc = 0.f;
#pragma unroll 4
                    for (int g = 0; g < 8; ++g) { const int ch = part * 1024 + hd * 128 + 16 * g + 4 * q; const bf16* pp = P + (size_t)m * PW + PC_GDN + ch;
                        const v2u x1 = *(const v2u*)pp; v2u x0 = *(const v2u*)(pp - (hp ? PW : 0)), x2 = *(const v2u*)(pp + (hn ? PW : 0)); x0.x = hp ? x0.x : 0u; x0.y = hp ? x0.y : 0u; x2.x = hn ? x2.x : 0u; x2.y = hn ? x2.y : 0u;
                        const f32x4 c0 = *(const LAS f32x4*)(lcw + ch), c1 = *(const LAS f32x4*)(lcw + 3072 + ch), c2 = *(const LAS f32x4*)(lcw + 2 * 3072 + ch);
                        float val[4];
                        val[0] = siluf_(bflo(x0.x) * c0[0] + bflo(x1.x) * c1[0] + bflo(x2.x) * c2[0]); val[1] = siluf_(bfhi(x0.x) * c0[1] + bfhi(x1.x) * c1[1] + bfhi(x2.x) * c2[1]);
                        val[2] = siluf_(bflo(x0.y) * c0[2] + bflo(x1.y) * c1[2] + bflo(x2.y) * c2[2]); val[3] = siluf_(bfhi(x0.y) * c0[3] + bfhi(x1.y) * c1[3] + bfhi(x2.y) * c2[3]);
                        if (pass == 0) acc += (val[0] * val[0] + val[1] * val[1]) + (val[2] * val[2] + val[3] * val[3]);
                        else *(v2u*)(dst + 256 * g) = (v2u){cvtpk(val[0] * sc, val[1] * sc), cvtpk(val[2] * sc, val[3] * sc)}; }
                    if (pass == 0) sqk[part] = acc;
                }
            }
        }
        for (int idx = tid; idx < 48 * 16; idx += NTHR) { const int tt = idx >> 4, dh = idx & 15; const int m = m0 + tt;
            BETA[(size_t)m * 16 + dh] = sigmoidf_(bf2f(P[(size_t)m * PW + PC_BETA + dh]));
            GG[(size_t)m * 16 + dh] = -1.4426950409f * __expf(a.in[I_ALOG][i * 16 + dh]) * softplusf_(bf2f(P[(size_t)m * PW + PC_ALPHA + dh]) + a.in[I_DTB][i * 16 + dh]); }
        __syncthreads();
    }
}
__device__ __forceinline__ void ph_post(const Args& a, int i) {
    const int tid = opaque_tid(), lane = tid & 63, wave = __builtin_amdgcn_readfirstlane(tid >> 6);
    const int gw = blockIdx.x * NWAVES + wave, NGW = gridDim.x * NWAVES; const int c = lane & 15, q = lane >> 4;
    constexpr size_t S1 = (size_t)NTOK * 1024;
    const float* GT = (const float*)((const bf16*)(a.ws + WS_SC) + 12 * S1); const bf16* YS = (const bf16*)(a.ws + WS_Y); const bf16* OG = YS + 2 * S1;
    const bf16* P = (const bf16*)(a.ws + WS_P); bf16* O = (bf16*)(a.ws + WS_O);
    const float* gnw = a.in[I_GNW] + i * 128;
    for (int u = gw; u < (NTOK / 16) * 24; u += NGW) {
        const int tb = u / 24, hh = u - tb * 24; const int m = tb * 16 + c;
        if (hh < 16) { const size_t blk = (((size_t)tb * 16 + hh) * 4) * 256 + c * 16 + 4 * q;
#pragma unroll
            for (int g = 0; g < 4; ++g) { const v2u y0 = *(const v2u*)(YS + blk + 256 * g), y1 = *(const v2u*)(YS + S1 + blk + 256 * g); const f32x4 gt = *(const f32x4*)(GT + blk + 256 * g);
                v2u w; w.x = pk2((bflo(y0.x) + bflo(y1.x)) * gt.x, (bfhi(y0.x) + bfhi(y1.x)) * gt.y); w.y = pk2((bflo(y0.y) + bflo(y1.y)) * gt.z, (bfhi(y0.y) + bfhi(y1.y)) * gt.w);
                *(v2u*)(O + (size_t)m * D + hh * 64 + 16 * g + 4 * q) = w; } }
        else { const int h = hh - 16; const size_t blk = (((size_t)tb * 8 + h) * 8) * 256 + c * 16 + 4 * q;
            float ov[8][4]; float ss = 0.f;
#pragma unroll
            for (int g = 0; g < 8; ++g) { const v2u o0 = *(const v2u*)(OG + blk + 256 * g), o1 = *(const v2u*)(OG + S1 + blk + 256 * g);
                ov[g][0] = bflo(o0.x) + bflo(o1.x); ov[g][1] = bfhi(o0.x) + bfhi(o1.x); ov[g][2] = bflo(o0.y) + bflo(o1.y); ov[g][3] = bfhi(o0.y) + bfhi(o1.y);
                ss += (ov[g][0] * ov[g][0] + ov[g][1] * ov[g][1]) + (ov[g][2] * ov[g][2] + ov[g][3] * ov[g][3]); }
            ss += __shfl_xor(ss, 16); ss += __shfl_xor(ss, 32);
            const float rs = __builtin_amdgcn_rsqf(ss * (1.0f / 128.0f) + RMS_EPS);
#pragma unroll
            for (int g = 0; g < 8; ++g) { const int ch = 16 * g + 4 * q; const v2u zz = *(const v2u*)(P + (size_t)m * PW + PC_Z + h * 128 + ch); const f32x4 gwv = *(const f32x4*)(gnw + ch);
                v2u w; w.x = pk2(ov[g][0] * rs * gwv.x * siluf_(bflo(zz.x)), ov[g][1] * rs * gwv.y * siluf_(bfhi(zz.x))); w.y = pk2(ov[g][2] * rs * gwv.z * siluf_(bflo(zz.y)), ov[g][3] * rs * gwv.w * siluf_(bfhi(zz.y)));
                *(v2u*)(O + (size_t)m * D + 1024 + h * 128 + ch) = w; } }
    }
}

constexpr int PH_PER_LAYER = 9, N_PHASES = 2 + 4 * PH_PER_LAYER;
__host__ __device__ inline bool phase_exists(int ph) { if (ph == 0 || ph == N_PHASES - 1) return true; const int l = (ph - 1) / PH_PER_LAYER, k = (ph - 1) % PH_PER_LAYER; return (l & 1) ? !(k == 2 || k == 3 || k == 4) : true; }

#define RUN(ph) (a.ph_lo <= (ph) && (ph) < a.ph_hi)
#define SEAM(ph) do { if ((ph) + 1 < a.ph_hi) xcd_barrier(bar); } while (0)
#define SEAMX(ph) xcd_barrier(bar)
template <int L> __device__ __forceinline__ void run_layer(const Args& a, LAS unsigned char* lds, const XcdBarrier& bar) {
    constexpr int l = L, pb = 1 + PH_PER_LAYER * L, i = L >> 1;
    const int G = gridDim.x, bx = blockIdx.x;
    bf16* H = (bf16*)(a.ws + WS_H); bf16* O = (bf16*)(a.ws + WS_O); bf16* P = (bf16*)(a.ws + WS_P);
    const float* modl = (const float*)(a.ws + WS_MOD) + (size_t)l * 9 * 12288;
    if (RUN(pb + 0)) { ph_norm(a, l, 0); SEAM(pb + 0); }
#ifdef DUP_NORM
    if (RUN(pb + 0)) { ph_norm(a, l, 0); SEAMX(pb + 0); }
#endif
    if constexpr ((L & 1) == 0) {
        if (RUN(pb + 1)) { pg8::Gemm g{H, (const bf16*)(a.ws + WS_WIN) + (size_t)i * PW * 2048, NTOK, PW, 2048, 2048, 2048, 0, 0}; pg8::StaticOrder S; S.init(NTOK, PW, G, bx);
            pg8::EpiBf16 E{P, PW}; pg8::gemm_phase<pg8::EpiBf16, pg8::StaticOrder, true, true>(lds, g, S, E); SEAM(pb + 1); }
#ifdef DUP_GIN
        if (RUN(pb + 1)) { pg8::Gemm g{H, (const bf16*)(a.ws + WS_WIN) + (size_t)i * PW * 2048, NTOK, PW, 2048, 2048, 2048, 0, 0}; pg8::StaticOrder S; S.init(NTOK, PW, G, bx);
            pg8::EpiBf16 E{P, PW}; pg8::gemm_phase<pg8::EpiBf16, pg8::StaticOrder, true, true>(lds, g, S, E); SEAMX(pb + 1); }
#endif
        if (RUN(pb + 2)) { ph_prep(a, lds, i); SEAM(pb + 2); }
#ifdef DUP_PREP
        if (RUN(pb + 2)) { ph_prep(a, lds, i); SEAMX(pb + 2); }
#endif
        if (RUN(pb + 3)) { ph_scan(a, lds, i, l == 0); SEAM(pb + 3); }
#ifdef DUP_SCAN
        if (RUN(pb + 3)) { ph_scan(a, lds, i, l == 0); SEAMX(pb + 3); }
#endif
        if (RUN(pb + 4)) { ph_post(a, i); SEAM(pb + 4); }
#ifdef DUP_POST
        if (RUN(pb + 4)) { ph_post(a, i); SEAMX(pb + 4); }
#endif
        if (RUN(pb + 5)) { pg8::Gemm g{O, (const bf16*)(a.ws + WS_WOUT) + (size_t)i * 2048 * 2048, NTOK, 2048, 2048, 2048, 2048, 0, 0}; pg8::StaticOrder S; S.init(NTOK, 2048, G, bx);
            pg8::EpiResid E{l == 0 ? a.in[I_XP] : nullptr, a.in[I_XS], a.out, modl + 2 * 2048, nullptr};
            pg8::gemm_phase<pg8::EpiResid, pg8::StaticOrder, true, true>(lds, g, S, E); SEAM(pb + 5); }
    } else {
        if (RUN(pb + 1)) { ph_pool(a); SEAM(pb + 1); }
#ifdef DUP_POOL
        if (RUN(pb + 1)) { ph_pool(a); SEAMX(pb + 1); }
#endif
        if (RUN(pb + 5)) { pg8::Gemm g{O, (const bf16*)(a.ws + WS_WPOOL) + (size_t)i * 2048 * 512, NTOK, 2048, 512, 2048, 512, 1, 512}; pg8::StaticOrder S; S.init(NTOK, 2048, G, bx);
            pg8::EpiResid E{nullptr, nullptr, a.out, modl + 2 * 2048, a.in[I_POOLS] + i * 2048};
            pg8::gemm_phase<pg8::EpiResid, pg8::StaticOrder, true, true>(lds, g, S, E); SEAM(pb + 5); }
    }
    if (RUN(pb + 6)) { ph_norm(a, l, 1); SEAM(pb + 6); }
    if (RUN(pb + 7)) { pg8::Gemm g{H, (const bf16*)(a.ws + WS_WGU) + (size_t)l * 11264 * 2048, NTOK, 11264, 2048, 2048, 2048, 0, 0}; pg8::StaticOrder S; S.init(NTOK, 11264, G, bx);
        pg8::EpiSwiGLU E{P, DFF}; pg8::gemm_phase<pg8::EpiSwiGLU, pg8::StaticOrder, true, true>(lds, g, S, E); SEAM(pb + 7); }
#ifdef DUP_GGU
    if (RUN(pb + 7)) { pg8::Gemm g{H, (const bf16*)(a.ws + WS_WGU) + (size_t)l * 11264 * 2048, NTOK, 11264, 2048, 2048, 2048, 0, 0}; pg8::StaticOrder S; S.init(NTOK, 11264, G, bx);
        pg8::EpiSwiGLU E{P, DFF}; pg8::gemm_phase<pg8::EpiSwiGLU, pg8::StaticOrder, true, true>(lds, g, S, E); SEAMX(pb + 7); }
#endif
    if (RUN(pb + 8)) { pg8::Gemm g{P, (const bf16*)(a.ws + WS_WDN) + (size_t)l * 2048 * DFF, NTOK, 2048, DFF, DFF, DFF, 0, 0}; pg8::StaticOrder S; S.init(NTOK, 2048, G, bx);
        pg8::EpiResid E{nullptr, nullptr, a.out, modl + 5 * 2048, nullptr};
        pg8::gemm_phase<pg8::EpiResid, pg8::StaticOrder, true, true>(lds, g, S, E); SEAM(pb + 8); }
}

__global__ void __launch_bounds__(NTHR, 2) fwd(Args a) {
    extern __shared__ __attribute__((aligned(16))) unsigned char lds_raw[];
    LAS unsigned char* lds = (LAS unsigned char*)lds_raw;
    const int tid = threadIdx.x;
    volatile LAS unsigned* MISC = (volatile LAS unsigned*)(lds + LDS_MISC);
    for (int u = tid; u < (LDS_BYTES - LDS_STAGE) / 4; u += NTHR) ((LAS unsigned*)(lds + LDS_STAGE))[u] = 0u;
    __syncthreads();
    XcdBarrier bar; bar.bar = (unsigned*)(a.ws + WS_CTL) + CW_BAR; bar.x = 0; bar.st = nullptr;
    const bool multi = a.ph_hi - a.ph_lo > 1;
    if (multi) bar = xcd_barrier_post((unsigned*)(a.ws + WS_CTL) + CW_BAR, MISC + 8);
    if (RUN(0)) { ph_pre(a, lds); SEAM(0); }
#ifdef DUP_PRE
    if (RUN(0)) { ph_pre(a, lds); SEAMX(0); }
#endif
    run_layer<0>(a, lds, bar);
    run_layer<1>(a, lds, bar);
    run_layer<2>(a, lds, bar);
    run_layer<3>(a, lds, bar);
    if (RUN(N_PHASES - 1)) ph_final(a);
}
#undef RUN
#undef SEAM
#undef SEAMX

#ifndef MK_ONE_LAUNCH
#define MK_ONE_LAUNCH 1
#endif
extern "C" void kernel_launch(void* const* d_in, const int* in_sizes, int n_in, void* d_out, int out_size, void* d_ws, size_t ws_size, hipStream_t stream) {
    static int grid = 0;
    if (grid == 0) {
        if (n_in != N_IN || ws_size < WS_END) { fprintf(stderr, "kernel_launch: expected %d inputs and >= %zu bytes of workspace; got %d, %zu\n", (int)N_IN, (size_t)WS_END, n_in, ws_size); grid = -1; return; }
        int dev = 0, cus = 0, per_cu = 0;
        if (hipGetDevice(&dev) != hipSuccess || hipDeviceGetAttribute(&cus, hipDeviceAttributeMultiprocessorCount, dev) != hipSuccess) { grid = -1; return; }
        if (hipFuncSetAttribute((const void*)fwd, hipFuncAttributeMaxDynamicSharedMemorySize, LDS_BYTES) != hipSuccess) { fprintf(stderr, "kernel_launch: hipFuncSetAttribute failed\n"); grid = -1; return; }
        if (hipOccupancyMaxActiveBlocksPerMultiprocessor(&per_cu, (const void*)fwd, NTHR, LDS_BYTES) != hipSuccess || per_cu < 1) fprintf(stderr, "kernel_launch: occupancy query reports %d\n", per_cu);
        (void)hipGetLastError();
        grid = cus;
    }
    if (grid < 0) return;
    if (hipMemsetAsync((char*)d_ws + WS_CTL, 0, CTL_ZERO_BYTES, stream) != hipSuccess) return;
    Args a{};
    for (int i = 0; i < N_IN; ++i) a.in[i] = (const float*)d_in[i];
    a.out = (float*)d_out; a.ws = (unsigned char*)d_ws;
#if MK_ONE_LAUNCH
    a.ph_lo = 0; a.ph_hi = N_PHASES;
    hipLaunchKernelGGL(fwd, dim3(grid), dim3(NTHR), LDS_BYTES, stream, a);
#else
    for (int ph = 0; ph < N_PHASES; ++ph) { if (!phase_exists(ph)) continue; a.ph_lo = ph; a.ph_hi = ph + 1; hipLaunchKernelGGL(fwd, dim3(grid), dim3(NTHR), LDS_BYTES, stream, a); }
#endif
}
```
